# Optimizing an MI355X kernel written in HIP

```python
import math
import jax, jax.numpy as jnp
from jax import lax
import numpy as np

D_MODEL = 1024
BATCH = 4
SEQ = 4096
DEPTH = 2

N_A = DEPTH // 2
N_B = DEPTH - N_A

GLA_HEADS = 4
GLA_DK = (D_MODEL // 2) // GLA_HEADS
GLA_DV = D_MODEL // GLA_HEADS
GLA_GATE_RANK = 16
GLA_TAU = 16.0
GLA_CHUNK = 64
GLA_COLS = (GLA_HEADS * GLA_DK, GLA_HEADS * GLA_DK, GLA_HEADS * GLA_DV, GLA_HEADS * GLA_DV, GLA_GATE_RANK)
GLA_SPLITS = list(np.cumsum(GLA_COLS)[:-1].tolist())
GLA_IN = int(sum(GLA_COLS))

DIFF_HEADS = 8
DIFF_DH = 64
DIFF_VD = 2 * DIFF_DH
Q_BLOCK = 128

MLP_HIDDEN = 4 * D_MODEL
NORM_EPS = 1e-6

kernel_name = "yoco_gla_diffattn_hybrid"


def rms_norm(x, g):
    xf = x.astype(jnp.float32)
    y = xf * lax.rsqrt(jnp.mean(xf * xf, axis=-1, keepdims=True) + NORM_EPS)
    return (y * g.astype(jnp.float32)).astype(x.dtype)


def sqrelu_mlp(xn, w1, w2):
    return jnp.square(jax.nn.relu(xn @ w1)) @ w2


def gla_chunked(q, k, v, log_a):
    B, S, H, DK = q.shape
    DV = v.shape[-1]
    C = GLA_CHUNK
    n = S // C

    def chunks(t):
        return t.astype(jnp.float32).reshape(B, n, C, H, t.shape[-1]).transpose(1, 0, 3, 2, 4)

    qc = chunks(q) * (DK ** -0.5)
    kc = chunks(k)
    vc = chunks(v)
    bc = jnp.cumsum(chunks(log_a), axis=-2)
    causal = jnp.tril(jnp.ones((C, C), bool))

    def step(state, inp):
        qi, ki, vi, bi = inp
        diff = bi[:, :, :, None, :] - bi[:, :, None, :, :]
        decay = jnp.exp(jnp.where(causal[:, :, None], diff, -jnp.inf))
        attn = jnp.einsum('bhid,bhjd,bhijd->bhij', qi, ki, decay)
        o = (jnp.einsum('bhij,bhjv->bhiv', attn, vi)
             + jnp.einsum('bhid,bhdv->bhiv', qi * jnp.exp(bi), state))
        b_last = bi[:, :, -1:, :]
        state = (jnp.exp(b_last[:, :, 0, :, None]) * state
                 + jnp.einsum('bhjd,bhjv->bhdv', ki * jnp.exp(b_last - bi), vi))
        return state, o

    _, o = lax.scan(step, jnp.zeros((B, H, DK, DV), jnp.float32), (qc, kc, vc, bc))
    return o.transpose(1, 0, 3, 2, 4).reshape(B, S, H, DV)


def gla_mixer(xn, w_in, w_gate_up, b_gate, head_gain, w_out):
    B, S, _ = xn.shape
    proj = xn @ w_in
    q, k, v, g, z = jnp.split(proj, GLA_SPLITS, axis=-1)
    log_a = jax.nn.log_sigmoid((z @ w_gate_up + b_gate).astype(jnp.float32)) / GLA_TAU
    hk = lambda t: t.reshape(B, S, GLA_HEADS, GLA_DK)
    o = gla_chunked(hk(q), hk(k), v.reshape(B, S, GLA_HEADS, GLA_DV), hk(log_a)).astype(xn.dtype)
    o = rms_norm(o, head_gain) * jax.nn.silu(g.reshape(B, S, GLA_HEADS, GLA_DV))
    return o.reshape(B, S, GLA_HEADS * GLA_DV) @ w_out


def shared_kv(h, kv_norm, w_kv, k_norm):
    B, S, _ = h.shape
    kv = rms_norm(h, kv_norm) @ w_kv
    k, v = jnp.split(kv, [DIFF_HEADS * 2 * DIFF_DH], axis=-1)
    k = rms_norm(k.reshape(B, S, DIFF_HEADS, 2, DIFF_DH), k_norm).transpose(0, 2, 3, 1, 4)
    v = v.reshape(B, S, DIFF_HEADS, DIFF_VD).transpose(0, 2, 1, 3)
    return k, v


def diff_mixer(xn, k, v, w_q, q_gain, lam_params, head_gain, w_out, lambda_init):
    B, S, _ = xn.shape
    q = rms_norm((xn @ w_q).reshape(B, S, DIFF_HEADS, 2, DIFF_DH), q_gain) * (DIFF_DH ** -0.5)
    lp = lam_params.astype(jnp.float32)
    lam = jnp.exp(jnp.sum(lp[0] * lp[1])) - jnp.exp(jnp.sum(lp[2] * lp[3])) + lambda_init
    nq = S // Q_BLOCK
    qb = q.transpose(0, 2, 3, 1, 4).reshape(B, DIFF_HEADS, 2, nq, Q_BLOCK, DIFF_DH).transpose(3, 0, 1, 2, 4, 5)
    kpos = jnp.arange(S)

    def attend(args):
        q_blk, bi = args
        s = jnp.einsum('bhcqd,bhckd->bhcqk', q_blk, k).astype(jnp.float32)
        qpos = bi * Q_BLOCK + jnp.arange(Q_BLOCK)
        s = jnp.where(kpos[None, :] <= qpos[:, None], s, -jnp.inf)
        p = jax.nn.softmax(s, axis=-1)
        a = p[:, :, 0] - lam * p[:, :, 1]
        return jnp.einsum('bhqk,bhkv->bhqv', a.astype(v.dtype), v)

    o = lax.map(attend, (qb, jnp.arange(nq)))
    o = o.transpose(1, 0, 3, 2, 4).reshape(B, S, DIFF_HEADS, DIFF_VD)
    o = rms_norm(o, head_gain) * (1.0 - lambda_init)
    return o.reshape(B, S, DIFF_HEADS * DIFF_VD) @ w_out


def setup_inputs(seed: int = 0) -> dict:
    key = jax.random.key(seed)
    ks = jax.random.split(key, 24)
    f32 = jnp.float32
    nrm = lambda k, shape, fan_in: jax.random.normal(k, shape, f32) * (fan_in ** -0.5)
    gain = lambda k, shape: 1.0 + 0.02 * jax.random.normal(k, shape, f32)
    D = D_MODEL
    return {
        "x": jax.random.normal(ks[0], (BATCH, SEQ, D), f32),
        "a_norm": gain(ks[1], (N_A, D)),
        "a_w_in": nrm(ks[2], (N_A, D, GLA_IN), D),
        "a_w_gate_up": nrm(ks[3], (N_A, GLA_GATE_RANK, GLA_HEADS * GLA_DK), GLA_GATE_RANK),
        "a_b_gate": 0.1 * jax.random.normal(ks[4], (N_A, GLA_HEADS * GLA_DK), f32),
        "a_head_norm": gain(ks[5], (N_A, GLA_DV)),
        "a_w_out": nrm(ks[6], (N_A, GLA_HEADS * GLA_DV, D), GLA_HEADS * GLA_DV),
        "kv_norm": gain(ks[7], (D,)),
        "w_kv": nrm(ks[8], (D, DIFF_HEADS * (2 * DIFF_DH + DIFF_VD)), D),
        "k_norm": gain(ks[9], (DIFF_DH,)),
        "b_norm": gain(ks[10], (N_B, D)),
        "b_w_q": nrm(ks[11], (N_B, D, DIFF_HEADS * 2 * DIFF_DH), D),
        "b_q_norm": gain(ks[12], (N_B, DIFF_DH)),
        "b_lambda": 0.1 * jax.random.normal(ks[13], (N_B, 4, DIFF_DH), f32),
        "b_head_norm": gain(ks[14], (N_B, DIFF_VD)),
        "b_w_out": nrm(ks[15], (N_B, DIFF_HEADS * DIFF_VD, D), DIFF_HEADS * DIFF_VD),
        "mlp_norm": gain(ks[16], (DEPTH, D)),
        "mlp_w1": nrm(ks[17], (DEPTH, D, MLP_HIDDEN), D),
        "mlp_w2": nrm(ks[18], (DEPTH, MLP_HIDDEN, D), MLP_HIDDEN),
    }


def reference(x, a_norm, a_w_in, a_w_gate_up, a_b_gate, a_head_norm, a_w_out,
              kv_norm, w_kv, k_norm, b_norm, b_w_q, b_q_norm, b_lambda, b_head_norm, b_w_out,
              mlp_norm, mlp_w1, mlp_w2):
    h = x
    k_sh, v_sh = None, None
    for layer in range(DEPTH):
        if layer < N_A:
            i = layer
            h = h + gla_mixer(rms_norm(h, a_norm[i]), a_w_in[i], a_w_gate_up[i], a_b_gate[i],
                              a_head_norm[i], a_w_out[i])
        else:
            if layer == N_A:
                k_sh, v_sh = shared_kv(h, kv_norm, w_kv, k_norm)
            j = layer - N_A
            lambda_init = 0.8 - 0.6 * math.exp(-0.3 * layer)
            h = h + diff_mixer(rms_norm(h, b_norm[j]), k_sh, v_sh, b_w_q[j], b_q_norm[j],
                               b_lambda[j], b_head_norm[j], b_w_out[j], lambda_init)
        h = h + sqrelu_mlp(rms_norm(h, mlp_norm[layer]), mlp_w1[layer], mlp_w2[layer])
    return h
```

```cpp
#include <hip/hip_runtime.h>
#include <cstdio>
#include <cstdint>

typedef unsigned short bf16;
typedef short bf16x8 __attribute__((ext_vector_type(8)));
typedef float f32x4 __attribute__((ext_vector_type(4)));

constexpr int NB = 4, SEQ = 4096, T = NB * SEQ, D = 1024, FF = 4096;
constexpr int GH = 4, GDK = 128, GDV = 256, GR = 16, CH = 64, NCH = SEQ / CH;
constexpr int GIN = 3088;
constexpr int DH = 8, DDH = 64, DVD = 128;
constexpr float EPS = 1e-6f;
constexpr float LOG2E = 1.4426950408889634f;
constexpr float LAMBDA_INIT = 0.35550906759f;

constexpr size_t MiB = 1u << 20;
constexpr size_t WS_CTL = 0;
constexpr size_t WS_SS = 1 * MiB;
constexpr size_t WS_ZB = 2 * MiB;
constexpr size_t WS_WZ = 3 * MiB;
constexpr size_t WS_WIN = 4 * MiB;
constexpr size_t WS_WAO = 10 * MiB;
constexpr size_t WS_W1A = 12 * MiB;
constexpr size_t WS_W2A = 20 * MiB;
constexpr size_t WS_WKVQ = 28 * MiB;
constexpr size_t WS_WBO = 34 * MiB;
constexpr size_t WS_W1B = 36 * MiB;
constexpr size_t WS_W2B = 44 * MiB;
constexpr size_t WS_B = 52 * MiB;
constexpr size_t WS_A = 180 * MiB;
constexpr size_t WS_C = 212 * MiB;
constexpr size_t WS_END = 244 * MiB;
constexpr size_t WS_QG = WS_B, WS_KG = WS_B + 16 * MiB, WS_VG = WS_B + 32 * MiB, WS_GG = WS_B + 64 * MiB, WS_BC = WS_B + 96 * MiB;
constexpr size_t WS_HM = WS_B;
constexpr size_t WS_KN = WS_B, WS_V2 = WS_B + 32 * MiB, WS_QN = WS_B + 64 * MiB;

__host__ __device__ __forceinline__ unsigned f2bf(float f) { unsigned u = __builtin_bit_cast(unsigned, f); return (u + 0x7fffu + ((u >> 16) & 1u)) >> 16; }
__host__ __device__ __forceinline__ float bf2f(unsigned h) { return __builtin_bit_cast(float, h << 16); }

__host__ __device__ __forceinline__ int kvq_dest_row(int n) {
    if (n >= 1024 && n < 2048) return n;
    const int tile = n >> 8, w = n & 255, lb = w >> 5, j = w & 31, wc = lb >> 1, bj = lb & 1;
    return (tile << 8) + 128 * bj + 32 * wc + j;
}

namespace pg8 {
#define PG8_LAS __attribute__((address_space(3)))
typedef unsigned short bf16_t;
typedef short bf16x8 __attribute__((ext_vector_type(8)));
typedef float f32x4 __attribute__((ext_vector_type(4)));
typedef unsigned u32x4 __attribute__((ext_vector_type(4)));
constexpr int BM = 256, BK = 64, HALF = 128, HTB = HALF * BK * 2  , STAGE_BYTES = 8 * HTB, NXCD = 8, WGM = 8;

__host__ __device__ __forceinline__ int lds_byte(int r, int c) { const int st = (r >> 4) * 2 + (c >> 5), rr = r & 15, cc = c & 31, ob = rr * 64 + cc * 2; return st * 1024 + (ob ^ (((ob >> 9) & 1) << 5)); }
__host__ __device__ __forceinline__ void stage_rc(int b, int& R, int& C) { const int st = b / 1024, sb = b % 1024, swz = sb ^ (((sb >> 9) & 1) << 5); R = (st >> 1) * 16 + swz / 64; C = (st & 1) * 32 + (swz % 64) / 2; }
__host__ __device__ __forceinline__ int perm32(int rho) { const int n = rho >> 4, i = rho & 15; return 8 * (i >> 2) + 4 * n + (i & 3); }

struct Unit { int pm, pn; };
struct Gemm { const bf16_t* A; const bf16_t* Bt; int M, N, K; };

struct StaticOrder {
    int nM, nN, nwg, G, c;
    __host__ __device__ void init(int M, int N, int G_, int c_) { nM = M / BM; nN = N / BM; nwg = nM * nN; G = G_; c = c_; }
    __host__ __device__ bool next(int i, Unit& u) const {
        const long L = (long)i * G + c; if (L >= nwg) return false;
        int wgid = (int)L; { const int q = nwg / NXCD, r = nwg % NXCD, xcd = wgid % NXCD, off = wgid / NXCD; wgid = (xcd < r ? xcd * (q + 1) : r * (q + 1) + (xcd - r) * q) + off; }
        const int nig = WGM * nN, gid = wgid / nig, fm = gid * WGM, gsz = (nM - fm) < WGM ? (nM - fm) : WGM;
        u.pm = fm + ((wgid % nig) % gsz); u.pn = (wgid % nig) / gsz; return true;
    }
    __device__ __forceinline__ void a_ready(const Unit&) const {}
    __device__ __forceinline__ void done(const Unit&) const {}
};

__device__ __forceinline__ unsigned cvt_pk_bf16(float lo, float hi) { unsigned r; asm volatile("v_cvt_pk_bf16_f32 %0, %1, %2" : "=v"(r) : "v"(lo), "v"(hi)); return r; }
typedef float f32x2 __attribute__((ext_vector_type(2)));
typedef unsigned u32x2 __attribute__((ext_vector_type(2)));
__device__ __forceinline__ void store16_wt(void* p, u32x4 v) { asm volatile("global_store_dwordx4 %0, %1, off sc1\n\ts_nop 1" :: "v"(p), "v"(v) : "memory"); }
constexpr int TOK = 16384;
constexpr float RMS_EPS = 1e-6f;
__device__ __forceinline__ float silu_f(float g) { return g * __builtin_amdgcn_rcpf(1.0f + __builtin_amdgcn_exp2f(-1.4426950408889634f * g)); }
__device__ __forceinline__ float row_rstd(const float* ss, int row) {
    const f32x4 a = *(const f32x4*)(ss + (size_t)row * 16), b = *(const f32x4*)(ss + (size_t)row * 16 + 4), c = *(const f32x4*)(ss + (size_t)row * 16 + 8), d = *(const f32x4*)(ss + (size_t)row * 16 + 12);
    const float q = ((a[0] + a[1]) + (a[2] + a[3])) + ((b[0] + b[1]) + (b[2] + b[3])) + ((c[0] + c[1]) + (c[2] + c[3])) + ((d[0] + d[1]) + (d[2] + d[3]));
    return __builtin_amdgcn_rsqf(q * (1.0f / 1024.0f) + RMS_EPS);
}
struct EpiInProj {
    static constexpr bool PERM = true, AFTER_DRAIN = false;
    bf16_t *q, *k, *v, *g; const PG8_LAS float* rt; mutable int ui;
    __device__ __forceinline__ void operator()(const f32x4 (&acc)[2][2][4][2], const Unit& u, int wr, int wc, int fr, int fq) const {
        const int row0 = u.pm * BM + wr * 64 + fr; const int pn = u.pn; const PG8_LAS float* rtu = rt + ui * 256 + wr * 64 + fr; ++ui;
        bf16_t* base; int ldc, colt; const bool act = pn >= 8;
        if (pn < 2) { base = q; ldc = 512; colt = pn * BM; } else if (pn < 4) { base = k; ldc = 512; colt = (pn - 2) * BM; }
        else if (pn < 8) { base = v; ldc = 1024; colt = (pn - 4) * BM; } else { base = g; ldc = 1024; colt = (pn - 8) * BM; }
        const int col0 = colt + wc * 32 + 8 * fq;
#pragma unroll
        for (int ai = 0; ai < 2; ++ai)
#pragma unroll
            for (int m = 0; m < 4; ++m) { bf16_t* rowp = base + (size_t)(row0 + ai * HALF + m * 16) * ldc + col0; const float rs = rtu[ai * HALF + m * 16];
#pragma unroll
                for (int bj = 0; bj < 2; ++bj) { f32x4 v0 = acc[ai][bj][m][0] * rs, v1 = acc[ai][bj][m][1] * rs;
                    if (act) { v0 = (f32x4){silu_f(v0[0]), silu_f(v0[1]), silu_f(v0[2]), silu_f(v0[3])}; v1 = (f32x4){silu_f(v1[0]), silu_f(v1[1]), silu_f(v1[2]), silu_f(v1[3])}; }
                    u32x4 w; w.x = cvt_pk_bf16(v0[0], v0[1]); w.y = cvt_pk_bf16(v0[2], v0[3]); w.z = cvt_pk_bf16(v1[0], v1[1]); w.w = cvt_pk_bf16(v1[2], v1[3]);
                    store16_wt(rowp + bj * HALF, w); } }
    }
};
template <int MODE> struct EpiResB {
    static constexpr bool PERM = true, AFTER_DRAIN = false;
    const float* basef; const bf16_t* baseb; bf16_t* hb; float* outf; float* ss;
    __device__ __forceinline__ void operator()(const f32x4 (&acc)[2][2][4][2], const Unit& u, int wr, int wc, int fr, int fq) const {
        const int col0 = u.pn * BM + wc * 32 + 8 * fq;
#pragma unroll
        for (int ai = 0; ai < 2; ++ai)
#pragma unroll
            for (int m = 0; m < 4; ++m) { const int row = u.pm * BM + ai * HALF + wr * 64 + m * 16 + fr; const size_t off = (size_t)row * 1024 + col0; float s = 0.f;
#pragma unroll
                for (int bj = 0; bj < 2; ++bj) { f32x4 h0, h1;
                    if (MODE == 0) { h0 = *(const f32x4*)(basef + off + bj * HALF); h1 = *(const f32x4*)(basef + off + bj * HALF + 4); }
                    else { const u32x4 b = *(const u32x4*)(baseb + off + bj * HALF);
                        h0 = (f32x4){__builtin_bit_cast(float, b.x << 16), __builtin_bit_cast(float, b.x & 0xffff0000u), __builtin_bit_cast(float, b.y << 16), __builtin_bit_cast(float, b.y & 0xffff0000u)};
                        h1 = (f32x4){__builtin_bit_cast(float, b.z << 16), __builtin_bit_cast(float, b.z & 0xffff0000u), __builtin_bit_cast(float, b.w << 16), __builtin_bit_cast(float, b.w & 0xffff0000u)}; }
                    h0 = h0 + acc[ai][bj][m][0]; h1 = h1 + acc[ai][bj][m][1];
                    if (MODE == 2) { __builtin_nontemporal_store(h0, (f32x4*)(outf + off + bj * HALF)); __builtin_nontemporal_store(h1, (f32x4*)(outf + off + bj * HALF + 4)); }
                    else { u32x4 w; w.x = cvt_pk_bf16(h0[0], h0[1]); w.y = cvt_pk_bf16(h0[2], h0[3]); w.z = cvt_pk_bf16(h1[0], h1[1]); w.w = cvt_pk_bf16(h1[2], h1[3]);
                        *(u32x4*)(hb + off + bj * HALF) = w;
                        s += ((h0[0] * h0[0] + h0[1] * h0[1]) + (h0[2] * h0[2] + h0[3] * h0[3])) + ((h1[0] * h1[0] + h1[1] * h1[1]) + (h1[2] * h1[2] + h1[3] * h1[3])); } }
                if (MODE != 2) { s += __shfl_xor(s, 16); s += __shfl_xor(s, 32); if (fq == 0) ss[(size_t)row * 16 + u.pn * 4 + wc] = s; }
                if (m & 1) asm volatile("" ::: "memory"); }
    }
};
struct EpiUp {
    static constexpr bool PERM = true, AFTER_DRAIN = false;
    bf16_t* O; const PG8_LAS float* rt; mutable int ui;
    __device__ __forceinline__ void operator()(const f32x4 (&acc)[2][2][4][2], const Unit& u, int wr, int wc, int fr, int fq) const {
        const int col0 = u.pn * BM + wc * 32 + 8 * fq; const PG8_LAS float* rtu = rt + ui * 256 + wr * 64 + fr; ++ui;
#pragma unroll
        for (int ai = 0; ai < 2; ++ai)
#pragma unroll
            for (int m = 0; m < 4; ++m) { const int row = u.pm * BM + ai * HALF + wr * 64 + m * 16 + fr; const float rs = rtu[ai * HALF + m * 16]; bf16_t* rowp = O + (size_t)row * 4096 + col0;
#pragma unroll
                for (int bj = 0; bj < 2; ++bj) { f32x4 v0 = acc[ai][bj][m][0] * rs, v1 = acc[ai][bj][m][1] * rs;
#pragma unroll
                    for (int e = 0; e < 4; ++e) { const float a = __builtin_fmaxf(v0[e], 0.f), b = __builtin_fmaxf(v1[e], 0.f); v0[e] = a * a; v1[e] = b * b; }
                    u32x4 w; w.x = cvt_pk_bf16(v0[0], v0[1]); w.y = cvt_pk_bf16(v0[2], v0[3]); w.z = cvt_pk_bf16(v1[0], v1[1]); w.w = cvt_pk_bf16(v1[2], v1[3]);
                    store16_wt(rowp + bj * HALF, w); } }
    }
};
struct EpiKVQ {
    static constexpr bool PERM = true, AFTER_DRAIN = false;
    bf16_t *kn, *v2, *qn; const PG8_LAS float* rt; const PG8_LAS float *gk, *gq; mutable int ui;
    __device__ __forceinline__ void operator()(const f32x4 (&acc)[2][2][4][2], const Unit& u, int wr, int wc, int fr, int fq) const {
        const int pn = u.pn; const PG8_LAS float* rtu = rt + ui * 256 + wr * 64 + fr; ++ui;
        if (pn >= 4 && pn < 8) {
            const int col0 = (pn - 4) * BM + wc * 32 + 8 * fq;
#pragma unroll
            for (int ai = 0; ai < 2; ++ai)
#pragma unroll
                for (int m = 0; m < 4; ++m) { const int row = u.pm * BM + ai * HALF + wr * 64 + m * 16 + fr; const float rs = rtu[ai * HALF + m * 16]; bf16_t* rowp = v2 + (size_t)row * 1024 + col0;
#pragma unroll
                    for (int bj = 0; bj < 2; ++bj) { const f32x4 v0 = acc[ai][bj][m][0] * rs, v1 = acc[ai][bj][m][1] * rs;
                        u32x4 w; w.x = cvt_pk_bf16(v0[0], v0[1]); w.y = cvt_pk_bf16(v0[2], v0[3]); w.z = cvt_pk_bf16(v1[0], v1[1]); w.w = cvt_pk_bf16(v1[2], v1[3]);
                        store16_wt(rowp + bj * HALF, w); } }
        } else {
            const bool isq = pn >= 8; const PG8_LAS float* gp = isq ? gq : gk; bf16_t* dst = isq ? qn : kn; const int pl = isq ? pn - 8 : pn;
            const float sc = isq ? 0.125f * 1.4426950408889634f : 1.0f;
            f32x4 gv[2][2];
#pragma unroll
            for (int bj = 0; bj < 2; ++bj)
#pragma unroll
                for (int n = 0; n < 2; ++n) gv[bj][n] = *(const PG8_LAS f32x4*)(gp + 32 * bj + 8 * fq + 4 * n) * sc;
            const int col0 = pl * BM + wc * 64 + 8 * fq;
#pragma unroll
            for (int ai = 0; ai < 2; ++ai)
#pragma unroll
                for (int m = 0; m < 4; ++m) { const int row = u.pm * BM + ai * HALF + wr * 64 + m * 16 + fr; const float rs = rtu[ai * HALF + m * 16]; bf16_t* rowp = dst + (size_t)row * 1024 + col0;
                    f32x4 x[2][2]; float s = 0.f;
#pragma unroll
                    for (int bj = 0; bj < 2; ++bj)
#pragma unroll
                        for (int n = 0; n < 2; ++n) { x[bj][n] = acc[ai][bj][m][n] * rs; s += (x[bj][n][0] * x[bj][n][0] + x[bj][n][1] * x[bj][n][1]) + (x[bj][n][2] * x[bj][n][2] + x[bj][n][3] * x[bj][n][3]); }
                    s += __shfl_xor(s, 16); s += __shfl_xor(s, 32);
                    const float r2 = __builtin_amdgcn_rsqf(s * (1.0f / 64.0f) + RMS_EPS);
#pragma unroll
                    for (int bj = 0; bj < 2; ++bj) { const f32x4 v0 = x[bj][0] * r2 * gv[bj][0], v1 = x[bj][1] * r2 * gv[bj][1];
                        u32x4 w; w.x = cvt_pk_bf16(v0[0], v0[1]); w.y = cvt_pk_bf16(v0[2], v0[3]); w.z = cvt_pk_bf16(v1[0], v1[1]); w.w = cvt_pk_bf16(v1[2], v1[3]);
                        store16_wt(rowp + 32 * bj, w); } }
        }
    }
};

template <class Epi, class Sched, bool ALIGN_EPI = false, bool SP2 = false>
__device__ __forceinline__ void gemm_phase(PG8_LAS unsigned char* lds, const Gemm g, const Sched& S, const Epi& E) {
    const int tid = threadIdx.x, wid = __builtin_amdgcn_readfirstlane(tid >> 6), lane = tid & 63, wr = wid >> 2, wc = wid & 3, fr = lane & 15, fq = lane >> 4;
    const int K = g.K, nt = K / BK;
    unsigned voffA[2], voffB[2];
#pragma unroll
    for (int i = 0; i < 2; ++i) { int R, C; stage_rc(tid * 16 + i * 8192, R, C); const int Rb = Epi::PERM ? ((R & ~31) + perm32(R & 31)) : R;
        voffA[i] = (unsigned)(R * K + C) * 2u; voffB[i] = (unsigned)(Rb * K + C) * 2u; }
    const size_t kstep = (size_t)(BK * 2);
    const size_t hstep = (size_t)HALF * K * 2;
    const size_t tstep = 2 * hstep;
    const unsigned ldsw = (unsigned)wid * 1024u;
    const int aoff = lds_byte(wr * 64 + fr, fq * 8), boff = lds_byte(wc * 32 + fr, fq * 8);
#define PG8_SA(b, h) (((b) * 2 + (h)) * HTB)
#define PG8_SB(b, h) ((4 + (b) * 2 + (h)) * HTB)
#define PG8_STAGE(bufoff, gbase, voff) do { _Pragma("unroll") for (int _i = 0; _i < 2; ++_i) \
        __builtin_amdgcn_global_load_lds((const unsigned*)((const char*)(gbase) + (voff)[_i]), (PG8_LAS unsigned*)(lds + (bufoff) + ldsw + _i * 8192), 16, 0, 0); } while (0)
#define PG8_LDA(dst, b, h) do { _Pragma("unroll") for (int m = 0; m < 4; ++m) _Pragma("unroll") for (int k = 0; k < 2; ++k) dst[m][k] = *(const PG8_LAS bf16x8*)(lds + PG8_SA(b, h) + aoff + m * 2048 + k * 1024); } while (0)
#define PG8_LDB(dst, b, h) do { _Pragma("unroll") for (int n = 0; n < 2; ++n) _Pragma("unroll") for (int k = 0; k < 2; ++k) dst[n][k] = *(const PG8_LAS bf16x8*)(lds + PG8_SB(b, h) + boff + n * 2048 + k * 1024); } while (0)
#define PG8_MMA(ai, bj, At, Bt) do { __builtin_amdgcn_s_setprio(1); _Pragma("unroll") for (int m = 0; m < 4; ++m) _Pragma("unroll") for (int n = 0; n < 2; ++n) _Pragma("unroll") for (int k = 0; k < 2; ++k) \
        acc[ai][bj][m][n] = __builtin_amdgcn_mfma_f32_16x16x32_bf16(Bt[n][k], At[m][k], acc[ai][bj][m][n], 0, 0, 0); __builtin_amdgcn_s_setprio(0); } while (0)
#define PG8_WAIT_V(n) asm volatile("s_waitcnt vmcnt(" #n ")" ::: "memory")
#define PG8_WAIT_L(n) asm volatile("s_waitcnt lgkmcnt(" #n ")" ::: "memory")
#define PG8_BAR __builtin_amdgcn_s_barrier()
#define PG8_SCHED __builtin_amdgcn_sched_barrier(0)
    Unit cur, nxt; int ui = 0;
    if (!S.next(0, cur)) return;
    f32x4 acc[2][2][4][2];
#pragma unroll
    for (int a = 0; a < 2; ++a)
#pragma unroll
        for (int b = 0; b < 2; ++b)
#pragma unroll
            for (int m = 0; m < 4; ++m)
#pragma unroll
                for (int n = 0; n < 2; ++n) acc[a][b][m][n] = (f32x4){0.f, 0.f, 0.f, 0.f};
    bf16x8 At[4][2], B0[2][2], B1[2][2];
    const char* cA = (const char*)g.A + (size_t)cur.pm * tstep; const char* cB = (const char*)g.Bt + (size_t)cur.pn * tstep;
    S.a_ready(cur);
    if constexpr (SP2) {
        PG8_STAGE(PG8_SB(0, 0), cB, voffB); PG8_STAGE(PG8_SB(0, 1), cB + hstep, voffB); PG8_STAGE(PG8_SA(0, 0), cA, voffA); PG8_STAGE(PG8_SA(0, 1), cA + hstep, voffA);
        if (wr == 1) PG8_BAR;
        PG8_WAIT_V(2); PG8_BAR;
        PG8_STAGE(PG8_SB(1, 0), cB + kstep, voffB); PG8_STAGE(PG8_SA(1, 0), cA + kstep, voffA); PG8_STAGE(PG8_SB(1, 1), cB + hstep + kstep, voffB);
        PG8_WAIT_V(6); PG8_BAR;
    } else {
        PG8_STAGE(PG8_SB(0, 0), cB, voffB); PG8_STAGE(PG8_SA(0, 0), cA, voffA); PG8_STAGE(PG8_SB(0, 1), cB + hstep, voffB); PG8_STAGE(PG8_SA(0, 1), cA + hstep, voffA);
        if (wr == 1) PG8_BAR;
        PG8_WAIT_V(4); PG8_BAR;
        PG8_STAGE(PG8_SB(1, 0), cB + kstep, voffB); PG8_STAGE(PG8_SA(1, 0), cA + kstep, voffA); PG8_STAGE(PG8_SB(1, 1), cB + hstep + kstep, voffB);
        PG8_WAIT_V(6); PG8_BAR;
    }
    for (;;) {
        const bool has_next = S.next(ui + 1, nxt);
        const char* nA = has_next ? (const char*)g.A + (size_t)nxt.pm * tstep : cA; const char* nB = has_next ? (const char*)g.Bt + (size_t)nxt.pn * tstep : cB;
        for (int t = 0; t < nt; t += 2) {
            const bool last = (t == nt - 2);
            const char* a1 = cA + (size_t)(t + 1) * kstep;
            const char* a2 = last ? nA : cA + (size_t)(t + 2) * kstep; const char* b2 = last ? nB : cB + (size_t)(t + 2) * kstep;
            const char* a3 = a2 + kstep; const char* b3 = b2 + kstep;
            if (last && has_next) S.a_ready(nxt);
            if constexpr (SP2) {
            PG8_LDB(B0, 0, 0); PG8_LDB(B1, 0, 1); PG8_SCHED; PG8_LDA(At, 0, 0); PG8_STAGE(PG8_SA(1, 1), a1 + hstep, voffA);
            PG8_WAIT_V(8); PG8_WAIT_L(0); PG8_BAR; PG8_MMA(0, 0, At, B0); PG8_MMA(0, 1, At, B1); PG8_BAR; PG8_SCHED;
            PG8_LDA(At, 0, 1); PG8_STAGE(PG8_SB(0, 0), b2, voffB); PG8_STAGE(PG8_SB(0, 1), b2 + hstep, voffB); PG8_STAGE(PG8_SA(0, 0), a2, voffA);
            PG8_WAIT_V(8); PG8_WAIT_L(0); PG8_BAR; PG8_MMA(1, 0, At, B0); PG8_MMA(1, 1, At, B1); PG8_BAR; PG8_SCHED;
            PG8_LDB(B0, 1, 0); PG8_LDB(B1, 1, 1); PG8_SCHED; PG8_LDA(At, 1, 0); PG8_STAGE(PG8_SA(0, 1), a2 + hstep, voffA);
            PG8_WAIT_V(8); PG8_WAIT_L(0); PG8_BAR; PG8_MMA(0, 0, At, B0); PG8_MMA(0, 1, At, B1); PG8_BAR; PG8_SCHED;
            PG8_LDA(At, 1, 1); PG8_STAGE(PG8_SB(1, 0), b3, voffB); PG8_STAGE(PG8_SB(1, 1), b3 + hstep, voffB); PG8_STAGE(PG8_SA(1, 0), a3, voffA);
            PG8_WAIT_V(8); PG8_WAIT_L(0); PG8_BAR; PG8_MMA(1, 0, At, B0); PG8_MMA(1, 1, At, B1); PG8_BAR; PG8_SCHED;
            } else {
            PG8_LDB(B0, 0, 0); PG8_SCHED; PG8_LDA(At, 0, 0); PG8_STAGE(PG8_SA(1, 1), a1 + hstep, voffA);
            PG8_WAIT_L(8); PG8_BAR; PG8_WAIT_L(0); PG8_MMA(0, 0, At, B0); PG8_BAR; PG8_SCHED;
            PG8_LDB(B1, 0, 1); PG8_STAGE(PG8_SB(0, 0), b2, voffB);
            PG8_BAR; PG8_WAIT_L(0); PG8_MMA(0, 1, At, B1); PG8_BAR;
            PG8_LDA(At, 0, 1); PG8_STAGE(PG8_SA(0, 0), a2, voffA);
            PG8_BAR; PG8_WAIT_L(0); PG8_MMA(1, 0, At, B0); PG8_BAR; PG8_SCHED;
            PG8_STAGE(PG8_SB(0, 1), b2 + hstep, voffB);
            PG8_WAIT_V(6); PG8_BAR; PG8_MMA(1, 1, At, B1); PG8_BAR;
            PG8_LDB(B0, 1, 0); PG8_SCHED; PG8_LDA(At, 1, 0); PG8_STAGE(PG8_SA(0, 1), a2 + hstep, voffA);
            PG8_WAIT_L(8); PG8_BAR; PG8_WAIT_L(0); PG8_MMA(0, 0, At, B0); PG8_BAR; PG8_SCHED;
            PG8_LDB(B1, 1, 1); PG8_STAGE(PG8_SB(1, 0), b3, voffB);
            PG8_BAR; PG8_WAIT_L(0); PG8_MMA(0, 1, At, B1); PG8_BAR;
            PG8_LDA(At, 1, 1); PG8_STAGE(PG8_SA(1, 0), a3, voffA);
            PG8_BAR; PG8_WAIT_L(0); PG8_MMA(1, 0, At, B0); PG8_BAR; PG8_SCHED;
            PG8_STAGE(PG8_SB(1, 1), b3 + hstep, voffB);
            PG8_WAIT_V(6); PG8_BAR; PG8_MMA(1, 1, At, B1); PG8_BAR;
            }
        }
        if constexpr (ALIGN_EPI) { if (wr == 0) PG8_BAR; }
        if constexpr (!Epi::AFTER_DRAIN) { E(acc, cur, wr, wc, fr, fq); S.done(cur); }
        if (!has_next) break;
#pragma unroll
        for (int a = 0; a < 2; ++a)
#pragma unroll
            for (int b = 0; b < 2; ++b)
#pragma unroll
                for (int m = 0; m < 4; ++m)
#pragma unroll
                    for (int n = 0; n < 2; ++n) acc[a][b][m][n] = (f32x4){0.f, 0.f, 0.f, 0.f};
        cur = nxt; cA = nA; cB = nB; ++ui;
        if constexpr (ALIGN_EPI) { if (wr == 1) PG8_BAR; }
    }
    PG8_WAIT_V(0);
    if constexpr (!ALIGN_EPI) { if (wr == 0) PG8_BAR; }
    PG8_BAR;
    if constexpr (Epi::AFTER_DRAIN) { E.fused(acc, cur, wr, wc, fr, fq, lds, wid, lane); S.done(cur); }
#undef PG8_SA
#undef PG8_SB
#undef PG8_STAGE
#undef PG8_LDA
#undef PG8_LDB
#undef PG8_MMA
#undef PG8_WAIT_V
#undef PG8_WAIT_L
#undef PG8_BAR
#undef PG8_SCHED
}
}

#ifndef PG8_SP2
#define PG8_SP2 true
#endif
#ifndef PG8_ALIGN
#define PG8_ALIGN true
#endif

#include <hip/hip_bf16.h>
#include <cmath>
namespace attn_body {
using bf16=__hip_bfloat16;
using bf16x8=__attribute__((ext_vector_type(8)))short;
using s16x4=__attribute__((ext_vector_type(4)))short;
using f32x16=__attribute__((ext_vector_type(16)))float;
using u32x4=__attribute__((ext_vector_type(4)))unsigned;
constexpr int BATCH=4,NHC=16,SEQ=4096,D=64,DVV=128;
constexpr int QP=1024,KP=1024,VP=1024,OP=2048;
constexpr int NW=8,QBLK=32,QB=QBLK*NW,KVBLK=64,NQB=SEQ/QB;
constexpr int ATTN_UNIT_ROWS=QB;
__device__ __forceinline__ int crow(int r,int hi){return (r&3)+8*(r>>2)+4*hi;}
#define SBAR() __builtin_amdgcn_sched_barrier(0)
__device__ __forceinline__ void cmask(f32x16&p0,f32x16&p1,int jb,int qrel,int hi){
  const float NEG=-INFINITY; int kb=64*jb+4*hi;
  #pragma unroll
  for(int r=0;r<16;++r){int kv=kb+(r&3)+8*(r>>2); if(kv>qrel)p0[r]=NEG; if(kv+32>qrel)p1[r]=NEG;}
}

constexpr int NSLOT=3, SLOTB=8192, VSLOTB=2*SLOTB;
constexpr int LDS_K=0, LDS_V=NSLOT*SLOTB, LDS_WS=LDS_V+NSLOT*VSLOTB, LDS_OST=LDS_WS+NW*64*4, LDS_BYTES=LDS_OST+NW*4096;
constexpr float C2=0.125f*1.4426950408889634f;
__device__ __forceinline__ void glds16(const void*gsrc,unsigned lds_dst){unsigned keep;
  asm volatile("s_mov_b32 %0, m0\n\ts_mov_b32 m0, %2\n\ts_nop 0\n\tglobal_load_lds_dwordx4 %1, off\n\ts_mov_b32 m0, %0":"=&s"(keep):"v"(gsrc),"s"(lds_dst):"memory");}
__device__ __forceinline__ float max3f(float a,float b,float c){float r;asm("v_max3_f32 %0, %1, %2, %3":"=v"(r):"v"(a),"v"(b),"v"(c));return r;}
__device__ __forceinline__ float max2f(float a,float b){float r;asm("v_max_f32_e32 %0, %1, %2":"=v"(r):"v"(a),"v"(b));return r;}
__device__ __forceinline__ float fadd_s(float a,float b){float r;asm("v_add_f32_e32 %0, %1, %2":"=v"(r):"v"(a),"v"(b));return r;}
__device__ __forceinline__ float fsub_s(float a,float b){float r;asm("v_sub_f32_e32 %0, %1, %2":"=v"(r):"v"(a),"v"(b));return r;}
typedef float f32x2_t __attribute__((ext_vector_type(2))); typedef __bf16 bf16x2_t __attribute__((ext_vector_type(2)));
__device__ __forceinline__ unsigned cvtpk_s(float lo,float hi){f32x2_t v={lo,hi};bf16x2_t b=__builtin_convertvector(v,bf16x2_t);return __builtin_bit_cast(unsigned,b);}
#define WAIT_BAR(N) asm volatile("s_waitcnt vmcnt(" #N ") lgkmcnt(0)\n\ts_barrier":::"memory")

__device__ __forceinline__ void qkt(f32x16&p0,f32x16&p1,const char*Kslot,const bf16x8*qr,const f32x16&negm,int r32,int hi){
  const char*kb=Kslot+hi*1024+r32*16;
  #pragma unroll
  for(int d0=0;d0<4;++d0){
    const bf16x8 b0=*reinterpret_cast<const bf16x8*>(kb+d0*2048);
    const bf16x8 b1=*reinterpret_cast<const bf16x8*>(kb+d0*2048+512);
    if(d0==0){p0=__builtin_amdgcn_mfma_f32_32x32x16_bf16(b0,qr[0],negm,0,0,0);p1=__builtin_amdgcn_mfma_f32_32x32x16_bf16(b1,qr[0],negm,0,0,0);}
    else{p0=__builtin_amdgcn_mfma_f32_32x32x16_bf16(b0,qr[d0],p0,0,0,0);p1=__builtin_amdgcn_mfma_f32_32x32x16_bf16(b1,qr[d0],p1,0,0,0);}}
}
typedef __attribute__((address_space(3))) const char* lds_cptr;
typedef short v4i16_t __attribute__((ext_vector_type(4)));
__device__ __forceinline__ void kload8(bf16x8*kf,lds_cptr kp){
  kf[0]=*(const __attribute__((address_space(3))) bf16x8*)(kp);      kf[1]=*(const __attribute__((address_space(3))) bf16x8*)(kp+512);
  kf[2]=*(const __attribute__((address_space(3))) bf16x8*)(kp+2048); kf[3]=*(const __attribute__((address_space(3))) bf16x8*)(kp+2560);
  kf[4]=*(const __attribute__((address_space(3))) bf16x8*)(kp+4096); kf[5]=*(const __attribute__((address_space(3))) bf16x8*)(kp+4608);
  kf[6]=*(const __attribute__((address_space(3))) bf16x8*)(kp+6144); kf[7]=*(const __attribute__((address_space(3))) bf16x8*)(kp+6656);
}
__device__ __forceinline__ void kload2(bf16x8*kf,lds_cptr kp,int j){ kf[2*j]=*(const __attribute__((address_space(3))) bf16x8*)(kp+j*2048); kf[2*j+1]=*(const __attribute__((address_space(3))) bf16x8*)(kp+j*2048+512); }
__device__ __forceinline__ s16x4 vtr(lds_cptr p){ return __builtin_bit_cast(s16x4,__builtin_amdgcn_ds_read_tr16_b64_v4i16((__attribute__((address_space(3))) v4i16_t*)p)); }
__device__ __forceinline__ float rowmax(const f32x16&p0,const f32x16&p1){
  float a=max3f(p0[0],p0[1],p1[0]),b=max3f(p0[2],p0[3],p1[1]);a=max3f(a,p1[2],p1[3]);
  #pragma unroll
  for(int r=4;r<16;r+=4){a=max3f(a,p0[r],p0[r+1]);b=max3f(b,p0[r+2],p0[r+3]);a=max3f(a,p1[r],p1[r+1]);b=max3f(b,p1[r+2],p1[r+3]);}
  const float m=max2f(a,b);
  auto rr=__builtin_amdgcn_permlane32_swap(__float_as_uint(m),__float_as_uint(m),false,false);
  return max2f(__uint_as_float(rr[0]),__uint_as_float(rr[1]));
}
__device__ __forceinline__ void pv(f32x16*o,int vb,bf16x8 pa0,bf16x8 pa1,bf16x8 pa2,bf16x8 pa3){
  #pragma unroll
  for(int d0=0;d0<4;++d0){s16x4 lo[4],hi[4];
    #pragma unroll
    for(int ks=0;ks<4;++ks){
      asm volatile("ds_read_b64_tr_b16 %0,%1 offset:%c2":"=&v"(lo[ks]):"v"(vb),"i"(d0*4096+ks*1024):"memory");
      asm volatile("ds_read_b64_tr_b16 %0,%1 offset:%c2":"=&v"(hi[ks]):"v"(vb),"i"(d0*4096+ks*1024+512):"memory");}
    asm volatile("s_waitcnt lgkmcnt(0)":::"memory");SBAR();
    #define PK(k) (bf16x8){lo[k][0],lo[k][1],lo[k][2],lo[k][3],hi[k][0],hi[k][1],hi[k][2],hi[k][3]}
    o[d0]=__builtin_amdgcn_mfma_f32_32x32x16_bf16(pa0,PK(0),o[d0],0,0,0);
    o[d0]=__builtin_amdgcn_mfma_f32_32x32x16_bf16(pa1,PK(1),o[d0],0,0,0);
    o[d0]=__builtin_amdgcn_mfma_f32_32x32x16_bf16(pa2,PK(2),o[d0],0,0,0);
    o[d0]=__builtin_amdgcn_mfma_f32_32x32x16_bf16(pa3,PK(3),o[d0],0,0,0);
    #undef PK
  }
}

#ifndef ATTN_STORE16
#define ATTN_STORE16(p,v) (*(u32x4*)(p)=(v))
#endif
template<int THRL> __device__ __forceinline__ void attn_unit(int b,int hc,int qb,const bf16*Q,const bf16*__restrict__ K,const bf16*__restrict__ V,bf16*O,char*shm){
  const int qkcol=hc*D, vcol=(hc>>1)*DVV, ocol=hc*DVV;
  const int tid=threadIdx.x,lane=tid&63,r32=lane&31,hi=lane>>5; const int wid=__builtin_amdgcn_readfirstlane(tid>>6);
  const long rowbase=(long)b*SEQ; const int q0=qb*QB;
  const bf16*Qw=Q+(rowbase+q0+wid*QBLK)*QP+qkcol;
  const bf16*Kh=K+rowbase*KP+qkcol,*Vh=V+rowbase*VP+vcol;
  const unsigned lds0=(unsigned)(uintptr_t)shm;
  float*wsf=(float*)(shm+LDS_WS)+wid*64;
  const bf16*ksrc=Kh+(long)lane*KP+wid*8;
  const bf16*vsrc=Vh+(long)(16*(wid&3)+(lane>>2))*VP+(wid>>2)*32+(lane&3)*8;
  const unsigned kdst=lds0+LDS_K+wid*1024, vdst=lds0+LDS_V+wid*1024;
  #define DMA_K(t,slot) glds16(ksrc+(long)(t)*KVBLK*KP,(unsigned)__builtin_amdgcn_readfirstlane(kdst+(slot)))
  #define DMA_V(t,slot) do{ glds16(vsrc+(long)(t)*KVBLK*VP,(unsigned)__builtin_amdgcn_readfirstlane(vdst+2*(slot))); glds16(vsrc+64+(long)(t)*KVBLK*VP,(unsigned)__builtin_amdgcn_readfirstlane(vdst+2*(slot)+8192)); }while(0)
  const int vb0=(int)(lds0+LDS_V)+((lane>>4)&1)*32+(lane&3)*8+(4*hi+((lane&15)>>2))*64;
  const char*Kbase=shm+LDS_K; bf16x8 kf[8];
  const lds_cptr shm3=(lds_cptr)shm; const lds_cptr kp0=shm3+LDS_K+hi*1024+r32*16; const lds_cptr vp0=shm3+LDS_V+((lane>>4)&1)*32+(lane&3)*8+(4*hi+((lane&15)>>2))*64;
  const int NT=(q0+QB)/KVBLK;
  DMA_K(0,0);DMA_V(0,0);DMA_K(1,SLOTB);
  bf16x8 qr[4];
  #pragma unroll
  for(int d0=0;d0<4;++d0)qr[d0]=*reinterpret_cast<const bf16x8*>(&Qw[(long)r32*QP+d0*16+hi*8]);
  float mhat=0.f,l_reg=0.f;f32x16 o[4];o[0]=f32x16{};o[1]=f32x16{};o[2]=f32x16{};o[3]=f32x16{};
  const int qrel=wid*QBLK+r32;
  #define CMASK(P0,P1,t) do{int jb_=(t)-(NT-4); if(jb_>=0)cmask(P0,P1,jb_,qrel,hi);}while(0)
  bool resc=false;
  #define START(P0,P1) do{ const float rm=rowmax(P0,P1); resc=false; \
    { const float dl=rm; mhat=fadd_s(mhat,dl); \
      _Pragma("unroll") for(int r=0;r<16;++r){P0[r]=fsub_s(P0[r],dl);P1[r]=fsub_s(P1[r],dl);} } \
    _Pragma("unroll") for(int r=0;r<16;++r)P0[r]=__builtin_amdgcn_exp2f(P0[r]); }while(0)
  #define RESC() do{ if(resc){ asm volatile("s_waitcnt lgkmcnt(0)":::"memory"); \
      _Pragma("unroll") for(int d_=0;d_<4;++d_) _Pragma("unroll") for(int r=0;r<16;++r)o[d_][r]*=wsf[crow(r,hi)]; } }while(0)
  f32x16 pA0,pA1,pB0,pB1;
  int sl_prev=0,sl_cur=0,sl_next=SLOTB;
  #define ROT() do{sl_prev=sl_cur;sl_cur=sl_next;sl_next=(sl_next==(NSLOT-1)*SLOTB)?0:sl_next+SLOTB;}while(0)
  DMA_K(2,2*SLOTB);
  WAIT_BAR(4);
  { const f32x16 z0=f32x16{}; qkt(pA0,pA1,Kbase,qr,z0,r32,hi); }asm volatile("s_nop 15\n\ts_nop 7":"+v"(pA0),"+v"(pA1));CMASK(pA0,pA1,0);
  START(pA0,pA1);
  _Pragma("unroll") for(int r=0;r<16;++r)pA1[r]=__builtin_amdgcn_exp2f(pA1[r]);
  WAIT_BAR(0);
  DMA_K(3,0);DMA_V(1,SLOTB);
  ROT();
  kload8(kf,kp0+sl_cur);
  WAIT_BAR(3);
  s16x4 vlo[4],vhi[4]; u32x4 pw0,pw1,pw2,pw3;
  #define PKW(P,B) cvtpk_s(P[B],P[B+1])
  #define PAF(k) __builtin_bit_cast(bf16x8,pw##k)
  #define VFR(i) (bf16x8){vlo[i][0],vlo[i][1],vlo[i][2],vlo[i][3],vhi[i][0],vhi[i][1],vhi[i][2],vhi[i][3]}
  #define PIN(x) asm volatile("":"+v"(x))
  #define MX3(a,b,c) __builtin_fmaxf(__builtin_fmaxf((a),(b)),(c))
  #define GAPA(MF,A0,A1,A2,A3,W0,W1,PW) do{ MF; sacc+=A0; sacc+=A1; sacc+=A2; sacc+=A3; PIN(sacc); W0; W1; PIN(PW); SBAR(); }while(0)
  #define EX(v) __builtin_amdgcn_exp2f(v)
  #define GAPB(MF,X,B) do{ MF; X[B]=EX(X[B]-mhat); X[B+1]=EX(X[B+1]-mhat); PIN(X); SBAR(); }while(0)
  #define VRD(p,i) do{ vlo[p]=vtr(vp_+(((i)>>2)*4096+((i)&3)*1024)); vhi[p]=vtr(vp_+(((i)>>2)*4096+((i)&3)*1024+512)); }while(0)
  #define KRD(G,j) do{ if(G){ kload2(kf,kp0+sl_next,j); SBAR(); } }while(0)
  #define ZC (f32x16{})
  #define STEP(C0,C1,P0,P1,t,GK,GV,GL) do{ SBAR(); \
    const lds_cptr vp_=vp0+2*sl_prev; \
    float sacc=(P0[0]+P0[1]); \
    GAPA(C0=__builtin_amdgcn_mfma_f32_32x32x16_bf16(kf[0],qr[0],ZC,0,0,0), P0[2],P0[3],P0[4],P0[5],     pw0[0]=PKW(P0,0), pw0[1]=PKW(P0,2), pw0); \
    GAPA(C1=__builtin_amdgcn_mfma_f32_32x32x16_bf16(kf[1],qr[0],ZC,0,0,0), P0[6],P0[7],P0[8],P0[9],     pw0[2]=PKW(P0,4), pw0[3]=PKW(P0,6), pw0); \
    GAPA(C0=__builtin_amdgcn_mfma_f32_32x32x16_bf16(kf[2],qr[1],C0,0,0,0),   P0[10],P0[11],P0[12],P0[13], pw1[0]=PKW(P0,8), pw1[1]=PKW(P0,10), pw1); \
    GAPA(C1=__builtin_amdgcn_mfma_f32_32x32x16_bf16(kf[3],qr[1],C1,0,0,0),   P0[14],P0[15],P1[0],P1[1],   pw1[2]=PKW(P0,12),pw1[3]=PKW(P0,14), pw1); \
    GAPA(C0=__builtin_amdgcn_mfma_f32_32x32x16_bf16(kf[4],qr[2],C0,0,0,0),   P1[2],P1[3],P1[4],P1[5],     pw2[0]=PKW(P1,0), pw2[1]=PKW(P1,2), pw2); \
    VRD(0,0); SBAR(); GAPA(C1=__builtin_amdgcn_mfma_f32_32x32x16_bf16(kf[5],qr[2],C1,0,0,0),   P1[6],P1[7],P1[8],P1[9],     pw2[2]=PKW(P1,4), pw2[3]=PKW(P1,6), pw2); \
    VRD(1,4); SBAR(); GAPA(C0=__builtin_amdgcn_mfma_f32_32x32x16_bf16(kf[6],qr[3],C0,0,0,0),   P1[10],P1[11],P1[12],P1[13], pw3[0]=PKW(P1,8), pw3[1]=PKW(P1,10), pw3); \
    VRD(2,1); SBAR(); GAPA(C1=__builtin_amdgcn_mfma_f32_32x32x16_bf16(kf[7],qr[3],C1,0,0,0),   P1[14],P1[15],0.f,0.f,       pw3[2]=PKW(P1,12),pw3[3]=PKW(P1,14), pw3); \
    l_reg+=sacc; \
    if(GK){DMA_K((t)+3,sl_cur);} if(GV){DMA_V((t)+1,sl_next);} \
    CMASK(C0,C1,t); \
    { float a=MX3(C0[0],C0[1],C1[0]),b=MX3(C0[2],C0[3],C1[1]); a=MX3(a,C1[2],C1[3]); \
      _Pragma("unroll") for(int r=4;r<16;r+=4){a=MX3(a,C0[r],C0[r+1]);b=MX3(b,C0[r+2],C0[r+3]);a=MX3(a,C1[r],C1[r+1]);b=MX3(b,C1[r+2],C1[r+3]);} \
      float rm=__builtin_fmaxf(a,b); { auto rr=__builtin_amdgcn_permlane32_swap(__float_as_uint(rm),__float_as_uint(rm),false,false); rm=__builtin_fmaxf(__uint_as_float(rr[0]),__uint_as_float(rr[1])); } \
      rm-=mhat; resc=false; \
      if(__builtin_expect(__any(rm>(float)THRL),0)){ const float dl=__builtin_fmaxf(rm,0.f); mhat+=dl; \
        const float f=__builtin_amdgcn_exp2f(-dl); l_reg*=f; if(hi==0)wsf[r32]=f; resc=true; } } \
    SBAR(); \
    VRD(3,5);  SBAR(); GAPB(o[0]=__builtin_amdgcn_mfma_f32_32x32x16_bf16(PAF(0),VFR(0),o[0],0,0,0), C0,0); \
    VRD(0,2);  SBAR(); GAPB(o[1]=__builtin_amdgcn_mfma_f32_32x32x16_bf16(PAF(0),VFR(1),o[1],0,0,0), C0,2); \
    VRD(1,6);  SBAR(); KRD(GL,0); GAPB(o[0]=__builtin_amdgcn_mfma_f32_32x32x16_bf16(PAF(1),VFR(2),o[0],0,0,0), C0,4); \
    VRD(2,3);  SBAR(); KRD(GL,1); GAPB(o[1]=__builtin_amdgcn_mfma_f32_32x32x16_bf16(PAF(1),VFR(3),o[1],0,0,0), C0,6); \
    VRD(3,7);  SBAR(); KRD(GL,2); GAPB(o[0]=__builtin_amdgcn_mfma_f32_32x32x16_bf16(PAF(2),VFR(0),o[0],0,0,0), C0,8); \
    VRD(0,8);  SBAR(); KRD(GL,3); GAPB(o[1]=__builtin_amdgcn_mfma_f32_32x32x16_bf16(PAF(2),VFR(1),o[1],0,0,0), C0,10); \
    VRD(1,12); SBAR(); GAPB(o[0]=__builtin_amdgcn_mfma_f32_32x32x16_bf16(PAF(3),VFR(2),o[0],0,0,0), C0,12); \
    VRD(2,9);  SBAR(); GAPB(o[1]=__builtin_amdgcn_mfma_f32_32x32x16_bf16(PAF(3),VFR(3),o[1],0,0,0), C0,14); \
    VRD(3,13); SBAR(); GAPB(o[2]=__builtin_amdgcn_mfma_f32_32x32x16_bf16(PAF(0),VFR(0),o[2],0,0,0), C1,0); \
    VRD(0,10); SBAR(); GAPB(o[3]=__builtin_amdgcn_mfma_f32_32x32x16_bf16(PAF(0),VFR(1),o[3],0,0,0), C1,2); \
    VRD(1,14); SBAR(); GAPB(o[2]=__builtin_amdgcn_mfma_f32_32x32x16_bf16(PAF(1),VFR(2),o[2],0,0,0), C1,4); \
    VRD(2,11); SBAR(); GAPB(o[3]=__builtin_amdgcn_mfma_f32_32x32x16_bf16(PAF(1),VFR(3),o[3],0,0,0), C1,6); \
    VRD(3,15); SBAR(); GAPB(o[2]=__builtin_amdgcn_mfma_f32_32x32x16_bf16(PAF(2),VFR(0),o[2],0,0,0), C1,8); \
    GAPB(o[3]=__builtin_amdgcn_mfma_f32_32x32x16_bf16(PAF(2),VFR(1),o[3],0,0,0), C1,10); \
    GAPB(o[2]=__builtin_amdgcn_mfma_f32_32x32x16_bf16(PAF(3),VFR(2),o[2],0,0,0), C1,12); \
    GAPB(o[3]=__builtin_amdgcn_mfma_f32_32x32x16_bf16(PAF(3),VFR(3),o[3],0,0,0), C1,14); \
    }while(0)
  int t=1;
  #undef CMASK
  #define CMASK(P0,P1,t) do{}while(0)
  for(;t+5<NT;t+=2){
    STEP(pB0,pB1,pA0,pA1,t,true,true,true);     WAIT_BAR(3); RESC(); ROT();
    STEP(pA0,pA1,pB0,pB1,t+1,true,true,true);   WAIT_BAR(3); RESC(); ROT();
  }
  #undef CMASK
  #define CMASK(P0,P1,t) do{int jb_=(t)-(NT-4); if(jb_>=0)cmask(P0,P1,jb_,qrel,hi);}while(0)
  #define ENDW(tt) do{ if((tt)+3<NT){WAIT_BAR(3);} else if((tt)+2<NT){WAIT_BAR(2);} else {WAIT_BAR(0);} }while(0)
  for(;t+1<NT;t+=2){
    STEP(pB0,pB1,pA0,pA1,t,(t+3<NT),(t+1<NT),(t+1<NT));       ENDW(t);   RESC(); ROT();
    STEP(pA0,pA1,pB0,pB1,t+1,(t+4<NT),(t+2<NT),(t+2<NT));     ENDW(t+1); RESC(); ROT();
  }
  STEP(pB0,pB1,pA0,pA1,NT-1,false,false,false); RESC();
  { float sacc=pB0[0]+pB0[1]; _Pragma("unroll") for(int r=2;r<16;++r)sacc+=pB0[r]; _Pragma("unroll") for(int r=0;r<16;++r)sacc+=pB1[r]; l_reg+=sacc;
    pw0=(u32x4){PKW(pB0,0),PKW(pB0,2),PKW(pB0,4),PKW(pB0,6)};pw1=(u32x4){PKW(pB0,8),PKW(pB0,10),PKW(pB0,12),PKW(pB0,14)};pw2=(u32x4){PKW(pB1,0),PKW(pB1,2),PKW(pB1,4),PKW(pB1,6)};pw3=(u32x4){PKW(pB1,8),PKW(pB1,10),PKW(pB1,12),PKW(pB1,14)};
    SBAR(); pv(o,vb0+2*sl_cur,PAF(0),PAF(1),PAF(2),PAF(3)); }
  #undef PKW
  #undef PAF
  #undef VFR
  #undef PIN
  #undef MX3
  #undef GAPA
  #undef GAPB
  #undef EX
  #undef VRD
  #undef KRD
  #undef STEP
  #undef ZC
  #undef ENDW
  {auto rr=__builtin_amdgcn_permlane32_swap(__float_as_uint(l_reg),__float_as_uint(l_reg),false,false);l_reg=__uint_as_float(rr[0])+__uint_as_float(rr[1]);}
  if(hi==0)wsf[32+r32]=l_reg;asm volatile("s_waitcnt lgkmcnt(0)":::"memory");
  float rli[16];
  #pragma unroll
  for(int r=0;r<16;++r)rli[r]=__builtin_amdgcn_rcpf(wsf[32+crow(r,hi)]);
  bf16*Ow=O+(rowbase+q0+wid*QBLK)*OP+ocol;
  { bf16*stg=(bf16*)(shm+LDS_OST)+wid*2048;
    #pragma unroll
    for(int h2=0;h2<2;++h2){
    #pragma unroll
    for(int r=0;r<16;++r){const int orow=crow(r,hi);
      #pragma unroll
      for(int d0=0;d0<2;++d0)stg[orow*64+d0*32+r32]=__float2bfloat16(o[2*h2+d0][r]*rli[r]);}
    asm volatile("s_waitcnt lgkmcnt(0)":::"memory");
    #pragma unroll
    for(int i=0;i<4;++i){const int row=i*8+(lane>>3),ch=lane&7; const u32x4 v=*(const u32x4*)(stg+row*64+ch*8); ATTN_STORE16(Ow+(long)row*OP+h2*64+ch*8,v);}
    asm volatile("s_waitcnt lgkmcnt(0)":::"memory"); } }
  asm volatile("s_waitcnt lgkmcnt(0)\n\ts_barrier":::"memory");
  #undef DMA_K
  #undef DMA_V
  #undef CMASK
  #undef START
  #undef RESC
  #undef ROT
}
constexpr int ATTN_LDS_BYTES=LDS_BYTES;
struct AttnTensors { const bf16* Q; const bf16* K; const bf16* V; bf16* O; };
struct AttnUnit { int bh; int qb; };
struct StaticOrder {
  int vcu;
  __device__ __forceinline__ explicit StaticOrder(int grid,int block):vcu((block%8)*(grid/8)+block/8){}
  __device__ __forceinline__ bool next(int i,AttnUnit&u)const{ if(i>=4)return false; const int p=vcu&7; u.bh=(vcu>>3)*2+(i>>1); u.qb=(i&1)?15-p:p; return true; }
  __device__ __forceinline__ void a_ready(const AttnUnit&)const{}
  __device__ __forceinline__ void done(const AttnUnit&)const{}
};
template<class Sched,int THRL=8> __device__ __forceinline__ void attn_phase(char*lds,const AttnTensors&T,const Sched&S){
  AttnUnit u;
  for(int i=0;S.next(i,u);++i){ S.a_ready(u); attn_unit<THRL>(u.bh/NHC,u.bh%NHC,u.qb,T.Q,T.K,T.V,T.O,lds); S.done(u); }
}
#undef SBAR
#undef WAIT_BAR
}

#define GAS __attribute__((address_space(1)))
#define LAS __attribute__((address_space(3)))
typedef unsigned v4u __attribute__((ext_vector_type(4)));
typedef GAS unsigned gu32;
typedef GAS unsigned long long gu64;
#define RLX_AGENT __ATOMIC_RELAXED, __HIP_MEMORY_SCOPE_AGENT
#define LDS_WAIT() asm volatile("s_waitcnt lgkmcnt(0)" ::: "memory")
#define VM_WAIT() asm volatile("s_waitcnt vmcnt(0)" ::: "memory")
__device__ __forceinline__ unsigned pk2(float lo, float hi) { return f2bf(lo) | (f2bf(hi) << 16); }

#define XB_TMO      128
#define XB_XCNT(j)  (256  + 64 * (j))
#define XB_XSUB(j)  (1280 + 64 * (j))
#define XB_XGEN(j)  (2304 + 64 * (j))
#define XB_TOP      3328
#define XB_TOPGEN   3392
#define XCD_BAR_WORDS 3456
#define XB_SPIN_CAP (1u << 18)

__device__ __forceinline__ unsigned xb_ld(unsigned* p)              { return __hip_atomic_load(p, __ATOMIC_RELAXED, __HIP_MEMORY_SCOPE_AGENT); }
__device__ __forceinline__ unsigned xb_add(unsigned* p, unsigned v) { return __hip_atomic_fetch_add(p, v, __ATOMIC_RELAXED, __HIP_MEMORY_SCOPE_AGENT); }
__device__ __forceinline__ unsigned xb_xcc_id() { return (unsigned)__builtin_amdgcn_s_getreg((3 << 11) | 20) & 0xFu; }
#define XB_SPIN(cond, bar) do { unsigned _sp = 0; while (cond) { __builtin_amdgcn_s_sleep(1); \
    if ((++_sp & 255u) == 0u) { if (xb_ld(&(bar)[XB_TMO])) break; if (_sp > XB_SPIN_CAP) { atomicAdd(&(bar)[XB_TMO], 1u); break; } } } } while (0)

struct XcdBarrier {
    unsigned* bar; unsigned x;
    volatile LAS unsigned* st;
};

__device__ __forceinline__ XcdBarrier xcd_barrier_post(unsigned* bar, volatile LAS unsigned* st) {
    XcdBarrier b; b.bar = bar; b.x = xb_xcc_id(); b.st = st;
    if (threadIdx.x == 0) (void)xb_add(&bar[XB_XCNT(b.x)], 1u);
    return b;
}
__device__ __forceinline__ void xcd_barrier_complete(unsigned* bar, unsigned x, unsigned& nloc, unsigned& nx) {
    const unsigned G = gridDim.x * gridDim.y * gridDim.z;
    unsigned sum, cnt, mine, sp = 0u;
    for (;;) {
        sum = 0u; cnt = 0u; mine = 0u;
#pragma unroll
        for (unsigned j = 0; j < 16; ++j) { const unsigned c = xb_ld(&bar[XB_XCNT(j)]); sum += c; cnt += (c > 0u) ? 1u : 0u; mine = (j == x) ? c : mine; }
        if (sum == G) break;
        __builtin_amdgcn_s_sleep(1);
        if ((++sp & 255u) == 0u) { if (xb_ld(&bar[XB_TMO])) break; if (sp > XB_SPIN_CAP) { atomicAdd(&bar[XB_TMO], 1u); break; } }
    }
    nloc = mine > 0u ? mine : 1u; nx = cnt > 0u ? cnt : 1u;
}

__device__ __forceinline__ void xcd_barrier(const XcdBarrier& b) {
    asm volatile("s_waitcnt vmcnt(0)" ::: "memory");
    __syncthreads();
    if (threadIdx.x == 0) {
        unsigned* bar = b.bar;
        __builtin_amdgcn_s_waitcnt(0);
        unsigned nloc = b.st[0], nx = b.st[1];
        if (nloc == 0u) { xcd_barrier_complete(bar, b.x, nloc, nx); b.st[0] = nloc; b.st[1] = nx; }
        const unsigned old = xb_add(&bar[XB_XSUB(b.x)], 1u);
        const unsigned gen = old / nloc;
        if (old + 1u == (gen + 1u) * nloc) {
            __builtin_amdgcn_fence(__ATOMIC_RELEASE, "agent");
            asm volatile("s_waitcnt vmcnt(0)" ::: "memory");
            const unsigned og = xb_add(&bar[XB_TOP], 1u);
            const unsigned tg = og / nx;
            if (og + 1u == (tg + 1u) * nx) xb_add(&bar[XB_TOPGEN], 1u);
            else XB_SPIN(xb_ld(&bar[XB_TOPGEN]) == tg, bar);
            __builtin_amdgcn_fence(__ATOMIC_ACQUIRE, "agent");
            xb_add(&bar[XB_XGEN(b.x)], 1u);
            asm volatile("s_waitcnt vmcnt(0)" ::: "memory");
        } else {
            XB_SPIN(xb_ld(&bar[XB_XGEN(b.x)]) == gen, bar);
            __builtin_amdgcn_fence(__ATOMIC_ACQUIRE, "agent");
            asm volatile("s_waitcnt vmcnt(0)" ::: "memory");
        }
    }
    __syncthreads();
}

constexpr int NWAVES = 8;
constexpr int RING_OFF = 0, RING_BYTES = 131072;
constexpr int LDSCTL_OFF = RING_BYTES, MISC_OFF = LDSCTL_OFF + 320;
constexpr int LDS_BYTES = 147456;
constexpr int CW_BAR = 4096;

struct Frame {
    LAS unsigned char* lds;
    volatile LAS unsigned* MISC;
    gu32* ctl;
    int tid, lane, wave, vcu, G;
    const float* in[19]; float* out; unsigned char* ws;
};
struct WDesc { const float* W; const float* gain; bf16* WT; int ldn, c0, K, ncols, roff, mode; };
__device__ __forceinline__ WDesc wdesc(const Frame& F, int i) {
    unsigned char* ws = F.ws; WDesc d;
    switch (i) {
    case 0:  d = WDesc{F.in[2], F.in[1], (bf16*)(ws + WS_WIN), GIN, 0, D, 3072, 0, 0}; break;
    case 1:  d = WDesc{F.in[6], nullptr, (bf16*)(ws + WS_WAO), D, 0, D, D, 0, 0}; break;
    case 2:  d = WDesc{F.in[17], F.in[16], (bf16*)(ws + WS_W1A), FF, 0, D, FF, 0, 0}; break;
    case 3:  d = WDesc{F.in[18], nullptr, (bf16*)(ws + WS_W2A), D, 0, FF, D, 0, 0}; break;
    case 4:  d = WDesc{F.in[8], F.in[7], (bf16*)(ws + WS_WKVQ), 2048, 0, D, 2048, 0, 1}; break;
    case 5:  d = WDesc{F.in[11], F.in[10], (bf16*)(ws + WS_WKVQ), D, 0, D, D, 2048, 1}; break;
    case 6:  d = WDesc{F.in[15], nullptr, (bf16*)(ws + WS_WBO), D, 0, D, D, 0, 0}; break;
    case 7:  d = WDesc{F.in[17] + (size_t)D * FF, F.in[16] + D, (bf16*)(ws + WS_W1B), FF, 0, D, FF, 0, 0}; break;
    default: d = WDesc{F.in[18] + (size_t)D * FF, nullptr, (bf16*)(ws + WS_W2B), D, 0, FF, D, 0, 0}; break;
    }
    return d;
}
__device__ __forceinline__ void p0_transpose_item(const WDesc& d, LAS float* scr, int item, int lane) {
    const int nblk = d.ncols / 64, kb = item / nblk, nb = item % nblk, k0 = 64 * kb, n0 = 64 * nb;
    const int kq = lane >> 4, n4 = (lane & 15) * 4;
    f32x4 v[16];
#pragma unroll
    for (int i = 0; i < 16; ++i) v[i] = __builtin_nontemporal_load((const GAS f32x4*)(d.W + (size_t)(k0 + 4 * i + kq) * d.ldn + d.c0 + n0 + n4));
    const int c = lane & 7;
    f32x4 g0 = (f32x4){1.f, 1.f, 1.f, 1.f}, g1 = g0;
    if (d.gain) { g0 = *(const GAS f32x4*)(d.gain + k0 + 8 * c); g1 = *(const GAS f32x4*)(d.gain + k0 + 8 * c + 4); }
#pragma unroll
    for (int i = 0; i < 16; ++i) { const int kk = 4 * i + kq; *(LAS f32x4*)(scr + kk * 64 + (n4 ^ (kk & 0x38))) = v[i]; }
    LDS_WAIT(); asm volatile("" ::: "memory");
#pragma unroll
    for (int jj = 0; jj < 8; ++jj) { const int n = (lane >> 3) + 8 * jj; const LAS float* sp = scr + (8 * c) * 64 + (n ^ (c << 3));
        const int dr = d.mode ? kvq_dest_row(d.roff + n0 + n) : d.roff + n0 + n;
        v4u o; o.x = pk2(sp[0 * 64] * g0[0], sp[1 * 64] * g0[1]); o.y = pk2(sp[2 * 64] * g0[2], sp[3 * 64] * g0[3]); o.z = pk2(sp[4 * 64] * g1[0], sp[5 * 64] * g1[1]); o.w = pk2(sp[6 * 64] * g1[2], sp[7 * 64] * g1[3]);
        pg8::store16_wt((void*)(d.WT + (size_t)dr * d.K + k0 + 8 * c), o); }
    LDS_WAIT(); asm volatile("" ::: "memory");
}
__device__ __forceinline__ float wave_sum(float v) {
#pragma unroll
    for (int o = 1; o < 64; o <<= 1) v += __shfl_xor(v, o);
    return v;
}
template <int NR> __device__ __forceinline__ void rows_to_bf16(const Frame& F, const float* xrow, bf16* orow, float* ssrow) {
    f32x4 v[NR][4];
#pragma unroll
    for (int r = 0; r < NR; ++r)
#pragma unroll
        for (int j = 0; j < 4; ++j) v[r][j] = __builtin_nontemporal_load(((const GAS f32x4*)(xrow + (size_t)r * D) + F.lane) + 64 * j);
#pragma unroll
    for (int r = 0; r < NR; ++r) { float s = 0.f;
#pragma unroll
        for (int j = 0; j < 4; ++j) s += (v[r][j].x * v[r][j].x + v[r][j].y * v[r][j].y) + (v[r][j].z * v[r][j].z + v[r][j].w * v[r][j].w);
        s = wave_sum(s);
        if (F.lane < 16) ssrow[(size_t)r * 16 + F.lane] = (F.lane == 0) ? s : 0.f;
        GAS unsigned long long* o8 = (GAS unsigned long long*)(orow + (size_t)r * D) + F.lane;
#pragma unroll
        for (int j = 0; j < 4; ++j) o8[64 * j] = (unsigned long long)pk2(v[r][j].x, v[r][j].y) | ((unsigned long long)pk2(v[r][j].z, v[r][j].w) << 32); }
}
__device__ __forceinline__ void p0_prologue(Frame& F) {
    LAS float* scr = (LAS float*)(F.lds + RING_OFF + F.wave * 16384);
    const int gw = F.vcu * NWAVES + F.wave, NGW = F.G * NWAVES;
    int base = 0;
    for (int mi = 0; mi < 9; ++mi) {
        const WDesc d = wdesc(F, mi); const int nit = (d.K / 64) * (d.ncols / 64);
        int it = gw - (base % NGW); if (it < 0) it += NGW;
        for (; it < nit; it += NGW) p0_transpose_item(d, scr, it, F.lane);
        base += nit;
    }
    { const float* W = F.in[2]; const float* g = F.in[1]; bf16* Wz = (bf16*)(F.ws + WS_WZ);
      for (int idx = gw * 64 + F.lane; idx < 16 * D; idx += NGW * 64) { const int k = idx >> 4, r = idx & 15; Wz[(size_t)r * D + k] = (bf16)f2bf(W[(size_t)k * GIN + 3072 + r] * g[k]); } }
    bf16* XB = (bf16*)(F.ws + WS_A); float* SS = (float*)(F.ws + WS_SS);
    for (int m = 4 * gw; m < T; m += 4 * NGW) rows_to_bf16<4>(F, F.in[0] + (size_t)m * D, XB + (size_t)m * D, SS + (size_t)m * 16);
}


__device__ __forceinline__ void combine_local(Frame& F) {
    const int lane = F.lane, wave = F.wave;
    const float* lp = F.in[13]; const float* hg = F.in[14];
    const float s1 = wave_sum(lp[lane] * lp[64 + lane]), s2 = wave_sum(lp[128 + lane] * lp[192 + lane]);
    const float lam = __expf(s1) - __expf(s2) + LAMBDA_INIT;
    const int bhh = F.vcu >> 3, p = F.vcu & 7, b = bhh >> 3, h = bhh & 7, sg = lane & 7;
    float g[16];
#pragma unroll
    for (int j = 0; j < 16; ++j) g[j] = hg[16 * sg + j] * (1.f - LAMBDA_INIT);
    const bf16* O32 = (const bf16*)F.out; bf16* OD = (bf16*)(F.ws + WS_C);
    asm volatile("s_waitcnt vmcnt(0)" ::: "memory"); __syncthreads();
    for (int it0 = 0; it0 < 8; it0 += 4) {
        bf16x8 a0[4], a1[4], b0[4], b1[4]; size_t tt[4];
#pragma unroll
        for (int q = 0; q < 4; ++q) { const int r = (it0 + q) * 64 + wave * 8 + (lane >> 3);
            tt[q] = (size_t)b * SEQ + (size_t)((r < 256) ? p : 15 - p) * 256 + (r & 255);
            const bf16* p0 = O32 + tt[q] * 2048 + (2 * h) * 128 + 16 * sg;
            a0[q] = *(const bf16x8*)p0; a1[q] = *(const bf16x8*)(p0 + 8); b0[q] = *(const bf16x8*)(p0 + 128); b1[q] = *(const bf16x8*)(p0 + 136); }
#pragma unroll
        for (int q = 0; q < 4; ++q) {
            float o[16]; float s = 0.f;
#pragma unroll
            for (int j = 0; j < 8; ++j) { o[j] = bf2f((unsigned short)a0[q][j]) - lam * bf2f((unsigned short)b0[q][j]); o[8 + j] = bf2f((unsigned short)a1[q][j]) - lam * bf2f((unsigned short)b1[q][j]); }
#pragma unroll
            for (int j = 0; j < 16; ++j) s += o[j] * o[j];
            s += __shfl_xor(s, 1); s += __shfl_xor(s, 2); s += __shfl_xor(s, 4);
            const float rstd = __builtin_amdgcn_rsqf(s * (1.f / 128.f) + EPS);
            v4u w0, w1;
            w0.x = pk2(o[0] * rstd * g[0], o[1] * rstd * g[1]); w0.y = pk2(o[2] * rstd * g[2], o[3] * rstd * g[3]); w0.z = pk2(o[4] * rstd * g[4], o[5] * rstd * g[5]); w0.w = pk2(o[6] * rstd * g[6], o[7] * rstd * g[7]);
            w1.x = pk2(o[8] * rstd * g[8], o[9] * rstd * g[9]); w1.y = pk2(o[10] * rstd * g[10], o[11] * rstd * g[11]); w1.z = pk2(o[12] * rstd * g[12], o[13] * rstd * g[13]); w1.w = pk2(o[14] * rstd * g[14], o[15] * rstd * g[15]);
            bf16* qd = OD + tt[q] * 1024 + h * 128 + 16 * sg;
            *(v4u*)qd = w0; *(v4u*)(qd + 8) = w1; }
    }
}
__device__ __forceinline__ unsigned off_b(unsigned row, unsigned ch) { return 256u * row + 16u * (ch ^ (((row & 3) << 2) | ((row >> 2) & 3))); }
__device__ __forceinline__ unsigned row_addr16(unsigned lane, unsigned rb, unsigned s) { return off_b((lane & 15) + 16 * rb, 4 * s + (lane >> 4)); }
__device__ __forceinline__ unsigned tr_addr16(unsigned lane, unsigned c, unsigned ks, unsigned t) { const unsigned g = lane >> 4, q = (lane & 15) >> 2, p = lane & 3; return off_b(32 * ks + 8 * g + 4 * t + q, 2 * c + (p >> 1)) + 8 * (p & 1); }
typedef short v4i16_t __attribute__((ext_vector_type(4)));
__device__ __forceinline__ bf16x8 tr_frag(LAS unsigned char* img, unsigned lane, unsigned c, unsigned ks) {
    const v4i16_t lo = __builtin_amdgcn_ds_read_tr16_b64_v4i16((LAS v4i16_t*)(img + tr_addr16(lane, c, ks, 0)));
    const v4i16_t hi = __builtin_amdgcn_ds_read_tr16_b64_v4i16((LAS v4i16_t*)(img + tr_addr16(lane, c, ks, 1)));
    return (bf16x8){lo[0], lo[1], lo[2], lo[3], hi[0], hi[1], hi[2], hi[3]};
}
__device__ __forceinline__ bf16x8 row_frag(LAS unsigned char* img, unsigned lane, unsigned rb, unsigned s) { return *(const LAS bf16x8*)(img + row_addr16(lane, rb, s)); }
#define MFMA16(a, b, c) __builtin_amdgcn_mfma_f32_16x16x32_bf16(a, b, c, 0, 0, 0)

constexpr int ZP_OFF = 137216;
__device__ __forceinline__ void gate_phase(Frame& F) {
    LAS float* ZP = (LAS float*)(F.lds + ZP_OFF);
    const bf16* XB = (const bf16*)(F.ws + WS_A); const bf16* Wz = (const bf16*)(F.ws + WS_WZ); const float* wgu = F.in[3]; const float* bg = F.in[4]; float* BC = (float*)(F.ws + WS_BC);
    const float* SS = (const float*)(F.ws + WS_SS);
    const int lane = F.lane, wave = F.wave, fr = lane & 15, fq = lane >> 4;
    LAS float* ST = (LAS float*)(F.lds + wave * 16384);
    float wb[4][4], bb[4];
#pragma unroll
    for (int nt = 0; nt < 4; ++nt) { bb[nt] = bg[64 * wave + 16 * nt + fr];
#pragma unroll
        for (int kk = 0; kk < 4; ++kk) wb[nt][kk] = wgu[(4 * kk + fq) * 512 + 64 * wave + 16 * nt + fr]; }
    for (int u = F.vcu; u < T / CH; u += F.G) {
        const size_t t0 = (size_t)u * CH;
        { const int mt = wave & 3, kh = wave >> 2; f32x4 acc = (f32x4){0.f, 0.f, 0.f, 0.f};
          const bf16* ap = XB + (t0 + mt * 16 + fr) * D + kh * 512 + 8 * fq; const bf16* bp = Wz + (size_t)fr * D + kh * 512 + 8 * fq;
#pragma unroll
          for (int ks = 0; ks < 16; ++ks) acc = MFMA16(__builtin_nontemporal_load((const bf16x8*)(ap + ks * 32)), *(const bf16x8*)(bp + ks * 32), acc);
#pragma unroll
          for (int j = 0; j < 4; ++j) ZP[(kh * 64 + mt * 16 + 4 * fq + j) * 17 + fr] = acc[j] * pg8::row_rstd(SS, (int)t0 + mt * 16 + 4 * fq + j); }
        __syncthreads();
        float carry[4] = {0.f, 0.f, 0.f, 0.f};
#pragma unroll 1
        for (int mt = 0; mt < 4; ++mt) {
            float za[4];
#pragma unroll
            for (int kk = 0; kk < 4; ++kk) za[kk] = ZP[(mt * 16 + fr) * 17 + 4 * kk + fq] + ZP[(64 + mt * 16 + fr) * 17 + 4 * kk + fq];
#pragma unroll
            for (int nt = 0; nt < 4; ++nt) {
                f32x4 x = (f32x4){bb[nt], bb[nt], bb[nt], bb[nt]};
#pragma unroll
                for (int kk = 0; kk < 4; ++kk) x = __builtin_amdgcn_mfma_f32_16x16x4f32(za[kk], wb[nt][kk], x, 0, 0, 0);
                float p[4]; float run = 0.f;
#pragma unroll
                for (int r = 0; r < 4; ++r) { const float ls = fminf(x[r], 0.f) - __logf(1.f + __expf(-fabsf(x[r]))); run += ls * (1.f / 16.f); p[r] = run; }
                float s1 = run; { const float t = __shfl_up(s1, 16); if (fq >= 1) s1 += t; }
                float s2 = s1;  { const float t = __shfl_up(s2, 32); if (fq >= 2) s2 += t; }
                const float base = carry[nt] + (s2 - run);
                carry[nt] += __shfl(s2, 48 + fr);
#pragma unroll
                for (int r = 0; r < 4; ++r) { const int row = mt * 16 + 4 * fq + r; ST[row * 64 + ((16 * nt + fr) ^ (((row >> 2) & 3) << 4))] = base + p[r]; }
            }
        }
        LDS_WAIT(); asm volatile("" ::: "memory");
#pragma unroll
        for (int i = 0; i < 16; ++i) { const int row = 4 * i + fq; const f32x4 v = *(const LAS f32x4*)(ST + row * 64 + ((4 * fr) ^ (((row >> 2) & 3) << 4)));
            *(f32x4*)(BC + (t0 + row) * 512 + 64 * wave + 4 * fr) = v; }
        __syncthreads();
    }
}

struct GlaSet { unsigned k0, k1; f32x4 bc, bl; v4u v; float dc; };
__device__ __forceinline__ void gla_state_phase(Frame& F) {
    LAS unsigned char* lds = F.lds;
    const bf16* KG = (const bf16*)(F.ws + WS_KG); const bf16* VG = (const bf16*)(F.ws + WS_VG); const float* BC = (const float*)(F.ws + WS_BC); bf16* SP = (bf16*)F.out;
    const int tid = F.tid, lane = F.lane, wave = F.wave;
    const int pos = tid >> 3, sub = tid & 7, mt = wave >> 1, nt = wave & 1;
    for (int u = F.vcu; u < 256; u += F.G) {
        const int bh = u >> 4, ki = (u >> 2) & 3, vi = u & 3, b = bh >> 2, h = bh & 3;
        const size_t tr0 = (size_t)b * SEQ;
        const bf16* kp = KG + (tr0 + pos) * 512 + h * GDK + ki * 32 + sub * 4;
        const float* bp = BC + (tr0 + pos) * 512 + h * GDK + ki * 32 + sub * 4;
        const float* blp = BC + (tr0 + 63) * 512 + h * GDK + ki * 32 + sub * 4;
        const bf16* vp = VG + (tr0 + pos) * 1024 + h * GDV + vi * 64 + sub * 8;
        const float* dcp = BC + (tr0 + 63) * 512 + h * GDK + ki * 32 + nt * 16 + (lane & 15);
        bf16* spp = SP + ((size_t)(bh * NCH) * GDV + vi * 64 + mt * 16 + 4 * (lane >> 4)) * GDK + ki * 32 + nt * 16 + (lane & 15);
        const unsigned kw = off_b(pos, sub >> 1) + 8 * (sub & 1), vw = off_b(pos, sub);
        f32x4 acc = (f32x4){0.f, 0.f, 0.f, 0.f};
#define GLA_LOAD(S, c) do { const size_t o_ = (size_t)(c) * CH; const unsigned long long kk_ = *(const unsigned long long*)(kp + o_ * 512); S.k0 = (unsigned)kk_; S.k1 = (unsigned)(kk_ >> 32); \
        S.bc = *(const f32x4*)(bp + o_ * 512); S.bl = *(const f32x4*)(blp + o_ * 512); S.v = *(const v4u*)(vp + o_ * 1024); S.dc = dcp[o_ * 512]; } while (0)
#define GLA_STEP(S, c, buf) do { \
        { const float e0 = __expf(S.bl[0] - S.bc[0]), e1 = __expf(S.bl[1] - S.bc[1]), e2 = __expf(S.bl[2] - S.bc[2]), e3 = __expf(S.bl[3] - S.bc[3]); \
          const unsigned w0 = pk2(bf2f(S.k0 & 0xffffu) * e0, bf2f(S.k0 >> 16) * e1), w1 = pk2(bf2f(S.k1 & 0xffffu) * e2, bf2f(S.k1 >> 16) * e3); \
          *(LAS unsigned long long*)(lds + (buf) * 32768 + kw) = (unsigned long long)w0 | ((unsigned long long)w1 << 32); \
          *(LAS v4u*)(lds + (buf) * 32768 + 16384 + vw) = S.v; } \
        const float dec_ = __expf(S.dc); \
        if ((c) + 4 < NCH) GLA_LOAD(S, (c) + 4); \
        __syncthreads(); \
        _Pragma("unroll") for (int j = 0; j < 4; ++j) __builtin_nontemporal_store((bf16)f2bf(acc[j]), spp + (size_t)(c) * GDV * GDK + j * GDK); \
        acc = acc * dec_; \
        _Pragma("unroll") for (int ks = 0; ks < 2; ++ks) acc = MFMA16(tr_frag(lds + (buf) * 32768 + 16384, lane, mt, ks), tr_frag(lds + (buf) * 32768, lane, nt, ks), acc); } while (0)
        GlaSet s0, s1, s2, s3;
        GLA_LOAD(s0, 0); GLA_LOAD(s1, 1); GLA_LOAD(s2, 2); GLA_LOAD(s3, 3);
        for (int c = 0; c < NCH; c += 4) { GLA_STEP(s0, c, 0); GLA_STEP(s1, c + 1, 1); GLA_STEP(s2, c + 2, 0); GLA_STEP(s3, c + 3, 1); }
#undef GLA_LOAD
#undef GLA_STEP
        __syncthreads();
    }
}

struct GlaRaw { bf16x8 q[2], k[2]; f32x4 b0[2], b1[2]; v4u v[4]; };
__device__ __forceinline__ void gla_out_phase(Frame& F) {
    LAS unsigned char* lds = F.lds;
    LAS unsigned char *QI = lds, *KI = lds + 16384, *VI0 = lds + 32768, *VI1 = lds + 49152, *AI = lds + 65536, *OL = lds + 32768;
    LAS float* RED = (LAS float*)(lds + 81920); LAS float* RS = RED + 512;
    const bf16* QG = (const bf16*)(F.ws + WS_QG); const bf16* KG = (const bf16*)(F.ws + WS_KG); const bf16* VG = (const bf16*)(F.ws + WS_VG); const bf16* GGp = (const bf16*)(F.ws + WS_GG);
    const float* BC = (const float*)(F.ws + WS_BC); const bf16* SP = (const bf16*)F.out; bf16* OG = (bf16*)(F.ws + WS_C); const float* hg = F.in[5];
    const int tid = F.tid, lane = F.lane, wave = F.wave, fr = lane & 15, fq = lane >> 4;
    const float g0 = hg[32 * wave + fr], g1 = hg[32 * wave + 16 + fr];
    constexpr int NU = NB * GH * NCH;
#define GLA_T0(u) ((size_t)((u) >> 8) * SEQ + (size_t)((u) & 63) * CH)
#define GLA_H(u) (((u) >> 6) & 3)
#define GLA_LOADRAW(R, u) do { const size_t t0_ = GLA_T0(u); const int h_ = GLA_H(u); \
        _Pragma("unroll") for (int r = 0; r < 2; ++r) { const int n = tid + 512 * r, pos = n >> 4, ch = n & 15; const size_t e = (t0_ + pos) * 512 + h_ * GDK + ch * 8; \
            R.q[r] = __builtin_nontemporal_load((const bf16x8*)(QG + e)); R.k[r] = __builtin_nontemporal_load((const bf16x8*)(KG + e)); \
            R.b0[r] = __builtin_nontemporal_load((const f32x4*)(BC + e)); R.b1[r] = __builtin_nontemporal_load((const f32x4*)(BC + e + 4)); } \
        _Pragma("unroll") for (int r = 0; r < 4; ++r) { const int n = tid + 512 * r, pos = n >> 5, c32 = n & 31; \
            R.v[r] = __builtin_nontemporal_load((const v4u*)(VG + (t0_ + pos) * 1024 + h_ * GDV + c32 * 8)); } } while (0)
#define GLA_LOADSF(u) do { const bf16* sp = SP + ((size_t)(u) * GDV + 32 * wave + fr) * GDK + 8 * fq; \
        _Pragma("unroll") for (int nt = 0; nt < 2; ++nt) _Pragma("unroll") for (int ks = 0; ks < 4; ++ks) sf[nt][ks] = __builtin_nontemporal_load((const bf16x8*)(sp + nt * 16 * GDK + ks * 32)); } while (0)
    int u = F.vcu;
    if (u >= NU) return;
    GlaRaw R; bf16x8 sf[2][4];
    GLA_LOADRAW(R, u); GLA_LOADSF(u);
    for (;;) {
        const size_t t0 = GLA_T0(u); const int h = GLA_H(u); const int un = u + F.G; const bool has_next = un < NU;
#pragma unroll
        for (int r = 0; r < 2; ++r) { const int n = tid + 512 * r, pos = n >> 4, ch = n & 15;
            float qq[8], kk[8];
#pragma unroll
            for (int j = 0; j < 8; ++j) { const float bj = j < 4 ? R.b0[r][j & 3] : R.b1[r][j & 3]; const float ex = __expf(bj);
                qq[j] = bf2f((unsigned short)R.q[r][j]) * ex * 0.08838834764831845f; kk[j] = bf2f((unsigned short)R.k[r][j]) * __builtin_amdgcn_rcpf(ex); }
            v4u wq, wk; wq.x = pk2(qq[0], qq[1]); wq.y = pk2(qq[2], qq[3]); wq.z = pk2(qq[4], qq[5]); wq.w = pk2(qq[6], qq[7]);
            wk.x = pk2(kk[0], kk[1]); wk.y = pk2(kk[2], kk[3]); wk.z = pk2(kk[4], kk[5]); wk.w = pk2(kk[6], kk[7]);
            *(LAS v4u*)(QI + off_b(pos, ch)) = wq; *(LAS v4u*)(KI + off_b(pos, ch)) = wk; }
#pragma unroll
        for (int r = 0; r < 4; ++r) { const int n = tid + 512 * r, pos = n >> 5, c32 = n & 31; *(LAS v4u*)((c32 >> 4 ? VI1 : VI0) + off_b(pos, c32 & 15)) = R.v[r]; }
        __syncthreads();
        if (has_next) GLA_LOADRAW(R, un);
        { const int mt = wave >> 1;
#pragma unroll
          for (int q = 0; q < 2; ++q) { const int nt = 2 * (wave & 1) + q; f32x4 a4 = (f32x4){0.f, 0.f, 0.f, 0.f};
              if (nt <= mt) {
#pragma unroll
                  for (int ks = 0; ks < 4; ++ks) a4 = MFMA16(row_frag(QI, lane, mt, ks), row_frag(KI, lane, nt, ks), a4); }
#pragma unroll
              for (int r = 0; r < 4; ++r) { const int ii = mt * 16 + 4 * fq + r, jj = nt * 16 + fr; const float val = (jj <= ii) ? a4[r] : 0.f;
                  *(LAS unsigned short*)(AI + off_b(ii, jj >> 3) + 2 * (jj & 7)) = (unsigned short)f2bf(val); } } }
        __syncthreads();
        f32x4 o[4][2];
#pragma unroll
        for (int m = 0; m < 4; ++m) { o[m][0] = (f32x4){0.f, 0.f, 0.f, 0.f}; o[m][1] = (f32x4){0.f, 0.f, 0.f, 0.f}; }
#pragma unroll
        for (int ks = 0; ks < 2; ++ks) { bf16x8 bfr[2];
#pragma unroll
            for (int nt = 0; nt < 2; ++nt) { const int dv = 32 * wave + 16 * nt; bfr[nt] = tr_frag((dv >> 7) ? VI1 : VI0, lane, (dv & 127) >> 4, ks); }
#pragma unroll
            for (int m = 0; m < 4; ++m) { const bf16x8 a = row_frag(AI, lane, m, ks); o[m][0] = MFMA16(a, bfr[0], o[m][0]); o[m][1] = MFMA16(a, bfr[1], o[m][1]); } }
#pragma unroll
        for (int ks = 0; ks < 4; ++ks)
#pragma unroll
            for (int m = 0; m < 4; ++m) { const bf16x8 a = row_frag(QI, lane, m, ks); o[m][0] = MFMA16(a, sf[0][ks], o[m][0]); o[m][1] = MFMA16(a, sf[1][ks], o[m][1]); }
        bf16x8 gv[4];
#pragma unroll
        for (int r = 0; r < 4; ++r) { const int n = tid + 512 * r, pos = n >> 5, c32 = n & 31; gv[r] = __builtin_nontemporal_load((const bf16x8*)(GGp + (t0 + pos) * 1024 + h * GDV + c32 * 8)); }
        if (has_next) GLA_LOADSF(un);
#pragma unroll
        for (int m = 0; m < 4; ++m)
#pragma unroll
            for (int r = 0; r < 4; ++r) { float s = o[m][0][r] * o[m][0][r] + o[m][1][r] * o[m][1][r];
                s += __shfl_xor(s, 1); s += __shfl_xor(s, 2); s += __shfl_xor(s, 4); s += __shfl_xor(s, 8);
                if (fr == 0) RED[wave * 64 + m * 16 + 4 * fq + r] = s; }
        __syncthreads();
        if (tid < 64) { float tot = 0.f;
#pragma unroll
            for (int w = 0; w < 8; ++w) tot += RED[w * 64 + tid];
            RS[tid] = __builtin_amdgcn_rsqf(tot * (1.f / GDV) + EPS); }
        __syncthreads();
#pragma unroll
        for (int m = 0; m < 4; ++m) { const f32x4 rs4 = *(const LAS f32x4*)(RS + m * 16 + 4 * fq);
#pragma unroll
            for (int r = 0; r < 4; ++r) { LAS unsigned char* rowp = OL + (m * 16 + 4 * fq + r) * 512 + (32 * wave + fr) * 2;
                *(LAS unsigned short*)rowp = (unsigned short)f2bf(o[m][0][r] * rs4[r] * g0); *(LAS unsigned short*)(rowp + 32) = (unsigned short)f2bf(o[m][1][r] * rs4[r] * g1); } }
        __syncthreads();
#pragma unroll
        for (int r = 0; r < 4; ++r) { const int n = tid + 512 * r, pos = n >> 5, c32 = n & 31;
            const bf16x8 ov = *(const LAS bf16x8*)(OL + pos * 512 + c32 * 16); const size_t e = (t0 + pos) * 1024 + h * GDV + c32 * 8;
            v4u w; w.x = pk2(bf2f((unsigned short)ov[0]) * bf2f((unsigned short)gv[r][0]), bf2f((unsigned short)ov[1]) * bf2f((unsigned short)gv[r][1]));
            w.y = pk2(bf2f((unsigned short)ov[2]) * bf2f((unsigned short)gv[r][2]), bf2f((unsigned short)ov[3]) * bf2f((unsigned short)gv[r][3]));
            w.z = pk2(bf2f((unsigned short)ov[4]) * bf2f((unsigned short)gv[r][4]), bf2f((unsigned short)ov[5]) * bf2f((unsigned short)gv[r][5]));
            w.w = pk2(bf2f((unsigned short)ov[6]) * bf2f((unsigned short)gv[r][6]), bf2f((unsigned short)ov[7]) * bf2f((unsigned short)gv[r][7]));
            *(v4u*)(OG + e) = w; }
        __syncthreads();
        if (!has_next) break;
        u = un;
    }
#undef GLA_T0
#undef GLA_H
#undef GLA_LOADRAW
#undef GLA_LOADSF
}
constexpr int RT_OFF = 132096;
__device__ __forceinline__ void fill_rstd_table(Frame& F, const pg8::StaticOrder& S, const float* ss) {
    LAS float* RT = (LAS float*)(F.lds + RT_OFF); pg8::Unit u;
    for (int i = 0; i < 4 && S.next(i, u); ++i) if (F.tid < 256) RT[i * 256 + F.tid] = pg8::row_rstd(ss, u.pm * 256 + F.tid);
    __syncthreads();
}

struct Args { const float* in[19]; float* out; unsigned char* ws; int ph_lo, ph_hi, li, pad; };
__global__ void __launch_bounds__(NWAVES * 64, 2) mega(Args args) {
    extern __shared__ __attribute__((aligned(16))) unsigned char lds[];
    Frame F;
    F.lds = (LAS unsigned char*)lds;
    F.MISC = (volatile LAS unsigned*)(F.lds + MISC_OFF);
    F.tid = threadIdx.x; F.lane = F.tid & 63; F.wave = __builtin_amdgcn_readfirstlane(F.tid >> 6);
    F.G = gridDim.x; { const int bx = blockIdx.x; F.vcu = (F.G % 8 == 0) ? (bx % 8) * (F.G / 8) + bx / 8 : bx; }
#pragma unroll
    for (int i = 0; i < 19; ++i) F.in[i] = args.in[i];
    F.out = args.out; F.ws = args.ws; F.ctl = (gu32*)(args.ws + WS_CTL);
    unsigned char* ws = args.ws;
    for (int u = F.tid; u < (LDS_BYTES - LDSCTL_OFF) / 4; u += NWAVES * 64) ((LAS unsigned*)(F.lds + LDSCTL_OFF))[u] = 0u;
    __syncthreads();
    const int lo = args.ph_lo, hi = args.ph_hi;
    XcdBarrier bar; bar.bar = (unsigned*)(F.ctl + CW_BAR) + args.li * XCD_BAR_WORDS; bar.x = 0; bar.st = nullptr;
    if (hi - lo > 1) bar = xcd_barrier_post((unsigned*)(F.ctl + CW_BAR) + args.li * XCD_BAR_WORDS, F.MISC + 8);
#define IN(k) (lo <= (k) && (k) < hi)
#define SEAM(k) do { if (IN(k) && IN((k) + ((k) == 8 ? 2 : 1))) xcd_barrier(bar); } while (0)
    bf16 *Win = (bf16*)(ws + WS_WIN), *Wao = (bf16*)(ws + WS_WAO), *W1a = (bf16*)(ws + WS_W1A), *W2a = (bf16*)(ws + WS_W2A);
    bf16 *Wkvq = (bf16*)(ws + WS_WKVQ), *Wbo = (bf16*)(ws + WS_WBO), *W1b = (bf16*)(ws + WS_W1B), *W2b = (bf16*)(ws + WS_W2B);
    float* SS = (float*)(ws + WS_SS);
    bf16 *RA = (bf16*)(ws + WS_A), *RC = (bf16*)(ws + WS_C), *HM = (bf16*)(ws + WS_HM);

    if (IN(0)) { p0_prologue(F); SEAM(0); }
    if (IN(1)) {
        pg8::Gemm g{RA, Win, T, 3072, D}; pg8::StaticOrder S; S.init(T, 3072, F.G, (int)blockIdx.x);
        fill_rstd_table(F, S, SS);
        pg8::EpiInProj E{(bf16*)(ws + WS_QG), (bf16*)(ws + WS_KG), (bf16*)(ws + WS_VG), (bf16*)(ws + WS_GG), (const LAS float*)(F.lds + RT_OFF), 0};
        pg8::gemm_phase<pg8::EpiInProj, pg8::StaticOrder, PG8_ALIGN, PG8_SP2>(F.lds + RING_OFF, g, S, E);
        gate_phase(F);
        SEAM(1);
    }
    if (IN(2)) { gla_state_phase(F); SEAM(2); }
    if (IN(3)) { gla_out_phase(F); SEAM(3); }
    if (IN(4)) {
        pg8::Gemm g{RC, Wao, T, D, D}; pg8::StaticOrder S; S.init(T, D, F.G, (int)blockIdx.x);
        pg8::EpiResB<1> E{nullptr, RA, (bf16*)F.out, nullptr, SS};
        pg8::gemm_phase<pg8::EpiResB<1>, pg8::StaticOrder, PG8_ALIGN, PG8_SP2>(F.lds + RING_OFF, g, S, E);
        SEAM(4);
    }
    if (IN(5)) {
        pg8::Gemm g{(const bf16*)F.out, W1a, T, FF, D}; pg8::StaticOrder S; S.init(T, FF, F.G, (int)blockIdx.x);
        fill_rstd_table(F, S, SS);
        pg8::EpiUp E{HM, (const LAS float*)(F.lds + RT_OFF), 0};
        pg8::gemm_phase<pg8::EpiUp, pg8::StaticOrder, PG8_ALIGN, PG8_SP2>(F.lds + RING_OFF, g, S, E);
        SEAM(5);
    }
    if (IN(6)) {
        pg8::Gemm g{HM, W2a, T, D, FF}; pg8::StaticOrder S; S.init(T, D, F.G, (int)blockIdx.x);
        pg8::EpiResB<1> E{nullptr, (const bf16*)F.out, RA, nullptr, SS};
        pg8::gemm_phase<pg8::EpiResB<1>, pg8::StaticOrder, PG8_ALIGN, PG8_SP2>(F.lds + RING_OFF, g, S, E);
        SEAM(6);
    }
    if (IN(7)) {
        pg8::Gemm g{RA, Wkvq, T, 3072, D}; pg8::StaticOrder S; S.init(T, 3072, F.G, (int)blockIdx.x);
        if (F.tid < 128) ((LAS float*)(F.lds + RT_OFF + 4096))[F.tid] = (F.tid < 64) ? F.in[9][F.tid] : F.in[12][F.tid - 64];
        fill_rstd_table(F, S, SS);
        pg8::EpiKVQ E{(bf16*)(ws + WS_KN), (bf16*)(ws + WS_V2), (bf16*)(ws + WS_QN), (const LAS float*)(F.lds + RT_OFF), (const LAS float*)(F.lds + RT_OFF + 4096), (const LAS float*)(F.lds + RT_OFF + 4096 + 256), 0};
        pg8::gemm_phase<pg8::EpiKVQ, pg8::StaticOrder, PG8_ALIGN, PG8_SP2>(F.lds + RING_OFF, g, S, E);
        SEAM(7);
    }
    if (IN(8)) {
        const attn_body::AttnTensors AT{(const attn_body::bf16*)(ws + WS_QN), (const attn_body::bf16*)(ws + WS_KN), (const attn_body::bf16*)(ws + WS_V2), (attn_body::bf16*)F.out};
        const attn_body::StaticOrder S((int)F.G, (int)blockIdx.x);
        attn_body::attn_phase<attn_body::StaticOrder>((char*)lds + RING_OFF, AT, S);
        combine_local(F);
        SEAM(8);
    }
    if (IN(10)) {
        pg8::Gemm g{RC, Wbo, T, D, D}; pg8::StaticOrder S; S.init(T, D, F.G, (int)blockIdx.x);
        pg8::EpiResB<1> E{nullptr, RA, RA, nullptr, SS};
        pg8::gemm_phase<pg8::EpiResB<1>, pg8::StaticOrder, PG8_ALIGN, PG8_SP2>(F.lds + RING_OFF, g, S, E);
        SEAM(10);
    }
    if (IN(11)) {
        pg8::Gemm g{RA, W1b, T, FF, D}; pg8::StaticOrder S; S.init(T, FF, F.G, (int)blockIdx.x);
        fill_rstd_table(F, S, SS);
        pg8::EpiUp E{HM, (const LAS float*)(F.lds + RT_OFF), 0};
        pg8::gemm_phase<pg8::EpiUp, pg8::StaticOrder, PG8_ALIGN, PG8_SP2>(F.lds + RING_OFF, g, S, E);
        SEAM(11);
    }
    if (IN(12)) {
        pg8::Gemm g{HM, W2b, T, D, FF}; pg8::StaticOrder S; S.init(T, D, F.G, (int)blockIdx.x);
        pg8::EpiResB<2> E{nullptr, RA, nullptr, F.out, nullptr};
        pg8::gemm_phase<pg8::EpiResB<2>, pg8::StaticOrder, PG8_ALIGN, PG8_SP2>(F.lds + RING_OFF, g, S, E);
    }
#undef IN
#undef SEAM
}

extern "C" void kernel_launch(void* const* d_in, const int* in_sizes, int n_in, void* d_out, int out_size, void* d_ws, size_t ws_size, hipStream_t stream) {
    static int grid = 0;
    if (grid == 0) {
        if (n_in != 19 || out_size != T * D || ws_size < WS_END) { fprintf(stderr, "kernel_launch: unexpected shapes (n_in %d out %d ws %zu)\n", n_in, out_size, ws_size); grid = -1; return; }
        int dev = 0, cus = 0, per_cu = 0;
        if (hipGetDevice(&dev) != hipSuccess || hipDeviceGetAttribute(&cus, hipDeviceAttributeMultiprocessorCount, dev) != hipSuccess) { grid = -1; return; }
        if (hipFuncSetAttribute((const void*)mega, hipFuncAttributeMaxDynamicSharedMemorySize, LDS_BYTES) != hipSuccess) { fprintf(stderr, "kernel_launch: hipFuncSetAttribute failed\n"); grid = -1; return; }
        if (hipOccupancyMaxActiveBlocksPerMultiprocessor(&per_cu, (const void*)mega, NWAVES * 64, LDS_BYTES) != hipSuccess || per_cu < 1) { fprintf(stderr, "kernel_launch: occupancy query says %d blocks per CU\n", per_cu); grid = -1; (void)hipGetLastError(); return; }
        if (cus < 256) { fprintf(stderr, "kernel_launch: built for the 256 CUs of an MI355X (one resident workgroup per CU), found %d\n", cus); grid = -1; return; }
        grid = 256;
    }
    if (grid < 0) return;
    unsigned char* ws = (unsigned char*)d_ws;
    (void)hipMemsetAsync(ws + WS_CTL, 0, 64 * 1024, stream);
    Args a{};
    for (int i = 0; i < 19; ++i) a.in[i] = (const float*)d_in[i];
    a.out = (float*)d_out; a.ws = ws;
    int li = 0;
    auto run = [&](int lo, int hi) { a.ph_lo = lo; a.ph_hi = hi; a.li = li++; hipLaunchKernelGGL(mega, dim3(grid), dim3(NWAVES * 64), LDS_BYTES, stream, a); };
    run(0, 13);
}
```

```cpp
#include <hip/hip_runtime.h>
#include <cstdio>
#include <cstdint>

typedef unsigned short bf16;
typedef short bf16x8 __attribute__((ext_vector_type(8)));
typedef float f32x4 __attribute__((ext_vector_type(4)));

constexpr int NB = 4, SEQ = 4096, T = NB * SEQ, D = 1024, FF = 4096;
constexpr int GH = 4, GDK = 128, GDV = 256, GR = 16, CH = 64, NCH = SEQ / CH;
constexpr int GIN = 3088;
constexpr int DH = 8, DDH = 64, DVD = 128;
constexpr float EPS = 1e-6f;
constexpr float LOG2E = 1.4426950408889634f;
constexpr float LAMBDA_INIT = 0.35550906759f;

constexpr size_t MiB = 1u << 20;
constexpr size_t WS_CTL = 0;
constexpr size_t WS_SS = 1 * MiB;
constexpr size_t WS_ZB = 2 * MiB;
constexpr size_t WS_WZ = 3 * MiB;
constexpr size_t WS_WIN = 4 * MiB;
constexpr size_t WS_WAO = 10 * MiB;
constexpr size_t WS_W1A = 12 * MiB;
constexpr size_t WS_W2A = 20 * MiB;
constexpr size_t WS_WKVQ = 28 * MiB;
constexpr size_t WS_WBO = 34 * MiB;
constexpr size_t WS_W1B = 36 * MiB;
constexpr size_t WS_W2B = 44 * MiB;
constexpr size_t WS_B = 52 * MiB;
constexpr size_t WS_A = 180 * MiB;
constexpr size_t WS_C = 212 * MiB;
constexpr size_t WS_END = 244 * MiB;
constexpr size_t WS_QG = WS_B, WS_KG = WS_B + 16 * MiB, WS_VG = WS_B + 32 * MiB, WS_GG = WS_B + 64 * MiB, WS_BC = WS_B + 96 * MiB;
constexpr size_t WS_HM = WS_B;
constexpr size_t WS_KN = WS_B, WS_V2 = WS_B + 32 * MiB, WS_QN = WS_B + 64 * MiB;

__host__ __device__ __forceinline__ unsigned f2bf(float f) { unsigned u = __builtin_bit_cast(unsigned, f); return (u + 0x7fffu + ((u >> 16) & 1u)) >> 16; }
__host__ __device__ __forceinline__ float bf2f(unsigned h) { return __builtin_bit_cast(float, h << 16); }

__host__ __device__ __forceinline__ int kvq_dest_row(int n) {
    if (n >= 1024 && n < 2048) return n;
    const int tile = n >> 8, w = n & 255, lb = w >> 5, j = w & 31, wc = lb >> 1, bj = lb & 1;
    return (tile << 8) + 128 * bj + 32 * wc + j;
}

namespace pg8 {
#define PG8_LAS __attribute__((address_space(3)))
typedef unsigned short bf16_t;
typedef short bf16x8 __attribute__((ext_vector_type(8)));
typedef float f32x4 __attribute__((ext_vector_type(4)));
typedef unsigned u32x4 __attribute__((ext_vector_type(4)));
constexpr int BM = 256, BK = 64, HALF = 128, HTB = HALF * BK * 2  , STAGE_BYTES = 8 * HTB, NXCD = 8, WGM = 8;

__host__ __device__ __forceinline__ int lds_byte(int r, int c) { const int st = (r >> 4) * 2 + (c >> 5), rr = r & 15, cc = c & 31, ob = rr * 64 + cc * 2; return st * 1024 + (ob ^ (((ob >> 9) & 1) << 5)); }
__host__ __device__ __forceinline__ void stage_rc(int b, int& R, int& C) { const int st = b / 1024, sb = b % 1024, swz = sb ^ (((sb >> 9) & 1) << 5); R = (st >> 1) * 16 + swz / 64; C = (st & 1) * 32 + (swz % 64) / 2; }
__host__ __device__ __forceinline__ int perm32(int rho) { const int n = rho >> 4, i = rho & 15; return 8 * (i >> 2) + 4 * n + (i & 3); }

struct Unit { int pm, pn; };
struct Gemm { const bf16_t* A; const bf16_t* Bt; int M, N, K; };

struct StaticOrder {
    int nM, nN, nwg, G, c;
    __host__ __device__ void init(int M, int N, int G_, int c_) { nM = M / BM; nN = N / BM; nwg = nM * nN; G = G_; c = c_; }
    __host__ __device__ bool next(int i, Unit& u) const {
        const long L = (long)i * G + c; if (L >= nwg) return false;
        int wgid = (int)L; { const int q = nwg / NXCD, r = nwg % NXCD, xcd = wgid % NXCD, off = wgid / NXCD; wgid = (xcd < r ? xcd * (q + 1) : r * (q + 1) + (xcd - r) * q) + off; }
        const int nig = WGM * nN, gid = wgid / nig, fm = gid * WGM, gsz = (nM - fm) < WGM ? (nM - fm) : WGM;
        u.pm = fm + ((wgid % nig) % gsz); u.pn = (wgid % nig) / gsz; return true;
    }
    __device__ __forceinline__ void a_ready(const Unit&) const {}
    __device__ __forceinline__ void done(const Unit&) const {}
};

__device__ __forceinline__ unsigned cvt_pk_bf16(float lo, float hi) { unsigned r; asm volatile("v_cvt_pk_bf16_f32 %0, %1, %2" : "=v"(r) : "v"(lo), "v"(hi)); return r; }
typedef float f32x2 __attribute__((ext_vector_type(2)));
typedef unsigned u32x2 __attribute__((ext_vector_type(2)));
__device__ __forceinline__ void store16_wt(void* p, u32x4 v) { asm volatile("global_store_dwordx4 %0, %1, off sc1\n\ts_nop 1" :: "v"(p), "v"(v) : "memory"); }
constexpr int TOK = 16384;
constexpr float RMS_EPS = 1e-6f;
__device__ __forceinline__ float silu_f(float g) { return g * __builtin_amdgcn_rcpf(1.0f + __builtin_amdgcn_exp2f(-1.4426950408889634f * g)); }
__device__ __forceinline__ float row_rstd(const float* ss, int row) {
    const f32x4 a = *(const f32x4*)(ss + (size_t)row * 16), b = *(const f32x4*)(ss + (size_t)row * 16 + 4), c = *(const f32x4*)(ss + (size_t)row * 16 + 8), d = *(const f32x4*)(ss + (size_t)row * 16 + 12);
    const float q = ((a[0] + a[1]) + (a[2] + a[3])) + ((b[0] + b[1]) + (b[2] + b[3])) + ((c[0] + c[1]) + (c[2] + c[3])) + ((d[0] + d[1]) + (d[2] + d[3]));
    return __builtin_amdgcn_rsqf(q * (1.0f / 1024.0f) + RMS_EPS);
}
struct EpiInProj {
    static constexpr bool PERM = true, AFTER_DRAIN = false;
    bf16_t *q, *k, *v, *g; const PG8_LAS float* rt; mutable int ui;
    __device__ __forceinline__ void operator()(const f32x4 (&acc)[2][2][4][2], const Unit& u, int wr, int wc, int fr, int fq) const {
        const int row0 = u.pm * BM + wr * 64 + fr; const int pn = u.pn; const PG8_LAS float* rtu = rt + ui * 256 + wr * 64 + fr; ++ui;
        bf16_t* base; int ldc, colt; const bool act = pn >= 8;
        if (pn < 2) { base = q; ldc = 512; colt = pn * BM; } else if (pn < 4) { base = k; ldc = 512; colt = (pn - 2) * BM; }
        else if (pn < 8) { base = v; ldc = 1024; colt = (pn - 4) * BM; } else { base = g; ldc = 1024; colt = (pn - 8) * BM; }
        const int col0 = colt + wc * 32 + 8 * fq;
#pragma unroll
        for (int ai = 0; ai < 2; ++ai)
#pragma unroll
            for (int m = 0; m < 4; ++m) { bf16_t* rowp = base + (size_t)(row0 + ai * HALF + m * 16) * ldc + col0; const float rs = rtu[ai * HALF + m * 16];
#pragma unroll
                for (int bj = 0; bj < 2; ++bj) { f32x4 v0 = acc[ai][bj][m][0] * rs, v1 = acc[ai][bj][m][1] * rs;
                    if (act) { v0 = (f32x4){silu_f(v0[0]), silu_f(v0[1]), silu_f(v0[2]), silu_f(v0[3])}; v1 = (f32x4){silu_f(v1[0]), silu_f(v1[1]), silu_f(v1[2]), silu_f(v1[3])}; }
                    u32x4 w; w.x = cvt_pk_bf16(v0[0], v0[1]); w.y = cvt_pk_bf16(v0[2], v0[3]); w.z = cvt_pk_bf16(v1[0], v1[1]); w.w = cvt_pk_bf16(v1[2], v1[3]);
                    store16_wt(rowp + bj * HALF, w); } }
    }
};
template <int MODE> struct EpiResB {
    static constexpr bool PERM = true, AFTER_DRAIN = false;
    const float* basef; const bf16_t* baseb; bf16_t* hb; float* outf; float* ss;
    __device__ __forceinline__ void operator()(const f32x4 (&acc)[2][2][4][2], const Unit& u, int wr, int wc, int fr, int fq) const {
        const int col0 = u.pn * BM + wc * 32 + 8 * fq;
#pragma unroll
        for (int ai = 0; ai < 2; ++ai)
#pragma unroll
            for (int m = 0; m < 4; ++m) { const int row = u.pm * BM + ai * HALF + wr * 64 + m * 16 + fr; const size_t off = (size_t)row * 1024 + col0; float s = 0.f;
#pragma unroll
                for (int bj = 0; bj < 2; ++bj) { f32x4 h0, h1;
                    if (MODE == 0) { h0 = *(const f32x4*)(basef + off + bj * HALF); h1 = *(const f32x4*)(basef + off + bj * HALF + 4); }
                    else { const u32x4 b = *(const u32x4*)(baseb + off + bj * HALF);
                        h0 = (f32x4){__builtin_bit_cast(float, b.x << 16), __builtin_bit_cast(float, b.x & 0xffff0000u), __builtin_bit_cast(float, b.y << 16), __builtin_bit_cast(float, b.y & 0xffff0000u)};
                        h1 = (f32x4){__builtin_bit_cast(float, b.z << 16), __builtin_bit_cast(float, b.z & 0xffff0000u), __builtin_bit_cast(float, b.w << 16), __builtin_bit_cast(float, b.w & 0xffff0000u)}; }
                    h0 = h0 + acc[ai][bj][m][0]; h1 = h1 + acc[ai][bj][m][1];
                    if (MODE == 2) { __builtin_nontemporal_store(h0, (f32x4*)(outf + off + bj * HALF)); __builtin_nontemporal_store(h1, (f32x4*)(outf + off + bj * HALF + 4)); }
                    else { u32x4 w; w.x = cvt_pk_bf16(h0[0], h0[1]); w.y = cvt_pk_bf16(h0[2], h0[3]); w.z = cvt_pk_bf16(h1[0], h1[1]); w.w = cvt_pk_bf16(h1[2], h1[3]);
                        *(u32x4*)(hb + off + bj * HALF) = w;
                        s += ((h0[0] * h0[0] + h0[1] * h0[1]) + (h0[2] * h0[2] + h0[3] * h0[3])) + ((h1[0] * h1[0] + h1[1] * h1[1]) + (h1[2] * h1[2] + h1[3] * h1[3])); } }
                if (MODE != 2) { s += __shfl_xor(s, 16); s += __shfl_xor(s, 32); if (fq == 0) ss[(size_t)row * 16 + u.pn * 4 + wc] = s; }
                if (m & 1) asm volatile("" ::: "memory"); }
    }
};
struct EpiUp {
    static constexpr bool PERM = true, AFTER_DRAIN = false;
    bf16_t* O; const PG8_LAS float* rt; mutable int ui;
    __device__ __forceinline__ void operator()(const f32x4 (&acc)[2][2][4][2], const Unit& u, int wr, int wc, int fr, int fq) const {
        const int col0 = u.pn * BM + wc * 32 + 8 * fq; const PG8_LAS float* rtu = rt + ui * 256 + wr * 64 + fr; ++ui;
#pragma unroll
        for (int ai = 0; ai < 2; ++ai)
#pragma unroll
            for (int m = 0; m < 4; ++m) { const int row = u.pm * BM + ai * HALF + wr * 64 + m * 16 + fr; const float rs = rtu[ai * HALF + m * 16]; bf16_t* rowp = O + (size_t)row * 4096 + col0;
#pragma unroll
                for (int bj = 0; bj < 2; ++bj) { f32x4 v0 = acc[ai][bj][m][0] * rs, v1 = acc[ai][bj][m][1] * rs;
#pragma unroll
                    for (int e = 0; e < 4; ++e) { const float a = __builtin_fmaxf(v0[e], 0.f), b = __builtin_fmaxf(v1[e], 0.f); v0[e] = a * a; v1[e] = b * b; }
                    u32x4 w; w.x = cvt_pk_bf16(v0[0], v0[1]); w.y = cvt_pk_bf16(v0[2], v0[3]); w.z = cvt_pk_bf16(v1[0], v1[1]); w.w = cvt_pk_bf16(v1[2], v1[3]);
                    store16_wt(rowp + bj * HALF, w); } }
    }
};
struct EpiKVQ {
    static constexpr bool PERM = true, AFTER_DRAIN = false;
    bf16_t *kn, *v2, *qn; const PG8_LAS float* rt; const PG8_LAS float *gk, *gq; mutable int ui;
    __device__ __forceinline__ void operator()(const f32x4 (&acc)[2][2][4][2], const Unit& u, int wr, int wc, int fr, int fq) const {
        const int pn = u.pn; const PG8_LAS float* rtu = rt + ui * 256 + wr * 64 + fr; ++ui;
        if (pn >= 4 && pn < 8) {
            const int col0 = (pn - 4) * BM + wc * 32 + 8 * fq;
#pragma unroll
            for (int ai = 0; ai < 2; ++ai)
#pragma unroll
                for (int m = 0; m < 4; ++m) { const int row = u.pm * BM + ai * HALF + wr * 64 + m * 16 + fr; const float rs = rtu[ai * HALF + m * 16]; bf16_t* rowp = v2 + (size_t)row * 1024 + col0;
#pragma unroll
                    for (int bj = 0; bj < 2; ++bj) { const f32x4 v0 = acc[ai][bj][m][0] * rs, v1 = acc[ai][bj][m][1] * rs;
                        u32x4 w; w.x = cvt_pk_bf16(v0[0], v0[1]); w.y = cvt_pk_bf16(v0[2], v0[3]); w.z = cvt_pk_bf16(v1[0], v1[1]); w.w = cvt_pk_bf16(v1[2], v1[3]);
                        store16_wt(rowp + bj * HALF, w); } }
        } else {
            const bool isq = pn >= 8; const PG8_LAS float* gp = isq ? gq : gk; bf16_t* dst = isq ? qn : kn; const int pl = isq ? pn - 8 : pn;
            const float sc = isq ? 0.125f * 1.4426950408889634f : 1.0f;
            f32x4 gv[2][2];
#pragma unroll
            for (int bj = 0; bj < 2; ++bj)
#pragma unroll
                for (int n = 0; n < 2; ++n) gv[bj][n] = *(const PG8_LAS f32x4*)(gp + 32 * bj + 8 * fq + 4 * n) * sc;
            const int col0 = pl * BM + wc * 64 + 8 * fq;
#pragma unroll
            for (int ai = 0; ai < 2; ++ai)
#pragma unroll
                for (int m = 0; m < 4; ++m) { const int row = u.pm * BM + ai * HALF + wr * 64 + m * 16 + fr; const float rs = rtu[ai * HALF + m * 16]; bf16_t* rowp = dst + (size_t)row * 1024 + col0;
                    f32x4 x[2][2]; float s = 0.f;
#pragma unroll
                    for (int bj = 0; bj < 2; ++bj)
#pragma unroll
                        for (int n = 0; n < 2; ++n) { x[bj][n] = acc[ai][bj][m][n] * rs; s += (x[bj][n][0] * x[bj][n][0] + x[bj][n][1] * x[bj][n][1]) + (x[bj][n][2] * x[bj][n][2] + x[bj][n][3] * x[bj][n][3]); }
                    s += __shfl_xor(s, 16); s += __shfl_xor(s, 32);
                    const float r2 = __builtin_amdgcn_rsqf(s * (1.0f / 64.0f) + RMS_EPS);
#pragma unroll
                    for (int bj = 0; bj < 2; ++bj) { const f32x4 v0 = x[bj][0] * r2 * gv[bj][0], v1 = x[bj][1] * r2 * gv[bj][1];
                        u32x4 w; w.x = cvt_pk_bf16(v0[0], v0[1]); w.y = cvt_pk_bf16(v0[2], v0[3]); w.z = cvt_pk_bf16(v1[0], v1[1]); w.w = cvt_pk_bf16(v1[2], v1[3]);
                        store16_wt(rowp + 32 * bj, w); } }
        }
    }
};

template <class Epi, class Sched, bool ALIGN_EPI = false, bool SP2 = false>
__device__ __forceinline__ void gemm_phase(PG8_LAS unsigned char* lds, const Gemm g, const Sched& S, const Epi& E) {
    const int tid = threadIdx.x, wid = __builtin_amdgcn_readfirstlane(tid >> 6), lane = tid & 63, wr = wid >> 2, wc = wid & 3, fr = lane & 15, fq = lane >> 4;
    const int K = g.K, nt = K / BK;
    unsigned voffA[2], voffB[2];
#pragma unroll
    for (int i = 0; i < 2; ++i) { int R, C; stage_rc(tid * 16 + i * 8192, R, C); const int Rb = Epi::PERM ? ((R & ~31) + perm32(R & 31)) : R;
        voffA[i] = (unsigned)(R * K + C) * 2u; voffB[i] = (unsigned)(Rb * K + C) * 2u; }
    const size_t kstep = (size_t)(BK * 2);
    const size_t hstep = (size_t)HALF * K * 2;
    const size_t tstep = 2 * hstep;
    const unsigned ldsw = (unsigned)wid * 1024u;
    const int aoff = lds_byte(wr * 64 + fr, fq * 8), boff = lds_byte(wc * 32 + fr, fq * 8);
#define PG8_SA(b, h) (((b) * 2 + (h)) * HTB)
#define PG8_SB(b, h) ((4 + (b) * 2 + (h)) * HTB)
#define PG8_STAGE(bufoff, gbase, voff) do { _Pragma("unroll") for (int _i = 0; _i < 2; ++_i) \
        __builtin_amdgcn_global_load_lds((const unsigned*)((const char*)(gbase) + (voff)[_i]), (PG8_LAS unsigned*)(lds + (bufoff) + ldsw + _i * 8192), 16, 0, 0); } while (0)
#define PG8_LDA(dst, b, h) do { _Pragma("unroll") for (int m = 0; m < 4; ++m) _Pragma("unroll") for (int k = 0; k < 2; ++k) dst[m][k] = *(const PG8_LAS bf16x8*)(lds + PG8_SA(b, h) + aoff + m * 2048 + k * 1024); } while (0)
#define PG8_LDB(dst, b, h) do { _Pragma("unroll") for (int n = 0; n < 2; ++n) _Pragma("unroll") for (int k = 0; k < 2; ++k) dst[n][k] = *(const PG8_LAS bf16x8*)(lds + PG8_SB(b, h) + boff + n * 2048 + k * 1024); } while (0)
#define PG8_MMA(ai, bj, At, Bt) do { __builtin_amdgcn_s_setprio(1); _Pragma("unroll") for (int m = 0; m < 4; ++m) _Pragma("unroll") for (int n = 0; n < 2; ++n) _Pragma("unroll") for (int k = 0; k < 2; ++k) \
        acc[ai][bj][m][n] = __builtin_amdgcn_mfma_f32_16x16x32_bf16(Bt[n][k], At[m][k], acc[ai][bj][m][n], 0, 0, 0); __builtin_amdgcn_s_setprio(0); } while (0)
#define PG8_WAIT_V(n) asm volatile("s_waitcnt vmcnt(" #n ")" ::: "memory")
#define PG8_WAIT_L(n) asm volatile("s_waitcnt lgkmcnt(" #n ")" ::: "memory")
#define PG8_BAR __builtin_amdgcn_s_barrier()
#define PG8_SCHED __builtin_amdgcn_sched_barrier(0)
    Unit cur, nxt; int ui = 0;
    if (!S.next(0, cur)) return;
    f32x4 acc[2][2][4][2];
#pragma unroll
    for (int a = 0; a < 2; ++a)
#pragma unroll
        for (int b = 0; b < 2; ++b)
#pragma unroll
            for (int m = 0; m < 4; ++m)
#pragma unroll
                for (int n = 0; n < 2; ++n) acc[a][b][m][n] = (f32x4){0.f, 0.f, 0.f, 0.f};
    bf16x8 At[4][2], B0[2][2], B1[2][2];
    const char* cA = (const char*)g.A + (size_t)cur.pm * tstep; const char* cB = (const char*)g.Bt + (size_t)cur.pn * tstep;
    S.a_ready(cur);
    if constexpr (SP2) {
        PG8_STAGE(PG8_SB(0, 0), cB, voffB); PG8_STAGE(PG8_SB(0, 1), cB + hstep, voffB); PG8_STAGE(PG8_SA(0, 0), cA, voffA); PG8_STAGE(PG8_SA(0, 1), cA + hstep, voffA);
        if (wr == 1) PG8_BAR;
        PG8_WAIT_V(2); PG8_BAR;
        PG8_STAGE(PG8_SB(1, 0), cB + kstep, voffB); PG8_STAGE(PG8_SA(1, 0), cA + kstep, voffA); PG8_STAGE(PG8_SB(1, 1), cB + hstep + kstep, voffB);
        PG8_WAIT_V(6); PG8_BAR;
    } else {
        PG8_STAGE(PG8_SB(0, 0), cB, voffB); PG8_STAGE(PG8_SA(0, 0), cA, voffA); PG8_STAGE(PG8_SB(0, 1), cB + hstep, voffB); PG8_STAGE(PG8_SA(0, 1), cA + hstep, voffA);
        if (wr == 1) PG8_BAR;
        PG8_WAIT_V(4); PG8_BAR;
        PG8_STAGE(PG8_SB(1, 0), cB + kstep, voffB); PG8_STAGE(PG8_SA(1, 0), cA + kstep, voffA); PG8_STAGE(PG8_SB(1, 1), cB + hstep + kstep, voffB);
        PG8_WAIT_V(6); PG8_BAR;
    }
    for (;;) {
        const bool has_next = S.next(ui + 1, nxt);
        const char* nA = has_next ? (const char*)g.A + (size_t)nxt.pm * tstep : cA; const char* nB = has_next ? (const char*)g.Bt + (size_t)nxt.pn * tstep : cB;
        for (int t = 0; t < nt; t += 2) {
            const bool last = (t == nt - 2);
            const char* a1 = cA + (size_t)(t + 1) * kstep;
            const char* a2 = last ? nA : cA + (size_t)(t + 2) * kstep; const char* b2 = last ? nB : cB + (size_t)(t + 2) * kstep;
            const char* a3 = a2 + kstep; const char* b3 = b2 + kstep;
            if (last && has_next) S.a_ready(nxt);
            if constexpr (SP2) {
            PG8_LDB(B0, 0, 0); PG8_LDB(B1, 0, 1); PG8_SCHED; PG8_LDA(At, 0, 0); PG8_STAGE(PG8_SA(1, 1), a1 + hstep, voffA);
            PG8_WAIT_V(8); PG8_WAIT_L(0); PG8_BAR; PG8_MMA(0, 0, At, B0); PG8_MMA(0, 1, At, B1); PG8_BAR; PG8_SCHED;
            PG8_LDA(At, 0, 1); PG8_STAGE(PG8_SB(0, 0), b2, voffB); PG8_STAGE(PG8_SB(0, 1), b2 + hstep, voffB); PG8_STAGE(PG8_SA(0, 0), a2, voffA);
            PG8_WAIT_V(8); PG8_WAIT_L(0); PG8_BAR; PG8_MMA(1, 0, At, B0); PG8_MMA(1, 1, At, B1); PG8_BAR; PG8_SCHED;
            PG8_LDB(B0, 1, 0); PG8_LDB(B1, 1, 1); PG8_SCHED; PG8_LDA(At, 1, 0); PG8_STAGE(PG8_SA(0, 1), a2 + hstep, voffA);
            PG8_WAIT_V(8); PG8_WAIT_L(0); PG8_BAR; PG8_MMA(0, 0, At, B0); PG8_MMA(0, 1, At, B1); PG8_BAR; PG8_SCHED;
            PG8_LDA(At, 1, 1); PG8_STAGE(PG8_SB(1, 0), b3, voffB); PG8_STAGE(PG8_SB(1, 1), b3 + hstep, voffB); PG8_STAGE(PG8_SA(1, 0), a3, voffA);
            PG8_WAIT_V(8); PG8_WAIT_L(0); PG8_BAR; PG8_MMA(1, 0, At, B0); PG8_MMA(1, 1, At, B1); PG8_BAR; PG8_SCHED;
            } else {
            PG8_LDB(B0, 0, 0); PG8_SCHED; PG8_LDA(At, 0, 0); PG8_STAGE(PG8_SA(1, 1), a1 + hstep, voffA);
            PG8_WAIT_L(8); PG8_BAR; PG8_WAIT_L(0); PG8_MMA(0, 0, At, B0); PG8_BAR; PG8_SCHED;
            PG8_LDB(B1, 0, 1); PG8_STAGE(PG8_SB(0, 0), b2, voffB);
            PG8_BAR; PG8_WAIT_L(0); PG8_MMA(0, 1, At, B1); PG8_BAR;
            PG8_LDA(At, 0, 1); PG8_STAGE(PG8_SA(0, 0), a2, voffA);
            PG8_BAR; PG8_WAIT_L(0); PG8_MMA(1, 0, At, B0); PG8_BAR; PG8_SCHED;
            PG8_STAGE(PG8_SB(0, 1), b2 + hstep, voffB);
            PG8_WAIT_V(6); PG8_BAR; PG8_MMA(1, 1, At, B1); PG8_BAR;
            PG8_LDB(B0, 1, 0); PG8_SCHED; PG8_LDA(At, 1, 0); PG8_STAGE(PG8_SA(0, 1), a2 + hstep, voffA);
            PG8_WAIT_L(8); PG8_BAR; PG8_WAIT_L(0); PG8_MMA(0, 0, At, B0); PG8_BAR; PG8_SCHED;
            PG8_LDB(B1, 1, 1); PG8_STAGE(PG8_SB(1, 0), b3, voffB);
            PG8_BAR; PG8_WAIT_L(0); PG8_MMA(0, 1, At, B1); PG8_BAR;
            PG8_LDA(At, 1, 1); PG8_STAGE(PG8_SA(1, 0), a3, voffA);
            PG8_BAR; PG8_WAIT_L(0); PG8_MMA(1, 0, At, B0); PG8_BAR; PG8_SCHED;
            PG8_STAGE(PG8_SB(1, 1), b3 + hstep, voffB);
            PG8_WAIT_V(6); PG8_BAR; PG8_MMA(1, 1, At, B1); PG8_BAR;
            }
        }
        if constexpr (ALIGN_EPI) { if (wr == 0) PG8_BAR; }
        if constexpr (!Epi::AFTER_DRAIN) { E(acc, cur, wr, wc, fr, fq); S.done(cur); }
        if (!has_next) break;
#pragma unroll
        for (int a = 0; a < 2; ++a)
#pragma unroll
            for (int b = 0; b < 2; ++b)
#pragma unroll
                for (int m = 0; m < 4; ++m)
#pragma unroll
                    for (int n = 0; n < 2; ++n) acc[a][b][m][n] = (f32x4){0.f, 0.f, 0.f, 0.f};
        cur = nxt; cA = nA; cB = nB; ++ui;
        if constexpr (ALIGN_EPI) { if (wr == 1) PG8_BAR; }
    }
    PG8_WAIT_V(0);
    if constexpr (!ALIGN_EPI) { if (wr == 0) PG8_BAR; }
    PG8_BAR;
    if constexpr (Epi::AFTER_DRAIN) { E.fused(acc, cur, wr, wc, fr, fq, lds, wid, lane); S.done(cur); }
#undef PG8_SA
#undef PG8_SB
#undef PG8_STAGE
#undef PG8_LDA
#undef PG8_LDB
#undef PG8_MMA
#undef PG8_WAIT_V
#undef PG8_WAIT_L
#undef PG8_BAR
#undef PG8_SCHED
}
}

#ifndef PG8_SP2
#define PG8_SP2 true
#endif
#ifndef PG8_ALIGN
#define PG8_ALIGN true
#endif

#include <hip/hip_bf16.h>
#include <cmath>
namespace attn_body {
using bf16=__hip_bfloat16;
using bf16x8=__attribute__((ext_vector_type(8)))short;
using s16x4=__attribute__((ext_vector_type(4)))short;
using f32x16=__attribute__((ext_vector_type(16)))float;
using u32x4=__attribute__((ext_vector_type(4)))unsigned;
constexpr int BATCH=4,NHC=16,SEQ=4096,D=64,DVV=128;
constexpr int QP=1024,KP=1024,VP=1024,OP=2048;
constexpr int NW=8,QBLK=32,QB=QBLK*NW,KVBLK=64,NQB=SEQ/QB;
constexpr int ATTN_UNIT_ROWS=QB;
__device__ __forceinline__ int crow(int r,int hi){return (r&3)+8*(r>>2)+4*hi;}
#define SBAR() __builtin_amdgcn_sched_barrier(0)
__device__ __forceinline__ void cmask(f32x16&p0,f32x16&p1,int jb,int qrel,int hi){
  const float NEG=-INFINITY; int kb=64*jb+4*hi;
  #pragma unroll
  for(int r=0;r<16;++r){int kv=kb+(r&3)+8*(r>>2); if(kv>qrel)p0[r]=NEG; if(kv+32>qrel)p1[r]=NEG;}
}

constexpr int NSLOT=3, SLOTB=8192, VSLOTB=2*SLOTB;
constexpr int LDS_K=0, LDS_V=NSLOT*SLOTB, LDS_WS=LDS_V+NSLOT*VSLOTB, LDS_OST=LDS_WS+NW*64*4, LDS_BYTES=LDS_OST+NW*4096;
constexpr float C2=0.125f*1.4426950408889634f;
__device__ __forceinline__ void glds16(const void*gsrc,unsigned lds_dst){unsigned keep;
  asm volatile("s_mov_b32 %0, m0\n\ts_mov_b32 m0, %2\n\ts_nop 0\n\tglobal_load_lds_dwordx4 %1, off\n\ts_mov_b32 m0, %0":"=&s"(keep):"v"(gsrc),"s"(lds_dst):"memory");}
__device__ __forceinline__ float max3f(float a,float b,float c){float r;asm("v_max3_f32 %0, %1, %2, %3":"=v"(r):"v"(a),"v"(b),"v"(c));return r;}
__device__ __forceinline__ float max2f(float a,float b){float r;asm("v_max_f32_e32 %0, %1, %2":"=v"(r):"v"(a),"v"(b));return r;}
__device__ __forceinline__ float fadd_s(float a,float b){float r;asm("v_add_f32_e32 %0, %1, %2":"=v"(r):"v"(a),"v"(b));return r;}
__device__ __forceinline__ float fsub_s(float a,float b){float r;asm("v_sub_f32_e32 %0, %1, %2":"=v"(r):"v"(a),"v"(b));return r;}
typedef float f32x2_t __attribute__((ext_vector_type(2))); typedef __bf16 bf16x2_t __attribute__((ext_vector_type(2)));
__device__ __forceinline__ unsigned cvtpk_s(float lo,float hi){f32x2_t v={lo,hi};bf16x2_t b=__builtin_convertvector(v,bf16x2_t);return __builtin_bit_cast(unsigned,b);}
#define WAIT_BAR(N) asm volatile("s_waitcnt vmcnt(" #N ") lgkmcnt(0)\n\ts_barrier":::"memory")

__device__ __forceinline__ void qkt(f32x16&p0,f32x16&p1,const char*Kslot,const bf16x8*qr,const f32x16&negm,int r32,int hi){
  const char*kb=Kslot+hi*1024+r32*16;
  #pragma unroll
  for(int d0=0;d0<4;++d0){
    const bf16x8 b0=*reinterpret_cast<const bf16x8*>(kb+d0*2048);
    const bf16x8 b1=*reinterpret_cast<const bf16x8*>(kb+d0*2048+512);
    if(d0==0){p0=__builtin_amdgcn_mfma_f32_32x32x16_bf16(b0,qr[0],negm,0,0,0);p1=__builtin_amdgcn_mfma_f32_32x32x16_bf16(b1,qr[0],negm,0,0,0);}
    else{p0=__builtin_amdgcn_mfma_f32_32x32x16_bf16(b0,qr[d0],p0,0,0,0);p1=__builtin_amdgcn_mfma_f32_32x32x16_bf16(b1,qr[d0],p1,0,0,0);}}
}
typedef __attribute__((address_space(3))) const char* lds_cptr;
typedef short v4i16_t __attribute__((ext_vector_type(4)));
__device__ __forceinline__ void kload8(bf16x8*kf,lds_cptr kp){
  kf[0]=*(const __attribute__((address_space(3))) bf16x8*)(kp);      kf[1]=*(const __attribute__((address_space(3))) bf16x8*)(kp+512);
  kf[2]=*(const __attribute__((address_space(3))) bf16x8*)(kp+2048); kf[3]=*(const __attribute__((address_space(3))) bf16x8*)(kp+2560);
  kf[4]=*(const __attribute__((address_space(3))) bf16x8*)(kp+4096); kf[5]=*(const __attribute__((address_space(3))) bf16x8*)(kp+4608);
  kf[6]=*(const __attribute__((address_space(3))) bf16x8*)(kp+6144); kf[7]=*(const __attribute__((address_space(3))) bf16x8*)(kp+6656);
}
__device__ __forceinline__ void kload2(bf16x8*kf,lds_cptr kp,int j){ kf[2*j]=*(const __attribute__((address_space(3))) bf16x8*)(kp+j*2048); kf[2*j+1]=*(const __attribute__((address_space(3))) bf16x8*)(kp+j*2048+512); }
__device__ __forceinline__ s16x4 vtr(lds_cptr p){ return __builtin_bit_cast(s16x4,__builtin_amdgcn_ds_read_tr16_b64_v4i16((__attribute__((address_space(3))) v4i16_t*)p)); }
__device__ __forceinline__ float rowmax(const f32x16&p0,const f32x16&p1){
  float a=max3f(p0[0],p0[1],p1[0]),b=max3f(p0[2],p0[3],p1[1]);a=max3f(a,p1[2],p1[3]);
  #pragma unroll
  for(int r=4;r<16;r+=4){a=max3f(a,p0[r],p0[r+1]);b=max3f(b,p0[r+2],p0[r+3]);a=max3f(a,p1[r],p1[r+1]);b=max3f(b,p1[r+2],p1[r+3]);}
  const float m=max2f(a,b);
  auto rr=__builtin_amdgcn_permlane32_swap(__float_as_uint(m),__float_as_uint(m),false,false);
  return max2f(__uint_as_float(rr[0]),__uint_as_float(rr[1]));
}
__device__ __forceinline__ void pv(f32x16*o,int vb,bf16x8 pa0,bf16x8 pa1,bf16x8 pa2,bf16x8 pa3){
  #pragma unroll
  for(int d0=0;d0<4;++d0){s16x4 lo[4],hi[4];
    #pragma unroll
    for(int ks=0;ks<4;++ks){
      asm volatile("ds_read_b64_tr_b16 %0,%1 offset:%c2":"=&v"(lo[ks]):"v"(vb),"i"(d0*4096+ks*1024):"memory");
      asm volatile("ds_read_b64_tr_b16 %0,%1 offset:%c2":"=&v"(hi[ks]):"v"(vb),"i"(d0*4096+ks*1024+512):"memory");}
    asm volatile("s_waitcnt lgkmcnt(0)":::"memory");SBAR();
    #define PK(k) (bf16x8){lo[k][0],lo[k][1],lo[k][2],lo[k][3],hi[k][0],hi[k][1],hi[k][2],hi[k][3]}
    o[d0]=__builtin_amdgcn_mfma_f32_32x32x16_bf16(pa0,PK(0),o[d0],0,0,0);
    o[d0]=__builtin_amdgcn_mfma_f32_32x32x16_bf16(pa1,PK(1),o[d0],0,0,0);
    o[d0]=__builtin_amdgcn_mfma_f32_32x32x16_bf16(pa2,PK(2),o[d0],0,0,0);
    o[d0]=__builtin_amdgcn_mfma_f32_32x32x16_bf16(pa3,PK(3),o[d0],0,0,0);
    #undef PK
  }
}

#ifndef ATTN_STORE16
#define ATTN_STORE16(p,v) (*(u32x4*)(p)=(v))
#endif
template<int THRL> __device__ __forceinline__ void attn_unit(int b,int hc,int qb,const bf16*Q,const bf16*__restrict__ K,const bf16*__restrict__ V,bf16*O,char*shm){
  const int qkcol=hc*D, vcol=(hc>>1)*DVV, ocol=hc*DVV;
  const int tid=threadIdx.x,lane=tid&63,r32=lane&31,hi=lane>>5; const int wid=__builtin_amdgcn_readfirstlane(tid>>6);
  const long rowbase=(long)b*SEQ; const int q0=qb*QB;
  const bf16*Qw=Q+(rowbase+q0+wid*QBLK)*QP+qkcol;
  const bf16*Kh=K+rowbase*KP+qkcol,*Vh=V+rowbase*VP+vcol;
  const unsigned lds0=(unsigned)(uintptr_t)shm;
  float*wsf=(float*)(shm+LDS_WS)+wid*64;
  const bf16*ksrc=Kh+(long)lane*KP+wid*8;
  const bf16*vsrc=Vh+(long)(16*(wid&3)+(lane>>2))*VP+(wid>>2)*32+(lane&3)*8;
  const unsigned kdst=lds0+LDS_K+wid*1024, vdst=lds0+LDS_V+wid*1024;
  #define DMA_K(t,slot) glds16(ksrc+(long)(t)*KVBLK*KP,(unsigned)__builtin_amdgcn_readfirstlane(kdst+(slot)))
  #define DMA_V(t,slot) do{ glds16(vsrc+(long)(t)*KVBLK*VP,(unsigned)__builtin_amdgcn_readfirstlane(vdst+2*(slot))); glds16(vsrc+64+(long)(t)*KVBLK*VP,(unsigned)__builtin_amdgcn_readfirstlane(vdst+2*(slot)+8192)); }while(0)
  const int vb0=(int)(lds0+LDS_V)+((lane>>4)&1)*32+(lane&3)*8+(4*hi+((lane&15)>>2))*64;
  const char*Kbase=shm+LDS_K; bf16x8 kf[8];
  const lds_cptr shm3=(lds_cptr)shm; const lds_cptr kp0=shm3+LDS_K+hi*1024+r32*16; const lds_cptr vp0=shm3+LDS_V+((lane>>4)&1)*32+(lane&3)*8+(4*hi+((lane&15)>>2))*64;
  const int NT=(q0+QB)/KVBLK;
  DMA_K(0,0);DMA_V(0,0);DMA_K(1,SLOTB);
  bf16x8 qr[4];
  #pragma unroll
  for(int d0=0;d0<4;++d0)qr[d0]=*reinterpret_cast<const bf16x8*>(&Qw[(long)r32*QP+d0*16+hi*8]);
  float mhat=0.f,l_reg=0.f;f32x16 o[4];o[0]=f32x16{};o[1]=f32x16{};o[2]=f32x16{};o[3]=f32x16{};
  const int qrel=wid*QBLK+r32;
  #define CMASK(P0,P1,t) do{int jb_=(t)-(NT-4); if(jb_>=0)cmask(P0,P1,jb_,qrel,hi);}while(0)
  bool resc=false;
  #define START(P0,P1) do{ const float rm=rowmax(P0,P1); resc=false; \
    { const float dl=rm; mhat=fadd_s(mhat,dl); \
      _Pragma("unroll") for(int r=0;r<16;++r){P0[r]=fsub_s(P0[r],dl);P1[r]=fsub_s(P1[r],dl);} } \
    _Pragma("unroll") for(int r=0;r<16;++r)P0[r]=__builtin_amdgcn_exp2f(P0[r]); }while(0)
  #define RESC() do{ if(resc){ asm volatile("s_waitcnt lgkmcnt(0)":::"memory"); \
      _Pragma("unroll") for(int d_=0;d_<4;++d_) _Pragma("unroll") for(int r=0;r<16;++r)o[d_][r]*=wsf[crow(r,hi)]; } }while(0)
  f32x16 pA0,pA1,pB0,pB1;
  int sl_prev=0,sl_cur=0,sl_next=SLOTB;
  #define ROT() do{sl_prev=sl_cur;sl_cur=sl_next;sl_next=(sl_next==(NSLOT-1)*SLOTB)?0:sl_next+SLOTB;}while(0)
  DMA_K(2,2*SLOTB);
  WAIT_BAR(4);
  { const f32x16 z0=f32x16{}; qkt(pA0,pA1,Kbase,qr,z0,r32,hi); }asm volatile("s_nop 15\n\ts_nop 7":"+v"(pA0),"+v"(pA1));CMASK(pA0,pA1,0);
  START(pA0,pA1);
  _Pragma("unroll") for(int r=0;r<16;++r)pA1[r]=__builtin_amdgcn_exp2f(pA1[r]);
  WAIT_BAR(0);
  DMA_K(3,0);DMA_V(1,SLOTB);
  ROT();
  kload8(kf,kp0+sl_cur);
  WAIT_BAR(3);
  s16x4 vlo[4],vhi[4]; u32x4 pw0,pw1,pw2,pw3;
  #define PKW(P,B) cvtpk_s(P[B],P[B+1])
  #define PAF(k) __builtin_bit_cast(bf16x8,pw##k)
  #define VFR(i) (bf16x8){vlo[i][0],vlo[i][1],vlo[i][2],vlo[i][3],vhi[i][0],vhi[i][1],vhi[i][2],vhi[i][3]}
  #define PIN(x) asm volatile("":"+v"(x))
  #define MX3(a,b,c) __builtin_fmaxf(__builtin_fmaxf((a),(b)),(c))
  #define GAPA(MF,A0,A1,A2,A3,W0,W1,PW) do{ MF; sacc+=A0; sacc+=A1; sacc+=A2; sacc+=A3; PIN(sacc); W0; W1; PIN(PW); SBAR(); }while(0)
  #define EX(v) __builtin_amdgcn_exp2f(v)
  #define GAPB(MF,X,B) do{ MF; X[B]=EX(X[B]-mhat); X[B+1]=EX(X[B+1]-mhat); PIN(X); SBAR(); }while(0)
  #define VRD(p,i) do{ vlo[p]=vtr(vp_+(((i)>>2)*4096+((i)&3)*1024)); vhi[p]=vtr(vp_+(((i)>>2)*4096+((i)&3)*1024+512)); }while(0)
  #define KRD(G,j) do{ if(G){ kload2(kf,kp0+sl_next,j); SBAR(); } }while(0)
  #define ZC (f32x16{})
  #define STEP(C0,C1,P0,P1,t,GK,GV,GL) do{ SBAR(); \
    const lds_cptr vp_=vp0+2*sl_prev; \
    float sacc=(P0[0]+P0[1]); \
    GAPA(C0=__builtin_amdgcn_mfma_f32_32x32x16_bf16(kf[0],qr[0],ZC,0,0,0), P0[2],P0[3],P0[4],P0[5],     pw0[0]=PKW(P0,0), pw0[1]=PKW(P0,2), pw0); \
    GAPA(C1=__builtin_amdgcn_mfma_f32_32x32x16_bf16(kf[1],qr[0],ZC,0,0,0), P0[6],P0[7],P0[8],P0[9],     pw0[2]=PKW(P0,4), pw0[3]=PKW(P0,6), pw0); \
    GAPA(C0=__builtin_amdgcn_mfma_f32_32x32x16_bf16(kf[2],qr[1],C0,0,0,0),   P0[10],P0[11],P0[12],P0[13], pw1[0]=PKW(P0,8), pw1[1]=PKW(P0,10), pw1); \
    GAPA(C1=__builtin_amdgcn_mfma_f32_32x32x16_bf16(kf[3],qr[1],C1,0,0,0),   P0[14],P0[15],P1[0],P1[1],   pw1[2]=PKW(P0,12),pw1[3]=PKW(P0,14), pw1); \
    GAPA(C0=__builtin_amdgcn_mfma_f32_32x32x16_bf16(kf[4],qr[2],C0,0,0,0),   P1[2],P1[3],P1[4],P1[5],     pw2[0]=PKW(P1,0), pw2[1]=PKW(P1,2), pw2); \
    VRD(0,0); SBAR(); GAPA(C1=__builtin_amdgcn_mfma_f32_32x32x16_bf16(kf[5],qr[2],C1,0,0,0),   P1[6],P1[7],P1[8],P1[9],     pw2[2]=PKW(P1,4), pw2[3]=PKW(P1,6), pw2); \
    VRD(1,4); SBAR(); GAPA(C0=__builtin_amdgcn_mfma_f32_32x32x16_bf16(kf[6],qr[3],C0,0,0,0),   P1[10],P1[11],P1[12],P1[13], pw3[0]=PKW(P1,8), pw3[1]=PKW(P1,10), pw3); \
    VRD(2,1); SBAR(); GAPA(C1=__builtin_amdgcn_mfma_f32_32x32x16_bf16(kf[7],qr[3],C1,0,0,0),   P1[14],P1[15],0.f,0.f,       pw3[2]=PKW(P1,12),pw3[3]=PKW(P1,14), pw3); \
    l_reg+=sacc; \
    if(GK){DMA_K((t)+3,sl_cur);} if(GV){DMA_V((t)+1,sl_next);} \
    CMASK(C0,C1,t); \
    { float a=MX3(C0[0],C0[1],C1[0]),b=MX3(C0[2],C0[3],C1[1]); a=MX3(a,C1[2],C1[3]); \
      _Pragma("unroll") for(int r=4;r<16;r+=4){a=MX3(a,C0[r],C0[r+1]);b=MX3(b,C0[r+2],C0[r+3]);a=MX3(a,C1[r],C1[r+1]);b=MX3(b,C1[r+2],C1[r+3]);} \
      float rm=__builtin_fmaxf(a,b); { auto rr=__builtin_amdgcn_permlane32_swap(__float_as_uint(rm),__float_as_uint(rm),false,false); rm=__builtin_fmaxf(__uint_as_float(rr[0]),__uint_as_float(rr[1])); } \
      rm-=mhat; resc=false; \
      if(__builtin_expect(__any(rm>(float)THRL),0)){ const float dl=__builtin_fmaxf(rm,0.f); mhat+=dl; \
        const float f=__builtin_amdgcn_exp2f(-dl); l_reg*=f; if(hi==0)wsf[r32]=f; resc=true; } } \
    SBAR(); \
    VRD(3,5);  SBAR(); GAPB(o[0]=__builtin_amdgcn_mfma_f32_32x32x16_bf16(PAF(0),VFR(0),o[0],0,0,0), C0,0); \
    VRD(0,2);  SBAR(); GAPB(o[1]=__builtin_amdgcn_mfma_f32_32x32x16_bf16(PAF(0),VFR(1),o[1],0,0,0), C0,2); \
    VRD(1,6);  SBAR(); KRD(GL,0); GAPB(o[0]=__builtin_amdgcn_mfma_f32_32x32x16_bf16(PAF(1),VFR(2),o[0],0,0,0), C0,4); \
    VRD(2,3);  SBAR(); KRD(GL,1); GAPB(o[1]=__builtin_amdgcn_mfma_f32_32x32x16_bf16(PAF(1),VFR(3),o[1],0,0,0), C0,6); \
    VRD(3,7);  SBAR(); KRD(GL,2); GAPB(o[0]=__builtin_amdgcn_mfma_f32_32x32x16_bf16(PAF(2),VFR(0),o[0],0,0,0), C0,8); \
    VRD(0,8);  SBAR(); KRD(GL,3); GAPB(o[1]=__builtin_amdgcn_mfma_f32_32x32x16_bf16(PAF(2),VFR(1),o[1],0,0,0), C0,10); \
    VRD(1,12); SBAR(); GAPB(o[0]=__builtin_amdgcn_mfma_f32_32x32x16_bf16(PAF(3),VFR(2),o[0],0,0,0), C0,12); \
    VRD(2,9);  SBAR(); GAPB(o[1]=__builtin_amdgcn_mfma_f32_32x32x16_bf16(PAF(3),VFR(3),o[1],0,0,0), C0,14); \
    VRD(3,13); SBAR(); GAPB(o[2]=__builtin_amdgcn_mfma_f32_32x32x16_bf16(PAF(0),VFR(0),o[2],0,0,0), C1,0); \
    VRD(0,10); SBAR(); GAPB(o[3]=__builtin_amdgcn_mfma_f32_32x32x16_bf16(PAF(0),VFR(1),o[3],0,0,0), C1,2); \
    VRD(1,14); SBAR(); GAPB(o[2]=__builtin_amdgcn_mfma_f32_32x32x16_bf16(PAF(1),VFR(2),o[2],0,0,0), C1,4); \
    VRD(2,11); SBAR(); GAPB(o[3]=__builtin_amdgcn_mfma_f32_32x32x16_bf16(PAF(1),VFR(3),o[3],0,0,0), C1,6); \
    VRD(3,15); SBAR(); GAPB(o[2]=__builtin_amdgcn_mfma_f32_32x32x16_bf16(PAF(2),VFR(0),o[2],0,0,0), C1,8); \
    GAPB(o[3]=__builtin_amdgcn_mfma_f32_32x32x16_bf16(PAF(2),VFR(1),o[3],0,0,0), C1,10); \
    GAPB(o[2]=__builtin_amdgcn_mfma_f32_32x32x16_bf16(PAF(3),VFR(2),o[2],0,0,0), C1,12); \
    GAPB(o[3]=__builtin_amdgcn_mfma_f32_32x32x16_bf16(PAF(3),VFR(3),o[3],0,0,0), C1,14); \
    }while(0)
  int t=1;
  #undef CMASK
  #define CMASK(P0,P1,t) do{}while(0)
  for(;t+5<NT;t+=2){
    STEP(pB0,pB1,pA0,pA1,t,true,true,true);     WAIT_BAR(3); RESC(); ROT();
    STEP(pA0,pA1,pB0,pB1,t+1,true,true,true);   WAIT_BAR(3); RESC(); ROT();
  }
  #undef CMASK
  #define CMASK(P0,P1,t) do{int jb_=(t)-(NT-4); if(jb_>=0)cmask(P0,P1,jb_,qrel,hi);}while(0)
  #define ENDW(tt) do{ if((tt)+3<NT){WAIT_BAR(3);} else if((tt)+2<NT){WAIT_BAR(2);} else {WAIT_BAR(0);} }while(0)
  for(;t+1<NT;t+=2){
    STEP(pB0,pB1,pA0,pA1,t,(t+3<NT),(t+1<NT),(t+1<NT));       ENDW(t);   RESC(); ROT();
    STEP(pA0,pA1,pB0,pB1,t+1,(t+4<NT),(t+2<NT),(t+2<NT));     ENDW(t+1); RESC(); ROT();
  }
  STEP(pB0,pB1,pA0,pA1,NT-1,false,false,false); RESC();
  { float sacc=pB0[0]+pB0[1]; _Pragma("unroll") for(int r=2;r<16;++r)sacc+=pB0[r]; _Pragma("unroll") for(int r=0;r<16;++r)sacc+=pB1[r]; l_reg+=sacc;
    pw0=(u32x4){PKW(pB0,0),PKW(pB0,2),PKW(pB0,4),PKW(pB0,6)};pw1=(u32x4){PKW(pB0,8),PKW(pB0,10),PKW(pB0,12),PKW(pB0,14)};pw2=(u32x4){PKW(pB1,0),PKW(pB1,2),PKW(pB1,4),PKW(pB1,6)};pw3=(u32x4){PKW(pB1,8),PKW(pB1,10),PKW(pB1,12),PKW(pB1,14)};
    SBAR(); pv(o,vb0+2*sl_cur,PAF(0),PAF(1),PAF(2),PAF(3)); }
  #undef PKW
  #undef PAF
  #undef VFR
  #undef PIN
  #undef MX3
  #undef GAPA
  #undef GAPB
  #undef EX
  #undef VRD
  #undef KRD
  #undef STEP
  #undef ZC
  #undef ENDW
  {auto rr=__builtin_amdgcn_permlane32_swap(__float_as_uint(l_reg),__float_as_uint(l_reg),false,false);l_reg=__uint_as_float(rr[0])+__uint_as_float(rr[1]);}
  if(hi==0)wsf[32+r32]=l_reg;asm volatile("s_waitcnt lgkmcnt(0)":::"memory");
  float rli[16];
  #pragma unroll
  for(int r=0;r<16;++r)rli[r]=__builtin_amdgcn_rcpf(wsf[32+crow(r,hi)]);
  bf16*Ow=O+(rowbase+q0+wid*QBLK)*OP+ocol;
  { bf16*stg=(bf16*)(shm+LDS_OST)+wid*2048;
    #pragma unroll
    for(int h2=0;h2<2;++h2){
    #pragma unroll
    for(int r=0;r<16;++r){const int orow=crow(r,hi);
      #pragma unroll
      for(int d0=0;d0<2;++d0)stg[orow*64+d0*32+r32]=__float2bfloat16(o[2*h2+d0][r]*rli[r]);}
    asm volatile("s_waitcnt lgkmcnt(0)":::"memory");
    #pragma unroll
    for(int i=0;i<4;++i){const int row=i*8+(lane>>3),ch=lane&7; const u32x4 v=*(const u32x4*)(stg+row*64+ch*8); ATTN_STORE16(Ow+(long)row*OP+h2*64+ch*8,v);}
    asm volatile("s_waitcnt lgkmcnt(0)":::"memory"); } }
  asm volatile("s_waitcnt lgkmcnt(0)\n\ts_barrier":::"memory");
  #undef DMA_K
  #undef DMA_V
  #undef CMASK
  #undef START
  #undef RESC
  #undef ROT
}
constexpr int ATTN_LDS_BYTES=LDS_BYTES;
struct AttnTensors { const bf16* Q; const bf16* K; const bf16* V; bf16* O; };
struct AttnUnit { int bh; int qb; };
struct StaticOrder {
  int vcu;
  __device__ __forceinline__ explicit StaticOrder(int grid,int block):vcu((block%8)*(grid/8)+block/8){}
  __device__ __forceinline__ bool next(int i,AttnUnit&u)const{ if(i>=4)return false; const int p=vcu&7; u.bh=(vcu>>3)*2+(i>>1); u.qb=(i&1)?15-p:p; return true; }
  __device__ __forceinline__ void a_ready(const AttnUnit&)const{}
  __device__ __forceinline__ void done(const AttnUnit&)const{}
};
template<class Sched,int THRL=8> __device__ __forceinline__ void attn_phase(char*lds,const AttnTensors&T,const Sched&S){
  AttnUnit u;
  for(int i=0;S.next(i,u);++i){ S.a_ready(u); attn_unit<THRL>(u.bh/NHC,u.bh%NHC,u.qb,T.Q,T.K,T.V,T.O,lds); S.done(u); }
}
#undef SBAR
#undef WAIT_BAR
}

#define GAS __attribute__((address_space(1)))
#define LAS __attribute__((address_space(3)))
typedef unsigned v4u __attribute__((ext_vector_type(4)));
typedef GAS unsigned gu32;
typedef GAS unsigned long long gu64;
#define RLX_AGENT __ATOMIC_RELAXED, __HIP_MEMORY_SCOPE_AGENT
#define LDS_WAIT() asm volatile("s_waitcnt lgkmcnt(0)" ::: "memory")
#define VM_WAIT() asm volatile("s_waitcnt vmcnt(0)" ::: "memory")
__device__ __forceinline__ unsigned pk2(float lo, float hi) { return f2bf(lo) | (f2bf(hi) << 16); }

#define XB_TMO      128
#define XB_XCNT(j)  (256  + 64 * (j))
#define XB_XSUB(j)  (1280 + 64 * (j))
#define XB_XGEN(j)  (2304 + 64 * (j))
#define XB_TOP      3328
#define XB_TOPGEN   3392
#define XCD_BAR_WORDS 3456
#define XB_SPIN_CAP (1u << 18)

__device__ __forceinline__ unsigned xb_ld(unsigned* p)              { return __hip_atomic_load(p, __ATOMIC_RELAXED, __HIP_MEMORY_SCOPE_AGENT); }
__device__ __forceinline__ unsigned xb_add(unsigned* p, unsigned v) { return __hip_atomic_fetch_add(p, v, __ATOMIC_RELAXED, __HIP_MEMORY_SCOPE_AGENT); }
__device__ __forceinline__ unsigned xb_xcc_id() { return (unsigned)__builtin_amdgcn_s_getreg((3 << 11) | 20) & 0xFu; }
#define XB_SPIN(cond, bar) do { unsigned _sp = 0; while (cond) { __builtin_amdgcn_s_sleep(1); \
    if ((++_sp & 255u) == 0u) { if (xb_ld(&(bar)[XB_TMO])) break; if (_sp > XB_SPIN_CAP) { atomicAdd(&(bar)[XB_TMO], 1u); break; } } } } while (0)

struct XcdBarrier {
    unsigned* bar; unsigned x;
    volatile LAS unsigned* st;
};

__device__ __forceinline__ XcdBarrier xcd_barrier_post(unsigned* bar, volatile LAS unsigned* st) {
    XcdBarrier b; b.bar = bar; b.x = xb_xcc_id(); b.st = st;
    if (threadIdx.x == 0) (void)xb_add(&bar[XB_XCNT(b.x)], 1u);
    return b;
}
__device__ __forceinline__ void xcd_barrier_complete(unsigned* bar, unsigned x, unsigned& nloc, unsigned& nx) {
    const unsigned G = gridDim.x * gridDim.y * gridDim.z;
    unsigned sum, cnt, mine, sp = 0u;
    for (;;) {
        sum = 0u; cnt = 0u; mine = 0u;
#pragma unroll
        for (unsigned j = 0; j < 16; ++j) { const unsigned c = xb_ld(&bar[XB_XCNT(j)]); sum += c; cnt += (c > 0u) ? 1u : 0u; mine = (j == x) ? c : mine; }
        if (sum == G) break;
        __builtin_amdgcn_s_sleep(1);
        if ((++sp & 255u) == 0u) { if (xb_ld(&bar[XB_TMO])) break; if (sp > XB_SPIN_CAP) { atomicAdd(&bar[XB_TMO], 1u); break; } }
    }
    nloc = mine > 0u ? mine : 1u; nx = cnt > 0u ? cnt : 1u;
}

__device__ __forceinline__ void xcd_barrier(const XcdBarrier& b) {
    asm volatile("s_waitcnt vmcnt(0)" ::: "memory");
    __syncthreads();
    if (threadIdx.x == 0) {
        unsigned* bar = b.bar;
        __builtin_amdgcn_s_waitcnt(0);
        unsigned nloc = b.st[0], nx = b.st[1];
        if (nloc == 0u) { xcd_barrier_complete(bar, b.x, nloc, nx); b.st[0] = nloc; b.st[1] = nx; }
        const unsigned old = xb_add(&bar[XB_XSUB(b.x)], 1u);
        const unsigned gen = old / nloc;
        if (old + 1u == (gen + 1u) * nloc) {
            __builtin_amdgcn_fence(__ATOMIC_RELEASE, "agent");
            asm volatile("s_waitcnt vmcnt(0)" ::: "memory");
            const unsigned og = xb_add(&bar[XB_TOP], 1u);
            const unsigned tg = og / nx;
            if (og + 1u == (tg + 1u) * nx) xb_add(&bar[XB_TOPGEN], 1u);
            else XB_SPIN(xb_ld(&bar[XB_TOPGEN]) == tg, bar);
            __builtin_amdgcn_fence(__ATOMIC_ACQUIRE, "agent");
            xb_add(&bar[XB_XGEN(b.x)], 1u);
            asm volatile("s_waitcnt vmcnt(0)" ::: "memory");
        } else {
            XB_SPIN(xb_ld(&bar[XB_XGEN(b.x)]) == gen, bar);
            __builtin_amdgcn_fence(__ATOMIC_ACQUIRE, "agent");
            asm volatile("s_waitcnt vmcnt(0)" ::: "memory");
        }
    }
    __syncthreads();
}

constexpr int NWAVES = 8;
constexpr int RING_OFF = 0, RING_BYTES = 131072;
constexpr int LDSCTL_OFF = RING_BYTES, MISC_OFF = LDSCTL_OFF + 320;
constexpr int LDS_BYTES = 147456;
constexpr int CW_BAR = 4096;

struct Frame {
    LAS unsigned char* lds;
    volatile LAS unsigned* MISC;
    gu32* ctl;
    int tid, lane, wave, vcu, G;
    const float* in[19]; float* out; unsigned char* ws;
};
struct WDesc { const float* W; const float* gain; bf16* WT; int ldn, c0, K, ncols, roff, mode; };
__device__ __forceinline__ WDesc wdesc(const Frame& F, int i) {
    unsigned char* ws = F.ws; WDesc d;
    switch (i) {
    case 0:  d = WDesc{F.in[2], F.in[1], (bf16*)(ws + WS_WIN), GIN, 0, D, 3072, 0, 0}; break;
    case 1:  d = WDesc{F.in[6], nullptr, (bf16*)(ws + WS_WAO), D, 0, D, D, 0, 0}; break;
    case 2:  d = WDesc{F.in[17], F.in[16], (bf16*)(ws + WS_W1A), FF, 0, D, FF, 0, 0}; break;
    case 3:  d = WDesc{F.in[18], nullptr, (bf16*)(ws + WS_W2A), D, 0, FF, D, 0, 0}; break;
    case 4:  d = WDesc{F.in[8], F.in[7], (bf16*)(ws + WS_WKVQ), 2048, 0, D, 2048, 0, 1}; break;
    case 5:  d = WDesc{F.in[11], F.in[10], (bf16*)(ws + WS_WKVQ), D, 0, D, D, 2048, 1}; break;
    case 6:  d = WDesc{F.in[15], nullptr, (bf16*)(ws + WS_WBO), D, 0, D, D, 0, 0}; break;
    case 7:  d = WDesc{F.in[17] + (size_t)D * FF, F.in[16] + D, (bf16*)(ws + WS_W1B), FF, 0, D, FF, 0, 0}; break;
    default: d = WDesc{F.in[18] + (size_t)D * FF, nullptr, (bf16*)(ws + WS_W2B), D, 0, FF, D, 0, 0}; break;
    }
    return d;
}
__device__ __forceinline__ void p0_transpose_item(const WDesc& d, LAS float* scr, int item, int lane) {
    const int nblk = d.ncols / 64, kb = item / nblk, nb = item % nblk, k0 = 64 * kb, n0 = 64 * nb;
    const int kq = lane >> 4, n4 = (lane & 15) * 4;
    f32x4 v[16];
#pragma unroll
    for (int i = 0; i < 16; ++i) v[i] = __builtin_nontemporal_load((const GAS f32x4*)(d.W + (size_t)(k0 + 4 * i + kq) * d.ldn + d.c0 + n0 + n4));
    const int c = lane & 7;
    f32x4 g0 = (f32x4){1.f, 1.f, 1.f, 1.f}, g1 = g0;
    if (d.gain) { g0 = *(const GAS f32x4*)(d.gain + k0 + 8 * c); g1 = *(const GAS f32x4*)(d.gain + k0 + 8 * c + 4); }
#pragma unroll
    for (int i = 0; i < 16; ++i) { const int kk = 4 * i + kq; *(LAS f32x4*)(scr + kk * 64 + (n4 ^ (kk & 0x38))) = v[i]; }
    LDS_WAIT(); asm volatile("" ::: "memory");
#pragma unroll
    for (int jj = 0; jj < 8; ++jj) { const int n = (lane >> 3) + 8 * jj; const LAS float* sp = scr + (8 * c) * 64 + (n ^ (c << 3));
        const int dr = d.mode ? kvq_dest_row(d.roff + n0 + n) : d.roff + n0 + n;
        v4u o; o.x = pk2(sp[0 * 64] * g0[0], sp[1 * 64] * g0[1]); o.y = pk2(sp[2 * 64] * g0[2], sp[3 * 64] * g0[3]); o.z = pk2(sp[4 * 64] * g1[0], sp[5 * 64] * g1[1]); o.w = pk2(sp[6 * 64] * g1[2], sp[7 * 64] * g1[3]);
        pg8::store16_wt((void*)(d.WT + (size_t)dr * d.K + k0 + 8 * c), o); }
    LDS_WAIT(); asm volatile("" ::: "memory");
}
__device__ __forceinline__ float wave_sum(float v) {
#pragma unroll
    for (int o = 1; o < 64; o <<= 1) v += __shfl_xor(v, o);
    return v;
}
template <int NR> __device__ __forceinline__ void rows_to_bf16(const Frame& F, const float* xrow, bf16* orow, float* ssrow) {
    f32x4 v[NR][4];
#pragma unroll
    for (int r = 0; r < NR; ++r)
#pragma unroll
        for (int j = 0; j < 4; ++j) v[r][j] = __builtin_nontemporal_load(((const GAS f32x4*)(xrow + (size_t)r * D) + F.lane) + 64 * j);
#pragma unroll
    for (int r = 0; r < NR; ++r) { float s = 0.f;
#pragma unroll
        for (int j = 0; j < 4; ++j) s += (v[r][j].x * v[r][j].x + v[r][j].y * v[r][j].y) + (v[r][j].z * v[r][j].z + v[r][j].w * v[r][j].w);
        s = wave_sum(s);
        if (F.lane < 16) ssrow[(size_t)r * 16 + F.lane] = (F.lane == 0) ? s : 0.f;
        GAS unsigned long long* o8 = (GAS unsigned long long*)(orow + (size_t)r * D) + F.lane;
#pragma unroll
        for (int j = 0; j < 4; ++j) o8[64 * j] = (unsigned long long)pk2(v[r][j].x, v[r][j].y) | ((unsigned long long)pk2(v[r][j].z, v[r][j].w) << 32); }
}
__device__ __forceinline__ void p0_prologue(Frame& F) {
    LAS float* scr = (LAS float*)(F.lds + RING_OFF + F.wave * 16384);
    const int gw = F.vcu * NWAVES + F.wave, NGW = F.G * NWAVES;
    int base = 0;
    for (int mi = 0; mi < 9; ++mi) {
        const WDesc d = wdesc(F, mi); const int nit = (d.K / 64) * (d.ncols / 64);
        int it = gw - (base % NGW); if (it < 0) it += NGW;
        for (; it < nit; it += NGW) p0_transpose_item(d, scr, it, F.lane);
        base += nit;
    }
    { const float* W = F.in[2]; const float* g = F.in[1]; bf16* Wz = (bf16*)(F.ws + WS_WZ);
      for (int idx = gw * 64 + F.lane; idx < 16 * D; idx += NGW * 64) { const int k = idx >> 4, r = idx & 15; Wz[(size_t)r * D + k] = (bf16)f2bf(W[(size_t)k * GIN + 3072 + r] * g[k]); } }
    bf16* XB = (bf16*)(F.ws + WS_A); float* SS = (float*)(F.ws + WS_SS);
    for (int m = 4 * gw; m < T; m += 4 * NGW) rows_to_bf16<4>(F, F.in[0] + (size_t)m * D, XB + (size_t)m * D, SS + (size_t)m * 16);
}


__device__ __forceinline__ void combine_local(Frame& F) {
    const int lane = F.lane, wave = F.wave;
    const float* lp = F.in[13]; const float* hg = F.in[14];
    const float s1 = wave_sum(lp[lane] * lp[64 + lane]), s2 = wave_sum(lp[128 + lane] * lp[192 + lane]);
    const float lam = __expf(s1) - __expf(s2) + LAMBDA_INIT;
    const int bhh = F.vcu >> 3, p = F.vcu & 7, b = bhh >> 3, h = bhh & 7, sg = lane & 7;
    float g[16];
#pragma unroll
    for (int j = 0; j < 16; ++j) g[j] = hg[16 * sg + j] * (1.f - LAMBDA_INIT);
    const bf16* O32 = (const bf16*)F.out; bf16* OD = (bf16*)(F.ws + WS_C);
    asm volatile("s_waitcnt vmcnt(0)" ::: "memory"); __syncthreads();
    for (int it0 = 0; it0 < 8; it0 += 4) {
        bf16x8 a0[4], a1[4], b0[4], b1[4]; size_t tt[4];
#pragma unroll
        for (int q = 0; q < 4; ++q) { const int r = (it0 + q) * 64 + wave * 8 + (lane >> 3);
            tt[q] = (size_t)b * SEQ + (size_t)((r < 256) ? p : 15 - p) * 256 + (r & 255);
            const bf16* p0 = O32 + tt[q] * 2048 + (2 * h) * 128 + 16 * sg;
            a0[q] = *(const bf16x8*)p0; a1[q] = *(const bf16x8*)(p0 + 8); b0[q] = *(const bf16x8*)(p0 + 128); b1[q] = *(const bf16x8*)(p0 + 136); }
#pragma unroll
        for (int q = 0; q < 4; ++q) {
            float o[16]; float s = 0.f;
#pragma unroll
            for (int j = 0; j < 8; ++j) { o[j] = bf2f((unsigned short)a0[q][j]) - lam * bf2f((unsigned short)b0[q][j]); o[8 + j] = bf2f((unsigned short)a1[q][j]) - lam * bf2f((unsigned short)b1[q][j]); }
#pragma unroll
            for (int j = 0; j < 16; ++j) s += o[j] * o[j];
            s += __shfl_xor(s, 1); s += __shfl_xor(s, 2); s += __shfl_xor(s, 4);
            const float rstd = __builtin_amdgcn_rsqf(s * (1.f / 128.f) + EPS);
            v4u w0, w1;
            w0.x = pk2(o[0] * rstd * g[0], o[1] * rstd * g[1]); w0.y = pk2(o[2] * rstd * g[2], o[3] * rstd * g[3]); w0.z = pk2(o[4] * rstd * g[4], o[5] * rstd * g[5]); w0.w = pk2(o[6] * rstd * g[6], o[7] * rstd * g[7]);
            w1.x = pk2(o[8] * rstd * g[8], o[9] * rstd * g[9]); w1.y = pk2(o[10] * rstd * g[10], o[11] * rstd * g[11]); w1.z = pk2(o[12] * rstd * g[12], o[13] * rstd * g[13]); w1.w = pk2(o[14] * rstd * g[14], o[15] * rstd * g[15]);
            bf16* qd = OD + tt[q] * 1024 + h * 128 + 16 * sg;
            *(v4u*)qd = w0; *(v4u*)(qd + 8) = w1; }
    }
}
constexpr int RT_OFF = 132096;
__device__ __forceinline__ unsigned off_b(unsigned row, unsigned ch) { return 256u * row + 16u * (ch ^ (((row & 3) << 2) | ((row >> 2) & 3))); }
__device__ __forceinline__ unsigned row_addr16(unsigned lane, unsigned rb, unsigned s) { return off_b((lane & 15) + 16 * rb, 4 * s + (lane >> 4)); }
__device__ __forceinline__ unsigned tr_addr16(unsigned lane, unsigned c, unsigned ks, unsigned t) { const unsigned g = lane >> 4, q = (lane & 15) >> 2, p = lane & 3; return off_b(32 * ks + 8 * g + 4 * t + q, 2 * c + (p >> 1)) + 8 * (p & 1); }
typedef short v4i16_t __attribute__((ext_vector_type(4)));
__device__ __forceinline__ bf16x8 tr_frag(LAS unsigned char* img, unsigned lane, unsigned c, unsigned ks) {
    const v4i16_t lo = __builtin_amdgcn_ds_read_tr16_b64_v4i16((LAS v4i16_t*)(img + tr_addr16(lane, c, ks, 0)));
    const v4i16_t hi = __builtin_amdgcn_ds_read_tr16_b64_v4i16((LAS v4i16_t*)(img + tr_addr16(lane, c, ks, 1)));
    return (bf16x8){lo[0], lo[1], lo[2], lo[3], hi[0], hi[1], hi[2], hi[3]};
}
__device__ __forceinline__ bf16x8 row_frag(LAS unsigned char* img, unsigned lane, unsigned rb, unsigned s) { return *(const LAS bf16x8*)(img + row_addr16(lane, rb, s)); }
#define MFMA16(a, b, c) __builtin_amdgcn_mfma_f32_16x16x32_bf16(a, b, c, 0, 0, 0)

constexpr int ZP_OFF = 137216;
__device__ __forceinline__ void gate_phase(Frame& F) {
    LAS float* ZP = (LAS float*)(F.lds + ZP_OFF);
    const bf16* XB = (const bf16*)(F.ws + WS_A); const bf16* Wz = (const bf16*)(F.ws + WS_WZ); const float* wgu = F.in[3]; const float* bg = F.in[4]; float* BC = (float*)(F.ws + WS_BC);
    const float* SS = (const float*)(F.ws + WS_SS);
    const int lane = F.lane, wave = F.wave, fr = lane & 15, fq = lane >> 4;
    LAS float* ST = (LAS float*)(F.lds + wave * 16384);
    float wb[4][4], bb[4];
#pragma unroll
    for (int nt = 0; nt < 4; ++nt) { bb[nt] = bg[64 * wave + 16 * nt + fr];
#pragma unroll
        for (int kk = 0; kk < 4; ++kk) wb[nt][kk] = wgu[(4 * kk + fq) * 512 + 64 * wave + 16 * nt + fr]; }
    for (int u = F.vcu; u < T / CH; u += F.G) {
        const size_t t0 = (size_t)u * CH;
        { const int mt = wave & 3, kh = wave >> 2; f32x4 acc = (f32x4){0.f, 0.f, 0.f, 0.f};
          const bf16* ap = XB + (t0 + mt * 16 + fr) * D + kh * 512 + 8 * fq; const bf16* bp = Wz + (size_t)fr * D + kh * 512 + 8 * fq;
#pragma unroll
          for (int ks = 0; ks < 16; ++ks) acc = MFMA16(__builtin_nontemporal_load((const bf16x8*)(ap + ks * 32)), *(const bf16x8*)(bp + ks * 32), acc);
#pragma unroll
          for (int j = 0; j < 4; ++j) ZP[(kh * 64 + mt * 16 + 4 * fq + j) * 17 + fr] = acc[j] * pg8::row_rstd(SS, (int)t0 + mt * 16 + 4 * fq + j); }
        __syncthreads();
        float carry[4] = {0.f, 0.f, 0.f, 0.f};
#pragma unroll 1
        for (int mt = 0; mt < 4; ++mt) {
            float za[4];
#pragma unroll
            for (int kk = 0; kk < 4; ++kk) za[kk] = ZP[(mt * 16 + fr) * 17 + 4 * kk + fq] + ZP[(64 + mt * 16 + fr) * 17 + 4 * kk + fq];
#pragma unroll
            for (int nt = 0; nt < 4; ++nt) {
                f32x4 x = (f32x4){bb[nt], bb[nt], bb[nt], bb[nt]};
#pragma unroll
                for (int kk = 0; kk < 4; ++kk) x = __builtin_amdgcn_mfma_f32_16x16x4f32(za[kk], wb[nt][kk], x, 0, 0, 0);
                float p[4]; float run = 0.f;
#pragma unroll
                for (int r = 0; r < 4; ++r) { const float ls = fminf(x[r], 0.f) - __logf(1.f + __expf(-fabsf(x[r]))); run += ls * (1.f / 16.f); p[r] = run; }
                float s1 = run; { const float t = __shfl_up(s1, 16); if (fq >= 1) s1 += t; }
                float s2 = s1;  { const float t = __shfl_up(s2, 32); if (fq >= 2) s2 += t; }
                const float base = carry[nt] + (s2 - run);
                carry[nt] += __shfl(s2, 48 + fr);
#pragma unroll
                for (int r = 0; r < 4; ++r) { const int row = mt * 16 + 4 * fq + r; ST[row * 64 + ((16 * nt + fr) ^ (((row >> 2) & 3) << 4))] = base + p[r]; }
            }
        }
        LDS_WAIT(); asm volatile("" ::: "memory");
#pragma unroll
        for (int i = 0; i < 16; ++i) { const int row = 4 * i + fq; const f32x4 v = *(const LAS f32x4*)(ST + row * 64 + ((4 * fr) ^ (((row >> 2) & 3) << 4)));
            *(f32x4*)(BC + (t0 + row) * 512 + 64 * wave + 4 * fr) = v; }
        __syncthreads();
    }
}

struct GlaSet { unsigned k0, k1; f32x4 bc, bl; v4u v; float dc; };
__device__ __forceinline__ void gla_state_phase(Frame& F) {
    LAS unsigned char* lds = F.lds;
    const bf16* KG = (const bf16*)(F.ws + WS_KG); const bf16* VG = (const bf16*)(F.ws + WS_VG); const float* BC = (const float*)(F.ws + WS_BC); bf16* SP = (bf16*)F.out;
    const int tid = F.tid, lane = F.lane, wave = F.wave;
    const int pos = tid >> 3, sub = tid & 7, mt = wave >> 1, nt = wave & 1;
    for (int u = F.vcu; u < 256; u += F.G) {
        const int bh = u >> 4, ki = (u >> 2) & 3, vi = u & 3, b = bh >> 2, h = bh & 3;
        const size_t tr0 = (size_t)b * SEQ;
        const bf16* kp = KG + (tr0 + pos) * 512 + h * GDK + ki * 32 + sub * 4;
        const float* bp = BC + (tr0 + pos) * 512 + h * GDK + ki * 32 + sub * 4;
        const float* blp = BC + (tr0 + 63) * 512 + h * GDK + ki * 32 + sub * 4;
        const bf16* vp = VG + (tr0 + pos) * 1024 + h * GDV + vi * 64 + sub * 8;
        const float* dcp = BC + (tr0 + 63) * 512 + h * GDK + ki * 32 + nt * 16 + (lane & 15);
        bf16* spp = SP + ((size_t)(bh * (NCH / 2)) * GDV + vi * 64 + mt * 16 + 4 * (lane >> 4)) * GDK + ki * 32 + nt * 16 + (lane & 15);
        const unsigned kw = off_b(pos, sub >> 1) + 8 * (sub & 1), vw = off_b(pos, sub);
        f32x4 acc = (f32x4){0.f, 0.f, 0.f, 0.f};
#define GLA_LOAD(S, c) do { const size_t o_ = (size_t)(c) * CH; const unsigned long long kk_ = *(const unsigned long long*)(kp + o_ * 512); S.k0 = (unsigned)kk_; S.k1 = (unsigned)(kk_ >> 32); \
        S.bc = *(const f32x4*)(bp + o_ * 512); S.bl = *(const f32x4*)(blp + o_ * 512); S.v = *(const v4u*)(vp + o_ * 1024); S.dc = dcp[o_ * 512]; } while (0)
#define GLA_STEP(S, c, buf) do { \
        { const float e0 = __expf(S.bl[0] - S.bc[0]), e1 = __expf(S.bl[1] - S.bc[1]), e2 = __expf(S.bl[2] - S.bc[2]), e3 = __expf(S.bl[3] - S.bc[3]); \
          const unsigned w0 = pk2(bf2f(S.k0 & 0xffffu) * e0, bf2f(S.k0 >> 16) * e1), w1 = pk2(bf2f(S.k1 & 0xffffu) * e2, bf2f(S.k1 >> 16) * e3); \
          *(LAS unsigned long long*)(lds + (buf) * 32768 + kw) = (unsigned long long)w0 | ((unsigned long long)w1 << 32); \
          *(LAS v4u*)(lds + (buf) * 32768 + 16384 + vw) = S.v; } \
        const float dec_ = __expf(S.dc); \
        if ((c) + 4 < NCH) GLA_LOAD(S, (c) + 4); \
        __syncthreads(); \
        if (!((c) & 1)) { _Pragma("unroll") for (int j = 0; j < 4; ++j) __builtin_nontemporal_store((bf16)f2bf(acc[j]), spp + (size_t)((c) >> 1) * GDV * GDK + j * GDK); } \
        acc = acc * dec_; \
        _Pragma("unroll") for (int ks = 0; ks < 2; ++ks) acc = MFMA16(tr_frag(lds + (buf) * 32768 + 16384, lane, mt, ks), tr_frag(lds + (buf) * 32768, lane, nt, ks), acc); } while (0)
        GlaSet s0, s1, s2, s3;
        GLA_LOAD(s0, 0); GLA_LOAD(s1, 1); GLA_LOAD(s2, 2); GLA_LOAD(s3, 3);
        for (int c = 0; c < NCH; c += 4) { GLA_STEP(s0, c, 0); GLA_STEP(s1, c + 1, 1); GLA_STEP(s2, c + 2, 0); GLA_STEP(s3, c + 3, 1); }
#undef GLA_LOAD
#undef GLA_STEP
        __syncthreads();
    }
}

struct GlaRaw { bf16x8 q[4], k[4]; f32x4 b0[4], b1[4], l0, l1; };
__device__ __forceinline__ void gla_out_phase(Frame& F) {
    LAS unsigned char* lds = F.lds;
    LAS unsigned char *QI = lds, *AI = lds + 16384, *KI = lds + 32768, *VI = lds + 65536, *OL = lds;
    LAS float* RED = (LAS float*)(lds + RT_OFF); LAS float* RS = RED + 512;
    const bf16* QG = (const bf16*)(F.ws + WS_QG); const bf16* KG = (const bf16*)(F.ws + WS_KG); const bf16* VG = (const bf16*)(F.ws + WS_VG); const bf16* GGp = (const bf16*)(F.ws + WS_GG);
    const float* BC = (const float*)(F.ws + WS_BC); const bf16* SP = (const bf16*)F.out; bf16* OG = (bf16*)(F.ws + WS_C); const float* hg = F.in[5];
    const int tid = F.tid, lane = F.lane, wave = F.wave, fr = lane & 15, fq = lane >> 4;
    const float g0 = hg[32 * wave + fr], g1 = hg[32 * wave + 16 + fr];
    constexpr int NU = NB * GH * (NCH / 2);
#define GLA_T0(u) ((size_t)((u) >> 7) * SEQ + (size_t)((u) & 31) * (2 * CH))
#define GLA_H(u) (((u) >> 5) & 3)
#define GLA_LOADRAW(R, u) do { const size_t t0_ = GLA_T0(u); const int h_ = GLA_H(u); \
        _Pragma("unroll") for (int r = 0; r < 4; ++r) { const int n = tid + 512 * r, pos = n >> 4, ch = n & 15; const size_t e = (t0_ + pos) * 512 + h_ * GDK + ch * 8; \
            R.q[r] = __builtin_nontemporal_load((const bf16x8*)(QG + e)); R.k[r] = __builtin_nontemporal_load((const bf16x8*)(KG + e)); \
            R.b0[r] = __builtin_nontemporal_load((const f32x4*)(BC + e)); R.b1[r] = __builtin_nontemporal_load((const f32x4*)(BC + e + 4)); } \
        { const size_t e = (t0_ + 63) * 512 + h_ * GDK + (tid & 15) * 8; R.l0 = *(const f32x4*)(BC + e); R.l1 = *(const f32x4*)(BC + e + 4); } } while (0)
#define GLA_LOADSF(u) do { const bf16* sp = SP + ((size_t)(u) * GDV + 32 * wave + fr) * GDK + 8 * fq; \
        _Pragma("unroll") for (int nt = 0; nt < 2; ++nt) _Pragma("unroll") for (int ks = 0; ks < 4; ++ks) sf[nt][ks] = __builtin_nontemporal_load((const bf16x8*)(sp + nt * 16 * GDK + ks * 32)); } while (0)
    int u = F.vcu;
    if (u >= NU) return;
    bf16x8 sf[2][4];
    GLA_LOADSF(u);
    for (;;) {
        const size_t t0 = GLA_T0(u); const int h = GLA_H(u); const int un = u + F.G; const bool has_next = un < NU;
        GlaRaw R; GLA_LOADRAW(R, u);
        v4u vv[8];
#pragma unroll
        for (int r = 0; r < 8; ++r) { const int n = tid + 512 * r, pos = n >> 5, c32 = n & 31; vv[r] = __builtin_nontemporal_load((const v4u*)(VG + (t0 + pos) * 1024 + h * GDV + c32 * 8)); }
        v4u wq1[2];
#pragma unroll
        for (int r = 0; r < 4; ++r) { const int n = tid + 512 * r, pos = n >> 4, ch = n & 15;
            float qq[8], kk[8];
#pragma unroll
            for (int j = 0; j < 8; ++j) { float bj = j < 4 ? R.b0[r][j & 3] : R.b1[r][j & 3]; if (r >= 2) bj += j < 4 ? R.l0[j & 3] : R.l1[j & 3]; const float ex = __expf(bj);
                qq[j] = bf2f((unsigned short)R.q[r][j]) * ex * 0.08838834764831845f; kk[j] = bf2f((unsigned short)R.k[r][j]) * __builtin_amdgcn_rcpf(ex); }
            v4u wqr; wqr.x = pk2(qq[0], qq[1]); wqr.y = pk2(qq[2], qq[3]); wqr.z = pk2(qq[4], qq[5]); wqr.w = pk2(qq[6], qq[7]);
            if (r < 2) *(LAS v4u*)(QI + off_b(pos, ch)) = wqr; else wq1[r - 2] = wqr;
            v4u wk; wk.x = pk2(kk[0], kk[1]); wk.y = pk2(kk[2], kk[3]); wk.z = pk2(kk[4], kk[5]); wk.w = pk2(kk[6], kk[7]);
            *(LAS v4u*)(KI + (pos >> 6) * 16384 + off_b(pos & 63, ch)) = wk; }
        {
#pragma unroll
          for (int r = 0; r < 8; ++r) { const int n = tid + 512 * r, pos = n >> 5, c32 = n & 31; *(LAS v4u*)(VI + ((pos >> 6) * 2 + (c32 >> 4)) * 16384 + off_b(pos & 63, c32 & 15)) = vv[r]; } }
#pragma unroll 1
        for (int hf = 0; hf < 2; ++hf) {
            if (hf) {
#pragma unroll
                for (int r = 0; r < 2; ++r) { const int n = tid + 512 * r, pos = n >> 4, ch = n & 15; *(LAS v4u*)(QI + off_b(pos, ch)) = wq1[r]; } }
            __syncthreads();
            { const int mt = wave >> 1;
#pragma unroll
              for (int q = 0; q < (hf ? 4 : 2); ++q) { const int nt = (hf ? 4 : 2) * (wave & 1) + q; f32x4 a4 = (f32x4){0.f, 0.f, 0.f, 0.f};
                  const bool diag = hf ? (nt >= 4) : true; const int ntl = (hf && nt >= 4) ? nt - 4 : nt;
                  if (!diag || ntl <= mt) { LAS unsigned char* kimg = KI + ((hf && nt >= 4) ? 16384 : 0);
#pragma unroll
                      for (int ks = 0; ks < 4; ++ks) a4 = MFMA16(row_frag(QI, lane, mt, ks), row_frag(kimg, lane, ntl, ks), a4); }
#pragma unroll
                  for (int r = 0; r < 4; ++r) { const int ii = mt * 16 + 4 * fq + r, jl = ntl * 16 + fr, jj = nt * 16 + fr; const float val = (!diag || jl <= ii) ? a4[r] : 0.f;
                      *(LAS unsigned short*)(AI + off_b(ii, jj >> 3) + 2 * (jj & 7)) = (unsigned short)f2bf(val); } } }
            __syncthreads();
            f32x4 o[4][2];
#pragma unroll
            for (int m = 0; m < 4; ++m) { o[m][0] = (f32x4){0.f, 0.f, 0.f, 0.f}; o[m][1] = (f32x4){0.f, 0.f, 0.f, 0.f}; }
#pragma unroll
            for (int ks = 0; ks < (hf ? 4 : 2); ++ks) { bf16x8 bfr[2];
#pragma unroll
                for (int nt = 0; nt < 2; ++nt) { const int dv = 32 * wave + 16 * nt; bfr[nt] = tr_frag(VI + ((ks >> 1) * 2 + (dv >> 7)) * 16384, lane, (dv & 127) >> 4, ks & 1); }
#pragma unroll
                for (int m = 0; m < 4; ++m) { const bf16x8 a = row_frag(AI, lane, m, ks); o[m][0] = MFMA16(a, bfr[0], o[m][0]); o[m][1] = MFMA16(a, bfr[1], o[m][1]); } }
#pragma unroll
            for (int ks = 0; ks < 4; ++ks)
#pragma unroll
                for (int m = 0; m < 4; ++m) { const bf16x8 a = row_frag(QI, lane, m, ks); o[m][0] = MFMA16(a, sf[0][ks], o[m][0]); o[m][1] = MFMA16(a, sf[1][ks], o[m][1]); }
            bf16x8 gv[4];
#pragma unroll
            for (int r = 0; r < 4; ++r) { const int n = tid + 512 * r, pos = n >> 5, c32 = n & 31; gv[r] = __builtin_nontemporal_load((const bf16x8*)(GGp + (t0 + 64 * hf + pos) * 1024 + h * GDV + c32 * 8)); }
            if (hf && has_next) GLA_LOADSF(un);
#pragma unroll
            for (int m = 0; m < 4; ++m)
#pragma unroll
                for (int r = 0; r < 4; ++r) { float s = o[m][0][r] * o[m][0][r] + o[m][1][r] * o[m][1][r];
                    s += __shfl_xor(s, 1); s += __shfl_xor(s, 2); s += __shfl_xor(s, 4); s += __shfl_xor(s, 8);
                    if (fr == 0) RED[wave * 64 + m * 16 + 4 * fq + r] = s; }
            __syncthreads();
            if (tid < 64) { float tot = 0.f;
#pragma unroll
                for (int w = 0; w < 8; ++w) tot += RED[w * 64 + tid];
                RS[tid] = __builtin_amdgcn_rsqf(tot * (1.f / GDV) + EPS); }
            __syncthreads();
#pragma unroll
            for (int m = 0; m < 4; ++m) { const f32x4 rs4 = *(const LAS f32x4*)(RS + m * 16 + 4 * fq);
#pragma unroll
                for (int r = 0; r < 4; ++r) { LAS unsigned char* rowp = OL + (m * 16 + 4 * fq + r) * 512 + (32 * wave + fr) * 2;
                    *(LAS unsigned short*)rowp = (unsigned short)f2bf(o[m][0][r] * rs4[r] * g0); *(LAS unsigned short*)(rowp + 32) = (unsigned short)f2bf(o[m][1][r] * rs4[r] * g1); } }
            __syncthreads();
#pragma unroll
            for (int r = 0; r < 4; ++r) { const int n = tid + 512 * r, pos = n >> 5, c32 = n & 31;
                const bf16x8 ov = *(const LAS bf16x8*)(OL + pos * 512 + c32 * 16); const size_t e = (t0 + 64 * hf + pos) * 1024 + h * GDV + c32 * 8;
                v4u w; w.x = pk2(bf2f((unsigned short)ov[0]) * bf2f((unsigned short)gv[r][0]), bf2f((unsigned short)ov[1]) * bf2f((unsigned short)gv[r][1]));
                w.y = pk2(bf2f((unsigned short)ov[2]) * bf2f((unsigned short)gv[r][2]), bf2f((unsigned short)ov[3]) * bf2f((unsigned short)gv[r][3]));
                w.z = pk2(bf2f((unsigned short)ov[4]) * bf2f((unsigned short)gv[r][4]), bf2f((unsigned short)ov[5]) * bf2f((unsigned short)gv[r][5]));
                w.w = pk2(bf2f((unsigned short)ov[6]) * bf2f((unsigned short)gv[r][6]), bf2f((unsigned short)ov[7]) * bf2f((unsigned short)gv[r][7]));
                *(v4u*)(OG + e) = w; }
            __syncthreads();
        }
        if (!has_next) break;
        u = un;
    }
#undef GLA_T0
#undef GLA_H
#undef GLA_LOADRAW
#undef GLA_LOADSF
}
__device__ __forceinline__ void fill_rstd_table(Frame& F, const pg8::StaticOrder& S, const float* ss) {
    LAS float* RT = (LAS float*)(F.lds + RT_OFF); pg8::Unit u;
    for (int i = 0; i < 4 && S.next(i, u); ++i) if (F.tid < 256) RT[i * 256 + F.tid] = pg8::row_rstd(ss, u.pm * 256 + F.tid);
    __syncthreads();
}

struct Args { const float* in[19]; float* out; unsigned char* ws; int ph_lo, ph_hi, li, pad; };
__global__ void __launch_bounds__(NWAVES * 64, 2) mega(Args args) {
    extern __shared__ __attribute__((aligned(16))) unsigned char lds[];
    Frame F;
    F.lds = (LAS unsigned char*)lds;
    F.MISC = (volatile LAS unsigned*)(F.lds + MISC_OFF);
    F.tid = threadIdx.x; F.lane = F.tid & 63; F.wave = __builtin_amdgcn_readfirstlane(F.tid >> 6);
    F.G = gridDim.x; { const int bx = blockIdx.x; F.vcu = (F.G % 8 == 0) ? (bx % 8) * (F.G / 8) + bx / 8 : bx; }
#pragma unroll
    for (int i = 0; i < 19; ++i) F.in[i] = args.in[i];
    F.out = args.out; F.ws = args.ws; F.ctl = (gu32*)(args.ws + WS_CTL);
    unsigned char* ws = args.ws;
    for (int u = F.tid; u < (LDS_BYTES - LDSCTL_OFF) / 4; u += NWAVES * 64) ((LAS unsigned*)(F.lds + LDSCTL_OFF))[u] = 0u;
    __syncthreads();
    const int lo = args.ph_lo, hi = args.ph_hi;
    XcdBarrier bar; bar.bar = (unsigned*)(F.ctl + CW_BAR) + args.li * XCD_BAR_WORDS; bar.x = 0; bar.st = nullptr;
    if (hi - lo > 1) bar = xcd_barrier_post((unsigned*)(F.ctl + CW_BAR) + args.li * XCD_BAR_WORDS, F.MISC + 8);
#define IN(k) (lo <= (k) && (k) < hi)
#define SEAM(k) do { if (IN(k) && IN((k) + ((k) == 8 ? 2 : 1))) xcd_barrier(bar); } while (0)
    bf16 *Win = (bf16*)(ws + WS_WIN), *Wao = (bf16*)(ws + WS_WAO), *W1a = (bf16*)(ws + WS_W1A), *W2a = (bf16*)(ws + WS_W2A);
    bf16 *Wkvq = (bf16*)(ws + WS_WKVQ), *Wbo = (bf16*)(ws + WS_WBO), *W1b = (bf16*)(ws + WS_W1B), *W2b = (bf16*)(ws + WS_W2B);
    float* SS = (float*)(ws + WS_SS);
    bf16 *RA = (bf16*)(ws + WS_A), *RC = (bf16*)(ws + WS_C), *HM = (bf16*)(ws + WS_HM);

    if (IN(0)) { p0_prologue(F); SEAM(0); }
    if (IN(1)) {
        pg8::Gemm g{RA, Win, T, 3072, D}; pg8::StaticOrder S; S.init(T, 3072, F.G, (int)blockIdx.x);
        fill_rstd_table(F, S, SS);
        pg8::EpiInProj E{(bf16*)(ws + WS_QG), (bf16*)(ws + WS_KG), (bf16*)(ws + WS_VG), (bf16*)(ws + WS_GG), (const LAS float*)(F.lds + RT_OFF), 0};
        pg8::gemm_phase<pg8::EpiInProj, pg8::StaticOrder, PG8_ALIGN, PG8_SP2>(F.lds + RING_OFF, g, S, E);
        gate_phase(F);
        SEAM(1);
    }
    if (IN(2)) { gla_state_phase(F); SEAM(2); }
    if (IN(3)) { gla_out_phase(F); SEAM(3); }
    if (IN(4)) {
        pg8::Gemm g{RC, Wao, T, D, D}; pg8::StaticOrder S; S.init(T, D, F.G, (int)blockIdx.x);
        pg8::EpiResB<1> E{nullptr, RA, (bf16*)F.out, nullptr, SS};
        pg8::gemm_phase<pg8::EpiResB<1>, pg8::StaticOrder, PG8_ALIGN, PG8_SP2>(F.lds + RING_OFF, g, S, E);
        SEAM(4);
    }
    if (IN(5)) {
        pg8::Gemm g{(const bf16*)F.out, W1a, T, FF, D}; pg8::StaticOrder S; S.init(T, FF, F.G, (int)blockIdx.x);
        fill_rstd_table(F, S, SS);
        pg8::EpiUp E{HM, (const LAS float*)(F.lds + RT_OFF), 0};
        pg8::gemm_phase<pg8::EpiUp, pg8::StaticOrder, PG8_ALIGN, PG8_SP2>(F.lds + RING_OFF, g, S, E);
        SEAM(5);
    }
    if (IN(6)) {
        pg8::Gemm g{HM, W2a, T, D, FF}; pg8::StaticOrder S; S.init(T, D, F.G, (int)blockIdx.x);
        pg8::EpiResB<1> E{nullptr, (const bf16*)F.out, RA, nullptr, SS};
        pg8::gemm_phase<pg8::EpiResB<1>, pg8::StaticOrder, PG8_ALIGN, PG8_SP2>(F.lds + RING_OFF, g, S, E);
        SEAM(6);
    }
    if (IN(7)) {
        pg8::Gemm g{RA, Wkvq, T, 3072, D}; pg8::StaticOrder S; S.init(T, 3072, F.G, (int)blockIdx.x);
        if (F.tid < 128) ((LAS float*)(F.lds + RT_OFF + 4096))[F.tid] = (F.tid < 64) ? F.in[9][F.tid] : F.in[12][F.tid - 64];
        fill_rstd_table(F, S, SS);
        pg8::EpiKVQ E{(bf16*)(ws + WS_KN), (bf16*)(ws + WS_V2), (bf16*)(ws + WS_QN), (const LAS float*)(F.lds + RT_OFF), (const LAS float*)(F.lds + RT_OFF + 4096), (const LAS float*)(F.lds + RT_OFF + 4096 + 256), 0};
        pg8::gemm_phase<pg8::EpiKVQ, pg8::StaticOrder, PG8_ALIGN, PG8_SP2>(F.lds + RING_OFF, g, S, E);
        SEAM(7);
    }
    if (IN(8)) {
        const attn_body::AttnTensors AT{(const attn_body::bf16*)(ws + WS_QN), (const attn_body::bf16*)(ws + WS_KN), (const attn_body::bf16*)(ws + WS_V2), (attn_body::bf16*)F.out};
        const attn_body::StaticOrder S((int)F.G, (int)blockIdx.x);
        attn_body::attn_phase<attn_body::StaticOrder>((char*)lds + RING_OFF, AT, S);
        combine_local(F);
        SEAM(8);
    }
    if (IN(10)) {
        pg8::Gemm g{RC, Wbo, T, D, D}; pg8::StaticOrder S; S.init(T, D, F.G, (int)blockIdx.x);
        pg8::EpiResB<1> E{nullptr, RA, RA, nullptr, SS};
        pg8::gemm_phase<pg8::EpiResB<1>, pg8::StaticOrder, PG8_ALIGN, PG8_SP2>(F.lds + RING_OFF, g, S, E);
        SEAM(10);
    }
    if (IN(11)) {
        pg8::Gemm g{RA, W1b, T, FF, D}; pg8::StaticOrder S; S.init(T, FF, F.G, (int)blockIdx.x);
        fill_rstd_table(F, S, SS);
        pg8::EpiUp E{HM, (const LAS float*)(F.lds + RT_OFF), 0};
        pg8::gemm_phase<pg8::EpiUp, pg8::StaticOrder, PG8_ALIGN, PG8_SP2>(F.lds + RING_OFF, g, S, E);
        SEAM(11);
    }
    if (IN(12)) {
        pg8::Gemm g{HM, W2b, T, D, FF}; pg8::StaticOrder S; S.init(T, D, F.G, (int)blockIdx.x);
        pg8::EpiResB<2> E{nullptr, RA, nullptr, F.out, nullptr};
        pg8::gemm_phase<pg8::EpiResB<2>, pg8::StaticOrder, PG8_ALIGN, PG8_SP2>(F.lds + RING_OFF, g, S, E);
    }
#undef IN
#undef SEAM
}

extern "C" void kernel_launch(void* const* d_in, const int* in_sizes, int n_in, void* d_out, int out_size, void* d_ws, size_t ws_size, hipStream_t stream) {
    static int grid = 0;
    if (grid == 0) {
        if (n_in != 19 || out_size != T * D || ws_size < WS_END) { fprintf(stderr, "kernel_launch: unexpected shapes (n_in %d out %d ws %zu)\n", n_in, out_size, ws_size); grid = -1; return; }
        int dev = 0, cus = 0, per_cu = 0;
        if (hipGetDevice(&dev) != hipSuccess || hipDeviceGetAttribute(&cus, hipDeviceAttributeMultiprocessorCount, dev) != hipSuccess) { grid = -1; return; }
        if (hipFuncSetAttribute((const void*)mega, hipFuncAttributeMaxDynamicSharedMemorySize, LDS_BYTES) != hipSuccess) { fprintf(stderr, "kernel_launch: hipFuncSetAttribute failed\n"); grid = -1; return; }
        if (hipOccupancyMaxActiveBlocksPerMultiprocessor(&per_cu, (const void*)mega, NWAVES * 64, LDS_BYTES) != hipSuccess || per_cu < 1) { fprintf(stderr, "kernel_launch: occupancy query says %d blocks per CU\n", per_cu); grid = -1; (void)hipGetLastError(); return; }
        if (cus < 256) { fprintf(stderr, "kernel_launch: built for the 256 CUs of an MI355X (one resident workgroup per CU), found %d\n", cus); grid = -1; return; }
        grid = 256;
    }
    if (grid < 0) return;
    unsigned char* ws = (unsigned char*)d_ws;
    (void)hipMemsetAsync(ws + WS_CTL, 0, 64 * 1024, stream);
    Args a{};
    for (int i = 0; i < 19; ++i) a.in[i] = (const float*)d_in[i];
    a.out = (float*)d_out; a.ws = ws;
    int li = 0;
    auto run = [&](int lo, int hi) { a.ph_lo = lo; a.ph_hi = hi; a.li = li++; hipLaunchKernelGGL(mega, dim3(grid), dim3(NWAVES * 64), LDS_BYTES, stream, a); };
    run(0, 13);
}
```

```cpp
#include <hip/hip_runtime.h>
#include <cstdio>
#include <cstdint>

typedef unsigned short bf16;
typedef short bf16x8 __attribute__((ext_vector_type(8)));
typedef float f32x4 __attribute__((ext_vector_type(4)));

constexpr int NB = 4, SEQ = 4096, T = NB * SEQ, D = 1024, FF = 4096;
constexpr int GH = 4, GDK = 128, GDV = 256, GR = 16, CH = 64, NCH = SEQ / CH;
constexpr int GIN = 3088;
constexpr int DH = 8, DDH = 64, DVD = 128;
constexpr float EPS = 1e-6f;
constexpr float LOG2E = 1.4426950408889634f;
constexpr float LAMBDA_INIT = 0.35550906759f;

constexpr size_t MiB = 1u << 20;
constexpr size_t WS_CTL = 0;
constexpr size_t WS_SS = 1 * MiB;
constexpr size_t WS_ZB = 2 * MiB;
constexpr size_t WS_WZ = 3 * MiB;
constexpr size_t WS_WIN = 4 * MiB;
constexpr size_t WS_WAO = 10 * MiB;
constexpr size_t WS_W1A = 12 * MiB;
constexpr size_t WS_W2A = 20 * MiB;
constexpr size_t WS_WKVQ = 28 * MiB;
constexpr size_t WS_WBO = 34 * MiB;
constexpr size_t WS_W1B = 36 * MiB;
constexpr size_t WS_W2B = 44 * MiB;
constexpr size_t WS_B = 52 * MiB;
constexpr size_t WS_A = 180 * MiB;
constexpr size_t WS_C = 212 * MiB;
constexpr size_t WS_END = 244 * MiB;
constexpr size_t WS_QG = WS_B, WS_KG = WS_B + 16 * MiB, WS_VG = WS_B + 32 * MiB, WS_GG = WS_B + 64 * MiB, WS_BC = WS_B + 96 * MiB;
constexpr size_t WS_HM = WS_B;
constexpr size_t WS_KN = WS_B, WS_V2 = WS_B + 32 * MiB, WS_QN = WS_B + 64 * MiB;

__host__ __device__ __forceinline__ unsigned f2bf(float f) { unsigned u = __builtin_bit_cast(unsigned, f); return (u + 0x7fffu + ((u >> 16) & 1u)) >> 16; }
__host__ __device__ __forceinline__ float bf2f(unsigned h) { return __builtin_bit_cast(float, h << 16); }

__host__ __device__ __forceinline__ int kvq_dest_row(int n) {
    if (n >= 1024 && n < 2048) return n;
    const int tile = n >> 8, w = n & 255, lb = w >> 5, j = w & 31, wc = lb >> 1, bj = lb & 1;
    return (tile << 8) + 128 * bj + 32 * wc + j;
}

namespace pg8 {
#define PG8_LAS __attribute__((address_space(3)))
typedef unsigned short bf16_t;
typedef short bf16x8 __attribute__((ext_vector_type(8)));
typedef float f32x4 __attribute__((ext_vector_type(4)));
typedef unsigned u32x4 __attribute__((ext_vector_type(4)));
constexpr int BM = 256, BK = 64, HALF = 128, HTB = HALF * BK * 2  , STAGE_BYTES = 8 * HTB, NXCD = 8, WGM = 8;

__host__ __device__ __forceinline__ int lds_byte(int r, int c) { const int st = (r >> 4) * 2 + (c >> 5), rr = r & 15, cc = c & 31, ob = rr * 64 + cc * 2; return st * 1024 + (ob ^ (((ob >> 9) & 1) << 5)); }
__host__ __device__ __forceinline__ void stage_rc(int b, int& R, int& C) { const int st = b / 1024, sb = b % 1024, swz = sb ^ (((sb >> 9) & 1) << 5); R = (st >> 1) * 16 + swz / 64; C = (st & 1) * 32 + (swz % 64) / 2; }
__host__ __device__ __forceinline__ int perm32(int rho) { const int n = rho >> 4, i = rho & 15; return 8 * (i >> 2) + 4 * n + (i & 3); }

struct Unit { int pm, pn; };
struct Gemm { const bf16_t* A; const bf16_t* Bt; int M, N, K; };

struct StaticOrder {
    int nM, nN, nwg, G, c;
    __host__ __device__ void init(int M, int N, int G_, int c_) { nM = M / BM; nN = N / BM; nwg = nM * nN; G = G_; c = c_; }
    __host__ __device__ bool next(int i, Unit& u) const {
        const long L = (long)i * G + c; if (L >= nwg) return false;
        int wgid = (int)L; { const int q = nwg / NXCD, r = nwg % NXCD, xcd = wgid % NXCD, off = wgid / NXCD; wgid = (xcd < r ? xcd * (q + 1) : r * (q + 1) + (xcd - r) * q) + off; }
        const int nig = WGM * nN, gid = wgid / nig, fm = gid * WGM, gsz = (nM - fm) < WGM ? (nM - fm) : WGM;
        u.pm = fm + ((wgid % nig) % gsz); u.pn = (wgid % nig) / gsz; return true;
    }
    __device__ __forceinline__ void a_ready(const Unit&) const {}
    __device__ __forceinline__ void done(const Unit&) const {}
};

__device__ __forceinline__ unsigned cvt_pk_bf16(float lo, float hi) { unsigned r; asm volatile("v_cvt_pk_bf16_f32 %0, %1, %2" : "=v"(r) : "v"(lo), "v"(hi)); return r; }
typedef float f32x2 __attribute__((ext_vector_type(2)));
typedef unsigned u32x2 __attribute__((ext_vector_type(2)));
__device__ __forceinline__ void store16_wt(void* p, u32x4 v) { asm volatile("global_store_dwordx4 %0, %1, off sc1\n\ts_nop 1" :: "v"(p), "v"(v) : "memory"); }
constexpr int TOK = 16384;
constexpr float RMS_EPS = 1e-6f;
__device__ __forceinline__ float silu_f(float g) { return g * __builtin_amdgcn_rcpf(1.0f + __builtin_amdgcn_exp2f(-1.4426950408889634f * g)); }
__device__ __forceinline__ float row_rstd(const float* ss, int row) {
    const f32x4 a = *(const f32x4*)(ss + (size_t)row * 16), b = *(const f32x4*)(ss + (size_t)row * 16 + 4), c = *(const f32x4*)(ss + (size_t)row * 16 + 8), d = *(const f32x4*)(ss + (size_t)row * 16 + 12);
    const float q = ((a[0] + a[1]) + (a[2] + a[3])) + ((b[0] + b[1]) + (b[2] + b[3])) + ((c[0] + c[1]) + (c[2] + c[3])) + ((d[0] + d[1]) + (d[2] + d[3]));
    return __builtin_amdgcn_rsqf(q * (1.0f / 1024.0f) + RMS_EPS);
}
struct EpiInProj {
    static constexpr bool PERM = true, AFTER_DRAIN = false;
    bf16_t *q, *k, *v, *g; const PG8_LAS float* rt; mutable int ui;
    __device__ __forceinline__ void operator()(const f32x4 (&acc)[2][2][4][2], const Unit& u, int wr, int wc, int fr, int fq) const {
        const int row0 = u.pm * BM + wr * 64 + fr; const int pn = u.pn; const PG8_LAS float* rtu = rt + ui * 256 + wr * 64 + fr; ++ui;
        bf16_t* base; int ldc, colt; const bool act = pn >= 8;
        if (pn < 2) { base = q; ldc = 512; colt = pn * BM; } else if (pn < 4) { base = k; ldc = 512; colt = (pn - 2) * BM; }
        else if (pn < 8) { base = v; ldc = 1024; colt = (pn - 4) * BM; } else { base = g; ldc = 1024; colt = (pn - 8) * BM; }
        const int col0 = colt + wc * 32 + 8 * fq;
#pragma unroll
        for (int ai = 0; ai < 2; ++ai)
#pragma unroll
            for (int m = 0; m < 4; ++m) { bf16_t* rowp = base + (size_t)(row0 + ai * HALF + m * 16) * ldc + col0; const float rs = rtu[ai * HALF + m * 16];
#pragma unroll
                for (int bj = 0; bj < 2; ++bj) { f32x4 v0 = acc[ai][bj][m][0] * rs, v1 = acc[ai][bj][m][1] * rs;
                    if (act) { v0 = (f32x4){silu_f(v0[0]), silu_f(v0[1]), silu_f(v0[2]), silu_f(v0[3])}; v1 = (f32x4){silu_f(v1[0]), silu_f(v1[1]), silu_f(v1[2]), silu_f(v1[3])}; }
                    u32x4 w; w.x = cvt_pk_bf16(v0[0], v0[1]); w.y = cvt_pk_bf16(v0[2], v0[3]); w.z = cvt_pk_bf16(v1[0], v1[1]); w.w = cvt_pk_bf16(v1[2], v1[3]);
                    store16_wt(rowp + bj * HALF, w); } }
    }
};
template <int MODE> struct EpiResB {
    static constexpr bool PERM = true, AFTER_DRAIN = false;
    const float* basef; const bf16_t* baseb; bf16_t* hb; float* outf; float* ss;
    __device__ __forceinline__ void operator()(const f32x4 (&acc)[2][2][4][2], const Unit& u, int wr, int wc, int fr, int fq) const {
        const int col0 = u.pn * BM + wc * 32 + 8 * fq;
#pragma unroll
        for (int ai = 0; ai < 2; ++ai)
#pragma unroll
            for (int m = 0; m < 4; ++m) { const int row = u.pm * BM + ai * HALF + wr * 64 + m * 16 + fr; const size_t off = (size_t)row * 1024 + col0; float s = 0.f;
#pragma unroll
                for (int bj = 0; bj < 2; ++bj) { f32x4 h0, h1;
                    if (MODE == 0) { h0 = *(const f32x4*)(basef + off + bj * HALF); h1 = *(const f32x4*)(basef + off + bj * HALF + 4); }
                    else { const u32x4 b = *(const u32x4*)(baseb + off + bj * HALF);
                        h0 = (f32x4){__builtin_bit_cast(float, b.x << 16), __builtin_bit_cast(float, b.x & 0xffff0000u), __builtin_bit_cast(float, b.y << 16), __builtin_bit_cast(float, b.y & 0xffff0000u)};
                        h1 = (f32x4){__builtin_bit_cast(float, b.z << 16), __builtin_bit_cast(float, b.z & 0xffff0000u), __builtin_bit_cast(float, b.w << 16), __builtin_bit_cast(float, b.w & 0xffff0000u)}; }
                    h0 = h0 + acc[ai][bj][m][0]; h1 = h1 + acc[ai][bj][m][1];
                    if (MODE == 2) { __builtin_nontemporal_store(h0, (f32x4*)(outf + off + bj * HALF)); __builtin_nontemporal_store(h1, (f32x4*)(outf + off + bj * HALF + 4)); }
                    else { u32x4 w; w.x = cvt_pk_bf16(h0[0], h0[1]); w.y = cvt_pk_bf16(h0[2], h0[3]); w.z = cvt_pk_bf16(h1[0], h1[1]); w.w = cvt_pk_bf16(h1[2], h1[3]);
                        *(u32x4*)(hb + off + bj * HALF) = w;
                        s += ((h0[0] * h0[0] + h0[1] * h0[1]) + (h0[2] * h0[2] + h0[3] * h0[3])) + ((h1[0] * h1[0] + h1[1] * h1[1]) + (h1[2] * h1[2] + h1[3] * h1[3])); } }
                if (MODE != 2) { s += __shfl_xor(s, 16); s += __shfl_xor(s, 32); if (fq == 0) ss[(size_t)row * 16 + u.pn * 4 + wc] = s; }
                if (m & 1) asm volatile("" ::: "memory"); }
    }
};
struct EpiUp {
    static constexpr bool PERM = true, AFTER_DRAIN = false;
    bf16_t* O; const PG8_LAS float* rt; mutable int ui;
    __device__ __forceinline__ void operator()(const f32x4 (&acc)[2][2][4][2], const Unit& u, int wr, int wc, int fr, int fq) const {
        const int col0 = u.pn * BM + wc * 32 + 8 * fq; const PG8_LAS float* rtu = rt + ui * 256 + wr * 64 + fr; ++ui;
#pragma unroll
        for (int ai = 0; ai < 2; ++ai)
#pragma unroll
            for (int m = 0; m < 4; ++m) { const int row = u.pm * BM + ai * HALF + wr * 64 + m * 16 + fr; const float rs = rtu[ai * HALF + m * 16]; bf16_t* rowp = O + (size_t)row * 4096 + col0;
#pragma unroll
                for (int bj = 0; bj < 2; ++bj) { f32x4 v0 = acc[ai][bj][m][0] * rs, v1 = acc[ai][bj][m][1] * rs;
#pragma unroll
                    for (int e = 0; e < 4; ++e) { const float a = __builtin_fmaxf(v0[e], 0.f), b = __builtin_fmaxf(v1[e], 0.f); v0[e] = a * a; v1[e] = b * b; }
                    u32x4 w; w.x = cvt_pk_bf16(v0[0], v0[1]); w.y = cvt_pk_bf16(v0[2], v0[3]); w.z = cvt_pk_bf16(v1[0], v1[1]); w.w = cvt_pk_bf16(v1[2], v1[3]);
                    store16_wt(rowp + bj * HALF, w); } }
    }
};
struct EpiKVQ {
    static constexpr bool PERM = true, AFTER_DRAIN = false;
    bf16_t *kn, *v2, *qn; const PG8_LAS float* rt; const PG8_LAS float *gk, *gq; mutable int ui;
    __device__ __forceinline__ void operator()(const f32x4 (&acc)[2][2][4][2], const Unit& u, int wr, int wc, int fr, int fq) const {
        const int pn = u.pn; const PG8_LAS float* rtu = rt + ui * 256 + wr * 64 + fr; ++ui;
        if (pn >= 4 && pn < 8) {
            const int col0 = (pn - 4) * BM + wc * 32 + 8 * fq;
#pragma unroll
            for (int ai = 0; ai < 2; ++ai)
#pragma unroll
                for (int m = 0; m < 4; ++m) { const int row = u.pm * BM + ai * HALF + wr * 64 + m * 16 + fr; const float rs = rtu[ai * HALF + m * 16]; bf16_t* rowp = v2 + (size_t)row * 1024 + col0;
#pragma unroll
                    for (int bj = 0; bj < 2; ++bj) { const f32x4 v0 = acc[ai][bj][m][0] * rs, v1 = acc[ai][bj][m][1] * rs;
                        u32x4 w; w.x = cvt_pk_bf16(v0[0], v0[1]); w.y = cvt_pk_bf16(v0[2], v0[3]); w.z = cvt_pk_bf16(v1[0], v1[1]); w.w = cvt_pk_bf16(v1[2], v1[3]);
                        store16_wt(rowp + bj * HALF, w); } }
        } else {
            const bool isq = pn >= 8; const PG8_LAS float* gp = isq ? gq : gk; bf16_t* dst = isq ? qn : kn; const int pl = isq ? pn - 8 : pn;
            const float sc = isq ? 0.125f * 1.4426950408889634f : 1.0f;
            f32x4 gv[2][2];
#pragma unroll
            for (int bj = 0; bj < 2; ++bj)
#pragma unroll
                for (int n = 0; n < 2; ++n) gv[bj][n] = *(const PG8_LAS f32x4*)(gp + 32 * bj + 8 * fq + 4 * n) * sc;
            const int col0 = pl * BM + wc * 64 + 8 * fq;
#pragma unroll
            for (int ai = 0; ai < 2; ++ai)
#pragma unroll
                for (int m = 0; m < 4; ++m) { const int row = u.pm * BM + ai * HALF + wr * 64 + m * 16 + fr; const float rs = rtu[ai * HALF + m * 16]; bf16_t* rowp = dst + (size_t)row * 1024 + col0;
                    f32x4 x[2][2]; float s = 0.f;
#pragma unroll
                    for (int bj = 0; bj < 2; ++bj)
#pragma unroll
                        for (int n = 0; n < 2; ++n) { x[bj][n] = acc[ai][bj][m][n] * rs; s += (x[bj][n][0] * x[bj][n][0] + x[bj][n][1] * x[bj][n][1]) + (x[bj][n][2] * x[bj][n][2] + x[bj][n][3] * x[bj][n][3]); }
                    s += __shfl_xor(s, 16); s += __shfl_xor(s, 32);
                    const float r2 = __builtin_amdgcn_rsqf(s * (1.0f / 64.0f) + RMS_EPS);
#pragma unroll
                    for (int bj = 0; bj < 2; ++bj) { const f32x4 v0 = x[bj][0] * r2 * gv[bj][0], v1 = x[bj][1] * r2 * gv[bj][1];
                        u32x4 w; w.x = cvt_pk_bf16(v0[0], v0[1]); w.y = cvt_pk_bf16(v0[2], v0[3]); w.z = cvt_pk_bf16(v1[0], v1[1]); w.w = cvt_pk_bf16(v1[2], v1[3]);
                        store16_wt(rowp + 32 * bj, w); } }
        }
    }
};

template <class Epi, class Sched, bool ALIGN_EPI = false, bool SP2 = false>
__device__ __forceinline__ void gemm_phase(PG8_LAS unsigned char* lds, const Gemm g, const Sched& S, const Epi& E) {
    const int tid = threadIdx.x, wid = __builtin_amdgcn_readfirstlane(tid >> 6), lane = tid & 63, wr = wid >> 2, wc = wid & 3, fr = lane & 15, fq = lane >> 4;
    const int K = g.K, nt = K / BK;
    unsigned voffA[2], voffB[2];
#pragma unroll
    for (int i = 0; i < 2; ++i) { int R, C; stage_rc(tid * 16 + i * 8192, R, C); const int Rb = Epi::PERM ? ((R & ~31) + perm32(R & 31)) : R;
        voffA[i] = (unsigned)(R * K + C) * 2u; voffB[i] = (unsigned)(Rb * K + C) * 2u; }
    const size_t kstep = (size_t)(BK * 2);
    const size_t hstep = (size_t)HALF * K * 2;
    const size_t tstep = 2 * hstep;
    const unsigned ldsw = (unsigned)wid * 1024u;
    const int aoff = lds_byte(wr * 64 + fr, fq * 8), boff = lds_byte(wc * 32 + fr, fq * 8);
#define PG8_SA(b, h) (((b) * 2 + (h)) * HTB)
#define PG8_SB(b, h) ((4 + (b) * 2 + (h)) * HTB)
#define PG8_STAGE(bufoff, gbase, voff) do { _Pragma("unroll") for (int _i = 0; _i < 2; ++_i) \
        __builtin_amdgcn_global_load_lds((const unsigned*)((const char*)(gbase) + (voff)[_i]), (PG8_LAS unsigned*)(lds + (bufoff) + ldsw + _i * 8192), 16, 0, 0); } while (0)
#define PG8_LDA(dst, b, h) do { _Pragma("unroll") for (int m = 0; m < 4; ++m) _Pragma("unroll") for (int k = 0; k < 2; ++k) dst[m][k] = *(const PG8_LAS bf16x8*)(lds + PG8_SA(b, h) + aoff + m * 2048 + k * 1024); } while (0)
#define PG8_LDB(dst, b, h) do { _Pragma("unroll") for (int n = 0; n < 2; ++n) _Pragma("unroll") for (int k = 0; k < 2; ++k) dst[n][k] = *(const PG8_LAS bf16x8*)(lds + PG8_SB(b, h) + boff + n * 2048 + k * 1024); } while (0)
#define PG8_MMA(ai, bj, At, Bt) do { __builtin_amdgcn_s_setprio(1); _Pragma("unroll") for (int m = 0; m < 4; ++m) _Pragma("unroll") for (int n = 0; n < 2; ++n) _Pragma("unroll") for (int k = 0; k < 2; ++k) \
        acc[ai][bj][m][n] = __builtin_amdgcn_mfma_f32_16x16x32_bf16(Bt[n][k], At[m][k], acc[ai][bj][m][n], 0, 0, 0); __builtin_amdgcn_s_setprio(0); } while (0)
#define PG8_WAIT_V(n) asm volatile("s_waitcnt vmcnt(" #n ")" ::: "memory")
#define PG8_WAIT_L(n) asm volatile("s_waitcnt lgkmcnt(" #n ")" ::: "memory")
#define PG8_BAR __builtin_amdgcn_s_barrier()
#define PG8_SCHED __builtin_amdgcn_sched_barrier(0)
    Unit cur, nxt; int ui = 0;
    if (!S.next(0, cur)) return;
    f32x4 acc[2][2][4][2];
#pragma unroll
    for (int a = 0; a < 2; ++a)
#pragma unroll
        for (int b = 0; b < 2; ++b)
#pragma unroll
            for (int m = 0; m < 4; ++m)
#pragma unroll
                for (int n = 0; n < 2; ++n) acc[a][b][m][n] = (f32x4){0.f, 0.f, 0.f, 0.f};
    bf16x8 At[4][2], B0[2][2], B1[2][2];
    const char* cA = (const char*)g.A + (size_t)cur.pm * tstep; const char* cB = (const char*)g.Bt + (size_t)cur.pn * tstep;
    S.a_ready(cur);
    if constexpr (SP2) {
        PG8_STAGE(PG8_SB(0, 0), cB, voffB); PG8_STAGE(PG8_SB(0, 1), cB + hstep, voffB); PG8_STAGE(PG8_SA(0, 0), cA, voffA); PG8_STAGE(PG8_SA(0, 1), cA + hstep, voffA);
        if (wr == 1) PG8_BAR;
        PG8_WAIT_V(2); PG8_BAR;
        PG8_STAGE(PG8_SB(1, 0), cB + kstep, voffB); PG8_STAGE(PG8_SA(1, 0), cA + kstep, voffA); PG8_STAGE(PG8_SB(1, 1), cB + hstep + kstep, voffB);
        PG8_WAIT_V(6); PG8_BAR;
    } else {
        PG8_STAGE(PG8_SB(0, 0), cB, voffB); PG8_STAGE(PG8_SA(0, 0), cA, voffA); PG8_STAGE(PG8_SB(0, 1), cB + hstep, voffB); PG8_STAGE(PG8_SA(0, 1), cA + hstep, voffA);
        if (wr == 1) PG8_BAR;
        PG8_WAIT_V(4); PG8_BAR;
        PG8_STAGE(PG8_SB(1, 0), cB + kstep, voffB); PG8_STAGE(PG8_SA(1, 0), cA + kstep, voffA); PG8_STAGE(PG8_SB(1, 1), cB + hstep + kstep, voffB);
        PG8_WAIT_V(6); PG8_BAR;
    }
    for (;;) {
        const bool has_next = S.next(ui + 1, nxt);
        const char* nA = has_next ? (const char*)g.A + (size_t)nxt.pm * tstep : cA; const char* nB = has_next ? (const char*)g.Bt + (size_t)nxt.pn * tstep : cB;
        for (int t = 0; t < nt; t += 2) {
            const bool last = (t == nt - 2);
            const char* a1 = cA + (size_t)(t + 1) * kstep;
            const char* a2 = last ? nA : cA + (size_t)(t + 2) * kstep; const char* b2 = last ? nB : cB + (size_t)(t + 2) * kstep;
            const char* a3 = a2 + kstep; const char* b3 = b2 + kstep;
            if (last && has_next) S.a_ready(nxt);
            if constexpr (SP2) {
            PG8_LDB(B0, 0, 0); PG8_LDB(B1, 0, 1); PG8_SCHED; PG8_LDA(At, 0, 0); PG8_STAGE(PG8_SA(1, 1), a1 + hstep, voffA);
            PG8_WAIT_V(8); PG8_WAIT_L(0); PG8_BAR; PG8_MMA(0, 0, At, B0); PG8_MMA(0, 1, At, B1); PG8_BAR; PG8_SCHED;
            PG8_LDA(At, 0, 1); PG8_STAGE(PG8_SB(0, 0), b2, voffB); PG8_STAGE(PG8_SB(0, 1), b2 + hstep, voffB); PG8_STAGE(PG8_SA(0, 0), a2, voffA);
            PG8_WAIT_V(8); PG8_WAIT_L(0); PG8_BAR; PG8_MMA(1, 0, At, B0); PG8_MMA(1, 1, At, B1); PG8_BAR; PG8_SCHED;
            PG8_LDB(B0, 1, 0); PG8_LDB(B1, 1, 1); PG8_SCHED; PG8_LDA(At, 1, 0); PG8_STAGE(PG8_SA(0, 1), a2 + hstep, voffA);
            PG8_WAIT_V(8); PG8_WAIT_L(0); PG8_BAR; PG8_MMA(0, 0, At, B0); PG8_MMA(0, 1, At, B1); PG8_BAR; PG8_SCHED;
            PG8_LDA(At, 1, 1); PG8_STAGE(PG8_SB(1, 0), b3, voffB); PG8_STAGE(PG8_SB(1, 1), b3 + hstep, voffB); PG8_STAGE(PG8_SA(1, 0), a3, voffA);
            PG8_WAIT_V(8); PG8_WAIT_L(0); PG8_BAR; PG8_MMA(1, 0, At, B0); PG8_MMA(1, 1, At, B1); PG8_BAR; PG8_SCHED;
            } else {
            PG8_LDB(B0, 0, 0); PG8_SCHED; PG8_LDA(At, 0, 0); PG8_STAGE(PG8_SA(1, 1), a1 + hstep, voffA);
            PG8_WAIT_L(8); PG8_BAR; PG8_WAIT_L(0); PG8_MMA(0, 0, At, B0); PG8_BAR; PG8_SCHED;
            PG8_LDB(B1, 0, 1); PG8_STAGE(PG8_SB(0, 0), b2, voffB);
            PG8_BAR; PG8_WAIT_L(0); PG8_MMA(0, 1, At, B1); PG8_BAR;
            PG8_LDA(At, 0, 1); PG8_STAGE(PG8_SA(0, 0), a2, voffA);
            PG8_BAR; PG8_WAIT_L(0); PG8_MMA(1, 0, At, B0); PG8_BAR; PG8_SCHED;
            PG8_STAGE(PG8_SB(0, 1), b2 + hstep, voffB);
            PG8_WAIT_V(6); PG8_BAR; PG8_MMA(1, 1, At, B1); PG8_BAR;
            PG8_LDB(B0, 1, 0); PG8_SCHED; PG8_LDA(At, 1, 0); PG8_STAGE(PG8_SA(0, 1), a2 + hstep, voffA);
            PG8_WAIT_L(8); PG8_BAR; PG8_WAIT_L(0); PG8_MMA(0, 0, At, B0); PG8_BAR; PG8_SCHED;
            PG8_LDB(B1, 1, 1); PG8_STAGE(PG8_SB(1, 0), b3, voffB);
            PG8_BAR; PG8_WAIT_L(0); PG8_MMA(0, 1, At, B1); PG8_BAR;
            PG8_LDA(At, 1, 1); PG8_STAGE(PG8_SA(1, 0), a3, voffA);
            PG8_BAR; PG8_WAIT_L(0); PG8_MMA(1, 0, At, B0); PG8_BAR; PG8_SCHED;
            PG8_STAGE(PG8_SB(1, 1), b3 + hstep, voffB);
            PG8_WAIT_V(6); PG8_BAR; PG8_MMA(1, 1, At, B1); PG8_BAR;
            }
        }
        if constexpr (ALIGN_EPI) { if (wr == 0) PG8_BAR; }
        if constexpr (!Epi::AFTER_DRAIN) { E(acc, cur, wr, wc, fr, fq); S.done(cur); }
        if (!has_next) break;
#pragma unroll
        for (int a = 0; a < 2; ++a)
#pragma unroll
            for (int b = 0; b < 2; ++b)
#pragma unroll
                for (int m = 0; m < 4; ++m)
#pragma unroll
                    for (int n = 0; n < 2; ++n) acc[a][b][m][n] = (f32x4){0.f, 0.f, 0.f, 0.f};
        cur = nxt; cA = nA; cB = nB; ++ui;
        if constexpr (ALIGN_EPI) { if (wr == 1) PG8_BAR; }
    }
    PG8_WAIT_V(0);
    if constexpr (!ALIGN_EPI) { if (wr == 0) PG8_BAR; }
    PG8_BAR;
    if constexpr (Epi::AFTER_DRAIN) { E.fused(acc, cur, wr, wc, fr, fq, lds, wid, lane); S.done(cur); }
#undef PG8_SA
#undef PG8_SB
#undef PG8_STAGE
#undef PG8_LDA
#undef PG8_LDB
#undef PG8_MMA
#undef PG8_WAIT_V
#undef PG8_WAIT_L
#undef PG8_BAR
#undef PG8_SCHED
}
}

#ifndef PG8_SP2
#define PG8_SP2 true
#endif
#ifndef PG8_ALIGN
#define PG8_ALIGN true
#endif

#include <hip/hip_bf16.h>
#include <cmath>
namespace attn_body {
using bf16=__hip_bfloat16;
using bf16x8=__attribute__((ext_vector_type(8)))short;
using s16x4=__attribute__((ext_vector_type(4)))short;
using f32x16=__attribute__((ext_vector_type(16)))float;
using u32x4=__attribute__((ext_vector_type(4)))unsigned;
constexpr int BATCH=4,NHC=16,SEQ=4096,D=64,DVV=128;
constexpr int QP=1024,KP=1024,VP=1024,OP=2048;
constexpr int NW=8,QBLK=32,QB=QBLK*NW,KVBLK=64,NQB=SEQ/QB;
constexpr int ATTN_UNIT_ROWS=QB;
__device__ __forceinline__ int crow(int r,int hi){return (r&3)+8*(r>>2)+4*hi;}
#define SBAR() __builtin_amdgcn_sched_barrier(0)
__device__ __forceinline__ void cmask(f32x16&p0,f32x16&p1,int jb,int qrel,int hi){
  const float NEG=-INFINITY; int kb=64*jb+4*hi;
  #pragma unroll
  for(int r=0;r<16;++r){int kv=kb+(r&3)+8*(r>>2); if(kv>qrel)p0[r]=NEG; if(kv+32>qrel)p1[r]=NEG;}
}

constexpr int NSLOT=3, SLOTB=8192, VSLOTB=2*SLOTB;
constexpr int LDS_K=0, LDS_V=NSLOT*SLOTB, LDS_WS=LDS_V+NSLOT*VSLOTB, LDS_OST=LDS_WS+NW*64*4, LDS_BYTES=LDS_OST+NW*4096;
constexpr float C2=0.125f*1.4426950408889634f;
__device__ __forceinline__ void glds16(const void*gsrc,unsigned lds_dst){unsigned keep;
  asm volatile("s_mov_b32 %0, m0\n\ts_mov_b32 m0, %2\n\ts_nop 0\n\tglobal_load_lds_dwordx4 %1, off\n\ts_mov_b32 m0, %0":"=&s"(keep):"v"(gsrc),"s"(lds_dst):"memory");}
__device__ __forceinline__ float max3f(float a,float b,float c){float r;asm("v_max3_f32 %0, %1, %2, %3":"=v"(r):"v"(a),"v"(b),"v"(c));return r;}
__device__ __forceinline__ float max2f(float a,float b){float r;asm("v_max_f32_e32 %0, %1, %2":"=v"(r):"v"(a),"v"(b));return r;}
__device__ __forceinline__ float fadd_s(float a,float b){float r;asm("v_add_f32_e32 %0, %1, %2":"=v"(r):"v"(a),"v"(b));return r;}
__device__ __forceinline__ float fsub_s(float a,float b){float r;asm("v_sub_f32_e32 %0, %1, %2":"=v"(r):"v"(a),"v"(b));return r;}
typedef float f32x2_t __attribute__((ext_vector_type(2))); typedef __bf16 bf16x2_t __attribute__((ext_vector_type(2)));
__device__ __forceinline__ unsigned cvtpk_s(float lo,float hi){f32x2_t v={lo,hi};bf16x2_t b=__builtin_convertvector(v,bf16x2_t);return __builtin_bit_cast(unsigned,b);}
#define WAIT_BAR(N) asm volatile("s_waitcnt vmcnt(" #N ") lgkmcnt(0)\n\ts_barrier":::"memory")

__device__ __forceinline__ void qkt(f32x16&p0,f32x16&p1,const char*Kslot,const bf16x8*qr,const f32x16&negm,int r32,int hi){
  const char*kb=Kslot+hi*1024+r32*16;
  #pragma unroll
  for(int d0=0;d0<4;++d0){
    const bf16x8 b0=*reinterpret_cast<const bf16x8*>(kb+d0*2048);
    const bf16x8 b1=*reinterpret_cast<const bf16x8*>(kb+d0*2048+512);
    if(d0==0){p0=__builtin_amdgcn_mfma_f32_32x32x16_bf16(b0,qr[0],negm,0,0,0);p1=__builtin_amdgcn_mfma_f32_32x32x16_bf16(b1,qr[0],negm,0,0,0);}
    else{p0=__builtin_amdgcn_mfma_f32_32x32x16_bf16(b0,qr[d0],p0,0,0,0);p1=__builtin_amdgcn_mfma_f32_32x32x16_bf16(b1,qr[d0],p1,0,0,0);}}
}
typedef __attribute__((address_space(3))) const char* lds_cptr;
typedef short v4i16_t __attribute__((ext_vector_type(4)));
__device__ __forceinline__ void kload8(bf16x8*kf,lds_cptr kp){
  kf[0]=*(const __attribute__((address_space(3))) bf16x8*)(kp);      kf[1]=*(const __attribute__((address_space(3))) bf16x8*)(kp+512);
  kf[2]=*(const __attribute__((address_space(3))) bf16x8*)(kp+2048); kf[3]=*(const __attribute__((address_space(3))) bf16x8*)(kp+2560);
  kf[4]=*(const __attribute__((address_space(3))) bf16x8*)(kp+4096); kf[5]=*(const __attribute__((address_space(3))) bf16x8*)(kp+4608);
  kf[6]=*(const __attribute__((address_space(3))) bf16x8*)(kp+6144); kf[7]=*(const __attribute__((address_space(3))) bf16x8*)(kp+6656);
}
__device__ __forceinline__ void kload2(bf16x8*kf,lds_cptr kp,int j){ kf[2*j]=*(const __attribute__((address_space(3))) bf16x8*)(kp+j*2048); kf[2*j+1]=*(const __attribute__((address_space(3))) bf16x8*)(kp+j*2048+512); }
__device__ __forceinline__ s16x4 vtr(lds_cptr p){ return __builtin_bit_cast(s16x4,__builtin_amdgcn_ds_read_tr16_b64_v4i16((__attribute__((address_space(3))) v4i16_t*)p)); }
__device__ __forceinline__ float rowmax(const f32x16&p0,const f32x16&p1){
  float a=max3f(p0[0],p0[1],p1[0]),b=max3f(p0[2],p0[3],p1[1]);a=max3f(a,p1[2],p1[3]);
  #pragma unroll
  for(int r=4;r<16;r+=4){a=max3f(a,p0[r],p0[r+1]);b=max3f(b,p0[r+2],p0[r+3]);a=max3f(a,p1[r],p1[r+1]);b=max3f(b,p1[r+2],p1[r+3]);}
  const float m=max2f(a,b);
  auto rr=__builtin_amdgcn_permlane32_swap(__float_as_uint(m),__float_as_uint(m),false,false);
  return max2f(__uint_as_float(rr[0]),__uint_as_float(rr[1]));
}
__device__ __forceinline__ void pv(f32x16*o,int vb,bf16x8 pa0,bf16x8 pa1,bf16x8 pa2,bf16x8 pa3){
  #pragma unroll
  for(int d0=0;d0<4;++d0){s16x4 lo[4],hi[4];
    #pragma unroll
    for(int ks=0;ks<4;++ks){
      asm volatile("ds_read_b64_tr_b16 %0,%1 offset:%c2":"=&v"(lo[ks]):"v"(vb),"i"(d0*4096+ks*1024):"memory");
      asm volatile("ds_read_b64_tr_b16 %0,%1 offset:%c2":"=&v"(hi[ks]):"v"(vb),"i"(d0*4096+ks*1024+512):"memory");}
    asm volatile("s_waitcnt lgkmcnt(0)":::"memory");SBAR();
    #define PK(k) (bf16x8){lo[k][0],lo[k][1],lo[k][2],lo[k][3],hi[k][0],hi[k][1],hi[k][2],hi[k][3]}
    o[d0]=__builtin_amdgcn_mfma_f32_32x32x16_bf16(pa0,PK(0),o[d0],0,0,0);
    o[d0]=__builtin_amdgcn_mfma_f32_32x32x16_bf16(pa1,PK(1),o[d0],0,0,0);
    o[d0]=__builtin_amdgcn_mfma_f32_32x32x16_bf16(pa2,PK(2),o[d0],0,0,0);
    o[d0]=__builtin_amdgcn_mfma_f32_32x32x16_bf16(pa3,PK(3),o[d0],0,0,0);
    #undef PK
  }
}

#ifndef ATTN_STORE16
#define ATTN_STORE16(p,v) (*(u32x4*)(p)=(v))
#endif
template<int THRL> __device__ __forceinline__ void attn_unit(int b,int hc,int qb,const bf16*Q,const bf16*__restrict__ K,const bf16*__restrict__ V,bf16*O,char*shm){
  const int qkcol=hc*D, vcol=(hc>>1)*DVV, ocol=hc*DVV;
  const int tid=threadIdx.x,lane=tid&63,r32=lane&31,hi=lane>>5; const int wid=__builtin_amdgcn_readfirstlane(tid>>6);
  const long rowbase=(long)b*SEQ; const int q0=qb*QB;
  const bf16*Qw=Q+(rowbase+q0+wid*QBLK)*QP+qkcol;
  const bf16*Kh=K+rowbase*KP+qkcol,*Vh=V+rowbase*VP+vcol;
  const unsigned lds0=(unsigned)(uintptr_t)shm;
  float*wsf=(float*)(shm+LDS_WS)+wid*64;
  const bf16*ksrc=Kh+(long)lane*KP+wid*8;
  const bf16*vsrc=Vh+(long)(16*(wid&3)+(lane>>2))*VP+(wid>>2)*32+(lane&3)*8;
  const unsigned kdst=lds0+LDS_K+wid*1024, vdst=lds0+LDS_V+wid*1024;
  #define DMA_K(t,slot) glds16(ksrc+(long)(t)*KVBLK*KP,(unsigned)__builtin_amdgcn_readfirstlane(kdst+(slot)))
  #define DMA_V(t,slot) do{ glds16(vsrc+(long)(t)*KVBLK*VP,(unsigned)__builtin_amdgcn_readfirstlane(vdst+2*(slot))); glds16(vsrc+64+(long)(t)*KVBLK*VP,(unsigned)__builtin_amdgcn_readfirstlane(vdst+2*(slot)+8192)); }while(0)
  const int vb0=(int)(lds0+LDS_V)+((lane>>4)&1)*32+(lane&3)*8+(4*hi+((lane&15)>>2))*64;
  const char*Kbase=shm+LDS_K; bf16x8 kf[8];
  const lds_cptr shm3=(lds_cptr)shm; const lds_cptr kp0=shm3+LDS_K+hi*1024+r32*16; const lds_cptr vp0=shm3+LDS_V+((lane>>4)&1)*32+(lane&3)*8+(4*hi+((lane&15)>>2))*64;
  const int NT=(q0+QB)/KVBLK;
  DMA_K(0,0);DMA_V(0,0);DMA_K(1,SLOTB);
  bf16x8 qr[4];
  #pragma unroll
  for(int d0=0;d0<4;++d0)qr[d0]=*reinterpret_cast<const bf16x8*>(&Qw[(long)r32*QP+d0*16+hi*8]);
  float mhat=0.f,l_reg=0.f;f32x16 o[4];o[0]=f32x16{};o[1]=f32x16{};o[2]=f32x16{};o[3]=f32x16{};
  const int qrel=wid*QBLK+r32;
  #define CMASK(P0,P1,t) do{int jb_=(t)-(NT-4); if(jb_>=0)cmask(P0,P1,jb_,qrel,hi);}while(0)
  bool resc=false;
  #define START(P0,P1) do{ const float rm=rowmax(P0,P1); resc=false; \
    { const float dl=rm; mhat=fadd_s(mhat,dl); \
      _Pragma("unroll") for(int r=0;r<16;++r){P0[r]=fsub_s(P0[r],dl);P1[r]=fsub_s(P1[r],dl);} } \
    _Pragma("unroll") for(int r=0;r<16;++r)P0[r]=__builtin_amdgcn_exp2f(P0[r]); }while(0)
  #define RESC() do{ if(resc){ asm volatile("s_waitcnt lgkmcnt(0)":::"memory"); \
      _Pragma("unroll") for(int d_=0;d_<4;++d_) _Pragma("unroll") for(int r=0;r<16;++r)o[d_][r]*=wsf[crow(r,hi)]; } }while(0)
  f32x16 pA0,pA1,pB0,pB1;
  int sl_prev=0,sl_cur=0,sl_next=SLOTB;
  #define ROT() do{sl_prev=sl_cur;sl_cur=sl_next;sl_next=(sl_next==(NSLOT-1)*SLOTB)?0:sl_next+SLOTB;}while(0)
  DMA_K(2,2*SLOTB);
  WAIT_BAR(4);
  { const f32x16 z0=f32x16{}; qkt(pA0,pA1,Kbase,qr,z0,r32,hi); }asm volatile("s_nop 15\n\ts_nop 7":"+v"(pA0),"+v"(pA1));CMASK(pA0,pA1,0);
  START(pA0,pA1);
  _Pragma("unroll") for(int r=0;r<16;++r)pA1[r]=__builtin_amdgcn_exp2f(pA1[r]);
  WAIT_BAR(0);
  DMA_K(3,0);DMA_V(1,SLOTB);
  ROT();
  kload8(kf,kp0+sl_cur);
  WAIT_BAR(3);
  s16x4 vlo[4],vhi[4]; u32x4 pw0,pw1,pw2,pw3;
  #define PKW(P,B) cvtpk_s(P[B],P[B+1])
  #define PAF(k) __builtin_bit_cast(bf16x8,pw##k)
  #define VFR(i) (bf16x8){vlo[i][0],vlo[i][1],vlo[i][2],vlo[i][3],vhi[i][0],vhi[i][1],vhi[i][2],vhi[i][3]}
  #define PIN(x) asm volatile("":"+v"(x))
  #define MX3(a,b,c) __builtin_fmaxf(__builtin_fmaxf((a),(b)),(c))
  #define GAPA(MF,A0,A1,A2,A3,W0,W1,PW) do{ MF; sacc+=A0; sacc+=A1; sacc+=A2; sacc+=A3; PIN(sacc); W0; W1; PIN(PW); SBAR(); }while(0)
  #define EX(v) __builtin_amdgcn_exp2f(v)
  #define GAPB(MF,X,B) do{ MF; X[B]=EX(X[B]-mhat); X[B+1]=EX(X[B+1]-mhat); PIN(X); SBAR(); }while(0)
  #define VRD(p,i) do{ vlo[p]=vtr(vp_+(((i)>>2)*4096+((i)&3)*1024)); vhi[p]=vtr(vp_+(((i)>>2)*4096+((i)&3)*1024+512)); }while(0)
  #define KRD(G,j) do{ if(G){ kload2(kf,kp0+sl_next,j); SBAR(); } }while(0)
  #define ZC (f32x16{})
  #define STEP(C0,C1,P0,P1,t,GK,GV,GL) do{ SBAR(); \
    const lds_cptr vp_=vp0+2*sl_prev; \
    float sacc=(P0[0]+P0[1]); \
    GAPA(C0=__builtin_amdgcn_mfma_f32_32x32x16_bf16(kf[0],qr[0],ZC,0,0,0), P0[2],P0[3],P0[4],P0[5],     pw0[0]=PKW(P0,0), pw0[1]=PKW(P0,2), pw0); \
    GAPA(C1=__builtin_amdgcn_mfma_f32_32x32x16_bf16(kf[1],qr[0],ZC,0,0,0), P0[6],P0[7],P0[8],P0[9],     pw0[2]=PKW(P0,4), pw0[3]=PKW(P0,6), pw0); \
    GAPA(C0=__builtin_amdgcn_mfma_f32_32x32x16_bf16(kf[2],qr[1],C0,0,0,0),   P0[10],P0[11],P0[12],P0[13], pw1[0]=PKW(P0,8), pw1[1]=PKW(P0,10), pw1); \
    GAPA(C1=__builtin_amdgcn_mfma_f32_32x32x16_bf16(kf[3],qr[1],C1,0,0,0),   P0[14],P0[15],P1[0],P1[1],   pw1[2]=PKW(P0,12),pw1[3]=PKW(P0,14), pw1); \
    GAPA(C0=__builtin_amdgcn_mfma_f32_32x32x16_bf16(kf[4],qr[2],C0,0,0,0),   P1[2],P1[3],P1[4],P1[5],     pw2[0]=PKW(P1,0), pw2[1]=PKW(P1,2), pw2); \
    VRD(0,0); SBAR(); GAPA(C1=__builtin_amdgcn_mfma_f32_32x32x16_bf16(kf[5],qr[2],C1,0,0,0),   P1[6],P1[7],P1[8],P1[9],     pw2[2]=PKW(P1,4), pw2[3]=PKW(P1,6), pw2); \
    VRD(1,4); SBAR(); GAPA(C0=__builtin_amdgcn_mfma_f32_32x32x16_bf16(kf[6],qr[3],C0,0,0,0),   P1[10],P1[11],P1[12],P1[13], pw3[0]=PKW(P1,8), pw3[1]=PKW(P1,10), pw3); \
    VRD(2,1); SBAR(); GAPA(C1=__builtin_amdgcn_mfma_f32_32x32x16_bf16(kf[7],qr[3],C1,0,0,0),   P1[14],P1[15],0.f,0.f,       pw3[2]=PKW(P1,12),pw3[3]=PKW(P1,14), pw3); \
    l_reg+=sacc; \
    if(GK){DMA_K((t)+3,sl_cur);} if(GV){DMA_V((t)+1,sl_next);} \
    CMASK(C0,C1,t); \
    { float a=MX3(C0[0],C0[1],C1[0]),b=MX3(C0[2],C0[3],C1[1]); a=MX3(a,C1[2],C1[3]); \
      _Pragma("unroll") for(int r=4;r<16;r+=4){a=MX3(a,C0[r],C0[r+1]);b=MX3(b,C0[r+2],C0[r+3]);a=MX3(a,C1[r],C1[r+1]);b=MX3(b,C1[r+2],C1[r+3]);} \
      float rm=__builtin_fmaxf(a,b); { auto rr=__builtin_amdgcn_permlane32_swap(__float_as_uint(rm),__float_as_uint(rm),false,false); rm=__builtin_fmaxf(__uint_as_float(rr[0]),__uint_as_float(rr[1])); } \
      rm-=mhat; resc=false; \
      if(__builtin_expect(__any(rm>(float)THRL),0)){ const float dl=__builtin_fmaxf(rm,0.f); mhat+=dl; \
        const float f=__builtin_amdgcn_exp2f(-dl); l_reg*=f; if(hi==0)wsf[r32]=f; resc=true; } } \
    SBAR(); \
    VRD(3,5);  SBAR(); GAPB(o[0]=__builtin_amdgcn_mfma_f32_32x32x16_bf16(PAF(0),VFR(0),o[0],0,0,0), C0,0); \
    VRD(0,2);  SBAR(); GAPB(o[1]=__builtin_amdgcn_mfma_f32_32x32x16_bf16(PAF(0),VFR(1),o[1],0,0,0), C0,2); \
    VRD(1,6);  SBAR(); KRD(GL,0); GAPB(o[0]=__builtin_amdgcn_mfma_f32_32x32x16_bf16(PAF(1),VFR(2),o[0],0,0,0), C0,4); \
    VRD(2,3);  SBAR(); KRD(GL,1); GAPB(o[1]=__builtin_amdgcn_mfma_f32_32x32x16_bf16(PAF(1),VFR(3),o[1],0,0,0), C0,6); \
    VRD(3,7);  SBAR(); KRD(GL,2); GAPB(o[0]=__builtin_amdgcn_mfma_f32_32x32x16_bf16(PAF(2),VFR(0),o[0],0,0,0), C0,8); \
    VRD(0,8);  SBAR(); KRD(GL,3); GAPB(o[1]=__builtin_amdgcn_mfma_f32_32x32x16_bf16(PAF(2),VFR(1),o[1],0,0,0), C0,10); \
    VRD(1,12); SBAR(); GAPB(o[0]=__builtin_amdgcn_mfma_f32_32x32x16_bf16(PAF(3),VFR(2),o[0],0,0,0), C0,12); \
    VRD(2,9);  SBAR(); GAPB(o[1]=__builtin_amdgcn_mfma_f32_32x32x16_bf16(PAF(3),VFR(3),o[1],0,0,0), C0,14); \
    VRD(3,13); SBAR(); GAPB(o[2]=__builtin_amdgcn_mfma_f32_32x32x16_bf16(PAF(0),VFR(0),o[2],0,0,0), C1,0); \
    VRD(0,10); SBAR(); GAPB(o[3]=__builtin_amdgcn_mfma_f32_32x32x16_bf16(PAF(0),VFR(1),o[3],0,0,0), C1,2); \
    VRD(1,14); SBAR(); GAPB(o[2]=__builtin_amdgcn_mfma_f32_32x32x16_bf16(PAF(1),VFR(2),o[2],0,0,0), C1,4); \
    VRD(2,11); SBAR(); GAPB(o[3]=__builtin_amdgcn_mfma_f32_32x32x16_bf16(PAF(1),VFR(3),o[3],0,0,0), C1,6); \
    VRD(3,15); SBAR(); GAPB(o[2]=__builtin_amdgcn_mfma_f32_32x32x16_bf16(PAF(2),VFR(0),o[2],0,0,0), C1,8); \
    GAPB(o[3]=__builtin_amdgcn_mfma_f32_32x32x16_bf16(PAF(2),VFR(1),o[3],0,0,0), C1,10); \
    GAPB(o[2]=__builtin_amdgcn_mfma_f32_32x32x16_bf16(PAF(3),VFR(2),o[2],0,0,0), C1,12); \
    GAPB(o[3]=__builtin_amdgcn_mfma_f32_32x32x16_bf16(PAF(3),VFR(3),o[3],0,0,0), C1,14); \
    }while(0)
  int t=1;
  #undef CMASK
  #define CMASK(P0,P1,t) do{}while(0)
  for(;t+5<NT;t+=2){
    STEP(pB0,pB1,pA0,pA1,t,true,true,true);     WAIT_BAR(3); RESC(); ROT();
    STEP(pA0,pA1,pB0,pB1,t+1,true,true,true);   WAIT_BAR(3); RESC(); ROT();
  }
  #undef CMASK
  #define CMASK(P0,P1,t) do{int jb_=(t)-(NT-4); if(jb_>=0)cmask(P0,P1,jb_,qrel,hi);}while(0)
  #define ENDW(tt) do{ if((tt)+3<NT){WAIT_BAR(3);} else if((tt)+2<NT){WAIT_BAR(2);} else {WAIT_BAR(0);} }while(0)
  for(;t+1<NT;t+=2){
    STEP(pB0,pB1,pA0,pA1,t,(t+3<NT),(t+1<NT),(t+1<NT));       ENDW(t);   RESC(); ROT();
    STEP(pA0,pA1,pB0,pB1,t+1,(t+4<NT),(t+2<NT),(t+2<NT));     ENDW(t+1); RESC(); ROT();
  }
  STEP(pB0,pB1,pA0,pA1,NT-1,false,false,false); RESC();
  { float sacc=pB0[0]+pB0[1]; _Pragma("unroll") for(int r=2;r<16;++r)sacc+=pB0[r]; _Pragma("unroll") for(int r=0;r<16;++r)sacc+=pB1[r]; l_reg+=sacc;
    pw0=(u32x4){PKW(pB0,0),PKW(pB0,2),PKW(pB0,4),PKW(pB0,6)};pw1=(u32x4){PKW(pB0,8),PKW(pB0,10),PKW(pB0,12),PKW(pB0,14)};pw2=(u32x4){PKW(pB1,0),PKW(pB1,2),PKW(pB1,4),PKW(pB1,6)};pw3=(u32x4){PKW(pB1,8),PKW(pB1,10),PKW(pB1,12),PKW(pB1,14)};
    SBAR(); pv(o,vb0+2*sl_cur,PAF(0),PAF(1),PAF(2),PAF(3)); }
  #undef PKW
  #undef PAF
  #undef VFR
  #undef PIN
  #undef MX3
  #undef GAPA
  #undef GAPB
  #undef EX
  #undef VRD
  #undef KRD
  #undef STEP
  #undef ZC
  #undef ENDW
  {auto rr=__builtin_amdgcn_permlane32_swap(__float_as_uint(l_reg),__float_as_uint(l_reg),false,false);l_reg=__uint_as_float(rr[0])+__uint_as_float(rr[1]);}
  if(hi==0)wsf[32+r32]=l_reg;asm volatile("s_waitcnt lgkmcnt(0)":::"memory");
  float rli[16];
  #pragma unroll
  for(int r=0;r<16;++r)rli[r]=__builtin_amdgcn_rcpf(wsf[32+crow(r,hi)]);
  bf16*Ow=O+(rowbase+q0+wid*QBLK)*OP+ocol;
  { bf16*stg=(bf16*)(shm+LDS_OST)+wid*2048;
    #pragma unroll
    for(int h2=0;h2<2;++h2){
    #pragma unroll
    for(int r=0;r<16;++r){const int orow=crow(r,hi);
      #pragma unroll
      for(int d0=0;d0<2;++d0)stg[orow*64+d0*32+r32]=__float2bfloat16(o[2*h2+d0][r]*rli[r]);}
    asm volatile("s_waitcnt lgkmcnt(0)":::"memory");
    #pragma unroll
    for(int i=0;i<4;++i){const int row=i*8+(lane>>3),ch=lane&7; const u32x4 v=*(const u32x4*)(stg+row*64+ch*8); ATTN_STORE16(Ow+(long)row*OP+h2*64+ch*8,v);}
    asm volatile("s_waitcnt lgkmcnt(0)":::"memory"); } }
  asm volatile("s_waitcnt lgkmcnt(0)\n\ts_barrier":::"memory");
  #undef DMA_K
  #undef DMA_V
  #undef CMASK
  #undef START
  #undef RESC
  #undef ROT
}
constexpr int ATTN_LDS_BYTES=LDS_BYTES;
struct AttnTensors { const bf16* Q; const bf16* K; const bf16* V; bf16* O; };
struct AttnUnit { int bh; int qb; };
struct StaticOrder {
  int vcu;
  __device__ __forceinline__ explicit StaticOrder(int grid,int block):vcu((block%8)*(grid/8)+block/8){}
  __device__ __forceinline__ bool next(int i,AttnUnit&u)const{ if(i>=4)return false; const int p=vcu&7; u.bh=(vcu>>3)*2+(i>>1); u.qb=(i&1)?15-p:p; return true; }
  __device__ __forceinline__ void a_ready(const AttnUnit&)const{}
  __device__ __forceinline__ void done(const AttnUnit&)const{}
};
template<class Sched,int THRL=8> __device__ __forceinline__ void attn_phase(char*lds,const AttnTensors&T,const Sched&S){
  AttnUnit u;
  for(int i=0;S.next(i,u);++i){ S.a_ready(u); attn_unit<THRL>(u.bh/NHC,u.bh%NHC,u.qb,T.Q,T.K,T.V,T.O,lds); S.done(u); }
}
#undef SBAR
#undef WAIT_BAR
}

#define GAS __attribute__((address_space(1)))
#define LAS __attribute__((address_space(3)))
typedef unsigned v4u __attribute__((ext_vector_type(4)));
typedef GAS unsigned gu32;
typedef GAS unsigned long long gu64;
#define RLX_AGENT __ATOMIC_RELAXED, __HIP_MEMORY_SCOPE_AGENT
#define LDS_WAIT() asm volatile("s_waitcnt lgkmcnt(0)" ::: "memory")
#define VM_WAIT() asm volatile("s_waitcnt vmcnt(0)" ::: "memory")
__device__ __forceinline__ unsigned pk2(float lo, float hi) { return f2bf(lo) | (f2bf(hi) << 16); }

#define XB_TMO      128
#define XB_XCNT(j)  (256  + 64 * (j))
#define XB_XSUB(j)  (1280 + 64 * (j))
#define XB_XGEN(j)  (2304 + 64 * (j))
#define XB_TOP      3328
#define XB_TOPGEN   3392
#define XCD_BAR_WORDS 3456
#define XB_SPIN_CAP (1u << 18)

__device__ __forceinline__ unsigned xb_ld(unsigned* p)              { return __hip_atomic_load(p, __ATOMIC_RELAXED, __HIP_MEMORY_SCOPE_AGENT); }
__device__ __forceinline__ unsigned xb_add(unsigned* p, unsigned v) { return __hip_atomic_fetch_add(p, v, __ATOMIC_RELAXED, __HIP_MEMORY_SCOPE_AGENT); }
__device__ __forceinline__ unsigned xb_xcc_id() { return (unsigned)__builtin_amdgcn_s_getreg((3 << 11) | 20) & 0xFu; }
#define XB_SPIN(cond, bar) do { unsigned _sp = 0; while (cond) { __builtin_amdgcn_s_sleep(1); \
    if ((++_sp & 255u) == 0u) { if (xb_ld(&(bar)[XB_TMO])) break; if (_sp > XB_SPIN_CAP) { atomicAdd(&(bar)[XB_TMO], 1u); break; } } } } while (0)

struct XcdBarrier {
    unsigned* bar; unsigned x;
    volatile LAS unsigned* st;
};

__device__ __forceinline__ XcdBarrier xcd_barrier_post(unsigned* bar, volatile LAS unsigned* st) {
    XcdBarrier b; b.bar = bar; b.x = xb_xcc_id(); b.st = st;
    if (threadIdx.x == 0) (void)xb_add(&bar[XB_XCNT(b.x)], 1u);
    return b;
}
__device__ __forceinline__ void xcd_barrier_complete(unsigned* bar, unsigned x, unsigned& nloc, unsigned& nx) {
    const unsigned G = gridDim.x * gridDim.y * gridDim.z;
    unsigned sum, cnt, mine, sp = 0u;
    for (;;) {
        sum = 0u; cnt = 0u; mine = 0u;
#pragma unroll
        for (unsigned j = 0; j < 16; ++j) { const unsigned c = xb_ld(&bar[XB_XCNT(j)]); sum += c; cnt += (c > 0u) ? 1u : 0u; mine = (j == x) ? c : mine; }
        if (sum == G) break;
        __builtin_amdgcn_s_sleep(1);
        if ((++sp & 255u) == 0u) { if (xb_ld(&bar[XB_TMO])) break; if (sp > XB_SPIN_CAP) { atomicAdd(&bar[XB_TMO], 1u); break; } }
    }
    nloc = mine > 0u ? mine : 1u; nx = cnt > 0u ? cnt : 1u;
}

__device__ __forceinline__ void xcd_barrier(const XcdBarrier& b) {
    asm volatile("s_waitcnt vmcnt(0)" ::: "memory");
    __syncthreads();
    if (threadIdx.x == 0) {
        unsigned* bar = b.bar;
        __builtin_amdgcn_s_waitcnt(0);
        unsigned nloc = b.st[0], nx = b.st[1];
        if (nloc == 0u) { xcd_barrier_complete(bar, b.x, nloc, nx); b.st[0] = nloc; b.st[1] = nx; }
        const unsigned old = xb_add(&bar[XB_XSUB(b.x)], 1u);
        const unsigned gen = old / nloc;
        if (old + 1u == (gen + 1u) * nloc) {
            __builtin_amdgcn_fence(__ATOMIC_RELEASE, "agent");
            asm volatile("s_waitcnt vmcnt(0)" ::: "memory");
            const unsigned og = xb_add(&bar[XB_TOP], 1u);
            const unsigned tg = og / nx;
            if (og + 1u == (tg + 1u) * nx) xb_add(&bar[XB_TOPGEN], 1u);
            else XB_SPIN(xb_ld(&bar[XB_TOPGEN]) == tg, bar);
            __builtin_amdgcn_fence(__ATOMIC_ACQUIRE, "agent");
            xb_add(&bar[XB_XGEN(b.x)], 1u);
            asm volatile("s_waitcnt vmcnt(0)" ::: "memory");
        } else {
            XB_SPIN(xb_ld(&bar[XB_XGEN(b.x)]) == gen, bar);
            __builtin_amdgcn_fence(__ATOMIC_ACQUIRE, "agent");
            asm volatile("s_waitcnt vmcnt(0)" ::: "memory");
        }
    }
    __syncthreads();
}

constexpr int NWAVES = 8;
constexpr int RING_OFF = 0, RING_BYTES = 131072;
constexpr int LDSCTL_OFF = RING_BYTES, MISC_OFF = LDSCTL_OFF + 320;
constexpr int LDS_BYTES = 147456;
constexpr int CW_BAR = 4096;

struct Frame {
    LAS unsigned char* lds;
    volatile LAS unsigned* MISC;
    gu32* ctl;
    int tid, lane, wave, vcu, G;
    const float* in[19]; float* out; unsigned char* ws;
};
struct WDesc { const float* W; const float* gain; bf16* WT; int ldn, c0, K, ncols, roff, mode; };
__device__ __forceinline__ WDesc wdesc(const Frame& F, int i) {
    unsigned char* ws = F.ws; WDesc d;
    switch (i) {
    case 0:  d = WDesc{F.in[2], F.in[1], (bf16*)(ws + WS_WIN), GIN, 0, D, 3072, 0, 0}; break;
    case 1:  d = WDesc{F.in[6], nullptr, (bf16*)(ws + WS_WAO), D, 0, D, D, 0, 0}; break;
    case 2:  d = WDesc{F.in[17], F.in[16], (bf16*)(ws + WS_W1A), FF, 0, D, FF, 0, 0}; break;
    case 3:  d = WDesc{F.in[18], nullptr, (bf16*)(ws + WS_W2A), D, 0, FF, D, 0, 0}; break;
    case 4:  d = WDesc{F.in[8], F.in[7], (bf16*)(ws + WS_WKVQ), 2048, 0, D, 2048, 0, 1}; break;
    case 5:  d = WDesc{F.in[11], F.in[10], (bf16*)(ws + WS_WKVQ), D, 0, D, D, 2048, 1}; break;
    case 6:  d = WDesc{F.in[15], nullptr, (bf16*)(ws + WS_WBO), D, 0, D, D, 0, 0}; break;
    case 7:  d = WDesc{F.in[17] + (size_t)D * FF, F.in[16] + D, (bf16*)(ws + WS_W1B), FF, 0, D, FF, 0, 0}; break;
    default: d = WDesc{F.in[18] + (size_t)D * FF, nullptr, (bf16*)(ws + WS_W2B), D, 0, FF, D, 0, 0}; break;
    }
    return d;
}
__device__ __forceinline__ void p0_transpose_item(const WDesc& d, LAS float* scr, int item, int lane) {
    const int nblk = d.ncols / 64, kb = item / nblk, nb = item % nblk, k0 = 64 * kb, n0 = 64 * nb;
    const int kq = lane >> 4, n4 = (lane & 15) * 4;
    f32x4 v[16];
#pragma unroll
    for (int i = 0; i < 16; ++i) v[i] = __builtin_nontemporal_load((const GAS f32x4*)(d.W + (size_t)(k0 + 4 * i + kq) * d.ldn + d.c0 + n0 + n4));
    const int c = lane & 7;
    f32x4 g0 = (f32x4){1.f, 1.f, 1.f, 1.f}, g1 = g0;
    if (d.gain) { g0 = *(const GAS f32x4*)(d.gain + k0 + 8 * c); g1 = *(const GAS f32x4*)(d.gain + k0 + 8 * c + 4); }
#pragma unroll
    for (int i = 0; i < 16; ++i) { const int kk = 4 * i + kq; *(LAS f32x4*)(scr + kk * 64 + (n4 ^ (kk & 0x38))) = v[i]; }
    LDS_WAIT(); asm volatile("" ::: "memory");
#pragma unroll
    for (int jj = 0; jj < 8; ++jj) { const int n = (lane >> 3) + 8 * jj; const LAS float* sp = scr + (8 * c) * 64 + (n ^ (c << 3));
        const int dr = d.mode ? kvq_dest_row(d.roff + n0 + n) : d.roff + n0 + n;
        v4u o; o.x = pk2(sp[0 * 64] * g0[0], sp[1 * 64] * g0[1]); o.y = pk2(sp[2 * 64] * g0[2], sp[3 * 64] * g0[3]); o.z = pk2(sp[4 * 64] * g1[0], sp[5 * 64] * g1[1]); o.w = pk2(sp[6 * 64] * g1[2], sp[7 * 64] * g1[3]);
        pg8::store16_wt((void*)(d.WT + (size_t)dr * d.K + k0 + 8 * c), o); }
    LDS_WAIT(); asm volatile("" ::: "memory");
}
__device__ __forceinline__ float wave_sum(float v) {
#pragma unroll
    for (int o = 1; o < 64; o <<= 1) v += __shfl_xor(v, o);
    return v;
}
template <int NR> __device__ __forceinline__ void rows_to_bf16(const Frame& F, const float* xrow, bf16* orow, float* ssrow) {
    f32x4 v[NR][4];
#pragma unroll
    for (int r = 0; r < NR; ++r)
#pragma unroll
        for (int j = 0; j < 4; ++j) v[r][j] = __builtin_nontemporal_load(((const GAS f32x4*)(xrow + (size_t)r * D) + F.lane) + 64 * j);
#pragma unroll
    for (int r = 0; r < NR; ++r) { float s = 0.f;
#pragma unroll
        for (int j = 0; j < 4; ++j) s += (v[r][j].x * v[r][j].x + v[r][j].y * v[r][j].y) + (v[r][j].z * v[r][j].z + v[r][j].w * v[r][j].w);
        s = wave_sum(s);
        if (F.lane < 16) ssrow[(size_t)r * 16 + F.lane] = (F.lane == 0) ? s : 0.f;
        GAS unsigned long long* o8 = (GAS unsigned long long*)(orow + (size_t)r * D) + F.lane;
#pragma unroll
        for (int j = 0; j < 4; ++j) o8[64 * j] = (unsigned long long)pk2(v[r][j].x, v[r][j].y) | ((unsigned long long)pk2(v[r][j].z, v[r][j].w) << 32); }
}
__device__ __forceinline__ void p0_prologue(Frame& F) {
    LAS float* scr = (LAS float*)(F.lds + RING_OFF + F.wave * 16384);
    const int gw = F.vcu * NWAVES + F.wave, NGW = F.G * NWAVES;
    int base = 0;
    for (int mi = 0; mi < 9; ++mi) {
        const WDesc d = wdesc(F, mi); const int nit = (d.K / 64) * (d.ncols / 64);
        int it = gw - (base % NGW); if (it < 0) it += NGW;
        for (; it < nit; it += NGW) p0_transpose_item(d, scr, it, F.lane);
        base += nit;
    }
    { const float* W = F.in[2]; const float* g = F.in[1]; bf16* Wz = (bf16*)(F.ws + WS_WZ);
      for (int idx = gw * 64 + F.lane; idx < 16 * D; idx += NGW * 64) { const int k = idx >> 4, r = idx & 15; Wz[(size_t)r * D + k] = (bf16)f2bf(W[(size_t)k * GIN + 3072 + r] * g[k]); } }
    bf16* XB = (bf16*)(F.ws + WS_A); float* SS = (float*)(F.ws + WS_SS);
    for (int m = 4 * gw; m < T; m += 4 * NGW) rows_to_bf16<4>(F, F.in[0] + (size_t)m * D, XB + (size_t)m * D, SS + (size_t)m * 16);
}


__device__ __forceinline__ void combine_local(Frame& F) {
    const int lane = F.lane, wave = F.wave;
    const float* lp = F.in[13]; const float* hg = F.in[14];
    const float s1 = wave_sum(lp[lane] * lp[64 + lane]), s2 = wave_sum(lp[128 + lane] * lp[192 + lane]);
    const float lam = __expf(s1) - __expf(s2) + LAMBDA_INIT;
    const int bhh = F.vcu >> 3, p = F.vcu & 7, b = bhh >> 3, h = bhh & 7, sg = lane & 7;
    float g[16];
#pragma unroll
    for (int j = 0; j < 16; ++j) g[j] = hg[16 * sg + j] * (1.f - LAMBDA_INIT);
    const bf16* O32 = (const bf16*)F.out; bf16* OD = (bf16*)(F.ws + WS_C);
    asm volatile("s_waitcnt vmcnt(0)" ::: "memory"); __syncthreads();
    for (int it0 = 0; it0 < 8; it0 += 4) {
        bf16x8 a0[4], a1[4], b0[4], b1[4]; size_t tt[4];
#pragma unroll
        for (int q = 0; q < 4; ++q) { const int r = (it0 + q) * 64 + wave * 8 + (lane >> 3);
            tt[q] = (size_t)b * SEQ + (size_t)((r < 256) ? p : 15 - p) * 256 + (r & 255);
            const bf16* p0 = O32 + tt[q] * 2048 + (2 * h) * 128 + 16 * sg;
            a0[q] = *(const bf16x8*)p0; a1[q] = *(const bf16x8*)(p0 + 8); b0[q] = *(const bf16x8*)(p0 + 128); b1[q] = *(const bf16x8*)(p0 + 136); }
#pragma unroll
        for (int q = 0; q < 4; ++q) {
            float o[16]; float s = 0.f;
#pragma unroll
            for (int j = 0; j < 8; ++j) { o[j] = bf2f((unsigned short)a0[q][j]) - lam * bf2f((unsigned short)b0[q][j]); o[8 + j] = bf2f((unsigned short)a1[q][j]) - lam * bf2f((unsigned short)b1[q][j]); }
#pragma unroll
            for (int j = 0; j < 16; ++j) s += o[j] * o[j];
            s += __shfl_xor(s, 1); s += __shfl_xor(s, 2); s += __shfl_xor(s, 4);
            const float rstd = __builtin_amdgcn_rsqf(s * (1.f / 128.f) + EPS);
            v4u w0, w1;
            w0.x = pk2(o[0] * rstd * g[0], o[1] * rstd * g[1]); w0.y = pk2(o[2] * rstd * g[2], o[3] * rstd * g[3]); w0.z = pk2(o[4] * rstd * g[4], o[5] * rstd * g[5]); w0.w = pk2(o[6] * rstd * g[6], o[7] * rstd * g[7]);
            w1.x = pk2(o[8] * rstd * g[8], o[9] * rstd * g[9]); w1.y = pk2(o[10] * rstd * g[10], o[11] * rstd * g[11]); w1.z = pk2(o[12] * rstd * g[12], o[13] * rstd * g[13]); w1.w = pk2(o[14] * rstd * g[14], o[15] * rstd * g[15]);
            bf16* qd = OD + tt[q] * 1024 + h * 128 + 16 * sg;
            *(v4u*)qd = w0; *(v4u*)(qd + 8) = w1; }
    }
}
constexpr int RT_OFF = 132096;
__device__ __forceinline__ unsigned off_b(unsigned row, unsigned ch) { return 256u * row + 16u * (ch ^ (((row & 3) << 2) | ((row >> 2) & 3))); }
__device__ __forceinline__ unsigned row_addr16(unsigned lane, unsigned rb, unsigned s) { return off_b((lane & 15) + 16 * rb, 4 * s + (lane >> 4)); }
__device__ __forceinline__ unsigned tr_addr16(unsigned lane, unsigned c, unsigned ks, unsigned t) { const unsigned g = lane >> 4, q = (lane & 15) >> 2, p = lane & 3; return off_b(32 * ks + 8 * g + 4 * t + q, 2 * c + (p >> 1)) + 8 * (p & 1); }
typedef short v4i16_t __attribute__((ext_vector_type(4)));
__device__ __forceinline__ bf16x8 tr_frag(LAS unsigned char* img, unsigned lane, unsigned c, unsigned ks) {
    const v4i16_t lo = __builtin_amdgcn_ds_read_tr16_b64_v4i16((LAS v4i16_t*)(img + tr_addr16(lane, c, ks, 0)));
    const v4i16_t hi = __builtin_amdgcn_ds_read_tr16_b64_v4i16((LAS v4i16_t*)(img + tr_addr16(lane, c, ks, 1)));
    return (bf16x8){lo[0], lo[1], lo[2], lo[3], hi[0], hi[1], hi[2], hi[3]};
}
__device__ __forceinline__ bf16x8 row_frag(LAS unsigned char* img, unsigned lane, unsigned rb, unsigned s) { return *(const LAS bf16x8*)(img + row_addr16(lane, rb, s)); }
#define MFMA16(a, b, c) __builtin_amdgcn_mfma_f32_16x16x32_bf16(a, b, c, 0, 0, 0)

constexpr int ZP_OFF = 137216;
__device__ __forceinline__ void gate_phase(Frame& F) {
    LAS float* ZP = (LAS float*)(F.lds + ZP_OFF);
    const bf16* XB = (const bf16*)(F.ws + WS_A); const bf16* Wz = (const bf16*)(F.ws + WS_WZ); const float* wgu = F.in[3]; const float* bg = F.in[4]; float* BC = (float*)(F.ws + WS_BC);
    const float* SS = (const float*)(F.ws + WS_SS);
    const int lane = F.lane, wave = F.wave, fr = lane & 15, fq = lane >> 4;
    LAS float* ST = (LAS float*)(F.lds + wave * 16384);
    float wb[4][4], bb[4];
#pragma unroll
    for (int nt = 0; nt < 4; ++nt) { bb[nt] = bg[64 * wave + 16 * nt + fr];
#pragma unroll
        for (int kk = 0; kk < 4; ++kk) wb[nt][kk] = wgu[(4 * kk + fq) * 512 + 64 * wave + 16 * nt + fr]; }
    for (int u = F.vcu; u < T / CH; u += F.G) {
        const size_t t0 = (size_t)u * CH;
        { const int mt = wave & 3, kh = wave >> 2; f32x4 acc = (f32x4){0.f, 0.f, 0.f, 0.f};
          const bf16* ap = XB + (t0 + mt * 16 + fr) * D + kh * 512 + 8 * fq; const bf16* bp = Wz + (size_t)fr * D + kh * 512 + 8 * fq;
#pragma unroll
          for (int ks = 0; ks < 16; ++ks) acc = MFMA16(__builtin_nontemporal_load((const bf16x8*)(ap + ks * 32)), *(const bf16x8*)(bp + ks * 32), acc);
#pragma unroll
          for (int j = 0; j < 4; ++j) ZP[(kh * 64 + mt * 16 + 4 * fq + j) * 17 + fr] = acc[j] * pg8::row_rstd(SS, (int)t0 + mt * 16 + 4 * fq + j); }
        __syncthreads();
        float carry[4] = {0.f, 0.f, 0.f, 0.f};
#pragma unroll 1
        for (int mt = 0; mt < 4; ++mt) {
            float za[4];
#pragma unroll
            for (int kk = 0; kk < 4; ++kk) za[kk] = ZP[(mt * 16 + fr) * 17 + 4 * kk + fq] + ZP[(64 + mt * 16 + fr) * 17 + 4 * kk + fq];
#pragma unroll
            for (int nt = 0; nt < 4; ++nt) {
                f32x4 x = (f32x4){bb[nt], bb[nt], bb[nt], bb[nt]};
#pragma unroll
                for (int kk = 0; kk < 4; ++kk) x = __builtin_amdgcn_mfma_f32_16x16x4f32(za[kk], wb[nt][kk], x, 0, 0, 0);
                float p[4]; float run = 0.f;
#pragma unroll
                for (int r = 0; r < 4; ++r) { const float ls = fminf(x[r], 0.f) - __logf(1.f + __expf(-fabsf(x[r]))); run += ls * (1.f / 16.f); p[r] = run; }
                float s1 = run; { const float t = __shfl_up(s1, 16); if (fq >= 1) s1 += t; }
                float s2 = s1;  { const float t = __shfl_up(s2, 32); if (fq >= 2) s2 += t; }
                const float base = carry[nt] + (s2 - run);
                carry[nt] += __shfl(s2, 48 + fr);
#pragma unroll
                for (int r = 0; r < 4; ++r) { const int row = mt * 16 + 4 * fq + r; ST[row * 64 + ((16 * nt + fr) ^ (((row >> 2) & 3) << 4))] = base + p[r]; }
            }
        }
        LDS_WAIT(); asm volatile("" ::: "memory");
#pragma unroll
        for (int i = 0; i < 16; ++i) { const int row = 4 * i + fq; const f32x4 v = *(const LAS f32x4*)(ST + row * 64 + ((4 * fr) ^ (((row >> 2) & 3) << 4)));
            *(f32x4*)(BC + (t0 + row) * 512 + 64 * wave + 4 * fr) = v; }
        __syncthreads();
    }
}

struct GlaSet { unsigned k0, k1, k2, k3; f32x4 bca, bcb, bla, blb; v4u va, vb; float dca, dcb; };
__device__ __forceinline__ void gla_state_phase(Frame& F) {
    LAS unsigned char* lds = F.lds;
    const bf16* KG = (const bf16*)(F.ws + WS_KG); const bf16* VG = (const bf16*)(F.ws + WS_VG); const float* BC = (const float*)(F.ws + WS_BC); bf16* SP = (bf16*)F.out;
    const int tid = F.tid, lane = F.lane, wave = F.wave;
    const int pos = tid >> 3, sub = tid & 7, mt = wave >> 1, nt = wave & 1;
    constexpr int NP = NCH / 2;
    for (int u = F.vcu; u < 256; u += F.G) {
        const int bh = u >> 4, ki = (u >> 2) & 3, vi = u & 3, b = bh >> 2, h = bh & 3;
        const size_t tr0 = (size_t)b * SEQ;
        const bf16* kp = KG + (tr0 + pos) * 512 + h * GDK + ki * 32 + sub * 4;
        const float* bp = BC + (tr0 + pos) * 512 + h * GDK + ki * 32 + sub * 4;
        const float* blp = BC + (tr0 + 63) * 512 + h * GDK + ki * 32 + sub * 4;
        const bf16* vp = VG + (tr0 + pos) * 1024 + h * GDV + vi * 64 + sub * 8;
        const float* dcp = BC + (tr0 + 63) * 512 + h * GDK + ki * 32 + nt * 16 + (lane & 15);
        bf16* spp = SP + ((size_t)(bh * NP) * GDV + vi * 64 + mt * 16 + 4 * (lane >> 4)) * GDK + ki * 32 + nt * 16 + (lane & 15);
        const unsigned kw = off_b(pos, sub >> 1) + 8 * (sub & 1), vw = off_b(pos, sub);
        f32x4 acc = (f32x4){0.f, 0.f, 0.f, 0.f};
#define GLA_LOAD(S, m) do { const size_t o_ = (size_t)(m) * (2 * CH); \
        { const unsigned long long ka_ = *(const unsigned long long*)(kp + o_ * 512), kb_ = *(const unsigned long long*)(kp + (o_ + 64) * 512); S.k0 = (unsigned)ka_; S.k1 = (unsigned)(ka_ >> 32); S.k2 = (unsigned)kb_; S.k3 = (unsigned)(kb_ >> 32); } \
        S.bca = *(const f32x4*)(bp + o_ * 512); S.bcb = *(const f32x4*)(bp + (o_ + 64) * 512); S.bla = *(const f32x4*)(blp + o_ * 512); S.blb = *(const f32x4*)(blp + (o_ + 64) * 512); \
        S.va = *(const v4u*)(vp + o_ * 1024); S.vb = *(const v4u*)(vp + (o_ + 64) * 1024); S.dca = dcp[o_ * 512]; S.dcb = dcp[(o_ + 64) * 512]; } while (0)
#define GLA_STEP(S, m, buf) do { \
        { const f32x4 ea = S.bla + S.blb - S.bca, eb = S.blb - S.bcb;                                    \
          const unsigned w0 = pk2(bf2f(S.k0 & 0xffffu) * __expf(ea[0]), bf2f(S.k0 >> 16) * __expf(ea[1])), w1 = pk2(bf2f(S.k1 & 0xffffu) * __expf(ea[2]), bf2f(S.k1 >> 16) * __expf(ea[3])); \
          const unsigned w2 = pk2(bf2f(S.k2 & 0xffffu) * __expf(eb[0]), bf2f(S.k2 >> 16) * __expf(eb[1])), w3 = pk2(bf2f(S.k3 & 0xffffu) * __expf(eb[2]), bf2f(S.k3 >> 16) * __expf(eb[3])); \
          *(LAS unsigned long long*)(lds + (buf) * 65536 + kw) = (unsigned long long)w0 | ((unsigned long long)w1 << 32); \
          *(LAS unsigned long long*)(lds + (buf) * 65536 + 16384 + kw) = (unsigned long long)w2 | ((unsigned long long)w3 << 32); \
          *(LAS v4u*)(lds + (buf) * 65536 + 32768 + vw) = S.va; *(LAS v4u*)(lds + (buf) * 65536 + 49152 + vw) = S.vb; } \
        const float dec_ = __expf(S.dca + S.dcb); \
        if ((m) + 2 < NP) GLA_LOAD(S, (m) + 2); \
        __syncthreads(); \
        _Pragma("unroll") for (int j = 0; j < 4; ++j) __builtin_nontemporal_store((bf16)f2bf(acc[j]), spp + (size_t)(m) * GDV * GDK + j * GDK); \
        acc = acc * dec_; \
        _Pragma("unroll") for (int ks = 0; ks < 4; ++ks) acc = MFMA16(tr_frag(lds + (buf) * 65536 + 32768, lane, mt, ks), tr_frag(lds + (buf) * 65536, lane, nt, ks), acc); } while (0)
        GlaSet s0, s1;
        GLA_LOAD(s0, 0); GLA_LOAD(s1, 1);
        for (int m = 0; m < NP; m += 2) { GLA_STEP(s0, m, 0); GLA_STEP(s1, m + 1, 1); }
#undef GLA_LOAD
#undef GLA_STEP
        __syncthreads();
    }
}

struct GlaRaw { bf16x8 q[4], k[4]; f32x4 b0[4], b1[4], l0, l1; };
__device__ __forceinline__ void gla_out_phase(Frame& F) {
    LAS unsigned char* lds = F.lds;
    LAS unsigned char *QI = lds, *AI = lds + 16384, *KI = lds + 32768, *VI = lds + 65536, *OL = lds;
    LAS float* RED = (LAS float*)(lds + RT_OFF); LAS float* RS = RED + 512;
    const bf16* QG = (const bf16*)(F.ws + WS_QG); const bf16* KG = (const bf16*)(F.ws + WS_KG); const bf16* VG = (const bf16*)(F.ws + WS_VG); const bf16* GGp = (const bf16*)(F.ws + WS_GG);
    const float* BC = (const float*)(F.ws + WS_BC); const bf16* SP = (const bf16*)F.out; bf16* OG = (bf16*)(F.ws + WS_C); const float* hg = F.in[5];
    const int tid = F.tid, lane = F.lane, wave = F.wave, fr = lane & 15, fq = lane >> 4;
    const float g0 = hg[32 * wave + fr], g1 = hg[32 * wave + 16 + fr];
    constexpr int NU = NB * GH * (NCH / 2);
#define GLA_T0(u) ((size_t)((u) >> 7) * SEQ + (size_t)((u) & 31) * (2 * CH))
#define GLA_H(u) (((u) >> 5) & 3)
#define GLA_LOADRAW(R, u) do { const size_t t0_ = GLA_T0(u); const int h_ = GLA_H(u); \
        _Pragma("unroll") for (int r = 0; r < 4; ++r) { const int n = tid + 512 * r, pos = n >> 4, ch = n & 15; const size_t e = (t0_ + pos) * 512 + h_ * GDK + ch * 8; \
            R.q[r] = __builtin_nontemporal_load((const bf16x8*)(QG + e)); R.k[r] = __builtin_nontemporal_load((const bf16x8*)(KG + e)); \
            R.b0[r] = __builtin_nontemporal_load((const f32x4*)(BC + e)); R.b1[r] = __builtin_nontemporal_load((const f32x4*)(BC + e + 4)); } \
        { const size_t e = (t0_ + 63) * 512 + h_ * GDK + (tid & 15) * 8; R.l0 = *(const f32x4*)(BC + e); R.l1 = *(const f32x4*)(BC + e + 4); } } while (0)
#define GLA_LOADSF(u) do { const bf16* sp = SP + ((size_t)(u) * GDV + 32 * wave + fr) * GDK + 8 * fq; \
        _Pragma("unroll") for (int nt = 0; nt < 2; ++nt) _Pragma("unroll") for (int ks = 0; ks < 4; ++ks) sf[nt][ks] = __builtin_nontemporal_load((const bf16x8*)(sp + nt * 16 * GDK + ks * 32)); } while (0)
    int u = F.vcu;
    if (u >= NU) return;
    bf16x8 sf[2][4];
    GLA_LOADSF(u);
    for (;;) {
        const size_t t0 = GLA_T0(u); const int h = GLA_H(u); const int un = u + F.G; const bool has_next = un < NU;
        GlaRaw R; GLA_LOADRAW(R, u);
        v4u vv[8];
#pragma unroll
        for (int r = 0; r < 8; ++r) { const int n = tid + 512 * r, pos = n >> 5, c32 = n & 31; vv[r] = __builtin_nontemporal_load((const v4u*)(VG + (t0 + pos) * 1024 + h * GDV + c32 * 8)); }
        v4u wq1[2];
#pragma unroll
        for (int r = 0; r < 4; ++r) { const int n = tid + 512 * r, pos = n >> 4, ch = n & 15;
            float qq[8], kk[8];
#pragma unroll
            for (int j = 0; j < 8; ++j) { float bj = j < 4 ? R.b0[r][j & 3] : R.b1[r][j & 3]; if (r >= 2) bj += j < 4 ? R.l0[j & 3] : R.l1[j & 3]; const float ex = __expf(bj);
                qq[j] = bf2f((unsigned short)R.q[r][j]) * ex * 0.08838834764831845f; kk[j] = bf2f((unsigned short)R.k[r][j]) * __builtin_amdgcn_rcpf(ex); }
            v4u wqr; wqr.x = pk2(qq[0], qq[1]); wqr.y = pk2(qq[2], qq[3]); wqr.z = pk2(qq[4], qq[5]); wqr.w = pk2(qq[6], qq[7]);
            if (r < 2) *(LAS v4u*)(QI + off_b(pos, ch)) = wqr; else wq1[r - 2] = wqr;
            v4u wk; wk.x = pk2(kk[0], kk[1]); wk.y = pk2(kk[2], kk[3]); wk.z = pk2(kk[4], kk[5]); wk.w = pk2(kk[6], kk[7]);
            *(LAS v4u*)(KI + (pos >> 6) * 16384 + off_b(pos & 63, ch)) = wk; }
        {
#pragma unroll
          for (int r = 0; r < 8; ++r) { const int n = tid + 512 * r, pos = n >> 5, c32 = n & 31; *(LAS v4u*)(VI + ((pos >> 6) * 2 + (c32 >> 4)) * 16384 + off_b(pos & 63, c32 & 15)) = vv[r]; } }
#pragma unroll 1
        for (int hf = 0; hf < 2; ++hf) {
            if (hf) {
#pragma unroll
                for (int r = 0; r < 2; ++r) { const int n = tid + 512 * r, pos = n >> 4, ch = n & 15; *(LAS v4u*)(QI + off_b(pos, ch)) = wq1[r]; } }
            __syncthreads();
            { const int mt = wave >> 1;
#pragma unroll
              for (int q = 0; q < (hf ? 4 : 2); ++q) { const int nt = (hf ? 4 : 2) * (wave & 1) + q; f32x4 a4 = (f32x4){0.f, 0.f, 0.f, 0.f};
                  const bool diag = hf ? (nt >= 4) : true; const int ntl = (hf && nt >= 4) ? nt - 4 : nt;
                  if (!diag || ntl <= mt) { LAS unsigned char* kimg = KI + ((hf && nt >= 4) ? 16384 : 0);
#pragma unroll
                      for (int ks = 0; ks < 4; ++ks) a4 = MFMA16(row_frag(QI, lane, mt, ks), row_frag(kimg, lane, ntl, ks), a4); }
#pragma unroll
                  for (int r = 0; r < 4; ++r) { const int ii = mt * 16 + 4 * fq + r, jl = ntl * 16 + fr, jj = nt * 16 + fr; const float val = (!diag || jl <= ii) ? a4[r] : 0.f;
                      *(LAS unsigned short*)(AI + off_b(ii, jj >> 3) + 2 * (jj & 7)) = (unsigned short)f2bf(val); } } }
            __syncthreads();
            f32x4 o[4][2];
#pragma unroll
            for (int m = 0; m < 4; ++m) { o[m][0] = (f32x4){0.f, 0.f, 0.f, 0.f}; o[m][1] = (f32x4){0.f, 0.f, 0.f, 0.f}; }
#pragma unroll
            for (int ks = 0; ks < (hf ? 4 : 2); ++ks) { bf16x8 bfr[2];
#pragma unroll
                for (int nt = 0; nt < 2; ++nt) { const int dv = 32 * wave + 16 * nt; bfr[nt] = tr_frag(VI + ((ks >> 1) * 2 + (dv >> 7)) * 16384, lane, (dv & 127) >> 4, ks & 1); }
#pragma unroll
                for (int m = 0; m < 4; ++m) { const bf16x8 a = row_frag(AI, lane, m, ks); o[m][0] = MFMA16(a, bfr[0], o[m][0]); o[m][1] = MFMA16(a, bfr[1], o[m][1]); } }
#pragma unroll
            for (int ks = 0; ks < 4; ++ks)
#pragma unroll
                for (int m = 0; m < 4; ++m) { const bf16x8 a = row_frag(QI, lane, m, ks); o[m][0] = MFMA16(a, sf[0][ks], o[m][0]); o[m][1] = MFMA16(a, sf[1][ks], o[m][1]); }
            bf16x8 gv[4];
#pragma unroll
            for (int r = 0; r < 4; ++r) { const int n = tid + 512 * r, pos = n >> 5, c32 = n & 31; gv[r] = __builtin_nontemporal_load((const bf16x8*)(GGp + (t0 + 64 * hf + pos) * 1024 + h * GDV + c32 * 8)); }
            if (hf && has_next) GLA_LOADSF(un);
#pragma unroll
            for (int m = 0; m < 4; ++m)
#pragma unroll
                for (int r = 0; r < 4; ++r) { float s = o[m][0][r] * o[m][0][r] + o[m][1][r] * o[m][1][r];
                    s += __shfl_xor(s, 1); s += __shfl_xor(s, 2); s += __shfl_xor(s, 4); s += __shfl_xor(s, 8);
                    if (fr == 0) RED[wave * 64 + m * 16 + 4 * fq + r] = s; }
            __syncthreads();
            if (tid < 64) { float tot = 0.f;
#pragma unroll
                for (int w = 0; w < 8; ++w) tot += RED[w * 64 + tid];
                RS[tid] = __builtin_amdgcn_rsqf(tot * (1.f / GDV) + EPS); }
            __syncthreads();
#pragma unroll
            for (int m = 0; m < 4; ++m) { const f32x4 rs4 = *(const LAS f32x4*)(RS + m * 16 + 4 * fq);
#pragma unroll
                for (int r = 0; r < 4; ++r) { LAS unsigned char* rowp = OL + (m * 16 + 4 * fq + r) * 512 + (32 * wave + fr) * 2;
                    *(LAS unsigned short*)rowp = (unsigned short)f2bf(o[m][0][r] * rs4[r] * g0); *(LAS unsigned short*)(rowp + 32) = (unsigned short)f2bf(o[m][1][r] * rs4[r] * g1); } }
            __syncthreads();
#pragma unroll
            for (int r = 0; r < 4; ++r) { const int n = tid + 512 * r, pos = n >> 5, c32 = n & 31;
                const bf16x8 ov = *(const LAS bf16x8*)(OL + pos * 512 + c32 * 16); const size_t e = (t0 + 64 * hf + pos) * 1024 + h * GDV + c32 * 8;
                v4u w; w.x = pk2(bf2f((unsigned short)ov[0]) * bf2f((unsigned short)gv[r][0]), bf2f((unsigned short)ov[1]) * bf2f((unsigned short)gv[r][1]));
                w.y = pk2(bf2f((unsigned short)ov[2]) * bf2f((unsigned short)gv[r][2]), bf2f((unsigned short)ov[3]) * bf2f((unsigned short)gv[r][3]));
                w.z = pk2(bf2f((unsigned short)ov[4]) * bf2f((unsigned short)gv[r][4]), bf2f((unsigned short)ov[5]) * bf2f((unsigned short)gv[r][5]));
                w.w = pk2(bf2f((unsigned short)ov[6]) * bf2f((unsigned short)gv[r][6]), bf2f((unsigned short)ov[7]) * bf2f((unsigned short)gv[r][7]));
                *(v4u*)(OG + e) = w; }
            __syncthreads();
        }
        if (!has_next) break;
        u = un;
    }
#undef GLA_T0
#undef GLA_H
#undef GLA_LOADRAW
#undef GLA_LOADSF
}
__device__ __forceinline__ void fill_rstd_table(Frame& F, const pg8::StaticOrder& S, const float* ss) {
    LAS float* RT = (LAS float*)(F.lds + RT_OFF); pg8::Unit u;
    for (int i = 0; i < 4 && S.next(i, u); ++i) if (F.tid < 256) RT[i * 256 + F.tid] = pg8::row_rstd(ss, u.pm * 256 + F.tid);
    __syncthreads();
}

struct Args { const float* in[19]; float* out; unsigned char* ws; int ph_lo, ph_hi, li, pad; };
__global__ void __launch_bounds__(NWAVES * 64, 2) mega(Args args) {
    extern __shared__ __attribute__((aligned(16))) unsigned char lds[];
    Frame F;
    F.lds = (LAS unsigned char*)lds;
    F.MISC = (volatile LAS unsigned*)(F.lds + MISC_OFF);
    F.tid = threadIdx.x; F.lane = F.tid & 63; F.wave = __builtin_amdgcn_readfirstlane(F.tid >> 6);
    F.G = gridDim.x; { const int bx = blockIdx.x; F.vcu = (F.G % 8 == 0) ? (bx % 8) * (F.G / 8) + bx / 8 : bx; }
#pragma unroll
    for (int i = 0; i < 19; ++i) F.in[i] = args.in[i];
    F.out = args.out; F.ws = args.ws; F.ctl = (gu32*)(args.ws + WS_CTL);
    unsigned char* ws = args.ws;
    for (int u = F.tid; u < (LDS_BYTES - LDSCTL_OFF) / 4; u += NWAVES * 64) ((LAS unsigned*)(F.lds + LDSCTL_OFF))[u] = 0u;
    __syncthreads();
    const int lo = args.ph_lo, hi = args.ph_hi;
    XcdBarrier bar; bar.bar = (unsigned*)(F.ctl + CW_BAR) + args.li * XCD_BAR_WORDS; bar.x = 0; bar.st = nullptr;
    if (hi - lo > 1) bar = xcd_barrier_post((unsigned*)(F.ctl + CW_BAR) + args.li * XCD_BAR_WORDS, F.MISC + 8);
#define IN(k) (lo <= (k) && (k) < hi)
#define SEAM(k) do { if (IN(k) && IN((k) + ((k) == 8 ? 2 : 1))) xcd_barrier(bar); } while (0)
    bf16 *Win = (bf16*)(ws + WS_WIN), *Wao = (bf16*)(ws + WS_WAO), *W1a = (bf16*)(ws + WS_W1A), *W2a = (bf16*)(ws + WS_W2A);
    bf16 *Wkvq = (bf16*)(ws + WS_WKVQ), *Wbo = (bf16*)(ws + WS_WBO), *W1b = (bf16*)(ws + WS_W1B), *W2b = (bf16*)(ws + WS_W2B);
    float* SS = (float*)(ws + WS_SS);
    bf16 *RA = (bf16*)(ws + WS_A), *RC = (bf16*)(ws + WS_C), *HM = (bf16*)(ws + WS_HM);

    if (IN(0)) { p0_prologue(F); SEAM(0); }
    if (IN(1)) {
        pg8::Gemm g{RA, Win, T, 3072, D}; pg8::StaticOrder S; S.init(T, 3072, F.G, (int)blockIdx.x);
        fill_rstd_table(F, S, SS);
        pg8::EpiInProj E{(bf16*)(ws + WS_QG), (bf16*)(ws + WS_KG), (bf16*)(ws + WS_VG), (bf16*)(ws + WS_GG), (const LAS float*)(F.lds + RT_OFF), 0};
        pg8::gemm_phase<pg8::EpiInProj, pg8::StaticOrder, PG8_ALIGN, PG8_SP2>(F.lds + RING_OFF, g, S, E);
        gate_phase(F);
        SEAM(1);
    }
    if (IN(2)) { gla_state_phase(F); SEAM(2); }
    if (IN(3)) { gla_out_phase(F); SEAM(3); }
    if (IN(4)) {
        pg8::Gemm g{RC, Wao, T, D, D}; pg8::StaticOrder S; S.init(T, D, F.G, (int)blockIdx.x);
        pg8::EpiResB<1> E{nullptr, RA, (bf16*)F.out, nullptr, SS};
        pg8::gemm_phase<pg8::EpiResB<1>, pg8::StaticOrder, PG8_ALIGN, PG8_SP2>(F.lds + RING_OFF, g, S, E);
        SEAM(4);
    }
    if (IN(5)) {
        pg8::Gemm g{(const bf16*)F.out, W1a, T, FF, D}; pg8::StaticOrder S; S.init(T, FF, F.G, (int)blockIdx.x);
        fill_rstd_table(F, S, SS);
        pg8::EpiUp E{HM, (const LAS float*)(F.lds + RT_OFF), 0};
        pg8::gemm_phase<pg8::EpiUp, pg8::StaticOrder, PG8_ALIGN, PG8_SP2>(F.lds + RING_OFF, g, S, E);
        SEAM(5);
    }
    if (IN(6)) {
        pg8::Gemm g{HM, W2a, T, D, FF}; pg8::StaticOrder S; S.init(T, D, F.G, (int)blockIdx.x);
        pg8::EpiResB<1> E{nullptr, (const bf16*)F.out, RA, nullptr, SS};
        pg8::gemm_phase<pg8::EpiResB<1>, pg8::StaticOrder, PG8_ALIGN, PG8_SP2>(F.lds + RING_OFF, g, S, E);
        SEAM(6);
    }
    if (IN(7)) {
        pg8::Gemm g{RA, Wkvq, T, 3072, D}; pg8::StaticOrder S; S.init(T, 3072, F.G, (int)blockIdx.x);
        if (F.tid < 128) ((LAS float*)(F.lds + RT_OFF + 4096))[F.tid] = (F.tid < 64) ? F.in[9][F.tid] : F.in[12][F.tid - 64];
        fill_rstd_table(F, S, SS);
        pg8::EpiKVQ E{(bf16*)(ws + WS_KN), (bf16*)(ws + WS_V2), (bf16*)(ws + WS_QN), (const LAS float*)(F.lds + RT_OFF), (const LAS float*)(F.lds + RT_OFF + 4096), (const LAS float*)(F.lds + RT_OFF + 4096 + 256), 0};
        pg8::gemm_phase<pg8::EpiKVQ, pg8::StaticOrder, PG8_ALIGN, PG8_SP2>(F.lds + RING_OFF, g, S, E);
        SEAM(7);
    }
    if (IN(8)) {
        const attn_body::AttnTensors AT{(const attn_body::bf16*)(ws + WS_QN), (const attn_body::bf16*)(ws + WS_KN), (const attn_body::bf16*)(ws + WS_V2), (attn_body::bf16*)F.out};
        const attn_body::StaticOrder S((int)F.G, (int)blockIdx.x);
        attn_body::attn_phase<attn_body::StaticOrder>((char*)lds + RING_OFF, AT, S);
        combine_local(F);
        SEAM(8);
    }
    if (IN(10)) {
        pg8::Gemm g{RC, Wbo, T, D, D}; pg8::StaticOrder S; S.init(T, D, F.G, (int)blockIdx.x);
        pg8::EpiResB<1> E{nullptr, RA, RA, nullptr, SS};
        pg8::gemm_phase<pg8::EpiResB<1>, pg8::StaticOrder, PG8_ALIGN, PG8_SP2>(F.lds + RING_OFF, g, S, E);
        SEAM(10);
    }
    if (IN(11)) {
        pg8::Gemm g{RA, W1b, T, FF, D}; pg8::StaticOrder S; S.init(T, FF, F.G, (int)blockIdx.x);
        fill_rstd_table(F, S, SS);
        pg8::EpiUp E{HM, (const LAS float*)(F.lds + RT_OFF), 0};
        pg8::gemm_phase<pg8::EpiUp, pg8::StaticOrder, PG8_ALIGN, PG8_SP2>(F.lds + RING_OFF, g, S, E);
        SEAM(11);
    }
    if (IN(12)) {
        pg8::Gemm g{HM, W2b, T, D, FF}; pg8::StaticOrder S; S.init(T, D, F.G, (int)blockIdx.x);
        pg8::EpiResB<2> E{nullptr, RA, nullptr, F.out, nullptr};
        pg8::gemm_phase<pg8::EpiResB<2>, pg8::StaticOrder, PG8_ALIGN, PG8_SP2>(F.lds + RING_OFF, g, S, E);
    }
#undef IN
#undef SEAM
}

extern "C" void kernel_launch(void* const* d_in, const int* in_sizes, int n_in, void* d_out, int out_size, void* d_ws, size_t ws_size, hipStream_t stream) {
    static int grid = 0;
    if (grid == 0) {
        if (n_in != 19 || out_size != T * D || ws_size < WS_END) { fprintf(stderr, "kernel_launch: unexpected shapes (n_in %d out %d ws %zu)\n", n_in, out_size, ws_size); grid = -1; return; }
        int dev = 0, cus = 0, per_cu = 0;
        if (hipGetDevice(&dev) != hipSuccess || hipDeviceGetAttribute(&cus, hipDeviceAttributeMultiprocessorCount, dev) != hipSuccess) { grid = -1; return; }
        if (hipFuncSetAttribute((const void*)mega, hipFuncAttributeMaxDynamicSharedMemorySize, LDS_BYTES) != hipSuccess) { fprintf(stderr, "kernel_launch: hipFuncSetAttribute failed\n"); grid = -1; return; }
        if (hipOccupancyMaxActiveBlocksPerMultiprocessor(&per_cu, (const void*)mega, NWAVES * 64, LDS_BYTES) != hipSuccess || per_cu < 1) { fprintf(stderr, "kernel_launch: occupancy query says %d blocks per CU\n", per_cu); grid = -1; (void)hipGetLastError(); return; }
        if (cus < 256) { fprintf(stderr, "kernel_launch: built for the 256 CUs of an MI355X (one resident workgroup per CU), found %d\n", cus); grid = -1; return; }
        grid = 256;
    }
    if (grid < 0) return;
    unsigned char* ws = (unsigned char*)d_ws;
    (void)hipMemsetAsync(ws + WS_CTL, 0, 64 * 1024, stream);
    Args a{};
    for (int i = 0; i < 19; ++i) a.in[i] = (const float*)d_in[i];
    a.out = (float*)d_out; a.ws = ws;
    int li = 0;
    auto run = [&](int lo, int hi) { a.ph_lo = lo; a.ph_hi = hi; a.li = li++; hipLaunchKernelGGL(mega, dim3(grid), dim3(NWAVES * 64), LDS_BYTES, stream, a); };
    run(0, 13);
}
```

```cpp
#include <hip/hip_runtime.h>
#include <cstdio>
#include <cstdint>

typedef unsigned short bf16;
typedef short bf16x8 __attribute__((ext_vector_type(8)));
typedef float f32x4 __attribute__((ext_vector_type(4)));

constexpr int NB = 4, SEQ = 4096, T = NB * SEQ, D = 1024, FF = 4096;
constexpr int GH = 4, GDK = 128, GDV = 256, GR = 16, CH = 64, NCH = SEQ / CH;
constexpr int GIN = 3088;
constexpr int DH = 8, DDH = 64, DVD = 128;
constexpr float EPS = 1e-6f;
constexpr float LOG2E = 1.4426950408889634f;
constexpr float LAMBDA_INIT = 0.35550906759f;

constexpr size_t MiB = 1u << 20;
constexpr size_t WS_CTL = 0;
constexpr size_t WS_SS = 1 * MiB;
constexpr size_t WS_ZB = 2 * MiB;
constexpr size_t WS_WZ = 3 * MiB;
constexpr size_t WS_WIN = 4 * MiB;
constexpr size_t WS_WAO = 10 * MiB;
constexpr size_t WS_W1A = 12 * MiB;
constexpr size_t WS_W2A = 20 * MiB;
constexpr size_t WS_WKVQ = 28 * MiB;
constexpr size_t WS_WBO = 34 * MiB;
constexpr size_t WS_W1B = 36 * MiB;
constexpr size_t WS_W2B = 44 * MiB;
constexpr size_t WS_B = 52 * MiB;
constexpr size_t WS_A = 180 * MiB;
constexpr size_t WS_C = 212 * MiB;
constexpr size_t WS_END = 244 * MiB;
constexpr size_t WS_QG = WS_B, WS_KG = WS_B + 16 * MiB, WS_VG = WS_B + 32 * MiB, WS_GG = WS_B + 64 * MiB, WS_BC = WS_B + 96 * MiB;
constexpr size_t WS_HM = WS_B;
constexpr size_t WS_KN = WS_B, WS_V2 = WS_B + 32 * MiB, WS_QN = WS_B + 64 * MiB;

__host__ __device__ __forceinline__ unsigned f2bf(float f) { unsigned u = __builtin_bit_cast(unsigned, f); return (u + 0x7fffu + ((u >> 16) & 1u)) >> 16; }
__host__ __device__ __forceinline__ float bf2f(unsigned h) { return __builtin_bit_cast(float, h << 16); }

__host__ __device__ __forceinline__ int kvq_dest_row(int n) {
    if (n >= 1024 && n < 2048) return n;
    const int tile = n >> 8, w = n & 255, lb = w >> 5, j = w & 31, wc = lb >> 1, bj = lb & 1;
    return (tile << 8) + 128 * bj + 32 * wc + j;
}

namespace pg8 {
#define PG8_LAS __attribute__((address_space(3)))
typedef unsigned short bf16_t;
typedef short bf16x8 __attribute__((ext_vector_type(8)));
typedef float f32x4 __attribute__((ext_vector_type(4)));
typedef unsigned u32x4 __attribute__((ext_vector_type(4)));
constexpr int BM = 256, BK = 64, HALF = 128, HTB = HALF * BK * 2  , STAGE_BYTES = 8 * HTB, NXCD = 8, WGM = 8;

__host__ __device__ __forceinline__ int lds_byte(int r, int c) { const int st = (r >> 4) * 2 + (c >> 5), rr = r & 15, cc = c & 31, ob = rr * 64 + cc * 2; return st * 1024 + (ob ^ (((ob >> 9) & 1) << 5)); }
__host__ __device__ __forceinline__ void stage_rc(int b, int& R, int& C) { const int st = b / 1024, sb = b % 1024, swz = sb ^ (((sb >> 9) & 1) << 5); R = (st >> 1) * 16 + swz / 64; C = (st & 1) * 32 + (swz % 64) / 2; }
__host__ __device__ __forceinline__ int perm32(int rho) { const int n = rho >> 4, i = rho & 15; return 8 * (i >> 2) + 4 * n + (i & 3); }

struct Unit { int pm, pn; };
struct Gemm { const bf16_t* A; const bf16_t* Bt; int M, N, K; };

struct StaticOrder {
    int nM, nN, nwg, G, c;
    __host__ __device__ void init(int M, int N, int G_, int c_) { nM = M / BM; nN = N / BM; nwg = nM * nN; G = G_; c = c_; }
    __host__ __device__ bool next(int i, Unit& u) const {
        const long L = (long)i * G + c; if (L >= nwg) return false;
        int wgid = (int)L; { const int q = nwg / NXCD, r = nwg % NXCD, xcd = wgid % NXCD, off = wgid / NXCD; wgid = (xcd < r ? xcd * (q + 1) : r * (q + 1) + (xcd - r) * q) + off; }
        const int nig = WGM * nN, gid = wgid / nig, fm = gid * WGM, gsz = (nM - fm) < WGM ? (nM - fm) : WGM;
        u.pm = fm + ((wgid % nig) % gsz); u.pn = (wgid % nig) / gsz; return true;
    }
    __device__ __forceinline__ void a_ready(const Unit&) const {}
    __device__ __forceinline__ void done(const Unit&) const {}
};

__device__ __forceinline__ unsigned cvt_pk_bf16(float lo, float hi) { unsigned r; asm volatile("v_cvt_pk_bf16_f32 %0, %1, %2" : "=v"(r) : "v"(lo), "v"(hi)); return r; }
typedef float f32x2 __attribute__((ext_vector_type(2)));
typedef unsigned u32x2 __attribute__((ext_vector_type(2)));
__device__ __forceinline__ void store16_wt(void* p, u32x4 v) { asm volatile("global_store_dwordx4 %0, %1, off sc1\n\ts_nop 1" :: "v"(p), "v"(v) : "memory"); }
constexpr int TOK = 16384;
constexpr float RMS_EPS = 1e-6f;
__device__ __forceinline__ float silu_f(float g) { return g * __builtin_amdgcn_rcpf(1.0f + __builtin_amdgcn_exp2f(-1.4426950408889634f * g)); }
__device__ __forceinline__ float row_rstd(const float* ss, int row) {
    const f32x4 a = *(const f32x4*)(ss + (size_t)row * 16), b = *(const f32x4*)(ss + (size_t)row * 16 + 4), c = *(const f32x4*)(ss + (size_t)row * 16 + 8), d = *(const f32x4*)(ss + (size_t)row * 16 + 12);
    const float q = ((a[0] + a[1]) + (a[2] + a[3])) + ((b[0] + b[1]) + (b[2] + b[3])) + ((c[0] + c[1]) + (c[2] + c[3])) + ((d[0] + d[1]) + (d[2] + d[3]));
    return __builtin_amdgcn_rsqf(q * (1.0f / 1024.0f) + RMS_EPS);
}
struct EpiInProj {
    static constexpr bool PERM = true, AFTER_DRAIN = false;
    bf16_t *q, *k, *v, *g; const PG8_LAS float* rt; mutable int ui;
    __device__ __forceinline__ void operator()(const f32x4 (&acc)[2][2][4][2], const Unit& u, int wr, int wc, int fr, int fq) const {
        const int row0 = u.pm * BM + wr * 64 + fr; const int pn = u.pn; const PG8_LAS float* rtu = rt + ui * 256 + wr * 64 + fr; ++ui;
        bf16_t* base; int ldc, colt; const bool act = pn >= 8;
        if (pn < 2) { base = q; ldc = 512; colt = pn * BM; } else if (pn < 4) { base = k; ldc = 512; colt = (pn - 2) * BM; }
        else if (pn < 8) { base = v; ldc = 1024; colt = (pn - 4) * BM; } else { base = g; ldc = 1024; colt = (pn - 8) * BM; }
        const int col0 = colt + wc * 32 + 8 * fq;
#pragma unroll
        for (int ai = 0; ai < 2; ++ai)
#pragma unroll
            for (int m = 0; m < 4; ++m) { bf16_t* rowp = base + (size_t)(row0 + ai * HALF + m * 16) * ldc + col0; const float rs = rtu[ai * HALF + m * 16];
#pragma unroll
                for (int bj = 0; bj < 2; ++bj) { f32x4 v0 = acc[ai][bj][m][0] * rs, v1 = acc[ai][bj][m][1] * rs;
                    if (act) { v0 = (f32x4){silu_f(v0[0]), silu_f(v0[1]), silu_f(v0[2]), silu_f(v0[3])}; v1 = (f32x4){silu_f(v1[0]), silu_f(v1[1]), silu_f(v1[2]), silu_f(v1[3])}; }
                    u32x4 w; w.x = cvt_pk_bf16(v0[0], v0[1]); w.y = cvt_pk_bf16(v0[2], v0[3]); w.z = cvt_pk_bf16(v1[0], v1[1]); w.w = cvt_pk_bf16(v1[2], v1[3]);
                    store16_wt(rowp + bj * HALF, w); } }
    }
};
template <int MODE> struct EpiResB {
    static constexpr bool PERM = true, AFTER_DRAIN = false;
    const float* basef; const bf16_t* baseb; bf16_t* hb; float* outf; float* ss;
    __device__ __forceinline__ void operator()(const f32x4 (&acc)[2][2][4][2], const Unit& u, int wr, int wc, int fr, int fq) const {
        const int col0 = u.pn * BM + wc * 32 + 8 * fq;
#pragma unroll
        for (int ai = 0; ai < 2; ++ai)
#pragma unroll
            for (int m = 0; m < 4; ++m) { const int row = u.pm * BM + ai * HALF + wr * 64 + m * 16 + fr; const size_t off = (size_t)row * 1024 + col0; float s = 0.f;
#pragma unroll
                for (int bj = 0; bj < 2; ++bj) { f32x4 h0, h1;
                    if (MODE == 0) { h0 = *(const f32x4*)(basef + off + bj * HALF); h1 = *(const f32x4*)(basef + off + bj * HALF + 4); }
                    else { const u32x4 b = *(const u32x4*)(baseb + off + bj * HALF);
                        h0 = (f32x4){__builtin_bit_cast(float, b.x << 16), __builtin_bit_cast(float, b.x & 0xffff0000u), __builtin_bit_cast(float, b.y << 16), __builtin_bit_cast(float, b.y & 0xffff0000u)};
                        h1 = (f32x4){__builtin_bit_cast(float, b.z << 16), __builtin_bit_cast(float, b.z & 0xffff0000u), __builtin_bit_cast(float, b.w << 16), __builtin_bit_cast(float, b.w & 0xffff0000u)}; }
                    h0 = h0 + acc[ai][bj][m][0]; h1 = h1 + acc[ai][bj][m][1];
                    if (MODE == 2) { __builtin_nontemporal_store(h0, (f32x4*)(outf + off + bj * HALF)); __builtin_nontemporal_store(h1, (f32x4*)(outf + off + bj * HALF + 4)); }
                    else { u32x4 w; w.x = cvt_pk_bf16(h0[0], h0[1]); w.y = cvt_pk_bf16(h0[2], h0[3]); w.z = cvt_pk_bf16(h1[0], h1[1]); w.w = cvt_pk_bf16(h1[2], h1[3]);
                        *(u32x4*)(hb + off + bj * HALF) = w;
                        s += ((h0[0] * h0[0] + h0[1] * h0[1]) + (h0[2] * h0[2] + h0[3] * h0[3])) + ((h1[0] * h1[0] + h1[1] * h1[1]) + (h1[2] * h1[2] + h1[3] * h1[3])); } }
                if (MODE != 2) { s += __shfl_xor(s, 16); s += __shfl_xor(s, 32); if (fq == 0) ss[(size_t)row * 16 + u.pn * 4 + wc] = s; }
                if (m & 1) asm volatile("" ::: "memory"); }
    }
};
struct EpiUp {
    static constexpr bool PERM = true, AFTER_DRAIN = false;
    bf16_t* O; const PG8_LAS float* rt; mutable int ui;
    __device__ __forceinline__ void operator()(const f32x4 (&acc)[2][2][4][2], const Unit& u, int wr, int wc, int fr, int fq) const {
        const int col0 = u.pn * BM + wc * 32 + 8 * fq; const PG8_LAS float* rtu = rt + ui * 256 + wr * 64 + fr; ++ui;
#pragma unroll
        for (int ai = 0; ai < 2; ++ai)
#pragma unroll
            for (int m = 0; m < 4; ++m) { const int row = u.pm * BM + ai * HALF + wr * 64 + m * 16 + fr; const float rs = rtu[ai * HALF + m * 16]; bf16_t* rowp = O + (size_t)row * 4096 + col0;
#pragma unroll
                for (int bj = 0; bj < 2; ++bj) { f32x4 v0 = acc[ai][bj][m][0] * rs, v1 = acc[ai][bj][m][1] * rs;
#pragma unroll
                    for (int e = 0; e < 4; ++e) { const float a = __builtin_fmaxf(v0[e], 0.f), b = __builtin_fmaxf(v1[e], 0.f); v0[e] = a * a; v1[e] = b * b; }
                    u32x4 w; w.x = cvt_pk_bf16(v0[0], v0[1]); w.y = cvt_pk_bf16(v0[2], v0[3]); w.z = cvt_pk_bf16(v1[0], v1[1]); w.w = cvt_pk_bf16(v1[2], v1[3]);
                    store16_wt(rowp + bj * HALF, w); } }
    }
};
struct EpiKVQ {
    static constexpr bool PERM = true, AFTER_DRAIN = false;
    bf16_t *kn, *v2, *qn; const PG8_LAS float* rt; const PG8_LAS float *gk, *gq; mutable int ui;
    __device__ __forceinline__ void operator()(const f32x4 (&acc)[2][2][4][2], const Unit& u, int wr, int wc, int fr, int fq) const {
        const int pn = u.pn; const PG8_LAS float* rtu = rt + ui * 256 + wr * 64 + fr; ++ui;
        if (pn >= 4 && pn < 8) {
            const int col0 = (pn - 4) * BM + wc * 32 + 8 * fq;
#pragma unroll
            for (int ai = 0; ai < 2; ++ai)
#pragma unroll
                for (int m = 0; m < 4; ++m) { const int row = u.pm * BM + ai * HALF + wr * 64 + m * 16 + fr; const float rs = rtu[ai * HALF + m * 16]; bf16_t* rowp = v2 + (size_t)row * 1024 + col0;
#pragma unroll
                    for (int bj = 0; bj < 2; ++bj) { const f32x4 v0 = acc[ai][bj][m][0] * rs, v1 = acc[ai][bj][m][1] * rs;
                        u32x4 w; w.x = cvt_pk_bf16(v0[0], v0[1]); w.y = cvt_pk_bf16(v0[2], v0[3]); w.z = cvt_pk_bf16(v1[0], v1[1]); w.w = cvt_pk_bf16(v1[2], v1[3]);
                        store16_wt(rowp + bj * HALF, w); } }
        } else {
            const bool isq = pn >= 8; const PG8_LAS float* gp = isq ? gq : gk; bf16_t* dst = isq ? qn : kn; const int pl = isq ? pn - 8 : pn;
            const float sc = isq ? 0.125f * 1.4426950408889634f : 1.0f;
            f32x4 gv[2][2];
#pragma unroll
            for (int bj = 0; bj < 2; ++bj)
#pragma unroll
                for (int n = 0; n < 2; ++n) gv[bj][n] = *(const PG8_LAS f32x4*)(gp + 32 * bj + 8 * fq + 4 * n) * sc;
            const int col0 = pl * BM + wc * 64 + 8 * fq;
#pragma unroll
            for (int ai = 0; ai < 2; ++ai)
#pragma unroll
                for (int m = 0; m < 4; ++m) { const int row = u.pm * BM + ai * HALF + wr * 64 + m * 16 + fr; const float rs = rtu[ai * HALF + m * 16]; bf16_t* rowp = dst + (size_t)row * 1024 + col0;
                    f32x4 x[2][2]; float s = 0.f;
#pragma unroll
                    for (int bj = 0; bj < 2; ++bj)
#pragma unroll
                        for (int n = 0; n < 2; ++n) { x[bj][n] = acc[ai][bj][m][n] * rs; s += (x[bj][n][0] * x[bj][n][0] + x[bj][n][1] * x[bj][n][1]) + (x[bj][n][2] * x[bj][n][2] + x[bj][n][3] * x[bj][n][3]); }
                    s += __shfl_xor(s, 16); s += __shfl_xor(s, 32);
                    const float r2 = __builtin_amdgcn_rsqf(s * (1.0f / 64.0f) + RMS_EPS);
#pragma unroll
                    for (int bj = 0; bj < 2; ++bj) { const f32x4 v0 = x[bj][0] * r2 * gv[bj][0], v1 = x[bj][1] * r2 * gv[bj][1];
                        u32x4 w; w.x = cvt_pk_bf16(v0[0], v0[1]); w.y = cvt_pk_bf16(v0[2], v0[3]); w.z = cvt_pk_bf16(v1[0], v1[1]); w.w = cvt_pk_bf16(v1[2], v1[3]);
                        store16_wt(rowp + 32 * bj, w); } }
        }
    }
};

template <class Epi, class Sched, bool ALIGN_EPI = false, bool SP2 = false>
__device__ __forceinline__ void gemm_phase(PG8_LAS unsigned char* lds, const Gemm g, const Sched& S, const Epi& E) {
    const int tid = threadIdx.x, wid = __builtin_amdgcn_readfirstlane(tid >> 6), lane = tid & 63, wr = wid >> 2, wc = wid & 3, fr = lane & 15, fq = lane >> 4;
    const int K = g.K, nt = K / BK;
    unsigned voffA[2], voffB[2];
#pragma unroll
    for (int i = 0; i < 2; ++i) { int R, C; stage_rc(tid * 16 + i * 8192, R, C); const int Rb = Epi::PERM ? ((R & ~31) + perm32(R & 31)) : R;
        voffA[i] = (unsigned)(R * K + C) * 2u; voffB[i] = (unsigned)(Rb * K + C) * 2u; }
    const size_t kstep = (size_t)(BK * 2);
    const size_t hstep = (size_t)HALF * K * 2;
    const size_t tstep = 2 * hstep;
    const unsigned ldsw = (unsigned)wid * 1024u;
    const int aoff = lds_byte(wr * 64 + fr, fq * 8), boff = lds_byte(wc * 32 + fr, fq * 8);
#define PG8_SA(b, h) (((b) * 2 + (h)) * HTB)
#define PG8_SB(b, h) ((4 + (b) * 2 + (h)) * HTB)
#define PG8_STAGE(bufoff, gbase, voff) do { _Pragma("unroll") for (int _i = 0; _i < 2; ++_i) \
        __builtin_amdgcn_global_load_lds((const unsigned*)((const char*)(gbase) + (voff)[_i]), (PG8_LAS unsigned*)(lds + (bufoff) + ldsw + _i * 8192), 16, 0, 0); } while (0)
#define PG8_LDA(dst, b, h) do { _Pragma("unroll") for (int m = 0; m < 4; ++m) _Pragma("unroll") for (int k = 0; k < 2; ++k) dst[m][k] = *(const PG8_LAS bf16x8*)(lds + PG8_SA(b, h) + aoff + m * 2048 + k * 1024); } while (0)
#define PG8_LDB(dst, b, h) do { _Pragma("unroll") for (int n = 0; n < 2; ++n) _Pragma("unroll") for (int k = 0; k < 2; ++k) dst[n][k] = *(const PG8_LAS bf16x8*)(lds + PG8_SB(b, h) + boff + n * 2048 + k * 1024); } while (0)
#define PG8_MMA(ai, bj, At, Bt) do { __builtin_amdgcn_s_setprio(1); _Pragma("unroll") for (int m = 0; m < 4; ++m) _Pragma("unroll") for (int n = 0; n < 2; ++n) _Pragma("unroll") for (int k = 0; k < 2; ++k) \
        acc[ai][bj][m][n] = __builtin_amdgcn_mfma_f32_16x16x32_bf16(Bt[n][k], At[m][k], acc[ai][bj][m][n], 0, 0, 0); __builtin_amdgcn_s_setprio(0); } while (0)
#define PG8_WAIT_V(n) asm volatile("s_waitcnt vmcnt(" #n ")" ::: "memory")
#define PG8_WAIT_L(n) asm volatile("s_waitcnt lgkmcnt(" #n ")" ::: "memory")
#define PG8_BAR __builtin_amdgcn_s_barrier()
#define PG8_SCHED __builtin_amdgcn_sched_barrier(0)
    Unit cur, nxt; int ui = 0;
    if (!S.next(0, cur)) return;
    f32x4 acc[2][2][4][2];
#pragma unroll
    for (int a = 0; a < 2; ++a)
#pragma unroll
        for (int b = 0; b < 2; ++b)
#pragma unroll
            for (int m = 0; m < 4; ++m)
#pragma unroll
                for (int n = 0; n < 2; ++n) acc[a][b][m][n] = (f32x4){0.f, 0.f, 0.f, 0.f};
    bf16x8 At[4][2], B0[2][2], B1[2][2];
    const char* cA = (const char*)g.A + (size_t)cur.pm * tstep; const char* cB = (const char*)g.Bt + (size_t)cur.pn * tstep;
    S.a_ready(cur);
    if constexpr (SP2) {
        PG8_STAGE(PG8_SB(0, 0), cB, voffB); PG8_STAGE(PG8_SB(0, 1), cB + hstep, voffB); PG8_STAGE(PG8_SA(0, 0), cA, voffA); PG8_STAGE(PG8_SA(0, 1), cA + hstep, voffA);
        if (wr == 1) PG8_BAR;
        PG8_WAIT_V(2); PG8_BAR;
        PG8_STAGE(PG8_SB(1, 0), cB + kstep, voffB); PG8_STAGE(PG8_SA(1, 0), cA + kstep, voffA); PG8_STAGE(PG8_SB(1, 1), cB + hstep + kstep, voffB);
        PG8_WAIT_V(6); PG8_BAR;
    } else {
        PG8_STAGE(PG8_SB(0, 0), cB, voffB); PG8_STAGE(PG8_SA(0, 0), cA, voffA); PG8_STAGE(PG8_SB(0, 1), cB + hstep, voffB); PG8_STAGE(PG8_SA(0, 1), cA + hstep, voffA);
        if (wr == 1) PG8_BAR;
        PG8_WAIT_V(4); PG8_BAR;
        PG8_STAGE(PG8_SB(1, 0), cB + kstep, voffB); PG8_STAGE(PG8_SA(1, 0), cA + kstep, voffA); PG8_STAGE(PG8_SB(1, 1), cB + hstep + kstep, voffB);
        PG8_WAIT_V(6); PG8_BAR;
    }
    for (;;) {
        const bool has_next = S.next(ui + 1, nxt);
        const char* nA = has_next ? (const char*)g.A + (size_t)nxt.pm * tstep : cA; const char* nB = has_next ? (const char*)g.Bt + (size_t)nxt.pn * tstep : cB;
        for (int t = 0; t < nt; t += 2) {
            const bool last = (t == nt - 2);
            const char* a1 = cA + (size_t)(t + 1) * kstep;
            const char* a2 = last ? nA : cA + (size_t)(t + 2) * kstep; const char* b2 = last ? nB : cB + (size_t)(t + 2) * kstep;
            const char* a3 = a2 + kstep; const char* b3 = b2 + kstep;
            if (last && has_next) S.a_ready(nxt);
            if constexpr (SP2) {
            PG8_LDB(B0, 0, 0); PG8_LDB(B1, 0, 1); PG8_SCHED; PG8_LDA(At, 0, 0); PG8_STAGE(PG8_SA(1, 1), a1 + hstep, voffA);
            PG8_WAIT_V(8); PG8_WAIT_L(0); PG8_BAR; PG8_MMA(0, 0, At, B0); PG8_MMA(0, 1, At, B1); PG8_BAR; PG8_SCHED;
            PG8_LDA(At, 0, 1); PG8_STAGE(PG8_SB(0, 0), b2, voffB); PG8_STAGE(PG8_SB(0, 1), b2 + hstep, voffB); PG8_STAGE(PG8_SA(0, 0), a2, voffA);
            PG8_WAIT_V(8); PG8_WAIT_L(0); PG8_BAR; PG8_MMA(1, 0, At, B0); PG8_MMA(1, 1, At, B1); PG8_BAR; PG8_SCHED;
            PG8_LDB(B0, 1, 0); PG8_LDB(B1, 1, 1); PG8_SCHED; PG8_LDA(At, 1, 0); PG8_STAGE(PG8_SA(0, 1), a2 + hstep, voffA);
            PG8_WAIT_V(8); PG8_WAIT_L(0); PG8_BAR; PG8_MMA(0, 0, At, B0); PG8_MMA(0, 1, At, B1); PG8_BAR; PG8_SCHED;
            PG8_LDA(At, 1, 1); PG8_STAGE(PG8_SB(1, 0), b3, voffB); PG8_STAGE(PG8_SB(1, 1), b3 + hstep, voffB); PG8_STAGE(PG8_SA(1, 0), a3, voffA);
            PG8_WAIT_V(8); PG8_WAIT_L(0); PG8_BAR; PG8_MMA(1, 0, At, B0); PG8_MMA(1, 1, At, B1); PG8_BAR; PG8_SCHED;
            } else {
            PG8_LDB(B0, 0, 0); PG8_SCHED; PG8_LDA(At, 0, 0); PG8_STAGE(PG8_SA(1, 1), a1 + hstep, voffA);
            PG8_WAIT_L(8); PG8_BAR; PG8_WAIT_L(0); PG8_MMA(0, 0, At, B0); PG8_BAR; PG8_SCHED;
            PG8_LDB(B1, 0, 1); PG8_STAGE(PG8_SB(0, 0), b2, voffB);
            PG8_BAR; PG8_WAIT_L(0); PG8_MMA(0, 1, At, B1); PG8_BAR;
            PG8_LDA(At, 0, 1); PG8_STAGE(PG8_SA(0, 0), a2, voffA);
            PG8_BAR; PG8_WAIT_L(0); PG8_MMA(1, 0, At, B0); PG8_BAR; PG8_SCHED;
            PG8_STAGE(PG8_SB(0, 1), b2 + hstep, voffB);
            PG8_WAIT_V(6); PG8_BAR; PG8_MMA(1, 1, At, B1); PG8_BAR;
            PG8_LDB(B0, 1, 0); PG8_SCHED; PG8_LDA(At, 1, 0); PG8_STAGE(PG8_SA(0, 1), a2 + hstep, voffA);
            PG8_WAIT_L(8); PG8_BAR; PG8_WAIT_L(0); PG8_MMA(0, 0, At, B0); PG8_BAR; PG8_SCHED;
            PG8_LDB(B1, 1, 1); PG8_STAGE(PG8_SB(1, 0), b3, voffB);
            PG8_BAR; PG8_WAIT_L(0); PG8_MMA(0, 1, At, B1); PG8_BAR;
            PG8_LDA(At, 1, 1); PG8_STAGE(PG8_SA(1, 0), a3, voffA);
            PG8_BAR; PG8_WAIT_L(0); PG8_MMA(1, 0, At, B0); PG8_BAR; PG8_SCHED;
            PG8_STAGE(PG8_SB(1, 1), b3 + hstep, voffB);
            PG8_WAIT_V(6); PG8_BAR; PG8_MMA(1, 1, At, B1); PG8_BAR;
            }
        }
        if constexpr (ALIGN_EPI) { if (wr == 0) PG8_BAR; }
        if constexpr (!Epi::AFTER_DRAIN) { E(acc, cur, wr, wc, fr, fq); S.done(cur); }
        if (!has_next) break;
#pragma unroll
        for (int a = 0; a < 2; ++a)
#pragma unroll
            for (int b = 0; b < 2; ++b)
#pragma unroll
                for (int m = 0; m < 4; ++m)
#pragma unroll
                    for (int n = 0; n < 2; ++n) acc[a][b][m][n] = (f32x4){0.f, 0.f, 0.f, 0.f};
        cur = nxt; cA = nA; cB = nB; ++ui;
        if constexpr (ALIGN_EPI) { if (wr == 1) PG8_BAR; }
    }
    PG8_WAIT_V(0);
    if constexpr (!ALIGN_EPI) { if (wr == 0) PG8_BAR; }
    PG8_BAR;
    if constexpr (Epi::AFTER_DRAIN) { E.fused(acc, cur, wr, wc, fr, fq, lds, wid, lane); S.done(cur); }
#undef PG8_SA
#undef PG8_SB
#undef PG8_STAGE
#undef PG8_LDA
#undef PG8_LDB
#undef PG8_MMA
#undef PG8_WAIT_V
#undef PG8_WAIT_L
#undef PG8_BAR
#undef PG8_SCHED
}
}

#ifndef PG8_SP2
#define PG8_SP2 true
#endif
#ifndef PG8_ALIGN
#define PG8_ALIGN true
#endif

#include <hip/hip_bf16.h>
#include <cmath>
namespace attn_body {
using bf16=__hip_bfloat16;
using bf16x8=__attribute__((ext_vector_type(8)))short;
using s16x4=__attribute__((ext_vector_type(4)))short;
using f32x16=__attribute__((ext_vector_type(16)))float;
using u32x4=__attribute__((ext_vector_type(4)))unsigned;
constexpr int BATCH=4,NHC=16,SEQ=4096,D=64,DVV=128;
constexpr int QP=1024,KP=1024,VP=1024,OP=2048;
constexpr int NW=8,QBLK=32,QB=QBLK*NW,KVBLK=64,NQB=SEQ/QB;
constexpr int ATTN_UNIT_ROWS=QB;
__device__ __forceinline__ int crow(int r,int hi){return (r&3)+8*(r>>2)+4*hi;}
#define SBAR() __builtin_amdgcn_sched_barrier(0)
__device__ __forceinline__ void cmask(f32x16&p0,f32x16&p1,int jb,int qrel,int hi){
  const float NEG=-INFINITY; int kb=64*jb+4*hi;
  #pragma unroll
  for(int r=0;r<16;++r){int kv=kb+(r&3)+8*(r>>2); if(kv>qrel)p0[r]=NEG; if(kv+32>qrel)p1[r]=NEG;}
}

constexpr int NSLOT=3, SLOTB=8192, VSLOTB=2*SLOTB;
constexpr int LDS_K=0, LDS_V=NSLOT*SLOTB, LDS_WS=LDS_V+NSLOT*VSLOTB, LDS_OST=LDS_WS+NW*64*4, LDS_BYTES=LDS_OST+NW*4096;
constexpr float C2=0.125f*1.4426950408889634f;
__device__ __forceinline__ void glds16(const void*gsrc,unsigned lds_dst){unsigned keep;
  asm volatile("s_mov_b32 %0, m0\n\ts_mov_b32 m0, %2\n\ts_nop 0\n\tglobal_load_lds_dwordx4 %1, off\n\ts_mov_b32 m0, %0":"=&s"(keep):"v"(gsrc),"s"(lds_dst):"memory");}
__device__ __forceinline__ float max3f(float a,float b,float c){float r;asm("v_max3_f32 %0, %1, %2, %3":"=v"(r):"v"(a),"v"(b),"v"(c));return r;}
__device__ __forceinline__ float max2f(float a,float b){float r;asm("v_max_f32_e32 %0, %1, %2":"=v"(r):"v"(a),"v"(b));return r;}
__device__ __forceinline__ float fadd_s(float a,float b){float r;asm("v_add_f32_e32 %0, %1, %2":"=v"(r):"v"(a),"v"(b));return r;}
__device__ __forceinline__ float fsub_s(float a,float b){float r;asm("v_sub_f32_e32 %0, %1, %2":"=v"(r):"v"(a),"v"(b));return r;}
typedef float f32x2_t __attribute__((ext_vector_type(2))); typedef __bf16 bf16x2_t __attribute__((ext_vector_type(2)));
__device__ __forceinline__ unsigned cvtpk_s(float lo,float hi){f32x2_t v={lo,hi};bf16x2_t b=__builtin_convertvector(v,bf16x2_t);return __builtin_bit_cast(unsigned,b);}
#define WAIT_BAR(N) asm volatile("s_waitcnt vmcnt(" #N ") lgkmcnt(0)\n\ts_barrier":::"memory")

__device__ __forceinline__ void qkt(f32x16&p0,f32x16&p1,const char*Kslot,const bf16x8*qr,const f32x16&negm,int r32,int hi){
  const char*kb=Kslot+hi*1024+r32*16;
  #pragma unroll
  for(int d0=0;d0<4;++d0){
    const bf16x8 b0=*reinterpret_cast<const bf16x8*>(kb+d0*2048);
    const bf16x8 b1=*reinterpret_cast<const bf16x8*>(kb+d0*2048+512);
    if(d0==0){p0=__builtin_amdgcn_mfma_f32_32x32x16_bf16(b0,qr[0],negm,0,0,0);p1=__builtin_amdgcn_mfma_f32_32x32x16_bf16(b1,qr[0],negm,0,0,0);}
    else{p0=__builtin_amdgcn_mfma_f32_32x32x16_bf16(b0,qr[d0],p0,0,0,0);p1=__builtin_amdgcn_mfma_f32_32x32x16_bf16(b1,qr[d0],p1,0,0,0);}}
}
typedef __attribute__((address_space(3))) const char* lds_cptr;
typedef short v4i16_t __attribute__((ext_vector_type(4)));
__device__ __forceinline__ void kload8(bf16x8*kf,lds_cptr kp){
  kf[0]=*(const __attribute__((address_space(3))) bf16x8*)(kp);      kf[1]=*(const __attribute__((address_space(3))) bf16x8*)(kp+512);
  kf[2]=*(const __attribute__((address_space(3))) bf16x8*)(kp+2048); kf[3]=*(const __attribute__((address_space(3))) bf16x8*)(kp+2560);
  kf[4]=*(const __attribute__((address_space(3))) bf16x8*)(kp+4096); kf[5]=*(const __attribute__((address_space(3))) bf16x8*)(kp+4608);
  kf[6]=*(const __attribute__((address_space(3))) bf16x8*)(kp+6144); kf[7]=*(const __attribute__((address_space(3))) bf16x8*)(kp+6656);
}
__device__ __forceinline__ void kload2(bf16x8*kf,lds_cptr kp,int j){ kf[2*j]=*(const __attribute__((address_space(3))) bf16x8*)(kp+j*2048); kf[2*j+1]=*(const __attribute__((address_space(3))) bf16x8*)(kp+j*2048+512); }
__device__ __forceinline__ s16x4 vtr(lds_cptr p){ return __builtin_bit_cast(s16x4,__builtin_amdgcn_ds_read_tr16_b64_v4i16((__attribute__((address_space(3))) v4i16_t*)p)); }
__device__ __forceinline__ float rowmax(const f32x16&p0,const f32x16&p1){
  float a=max3f(p0[0],p0[1],p1[0]),b=max3f(p0[2],p0[3],p1[1]);a=max3f(a,p1[2],p1[3]);
  #pragma unroll
  for(int r=4;r<16;r+=4){a=max3f(a,p0[r],p0[r+1]);b=max3f(b,p0[r+2],p0[r+3]);a=max3f(a,p1[r],p1[r+1]);b=max3f(b,p1[r+2],p1[r+3]);}
  const float m=max2f(a,b);
  auto rr=__builtin_amdgcn_permlane32_swap(__float_as_uint(m),__float_as_uint(m),false,false);
  return max2f(__uint_as_float(rr[0]),__uint_as_float(rr[1]));
}
__device__ __forceinline__ void pv(f32x16*o,int vb,bf16x8 pa0,bf16x8 pa1,bf16x8 pa2,bf16x8 pa3){
  #pragma unroll
  for(int d0=0;d0<4;++d0){s16x4 lo[4],hi[4];
    #pragma unroll
    for(int ks=0;ks<4;++ks){
      asm volatile("ds_read_b64_tr_b16 %0,%1 offset:%c2":"=&v"(lo[ks]):"v"(vb),"i"(d0*4096+ks*1024):"memory");
      asm volatile("ds_read_b64_tr_b16 %0,%1 offset:%c2":"=&v"(hi[ks]):"v"(vb),"i"(d0*4096+ks*1024+512):"memory");}
    asm volatile("s_waitcnt lgkmcnt(0)":::"memory");SBAR();
    #define PK(k) (bf16x8){lo[k][0],lo[k][1],lo[k][2],lo[k][3],hi[k][0],hi[k][1],hi[k][2],hi[k][3]}
    o[d0]=__builtin_amdgcn_mfma_f32_32x32x16_bf16(pa0,PK(0),o[d0],0,0,0);
    o[d0]=__builtin_amdgcn_mfma_f32_32x32x16_bf16(pa1,PK(1),o[d0],0,0,0);
    o[d0]=__builtin_amdgcn_mfma_f32_32x32x16_bf16(pa2,PK(2),o[d0],0,0,0);
    o[d0]=__builtin_amdgcn_mfma_f32_32x32x16_bf16(pa3,PK(3),o[d0],0,0,0);
    #undef PK
  }
}

#ifndef ATTN_STORE16
#define ATTN_STORE16(p,v) (*(u32x4*)(p)=(v))
#endif
template<int THRL> __device__ __forceinline__ void attn_unit(int b,int hc,int qb,const bf16*Q,const bf16*__restrict__ K,const bf16*__restrict__ V,bf16*O,char*shm){
  const int qkcol=hc*D, vcol=(hc>>1)*DVV, ocol=hc*DVV;
  const int tid=threadIdx.x,lane=tid&63,r32=lane&31,hi=lane>>5; const int wid=__builtin_amdgcn_readfirstlane(tid>>6);
  const long rowbase=(long)b*SEQ; const int q0=qb*QB;
  const bf16*Qw=Q+(rowbase+q0+wid*QBLK)*QP+qkcol;
  const bf16*Kh=K+rowbase*KP+qkcol,*Vh=V+rowbase*VP+vcol;
  const unsigned lds0=(unsigned)(uintptr_t)shm;
  float*wsf=(float*)(shm+LDS_WS)+wid*64;
  const bf16*ksrc=Kh+(long)lane*KP+wid*8;
  const bf16*vsrc=Vh+(long)(16*(wid&3)+(lane>>2))*VP+(wid>>2)*32+(lane&3)*8;
  const unsigned kdst=lds0+LDS_K+wid*1024, vdst=lds0+LDS_V+wid*1024;
  #define DMA_K(t,slot) glds16(ksrc+(long)(t)*KVBLK*KP,(unsigned)__builtin_amdgcn_readfirstlane(kdst+(slot)))
  #define DMA_V(t,slot) do{ glds16(vsrc+(long)(t)*KVBLK*VP,(unsigned)__builtin_amdgcn_readfirstlane(vdst+2*(slot))); glds16(vsrc+64+(long)(t)*KVBLK*VP,(unsigned)__builtin_amdgcn_readfirstlane(vdst+2*(slot)+8192)); }while(0)
  const int vb0=(int)(lds0+LDS_V)+((lane>>4)&1)*32+(lane&3)*8+(4*hi+((lane&15)>>2))*64;
  const char*Kbase=shm+LDS_K; bf16x8 kf[8];
  const lds_cptr shm3=(lds_cptr)shm; const lds_cptr kp0=shm3+LDS_K+hi*1024+r32*16; const lds_cptr vp0=shm3+LDS_V+((lane>>4)&1)*32+(lane&3)*8+(4*hi+((lane&15)>>2))*64;
  const int NT=(q0+QB)/KVBLK;
  DMA_K(0,0);DMA_V(0,0);DMA_K(1,SLOTB);
  bf16x8 qr[4];
  #pragma unroll
  for(int d0=0;d0<4;++d0)qr[d0]=*reinterpret_cast<const bf16x8*>(&Qw[(long)r32*QP+d0*16+hi*8]);
  float mhat=0.f,l_reg=0.f;f32x16 o[4];o[0]=f32x16{};o[1]=f32x16{};o[2]=f32x16{};o[3]=f32x16{};
  const int qrel=wid*QBLK+r32;
  #define CMASK(P0,P1,t) do{int jb_=(t)-(NT-4); if(jb_>=0)cmask(P0,P1,jb_,qrel,hi);}while(0)
  bool resc=false;
  #define START(P0,P1) do{ const float rm=rowmax(P0,P1); resc=false; \
    { const float dl=rm; mhat=fadd_s(mhat,dl); \
      _Pragma("unroll") for(int r=0;r<16;++r){P0[r]=fsub_s(P0[r],dl);P1[r]=fsub_s(P1[r],dl);} } \
    _Pragma("unroll") for(int r=0;r<16;++r)P0[r]=__builtin_amdgcn_exp2f(P0[r]); }while(0)
  #define RESC() do{ if(resc){ asm volatile("s_waitcnt lgkmcnt(0)":::"memory"); \
      _Pragma("unroll") for(int d_=0;d_<4;++d_) _Pragma("unroll") for(int r=0;r<16;++r)o[d_][r]*=wsf[crow(r,hi)]; } }while(0)
  f32x16 pA0,pA1,pB0,pB1;
  int sl_prev=0,sl_cur=0,sl_next=SLOTB;
  #define ROT() do{sl_prev=sl_cur;sl_cur=sl_next;sl_next=(sl_next==(NSLOT-1)*SLOTB)?0:sl_next+SLOTB;}while(0)
  DMA_K(2,2*SLOTB);
  WAIT_BAR(4);
  { const f32x16 z0=f32x16{}; qkt(pA0,pA1,Kbase,qr,z0,r32,hi); }asm volatile("s_nop 15\n\ts_nop 7":"+v"(pA0),"+v"(pA1));CMASK(pA0,pA1,0);
  START(pA0,pA1);
  _Pragma("unroll") for(int r=0;r<16;++r)pA1[r]=__builtin_amdgcn_exp2f(pA1[r]);
  WAIT_BAR(0);
  DMA_K(3,0);DMA_V(1,SLOTB);
  ROT();
  kload8(kf,kp0+sl_cur);
  WAIT_BAR(3);
  s16x4 vlo[4],vhi[4]; u32x4 pw0,pw1,pw2,pw3;
  #define PKW(P,B) cvtpk_s(P[B],P[B+1])
  #define PAF(k) __builtin_bit_cast(bf16x8,pw##k)
  #define VFR(i) (bf16x8){vlo[i][0],vlo[i][1],vlo[i][2],vlo[i][3],vhi[i][0],vhi[i][1],vhi[i][2],vhi[i][3]}
  #define PIN(x) asm volatile("":"+v"(x))
  #define MX3(a,b,c) __builtin_fmaxf(__builtin_fmaxf((a),(b)),(c))
  #define GAPA(MF,A0,A1,A2,A3,W0,W1,PW) do{ MF; sacc+=A0; sacc+=A1; sacc+=A2; sacc+=A3; PIN(sacc); W0; W1; PIN(PW); SBAR(); }while(0)
  #define EX(v) __builtin_amdgcn_exp2f(v)
  #define GAPB(MF,X,B) do{ MF; X[B]=EX(X[B]-mhat); X[B+1]=EX(X[B+1]-mhat); PIN(X); SBAR(); }while(0)
  #define VRD(p,i) do{ vlo[p]=vtr(vp_+(((i)>>2)*4096+((i)&3)*1024)); vhi[p]=vtr(vp_+(((i)>>2)*4096+((i)&3)*1024+512)); }while(0)
  #define KRD(G,j) do{ if(G){ kload2(kf,kp0+sl_next,j); SBAR(); } }while(0)
  #define ZC (f32x16{})
  #define STEP(C0,C1,P0,P1,t,GK,GV,GL) do{ SBAR(); \
    const lds_cptr vp_=vp0+2*sl_prev; \
    float sacc=(P0[0]+P0[1]); \
    GAPA(C0=__builtin_amdgcn_mfma_f32_32x32x16_bf16(kf[0],qr[0],ZC,0,0,0), P0[2],P0[3],P0[4],P0[5],     pw0[0]=PKW(P0,0), pw0[1]=PKW(P0,2), pw0); \
    GAPA(C1=__builtin_amdgcn_mfma_f32_32x32x16_bf16(kf[1],qr[0],ZC,0,0,0), P0[6],P0[7],P0[8],P0[9],     pw0[2]=PKW(P0,4), pw0[3]=PKW(P0,6), pw0); \
    GAPA(C0=__builtin_amdgcn_mfma_f32_32x32x16_bf16(kf[2],qr[1],C0,0,0,0),   P0[10],P0[11],P0[12],P0[13], pw1[0]=PKW(P0,8), pw1[1]=PKW(P0,10), pw1); \
    GAPA(C1=__builtin_amdgcn_mfma_f32_32x32x16_bf16(kf[3],qr[1],C1,0,0,0),   P0[14],P0[15],P1[0],P1[1],   pw1[2]=PKW(P0,12),pw1[3]=PKW(P0,14), pw1); \
    GAPA(C0=__builtin_amdgcn_mfma_f32_32x32x16_bf16(kf[4],qr[2],C0,0,0,0),   P1[2],P1[3],P1[4],P1[5],     pw2[0]=PKW(P1,0), pw2[1]=PKW(P1,2), pw2); \
    VRD(0,0); SBAR(); GAPA(C1=__builtin_amdgcn_mfma_f32_32x32x16_bf16(kf[5],qr[2],C1,0,0,0),   P1[6],P1[7],P1[8],P1[9],     pw2[2]=PKW(P1,4), pw2[3]=PKW(P1,6), pw2); \
    VRD(1,4); SBAR(); GAPA(C0=__builtin_amdgcn_mfma_f32_32x32x16_bf16(kf[6],qr[3],C0,0,0,0),   P1[10],P1[11],P1[12],P1[13], pw3[0]=PKW(P1,8), pw3[1]=PKW(P1,10), pw3); \
    VRD(2,1); SBAR(); GAPA(C1=__builtin_amdgcn_mfma_f32_32x32x16_bf16(kf[7],qr[3],C1,0,0,0),   P1[14],P1[15],0.f,0.f,       pw3[2]=PKW(P1,12),pw3[3]=PKW(P1,14), pw3); \
    l_reg+=sacc; \
    if(GK){DMA_K((t)+3,sl_cur);} if(GV){DMA_V((t)+1,sl_next);} \
    CMASK(C0,C1,t); \
    { float a=MX3(C0[0],C0[1],C1[0]),b=MX3(C0[2],C0[3],C1[1]); a=MX3(a,C1[2],C1[3]); \
      _Pragma("unroll") for(int r=4;r<16;r+=4){a=MX3(a,C0[r],C0[r+1]);b=MX3(b,C0[r+2],C0[r+3]);a=MX3(a,C1[r],C1[r+1]);b=MX3(b,C1[r+2],C1[r+3]);} \
      float rm=__builtin_fmaxf(a,b); { auto rr=__builtin_amdgcn_permlane32_swap(__float_as_uint(rm),__float_as_uint(rm),false,false); rm=__builtin_fmaxf(__uint_as_float(rr[0]),__uint_as_float(rr[1])); } \
      rm-=mhat; resc=false; \
      if(__builtin_expect(__any(rm>(float)THRL),0)){ const float dl=__builtin_fmaxf(rm,0.f); mhat+=dl; \
        const float f=__builtin_amdgcn_exp2f(-dl); l_reg*=f; if(hi==0)wsf[r32]=f; resc=true; } } \
    SBAR(); \
    VRD(3,5);  SBAR(); GAPB(o[0]=__builtin_amdgcn_mfma_f32_32x32x16_bf16(PAF(0),VFR(0),o[0],0,0,0), C0,0); \
    VRD(0,2);  SBAR(); GAPB(o[1]=__builtin_amdgcn_mfma_f32_32x32x16_bf16(PAF(0),VFR(1),o[1],0,0,0), C0,2); \
    VRD(1,6);  SBAR(); KRD(GL,0); GAPB(o[0]=__builtin_amdgcn_mfma_f32_32x32x16_bf16(PAF(1),VFR(2),o[0],0,0,0), C0,4); \
    VRD(2,3);  SBAR(); KRD(GL,1); GAPB(o[1]=__builtin_amdgcn_mfma_f32_32x32x16_bf16(PAF(1),VFR(3),o[1],0,0,0), C0,6); \
    VRD(3,7);  SBAR(); KRD(GL,2); GAPB(o[0]=__builtin_amdgcn_mfma_f32_32x32x16_bf16(PAF(2),VFR(0),o[0],0,0,0), C0,8); \
    VRD(0,8);  SBAR(); KRD(GL,3); GAPB(o[1]=__builtin_amdgcn_mfma_f32_32x32x16_bf16(PAF(2),VFR(1),o[1],0,0,0), C0,10); \
    VRD(1,12); SBAR(); GAPB(o[0]=__builtin_amdgcn_mfma_f32_32x32x16_bf16(PAF(3),VFR(2),o[0],0,0,0), C0,12); \
    VRD(2,9);  SBAR(); GAPB(o[1]=__builtin_amdgcn_mfma_f32_32x32x16_bf16(PAF(3),VFR(3),o[1],0,0,0), C0,14); \
    VRD(3,13); SBAR(); GAPB(o[2]=__builtin_amdgcn_mfma_f32_32x32x16_bf16(PAF(0),VFR(0),o[2],0,0,0), C1,0); \
    VRD(0,10); SBAR(); GAPB(o[3]=__builtin_amdgcn_mfma_f32_32x32x16_bf16(PAF(0),VFR(1),o[3],0,0,0), C1,2); \
    VRD(1,14); SBAR(); GAPB(o[2]=__builtin_amdgcn_mfma_f32_32x32x16_bf16(PAF(1),VFR(2),o[2],0,0,0), C1,4); \
    VRD(2,11); SBAR(); GAPB(o[3]=__builtin_amdgcn_mfma_f32_32x32x16_bf16(PAF(1),VFR(3),o[3],0,0,0), C1,6); \
    VRD(3,15); SBAR(); GAPB(o[2]=__builtin_amdgcn_mfma_f32_32x32x16_bf16(PAF(2),VFR(0),o[2],0,0,0), C1,8); \
    GAPB(o[3]=__builtin_amdgcn_mfma_f32_32x32x16_bf16(PAF(2),VFR(1),o[3],0,0,0), C1,10); \
    GAPB(o[2]=__builtin_amdgcn_mfma_f32_32x32x16_bf16(PAF(3),VFR(2),o[2],0,0,0), C1,12); \
    GAPB(o[3]=__builtin_amdgcn_mfma_f32_32x32x16_bf16(PAF(3),VFR(3),o[3],0,0,0), C1,14); \
    }while(0)
  int t=1;
  #undef CMASK
  #define CMASK(P0,P1,t) do{}while(0)
  for(;t+5<NT;t+=2){
    STEP(pB0,pB1,pA0,pA1,t,true,true,true);     WAIT_BAR(3); RESC(); ROT();
    STEP(pA0,pA1,pB0,pB1,t+1,true,true,true);   WAIT_BAR(3); RESC(); ROT();
  }
  #undef CMASK
  #define CMASK(P0,P1,t) do{int jb_=(t)-(NT-4); if(jb_>=0)cmask(P0,P1,jb_,qrel,hi);}while(0)
  #define ENDW(tt) do{ if((tt)+3<NT){WAIT_BAR(3);} else if((tt)+2<NT){WAIT_BAR(2);} else {WAIT_BAR(0);} }while(0)
  for(;t+1<NT;t+=2){
    STEP(pB0,pB1,pA0,pA1,t,(t+3<NT),(t+1<NT),(t+1<NT));       ENDW(t);   RESC(); ROT();
    STEP(pA0,pA1,pB0,pB1,t+1,(t+4<NT),(t+2<NT),(t+2<NT));     ENDW(t+1); RESC(); ROT();
  }
  STEP(pB0,pB1,pA0,pA1,NT-1,false,false,false); RESC();
  { float sacc=pB0[0]+pB0[1]; _Pragma("unroll") for(int r=2;r<16;++r)sacc+=pB0[r]; _Pragma("unroll") for(int r=0;r<16;++r)sacc+=pB1[r]; l_reg+=sacc;
    pw0=(u32x4){PKW(pB0,0),PKW(pB0,2),PKW(pB0,4),PKW(pB0,6)};pw1=(u32x4){PKW(pB0,8),PKW(pB0,10),PKW(pB0,12),PKW(pB0,14)};pw2=(u32x4){PKW(pB1,0),PKW(pB1,2),PKW(pB1,4),PKW(pB1,6)};pw3=(u32x4){PKW(pB1,8),PKW(pB1,10),PKW(pB1,12),PKW(pB1,14)};
    SBAR(); pv(o,vb0+2*sl_cur,PAF(0),PAF(1),PAF(2),PAF(3)); }
  #undef PKW
  #undef PAF
  #undef VFR
  #undef PIN
  #undef MX3
  #undef GAPA
  #undef GAPB
  #undef EX
  #undef VRD
  #undef KRD
  #undef STEP
  #undef ZC
  #undef ENDW
  {auto rr=__builtin_amdgcn_permlane32_swap(__float_as_uint(l_reg),__float_as_uint(l_reg),false,false);l_reg=__uint_as_float(rr[0])+__uint_as_float(rr[1]);}
  if(hi==0)wsf[32+r32]=l_reg;asm volatile("s_waitcnt lgkmcnt(0)":::"memory");
  float rli[16];
  #pragma unroll
  for(int r=0;r<16;++r)rli[r]=__builtin_amdgcn_rcpf(wsf[32+crow(r,hi)]);
  bf16*Ow=O+(rowbase+q0+wid*QBLK)*OP+ocol;
  { bf16*stg=(bf16*)(shm+LDS_OST)+wid*2048;
    #pragma unroll
    for(int h2=0;h2<2;++h2){
    #pragma unroll
    for(int r=0;r<16;++r){const int orow=crow(r,hi);
      #pragma unroll
      for(int d0=0;d0<2;++d0)stg[orow*64+d0*32+r32]=__float2bfloat16(o[2*h2+d0][r]*rli[r]);}
    asm volatile("s_waitcnt lgkmcnt(0)":::"memory");
    #pragma unroll
    for(int i=0;i<4;++i){const int row=i*8+(lane>>3),ch=lane&7; const u32x4 v=*(const u32x4*)(stg+row*64+ch*8); ATTN_STORE16(Ow+(long)row*OP+h2*64+ch*8,v);}
    asm volatile("s_waitcnt lgkmcnt(0)":::"memory"); } }
  asm volatile("s_waitcnt lgkmcnt(0)\n\ts_barrier":::"memory");
  #undef DMA_K
  #undef DMA_V
  #undef CMASK
  #undef START
  #undef RESC
  #undef ROT
}
constexpr int ATTN_LDS_BYTES=LDS_BYTES;
struct AttnTensors { const bf16* Q; const bf16* K; const bf16* V; bf16* O; };
struct AttnUnit { int bh; int qb; };
struct StaticOrder {
  int vcu;
  __device__ __forceinline__ explicit StaticOrder(int grid,int block):vcu((block%8)*(grid/8)+block/8){}
  __device__ __forceinline__ bool next(int i,AttnUnit&u)const{ if(i>=4)return false; const int p=vcu&7; u.bh=(vcu>>3)*2+(i>>1); u.qb=(i&1)?15-p:p; return true; }
  __device__ __forceinline__ void a_ready(const AttnUnit&)const{}
  __device__ __forceinline__ void done(const AttnUnit&)const{}
};
template<class Sched,int THRL=8> __device__ __forceinline__ void attn_phase(char*lds,const AttnTensors&T,const Sched&S){
  AttnUnit u;
  for(int i=0;S.next(i,u);++i){ S.a_ready(u); attn_unit<THRL>(u.bh/NHC,u.bh%NHC,u.qb,T.Q,T.K,T.V,T.O,lds); S.done(u); }
}
#undef SBAR
#undef WAIT_BAR
}

#define GAS __attribute__((address_space(1)))
#define LAS __attribute__((address_space(3)))
typedef unsigned v4u __attribute__((ext_vector_type(4)));
typedef GAS unsigned gu32;
typedef GAS unsigned long long gu64;
#define RLX_AGENT __ATOMIC_RELAXED, __HIP_MEMORY_SCOPE_AGENT
#define LDS_WAIT() asm volatile("s_waitcnt lgkmcnt(0)" ::: "memory")
#define VM_WAIT() asm volatile("s_waitcnt vmcnt(0)" ::: "memory")
__device__ __forceinline__ unsigned pk2(float lo, float hi) { return f2bf(lo) | (f2bf(hi) << 16); }

#define XB_TMO      128
#define XB_XCNT(j)  (256  + 64 * (j))
#define XB_XSUB(j)  (1280 + 64 * (j))
#define XB_XGEN(j)  (2304 + 64 * (j))
#define XB_TOP      3328
#define XB_TOPGEN   3392
#define XCD_BAR_WORDS 3456
#define XB_SPIN_CAP (1u << 18)

__device__ __forceinline__ unsigned xb_ld(unsigned* p)              { return __hip_atomic_load(p, __ATOMIC_RELAXED, __HIP_MEMORY_SCOPE_AGENT); }
__device__ __forceinline__ unsigned xb_add(unsigned* p, unsigned v) { return __hip_atomic_fetch_add(p, v, __ATOMIC_RELAXED, __HIP_MEMORY_SCOPE_AGENT); }
__device__ __forceinline__ unsigned xb_xcc_id() { return (unsigned)__builtin_amdgcn_s_getreg((3 << 11) | 20) & 0xFu; }
#define XB_SPIN(cond, bar) do { unsigned _sp = 0; while (cond) { __builtin_amdgcn_s_sleep(1); \
    if ((++_sp & 255u) == 0u) { if (xb_ld(&(bar)[XB_TMO])) break; if (_sp > XB_SPIN_CAP) { atomicAdd(&(bar)[XB_TMO], 1u); break; } } } } while (0)

struct XcdBarrier {
    unsigned* bar; unsigned x;
    volatile LAS unsigned* st;
};

__device__ __forceinline__ XcdBarrier xcd_barrier_post(unsigned* bar, volatile LAS unsigned* st) {
    XcdBarrier b; b.bar = bar; b.x = xb_xcc_id(); b.st = st;
    if (threadIdx.x == 0) (void)xb_add(&bar[XB_XCNT(b.x)], 1u);
    return b;
}
__device__ __forceinline__ void xcd_barrier_complete(unsigned* bar, unsigned x, unsigned& nloc, unsigned& nx) {
    const unsigned G = gridDim.x * gridDim.y * gridDim.z;
    unsigned sum, cnt, mine, sp = 0u;
    for (;;) {
        sum = 0u; cnt = 0u; mine = 0u;
#pragma unroll
        for (unsigned j = 0; j < 16; ++j) { const unsigned c = xb_ld(&bar[XB_XCNT(j)]); sum += c; cnt += (c > 0u) ? 1u : 0u; mine = (j == x) ? c : mine; }
        if (sum == G) break;
        __builtin_amdgcn_s_sleep(1);
        if ((++sp & 255u) == 0u) { if (xb_ld(&bar[XB_TMO])) break; if (sp > XB_SPIN_CAP) { atomicAdd(&bar[XB_TMO], 1u); break; } }
    }
    nloc = mine > 0u ? mine : 1u; nx = cnt > 0u ? cnt : 1u;
}

__device__ __forceinline__ void xcd_barrier(const XcdBarrier& b) {
    asm volatile("s_waitcnt vmcnt(0)" ::: "memory");
    __syncthreads();
    if (threadIdx.x == 0) {
        unsigned* bar = b.bar;
        __builtin_amdgcn_s_waitcnt(0);
        unsigned nloc = b.st[0], nx = b.st[1];
        if (nloc == 0u) { xcd_barrier_complete(bar, b.x, nloc, nx); b.st[0] = nloc; b.st[1] = nx; }
        const unsigned old = xb_add(&bar[XB_XSUB(b.x)], 1u);
        const unsigned gen = old / nloc;
        if (old + 1u == (gen + 1u) * nloc) {
            __builtin_amdgcn_fence(__ATOMIC_RELEASE, "agent");
            asm volatile("s_waitcnt vmcnt(0)" ::: "memory");
            const unsigned og = xb_add(&bar[XB_TOP], 1u);
            const unsigned tg = og / nx;
            if (og + 1u == (tg + 1u) * nx) xb_add(&bar[XB_TOPGEN], 1u);
            else XB_SPIN(xb_ld(&bar[XB_TOPGEN]) == tg, bar);
            __builtin_amdgcn_fence(__ATOMIC_ACQUIRE, "agent");
            xb_add(&bar[XB_XGEN(b.x)], 1u);
            asm volatile("s_waitcnt vmcnt(0)" ::: "memory");
        } else {
            XB_SPIN(xb_ld(&bar[XB_XGEN(b.x)]) == gen, bar);
            __builtin_amdgcn_fence(__ATOMIC_ACQUIRE, "agent");
            asm volatile("s_waitcnt vmcnt(0)" ::: "memory");
        }
    }
    __syncthreads();
}

constexpr int NWAVES = 8;
constexpr int RING_OFF = 0, RING_BYTES = 131072;
constexpr int LDSCTL_OFF = RING_BYTES, MISC_OFF = LDSCTL_OFF + 320;
constexpr int LDS_BYTES = 147456;

constexpr int CW_XCC = 8192;
constexpr int CW_PANEL = 8448;
__device__ __forceinline__ void panel_sync(gu32* ctl, unsigned* tmo, int seam, int pm, bool same_xcc) {
    asm volatile("s_waitcnt vmcnt(0)" ::: "memory");
    __syncthreads();
    if (threadIdx.x == 0) {
        gu32* c = ctl + CW_PANEL + (seam * 64 + pm) * 16;
        if (!same_xcc) { __builtin_amdgcn_fence(__ATOMIC_RELEASE, "agent"); asm volatile("s_waitcnt vmcnt(0)" ::: "memory"); }
        __hip_atomic_fetch_add(c, 1u, __ATOMIC_RELAXED, __HIP_MEMORY_SCOPE_AGENT);
        unsigned sp = 0;
        while (__hip_atomic_load(c, __ATOMIC_RELAXED, __HIP_MEMORY_SCOPE_AGENT) < 4u) { __builtin_amdgcn_s_sleep(1);
            if ((++sp & 255u) == 0u) { if (xb_ld(tmo)) break; if (sp > XB_SPIN_CAP) { atomicAdd(tmo, 1u); break; } } }
        __builtin_amdgcn_fence(__ATOMIC_ACQUIRE, "agent");
        asm volatile("s_waitcnt vmcnt(0)" ::: "memory");
    }
    __syncthreads();
}
constexpr int CW_BAR = 4096;

struct Frame {
    LAS unsigned char* lds;
    volatile LAS unsigned* MISC;
    gu32* ctl;
    int tid, lane, wave, vcu, G;
    const float* in[19]; float* out; unsigned char* ws;
};
struct WDesc { const float* W; const float* gain; bf16* WT; int ldn, c0, K, ncols, roff, mode; };
__device__ __forceinline__ WDesc wdesc(const Frame& F, int i) {
    unsigned char* ws = F.ws; WDesc d;
    switch (i) {
    case 0:  d = WDesc{F.in[2], F.in[1], (bf16*)(ws + WS_WIN), GIN, 0, D, 3072, 0, 0}; break;
    case 1:  d = WDesc{F.in[6], nullptr, (bf16*)(ws + WS_WAO), D, 0, D, D, 0, 0}; break;
    case 2:  d = WDesc{F.in[17], F.in[16], (bf16*)(ws + WS_W1A), FF, 0, D, FF, 0, 0}; break;
    case 3:  d = WDesc{F.in[18], nullptr, (bf16*)(ws + WS_W2A), D, 0, FF, D, 0, 0}; break;
    case 4:  d = WDesc{F.in[8], F.in[7], (bf16*)(ws + WS_WKVQ), 2048, 0, D, 2048, 0, 1}; break;
    case 5:  d = WDesc{F.in[11], F.in[10], (bf16*)(ws + WS_WKVQ), D, 0, D, D, 2048, 1}; break;
    case 6:  d = WDesc{F.in[15], nullptr, (bf16*)(ws + WS_WBO), D, 0, D, D, 0, 0}; break;
    case 7:  d = WDesc{F.in[17] + (size_t)D * FF, F.in[16] + D, (bf16*)(ws + WS_W1B), FF, 0, D, FF, 0, 0}; break;
    default: d = WDesc{F.in[18] + (size_t)D * FF, nullptr, (bf16*)(ws + WS_W2B), D, 0, FF, D, 0, 0}; break;
    }
    return d;
}
__device__ __forceinline__ void p0_transpose_item(const WDesc& d, LAS float* scr, int item, int lane) {
    const int nblk = d.ncols / 64, kb = item / nblk, nb = item % nblk, k0 = 64 * kb, n0 = 64 * nb;
    const int kq = lane >> 4, n4 = (lane & 15) * 4;
    f32x4 v[16];
#pragma unroll
    for (int i = 0; i < 16; ++i) v[i] = __builtin_nontemporal_load((const GAS f32x4*)(d.W + (size_t)(k0 + 4 * i + kq) * d.ldn + d.c0 + n0 + n4));
    const int c = lane & 7;
    f32x4 g0 = (f32x4){1.f, 1.f, 1.f, 1.f}, g1 = g0;
    if (d.gain) { g0 = *(const GAS f32x4*)(d.gain + k0 + 8 * c); g1 = *(const GAS f32x4*)(d.gain + k0 + 8 * c + 4); }
#pragma unroll
    for (int i = 0; i < 16; ++i) { const int kk = 4 * i + kq; *(LAS f32x4*)(scr + kk * 64 + (n4 ^ (kk & 0x38))) = v[i]; }
    LDS_WAIT(); asm volatile("" ::: "memory");
#pragma unroll
    for (int jj = 0; jj < 8; ++jj) { const int n = (lane >> 3) + 8 * jj; const LAS float* sp = scr + (8 * c) * 64 + (n ^ (c << 3));
        const int dr = d.mode ? kvq_dest_row(d.roff + n0 + n) : d.roff + n0 + n;
        v4u o; o.x = pk2(sp[0 * 64] * g0[0], sp[1 * 64] * g0[1]); o.y = pk2(sp[2 * 64] * g0[2], sp[3 * 64] * g0[3]); o.z = pk2(sp[4 * 64] * g1[0], sp[5 * 64] * g1[1]); o.w = pk2(sp[6 * 64] * g1[2], sp[7 * 64] * g1[3]);
        pg8::store16_wt((void*)(d.WT + (size_t)dr * d.K + k0 + 8 * c), o); }
    LDS_WAIT(); asm volatile("" ::: "memory");
}
__device__ __forceinline__ float wave_sum(float v) {
#pragma unroll
    for (int o = 1; o < 64; o <<= 1) v += __shfl_xor(v, o);
    return v;
}
template <int NR> __device__ __forceinline__ void rows_to_bf16(const Frame& F, const float* xrow, bf16* orow, float* ssrow) {
    f32x4 v[NR][4];
#pragma unroll
    for (int r = 0; r < NR; ++r)
#pragma unroll
        for (int j = 0; j < 4; ++j) v[r][j] = __builtin_nontemporal_load(((const GAS f32x4*)(xrow + (size_t)r * D) + F.lane) + 64 * j);
#pragma unroll
    for (int r = 0; r < NR; ++r) { float s = 0.f;
#pragma unroll
        for (int j = 0; j < 4; ++j) s += (v[r][j].x * v[r][j].x + v[r][j].y * v[r][j].y) + (v[r][j].z * v[r][j].z + v[r][j].w * v[r][j].w);
        s = wave_sum(s);
        if (F.lane < 16) ssrow[(size_t)r * 16 + F.lane] = (F.lane == 0) ? s : 0.f;
        GAS unsigned long long* o8 = (GAS unsigned long long*)(orow + (size_t)r * D) + F.lane;
#pragma unroll
        for (int j = 0; j < 4; ++j) o8[64 * j] = (unsigned long long)pk2(v[r][j].x, v[r][j].y) | ((unsigned long long)pk2(v[r][j].z, v[r][j].w) << 32); }
}
__device__ __forceinline__ void p0_prologue(Frame& F) {
    LAS float* scr = (LAS float*)(F.lds + RING_OFF + F.wave * 16384);
    const int gw = F.vcu * NWAVES + F.wave, NGW = F.G * NWAVES;
    int base = 0;
    for (int mi = 0; mi < 9; ++mi) {
        const WDesc d = wdesc(F, mi); const int nit = (d.K / 64) * (d.ncols / 64);
        int it = gw - (base % NGW); if (it < 0) it += NGW;
        for (; it < nit; it += NGW) p0_transpose_item(d, scr, it, F.lane);
        base += nit;
    }
    { const float* W = F.in[2]; const float* g = F.in[1]; bf16* Wz = (bf16*)(F.ws + WS_WZ);
      for (int idx = gw * 64 + F.lane; idx < 16 * D; idx += NGW * 64) { const int k = idx >> 4, r = idx & 15; Wz[(size_t)r * D + k] = (bf16)f2bf(W[(size_t)k * GIN + 3072 + r] * g[k]); } }
    bf16* XB = (bf16*)(F.ws + WS_A); float* SS = (float*)(F.ws + WS_SS);
    for (int m = 4 * gw; m < T; m += 4 * NGW) rows_to_bf16<4>(F, F.in[0] + (size_t)m * D, XB + (size_t)m * D, SS + (size_t)m * 16);
}


__device__ __forceinline__ void combine_local(Frame& F) {
    const int lane = F.lane, wave = F.wave;
    const float* lp = F.in[13]; const float* hg = F.in[14];
    const float s1 = wave_sum(lp[lane] * lp[64 + lane]), s2 = wave_sum(lp[128 + lane] * lp[192 + lane]);
    const float lam = __expf(s1) - __expf(s2) + LAMBDA_INIT;
    const int bhh = F.vcu >> 3, p = F.vcu & 7, b = bhh >> 3, h = bhh & 7, sg = lane & 7;
    float g[16];
#pragma unroll
    for (int j = 0; j < 16; ++j) g[j] = hg[16 * sg + j] * (1.f - LAMBDA_INIT);
    const bf16* O32 = (const bf16*)F.out; bf16* OD = (bf16*)(F.ws + WS_C);
    asm volatile("s_waitcnt vmcnt(0)" ::: "memory"); __syncthreads();
    for (int it0 = 0; it0 < 8; it0 += 4) {
        bf16x8 a0[4], a1[4], b0[4], b1[4]; size_t tt[4];
#pragma unroll
        for (int q = 0; q < 4; ++q) { const int r = (it0 + q) * 64 + wave * 8 + (lane >> 3);
            tt[q] = (size_t)b * SEQ + (size_t)((r < 256) ? p : 15 - p) * 256 + (r & 255);
            const bf16* p0 = O32 + tt[q] * 2048 + (2 * h) * 128 + 16 * sg;
            a0[q] = *(const bf16x8*)p0; a1[q] = *(const bf16x8*)(p0 + 8); b0[q] = *(const bf16x8*)(p0 + 128); b1[q] = *(const bf16x8*)(p0 + 136); }
#pragma unroll
        for (int q = 0; q < 4; ++q) {
            float o[16]; float s = 0.f;
#pragma unroll
            for (int j = 0; j < 8; ++j) { o[j] = bf2f((unsigned short)a0[q][j]) - lam * bf2f((unsigned short)b0[q][j]); o[8 + j] = bf2f((unsigned short)a1[q][j]) - lam * bf2f((unsigned short)b1[q][j]); }
#pragma unroll
            for (int j = 0; j < 16; ++j) s += o[j] * o[j];
            s += __shfl_xor(s, 1); s += __shfl_xor(s, 2); s += __shfl_xor(s, 4);
            const float rstd = __builtin_amdgcn_rsqf(s * (1.f / 128.f) + EPS);
            v4u w0, w1;
            w0.x = pk2(o[0] * rstd * g[0], o[1] * rstd * g[1]); w0.y = pk2(o[2] * rstd * g[2], o[3] * rstd * g[3]); w0.z = pk2(o[4] * rstd * g[4], o[5] * rstd * g[5]); w0.w = pk2(o[6] * rstd * g[6], o[7] * rstd * g[7]);
            w1.x = pk2(o[8] * rstd * g[8], o[9] * rstd * g[9]); w1.y = pk2(o[10] * rstd * g[10], o[11] * rstd * g[11]); w1.z = pk2(o[12] * rstd * g[12], o[13] * rstd * g[13]); w1.w = pk2(o[14] * rstd * g[14], o[15] * rstd * g[15]);
            bf16* qd = OD + tt[q] * 1024 + h * 128 + 16 * sg;
            *(v4u*)qd = w0; *(v4u*)(qd + 8) = w1; }
    }
}
constexpr int RT_OFF = 132096;
__device__ __forceinline__ unsigned off_b(unsigned row, unsigned ch) { return 256u * row + 16u * (ch ^ (((row & 3) << 2) | ((row >> 2) & 3))); }
__device__ __forceinline__ unsigned row_addr16(unsigned lane, unsigned rb, unsigned s) { return off_b((lane & 15) + 16 * rb, 4 * s + (lane >> 4)); }
__device__ __forceinline__ unsigned tr_addr16(unsigned lane, unsigned c, unsigned ks, unsigned t) { const unsigned g = lane >> 4, q = (lane & 15) >> 2, p = lane & 3; return off_b(32 * ks + 8 * g + 4 * t + q, 2 * c + (p >> 1)) + 8 * (p & 1); }
typedef short v4i16_t __attribute__((ext_vector_type(4)));
__device__ __forceinline__ bf16x8 tr_frag(LAS unsigned char* img, unsigned lane, unsigned c, unsigned ks) {
    const v4i16_t lo = __builtin_amdgcn_ds_read_tr16_b64_v4i16((LAS v4i16_t*)(img + tr_addr16(lane, c, ks, 0)));
    const v4i16_t hi = __builtin_amdgcn_ds_read_tr16_b64_v4i16((LAS v4i16_t*)(img + tr_addr16(lane, c, ks, 1)));
    return (bf16x8){lo[0], lo[1], lo[2], lo[3], hi[0], hi[1], hi[2], hi[3]};
}
__device__ __forceinline__ bf16x8 row_frag(LAS unsigned char* img, unsigned lane, unsigned rb, unsigned s) { return *(const LAS bf16x8*)(img + row_addr16(lane, rb, s)); }
#define MFMA16(a, b, c) __builtin_amdgcn_mfma_f32_16x16x32_bf16(a, b, c, 0, 0, 0)

constexpr int ZP_OFF = 137216;
__device__ __forceinline__ void gate_phase(Frame& F) {
    LAS float* ZP = (LAS float*)(F.lds + ZP_OFF);
    const bf16* XB = (const bf16*)(F.ws + WS_A); const bf16* Wz = (const bf16*)(F.ws + WS_WZ); const float* wgu = F.in[3]; const float* bg = F.in[4]; float* BC = (float*)(F.ws + WS_BC);
    const float* SS = (const float*)(F.ws + WS_SS);
    const int lane = F.lane, wave = F.wave, fr = lane & 15, fq = lane >> 4;
    LAS float* ST = (LAS float*)(F.lds + wave * 16384);
    float wb[4][4], bb[4];
#pragma unroll
    for (int nt = 0; nt < 4; ++nt) { bb[nt] = bg[64 * wave + 16 * nt + fr];
#pragma unroll
        for (int kk = 0; kk < 4; ++kk) wb[nt][kk] = wgu[(4 * kk + fq) * 512 + 64 * wave + 16 * nt + fr]; }
    for (int u = F.vcu; u < T / CH; u += F.G) {
        const size_t t0 = (size_t)u * CH;
        { const int mt = wave & 3, kh = wave >> 2; f32x4 acc = (f32x4){0.f, 0.f, 0.f, 0.f};
          const bf16* ap = XB + (t0 + mt * 16 + fr) * D + kh * 512 + 8 * fq; const bf16* bp = Wz + (size_t)fr * D + kh * 512 + 8 * fq;
#pragma unroll
          for (int ks = 0; ks < 16; ++ks) acc = MFMA16(__builtin_nontemporal_load((const bf16x8*)(ap + ks * 32)), *(const bf16x8*)(bp + ks * 32), acc);
#pragma unroll
          for (int j = 0; j < 4; ++j) ZP[(kh * 64 + mt * 16 + 4 * fq + j) * 17 + fr] = acc[j] * pg8::row_rstd(SS, (int)t0 + mt * 16 + 4 * fq + j); }
        __syncthreads();
        float carry[4] = {0.f, 0.f, 0.f, 0.f};
#pragma unroll 1
        for (int mt = 0; mt < 4; ++mt) {
            float za[4];
#pragma unroll
            for (int kk = 0; kk < 4; ++kk) za[kk] = ZP[(mt * 16 + fr) * 17 + 4 * kk + fq] + ZP[(64 + mt * 16 + fr) * 17 + 4 * kk + fq];
#pragma unroll
            for (int nt = 0; nt < 4; ++nt) {
                f32x4 x = (f32x4){bb[nt], bb[nt], bb[nt], bb[nt]};
#pragma unroll
                for (int kk = 0; kk < 4; ++kk) x = __builtin_amdgcn_mfma_f32_16x16x4f32(za[kk], wb[nt][kk], x, 0, 0, 0);
                float p[4]; float run = 0.f;
#pragma unroll
                for (int r = 0; r < 4; ++r) { const float ls = fminf(x[r], 0.f) - __logf(1.f + __expf(-fabsf(x[r]))); run += ls * (1.f / 16.f); p[r] = run; }
                float s1 = run; { const float t = __shfl_up(s1, 16); if (fq >= 1) s1 += t; }
                float s2 = s1;  { const float t = __shfl_up(s2, 32); if (fq >= 2) s2 += t; }
                const float base = carry[nt] + (s2 - run);
                carry[nt] += __shfl(s2, 48 + fr);
#pragma unroll
                for (int r = 0; r < 4; ++r) { const int row = mt * 16 + 4 * fq + r; ST[row * 64 + ((16 * nt + fr) ^ (((row >> 2) & 3) << 4))] = base + p[r]; }
            }
        }
        LDS_WAIT(); asm volatile("" ::: "memory");
#pragma unroll
        for (int i = 0; i < 16; ++i) { const int row = 4 * i + fq; const f32x4 v = *(const LAS f32x4*)(ST + row * 64 + ((4 * fr) ^ (((row >> 2) & 3) << 4)));
            *(f32x4*)(BC + (t0 + row) * 512 + 64 * wave + 4 * fr) = v; }
        __syncthreads();
    }
}

struct GlaSet { unsigned k0, k1, k2, k3; f32x4 bca, bcb, bla, blb; v4u va, vb; float dca, dcb; };
__device__ __forceinline__ void gla_state_phase(Frame& F) {
    LAS unsigned char* lds = F.lds;
    const bf16* KG = (const bf16*)(F.ws + WS_KG); const bf16* VG = (const bf16*)(F.ws + WS_VG); const float* BC = (const float*)(F.ws + WS_BC); bf16* SP = (bf16*)F.out;
    const int tid = F.tid, lane = F.lane, wave = F.wave;
    const int pos = tid >> 3, sub = tid & 7, mt = wave >> 1, nt = wave & 1;
    constexpr int NP = NCH / 2;
    for (int u = F.vcu; u < 256; u += F.G) {
        const int bh = u >> 4, ki = (u >> 2) & 3, vi = u & 3, b = bh >> 2, h = bh & 3;
        const size_t tr0 = (size_t)b * SEQ;
        const bf16* kp = KG + (tr0 + pos) * 512 + h * GDK + ki * 32 + sub * 4;
        const float* bp = BC + (tr0 + pos) * 512 + h * GDK + ki * 32 + sub * 4;
        const float* blp = BC + (tr0 + 63) * 512 + h * GDK + ki * 32 + sub * 4;
        const bf16* vp = VG + (tr0 + pos) * 1024 + h * GDV + vi * 64 + sub * 8;
        const float* dcp = BC + (tr0 + 63) * 512 + h * GDK + ki * 32 + nt * 16 + (lane & 15);
        bf16* spp = SP + ((size_t)(bh * NP) * GDV + vi * 64 + mt * 16 + 4 * (lane >> 4)) * GDK + ki * 32 + nt * 16 + (lane & 15);
        const unsigned kw = off_b(pos, sub >> 1) + 8 * (sub & 1), vw = off_b(pos, sub);
        f32x4 acc = (f32x4){0.f, 0.f, 0.f, 0.f};
#define GLA_LOAD(S, m) do { const size_t o_ = (size_t)(m) * (2 * CH); \
        { const unsigned long long ka_ = *(const unsigned long long*)(kp + o_ * 512), kb_ = *(const unsigned long long*)(kp + (o_ + 64) * 512); S.k0 = (unsigned)ka_; S.k1 = (unsigned)(ka_ >> 32); S.k2 = (unsigned)kb_; S.k3 = (unsigned)(kb_ >> 32); } \
        S.bca = *(const f32x4*)(bp + o_ * 512); S.bcb = *(const f32x4*)(bp + (o_ + 64) * 512); S.bla = *(const f32x4*)(blp + o_ * 512); S.blb = *(const f32x4*)(blp + (o_ + 64) * 512); \
        S.va = *(const v4u*)(vp + o_ * 1024); S.vb = *(const v4u*)(vp + (o_ + 64) * 1024); S.dca = dcp[o_ * 512]; S.dcb = dcp[(o_ + 64) * 512]; } while (0)
#define GLA_STEP(S, m, buf) do { \
        { const f32x4 ea = S.bla + S.blb - S.bca, eb = S.blb - S.bcb;                                    \
          const unsigned w0 = pk2(bf2f(S.k0 & 0xffffu) * __expf(ea[0]), bf2f(S.k0 >> 16) * __expf(ea[1])), w1 = pk2(bf2f(S.k1 & 0xffffu) * __expf(ea[2]), bf2f(S.k1 >> 16) * __expf(ea[3])); \
          const unsigned w2 = pk2(bf2f(S.k2 & 0xffffu) * __expf(eb[0]), bf2f(S.k2 >> 16) * __expf(eb[1])), w3 = pk2(bf2f(S.k3 & 0xffffu) * __expf(eb[2]), bf2f(S.k3 >> 16) * __expf(eb[3])); \
          *(LAS unsigned long long*)(lds + (buf) * 65536 + kw) = (unsigned long long)w0 | ((unsigned long long)w1 << 32); \
          *(LAS unsigned long long*)(lds + (buf) * 65536 + 16384 + kw) = (unsigned long long)w2 | ((unsigned long long)w3 << 32); \
          *(LAS v4u*)(lds + (buf) * 65536 + 32768 + vw) = S.va; *(LAS v4u*)(lds + (buf) * 65536 + 49152 + vw) = S.vb; } \
        const float dec_ = __expf(S.dca + S.dcb); \
        if ((m) + 2 < NP) GLA_LOAD(S, (m) + 2); \
        __syncthreads(); \
        _Pragma("unroll") for (int j = 0; j < 4; ++j) __builtin_nontemporal_store((bf16)f2bf(acc[j]), spp + (size_t)(m) * GDV * GDK + j * GDK); \
        acc = acc * dec_; \
        _Pragma("unroll") for (int ks = 0; ks < 4; ++ks) acc = MFMA16(tr_frag(lds + (buf) * 65536 + 32768, lane, mt, ks), tr_frag(lds + (buf) * 65536, lane, nt, ks), acc); } while (0)
        GlaSet s0, s1;
        GLA_LOAD(s0, 0); GLA_LOAD(s1, 1);
        for (int m = 0; m < NP; m += 2) { GLA_STEP(s0, m, 0); GLA_STEP(s1, m + 1, 1); }
#undef GLA_LOAD
#undef GLA_STEP
        __syncthreads();
    }
}

struct GlaRaw { bf16x8 q[4], k[4]; f32x4 b0[4], b1[4], l0, l1; };
__device__ __forceinline__ void gla_out_phase(Frame& F) {
    LAS unsigned char* lds = F.lds;
    LAS unsigned char *QI = lds, *AI = lds + 16384, *KI = lds + 32768, *VI = lds + 65536, *OL = lds;
    LAS float* RED = (LAS float*)(lds + RT_OFF); LAS float* RS = RED + 512;
    const bf16* QG = (const bf16*)(F.ws + WS_QG); const bf16* KG = (const bf16*)(F.ws + WS_KG); const bf16* VG = (const bf16*)(F.ws + WS_VG); const bf16* GGp = (const bf16*)(F.ws + WS_GG);
    const float* BC = (const float*)(F.ws + WS_BC); const bf16* SP = (const bf16*)F.out; bf16* OG = (bf16*)(F.ws + WS_C); const float* hg = F.in[5];
    const int tid = F.tid, lane = F.lane, wave = F.wave, fr = lane & 15, fq = lane >> 4;
    const float g0 = hg[32 * wave + fr], g1 = hg[32 * wave + 16 + fr];
    constexpr int NU = NB * GH * (NCH / 2);
#define GLA_T0(u) ((size_t)((u) >> 7) * SEQ + (size_t)((u) & 31) * (2 * CH))
#define GLA_H(u) (((u) >> 5) & 3)
#define GLA_LOADRAW(R, u) do { const size_t t0_ = GLA_T0(u); const int h_ = GLA_H(u); \
        _Pragma("unroll") for (int r = 0; r < 4; ++r) { const int n = tid + 512 * r, pos = n >> 4, ch = n & 15; const size_t e = (t0_ + pos) * 512 + h_ * GDK + ch * 8; \
            R.q[r] = __builtin_nontemporal_load((const bf16x8*)(QG + e)); R.k[r] = __builtin_nontemporal_load((const bf16x8*)(KG + e)); \
            R.b0[r] = __builtin_nontemporal_load((const f32x4*)(BC + e)); R.b1[r] = __builtin_nontemporal_load((const f32x4*)(BC + e + 4)); } \
        { const size_t e = (t0_ + 63) * 512 + h_ * GDK + (tid & 15) * 8; R.l0 = *(const f32x4*)(BC + e); R.l1 = *(const f32x4*)(BC + e + 4); } } while (0)
#define GLA_LOADSF(u) do { const bf16* sp = SP + ((size_t)(u) * GDV + 32 * wave + fr) * GDK + 8 * fq; \
        _Pragma("unroll") for (int nt = 0; nt < 2; ++nt) _Pragma("unroll") for (int ks = 0; ks < 4; ++ks) sf[nt][ks] = __builtin_nontemporal_load((const bf16x8*)(sp + nt * 16 * GDK + ks * 32)); } while (0)
    int u = F.vcu;
    if (u >= NU) return;
    bf16x8 sf[2][4];
    GLA_LOADSF(u);
    for (;;) {
        const size_t t0 = GLA_T0(u); const int h = GLA_H(u); const int un = u + F.G; const bool has_next = un < NU;
        GlaRaw R; GLA_LOADRAW(R, u);
        v4u vv[8];
#pragma unroll
        for (int r = 0; r < 8; ++r) { const int n = tid + 512 * r, pos = n >> 5, c32 = n & 31; vv[r] = __builtin_nontemporal_load((const v4u*)(VG + (t0 + pos) * 1024 + h * GDV + c32 * 8)); }
        v4u wq1[2];
#pragma unroll
        for (int r = 0; r < 4; ++r) { const int n = tid + 512 * r, pos = n >> 4, ch = n & 15;
            float qq[8], kk[8];
#pragma unroll
            for (int j = 0; j < 8; ++j) { float bj = j < 4 ? R.b0[r][j & 3] : R.b1[r][j & 3]; if (r >= 2) bj += j < 4 ? R.l0[j & 3] : R.l1[j & 3]; const float ex = __expf(bj);
                qq[j] = bf2f((unsigned short)R.q[r][j]) * ex * 0.08838834764831845f; kk[j] = bf2f((unsigned short)R.k[r][j]) * __builtin_amdgcn_rcpf(ex); }
            v4u wqr; wqr.x = pk2(qq[0], qq[1]); wqr.y = pk2(qq[2], qq[3]); wqr.z = pk2(qq[4], qq[5]); wqr.w = pk2(qq[6], qq[7]);
            if (r < 2) *(LAS v4u*)(QI + off_b(pos, ch)) = wqr; else wq1[r - 2] = wqr;
            v4u wk; wk.x = pk2(kk[0], kk[1]); wk.y = pk2(kk[2], kk[3]); wk.z = pk2(kk[4], kk[5]); wk.w = pk2(kk[6], kk[7]);
            *(LAS v4u*)(KI + (pos >> 6) * 16384 + off_b(pos & 63, ch)) = wk; }
        {
#pragma unroll
          for (int r = 0; r < 8; ++r) { const int n = tid + 512 * r, pos = n >> 5, c32 = n & 31; *(LAS v4u*)(VI + ((pos >> 6) * 2 + (c32 >> 4)) * 16384 + off_b(pos & 63, c32 & 15)) = vv[r]; } }
#pragma unroll 1
        for (int hf = 0; hf < 2; ++hf) {
            if (hf) {
#pragma unroll
                for (int r = 0; r < 2; ++r) { const int n = tid + 512 * r, pos = n >> 4, ch = n & 15; *(LAS v4u*)(QI + off_b(pos, ch)) = wq1[r]; } }
            __syncthreads();
            { const int mt = wave >> 1;
#pragma unroll
              for (int q = 0; q < (hf ? 4 : 2); ++q) { const int nt = (hf ? 4 : 2) * (wave & 1) + q; f32x4 a4 = (f32x4){0.f, 0.f, 0.f, 0.f};
                  const bool diag = hf ? (nt >= 4) : true; const int ntl = (hf && nt >= 4) ? nt - 4 : nt;
                  if (!diag || ntl <= mt) { LAS unsigned char* kimg = KI + ((hf && nt >= 4) ? 16384 : 0);
#pragma unroll
                      for (int ks = 0; ks < 4; ++ks) a4 = MFMA16(row_frag(QI, lane, mt, ks), row_frag(kimg, lane, ntl, ks), a4); }
#pragma unroll
                  for (int r = 0; r < 4; ++r) { const int ii = mt * 16 + 4 * fq + r, jl = ntl * 16 + fr, jj = nt * 16 + fr; const float val = (!diag || jl <= ii) ? a4[r] : 0.f;
                      *(LAS unsigned short*)(AI + off_b(ii, jj >> 3) + 2 * (jj & 7)) = (unsigned short)f2bf(val); } } }
            __syncthreads();
            f32x4 o[4][2];
#pragma unroll
            for (int m = 0; m < 4; ++m) { o[m][0] = (f32x4){0.f, 0.f, 0.f, 0.f}; o[m][1] = (f32x4){0.f, 0.f, 0.f, 0.f}; }
#pragma unroll
            for (int ks = 0; ks < (hf ? 4 : 2); ++ks) { bf16x8 bfr[2];
#pragma unroll
                for (int nt = 0; nt < 2; ++nt) { const int dv = 32 * wave + 16 * nt; bfr[nt] = tr_frag(VI + ((ks >> 1) * 2 + (dv >> 7)) * 16384, lane, (dv & 127) >> 4, ks & 1); }
#pragma unroll
                for (int m = 0; m < 4; ++m) { const bf16x8 a = row_frag(AI, lane, m, ks); o[m][0] = MFMA16(a, bfr[0], o[m][0]); o[m][1] = MFMA16(a, bfr[1], o[m][1]); } }
#pragma unroll
            for (int ks = 0; ks < 4; ++ks)
#pragma unroll
                for (int m = 0; m < 4; ++m) { const bf16x8 a = row_frag(QI, lane, m, ks); o[m][0] = MFMA16(a, sf[0][ks], o[m][0]); o[m][1] = MFMA16(a, sf[1][ks], o[m][1]); }
            bf16x8 gv[4];
#pragma unroll
            for (int r = 0; r < 4; ++r) { const int n = tid + 512 * r, pos = n >> 5, c32 = n & 31; gv[r] = __builtin_nontemporal_load((const bf16x8*)(GGp + (t0 + 64 * hf + pos) * 1024 + h * GDV + c32 * 8)); }
            if (hf && has_next) GLA_LOADSF(un);
#pragma unroll
            for (int m = 0; m < 4; ++m)
#pragma unroll
                for (int r = 0; r < 4; ++r) { float s = o[m][0][r] * o[m][0][r] + o[m][1][r] * o[m][1][r];
                    s += __shfl_xor(s, 1); s += __shfl_xor(s, 2); s += __shfl_xor(s, 4); s += __shfl_xor(s, 8);
                    if (fr == 0) RED[wave * 64 + m * 16 + 4 * fq + r] = s; }
            __syncthreads();
            if (tid < 64) { float tot = 0.f;
#pragma unroll
                for (int w = 0; w < 8; ++w) tot += RED[w * 64 + tid];
                RS[tid] = __builtin_amdgcn_rsqf(tot * (1.f / GDV) + EPS); }
            __syncthreads();
#pragma unroll
            for (int m = 0; m < 4; ++m) { const f32x4 rs4 = *(const LAS f32x4*)(RS + m * 16 + 4 * fq);
#pragma unroll
                for (int r = 0; r < 4; ++r) { LAS unsigned char* rowp = OL + (m * 16 + 4 * fq + r) * 512 + (32 * wave + fr) * 2;
                    *(LAS unsigned short*)rowp = (unsigned short)f2bf(o[m][0][r] * rs4[r] * g0); *(LAS unsigned short*)(rowp + 32) = (unsigned short)f2bf(o[m][1][r] * rs4[r] * g1); } }
            __syncthreads();
#pragma unroll
            for (int r = 0; r < 4; ++r) { const int n = tid + 512 * r, pos = n >> 5, c32 = n & 31;
                const bf16x8 ov = *(const LAS bf16x8*)(OL + pos * 512 + c32 * 16); const size_t e = (t0 + 64 * hf + pos) * 1024 + h * GDV + c32 * 8;
                v4u w; w.x = pk2(bf2f((unsigned short)ov[0]) * bf2f((unsigned short)gv[r][0]), bf2f((unsigned short)ov[1]) * bf2f((unsigned short)gv[r][1]));
                w.y = pk2(bf2f((unsigned short)ov[2]) * bf2f((unsigned short)gv[r][2]), bf2f((unsigned short)ov[3]) * bf2f((unsigned short)gv[r][3]));
                w.z = pk2(bf2f((unsigned short)ov[4]) * bf2f((unsigned short)gv[r][4]), bf2f((unsigned short)ov[5]) * bf2f((unsigned short)gv[r][5]));
                w.w = pk2(bf2f((unsigned short)ov[6]) * bf2f((unsigned short)gv[r][6]), bf2f((unsigned short)ov[7]) * bf2f((unsigned short)gv[r][7]));
                *(v4u*)(OG + e) = w; }
            __syncthreads();
        }
        if (!has_next) break;
        u = un;
    }
#undef GLA_T0
#undef GLA_H
#undef GLA_LOADRAW
#undef GLA_LOADSF
}
__device__ __forceinline__ void fill_rstd_table(Frame& F, const pg8::StaticOrder& S, const float* ss) {
    LAS float* RT = (LAS float*)(F.lds + RT_OFF); pg8::Unit u;
    for (int i = 0; i < 4 && S.next(i, u); ++i) if (F.tid < 256) RT[i * 256 + F.tid] = pg8::row_rstd(ss, u.pm * 256 + F.tid);
    __syncthreads();
}

struct Args { const float* in[19]; float* out; unsigned char* ws; int ph_lo, ph_hi, li, pad; };
__global__ void __launch_bounds__(NWAVES * 64, 2) mega(Args args) {
    extern __shared__ __attribute__((aligned(16))) unsigned char lds[];
    Frame F;
    F.lds = (LAS unsigned char*)lds;
    F.MISC = (volatile LAS unsigned*)(F.lds + MISC_OFF);
    F.tid = threadIdx.x; F.lane = F.tid & 63; F.wave = __builtin_amdgcn_readfirstlane(F.tid >> 6);
    F.G = gridDim.x; { const int bx = blockIdx.x; F.vcu = (F.G % 8 == 0) ? (bx % 8) * (F.G / 8) + bx / 8 : bx; }
#pragma unroll
    for (int i = 0; i < 19; ++i) F.in[i] = args.in[i];
    F.out = args.out; F.ws = args.ws; F.ctl = (gu32*)(args.ws + WS_CTL);
    unsigned char* ws = args.ws;
    for (int u = F.tid; u < (LDS_BYTES - LDSCTL_OFF) / 4; u += NWAVES * 64) ((LAS unsigned*)(F.lds + LDSCTL_OFF))[u] = 0u;
    __syncthreads();
    const int lo = args.ph_lo, hi = args.ph_hi;
    XcdBarrier bar; bar.bar = (unsigned*)(F.ctl + CW_BAR) + args.li * XCD_BAR_WORDS; bar.x = 0; bar.st = nullptr;
    if (hi - lo > 1) bar = xcd_barrier_post((unsigned*)(F.ctl + CW_BAR) + args.li * XCD_BAR_WORDS, F.MISC + 8);
    if (F.tid == 0) __hip_atomic_store(F.ctl + CW_XCC + blockIdx.x, xb_xcc_id() + 1u, RLX_AGENT);
    const int pm_own = 8 * ((int)blockIdx.x & 7) + (((int)blockIdx.x >> 3) & 7);
    bool grp_same = false;
#define IN(k) (lo <= (k) && (k) < hi)
#define SEAM(k) do { if (IN(k) && IN((k) + ((k) == 8 ? 2 : 1))) xcd_barrier(bar); } while (0)
#define PSEAM(k, s) do { if (IN(k) && IN((k) + 1)) panel_sync(F.ctl, bar.bar + XB_TMO, (s), pm_own, grp_same); } while (0)
    bf16 *Win = (bf16*)(ws + WS_WIN), *Wao = (bf16*)(ws + WS_WAO), *W1a = (bf16*)(ws + WS_W1A), *W2a = (bf16*)(ws + WS_W2A);
    bf16 *Wkvq = (bf16*)(ws + WS_WKVQ), *Wbo = (bf16*)(ws + WS_WBO), *W1b = (bf16*)(ws + WS_W1B), *W2b = (bf16*)(ws + WS_W2B);
    float* SS = (float*)(ws + WS_SS);
    bf16 *RA = (bf16*)(ws + WS_A), *RC = (bf16*)(ws + WS_C), *HM = (bf16*)(ws + WS_HM);

    if (IN(0)) { p0_prologue(F); SEAM(0); }
    if (hi - lo > 1) {
        const int b0 = ((int)blockIdx.x & 7) + 8 * (((int)blockIdx.x >> 3) & 7); unsigned x0 = 0, same = 1;
        for (int q = 0; q < 4; ++q) { const unsigned xq = __hip_atomic_load(F.ctl + CW_XCC + b0 + 64 * q, RLX_AGENT); if (q == 0) x0 = xq; same &= (xq == x0 && xq != 0u) ? 1u : 0u; }
        grp_same = __builtin_amdgcn_readfirstlane(same) != 0;
    }
    if (IN(1)) {
        pg8::Gemm g{RA, Win, T, 3072, D}; pg8::StaticOrder S; S.init(T, 3072, F.G, (int)blockIdx.x);
        fill_rstd_table(F, S, SS);
        pg8::EpiInProj E{(bf16*)(ws + WS_QG), (bf16*)(ws + WS_KG), (bf16*)(ws + WS_VG), (bf16*)(ws + WS_GG), (const LAS float*)(F.lds + RT_OFF), 0};
        pg8::gemm_phase<pg8::EpiInProj, pg8::StaticOrder, PG8_ALIGN, PG8_SP2>(F.lds + RING_OFF, g, S, E);
        gate_phase(F);
        SEAM(1);
    }
    if (IN(2)) { gla_state_phase(F); SEAM(2); }
    if (IN(3)) { gla_out_phase(F); SEAM(3); }
    if (IN(4)) {
        pg8::Gemm g{RC, Wao, T, D, D}; pg8::StaticOrder S; S.init(T, D, F.G, (int)blockIdx.x);
        pg8::EpiResB<1> E{nullptr, RA, (bf16*)F.out, nullptr, SS};
        pg8::gemm_phase<pg8::EpiResB<1>, pg8::StaticOrder, PG8_ALIGN, PG8_SP2>(F.lds + RING_OFF, g, S, E);
        PSEAM(4, 0);
    }
    if (IN(5)) {
        pg8::Gemm g{(const bf16*)F.out, W1a, T, FF, D}; pg8::StaticOrder S; S.init(T, FF, F.G, (int)blockIdx.x);
        fill_rstd_table(F, S, SS);
        pg8::EpiUp E{HM, (const LAS float*)(F.lds + RT_OFF), 0};
        pg8::gemm_phase<pg8::EpiUp, pg8::StaticOrder, PG8_ALIGN, PG8_SP2>(F.lds + RING_OFF, g, S, E);
        PSEAM(5, 1);
    }
    if (IN(6)) {
        pg8::Gemm g{HM, W2a, T, D, FF}; pg8::StaticOrder S; S.init(T, D, F.G, (int)blockIdx.x);
        pg8::EpiResB<1> E{nullptr, (const bf16*)F.out, RA, nullptr, SS};
        pg8::gemm_phase<pg8::EpiResB<1>, pg8::StaticOrder, PG8_ALIGN, PG8_SP2>(F.lds + RING_OFF, g, S, E);
        SEAM(6);
    }
    if (IN(7)) {
        pg8::Gemm g{RA, Wkvq, T, 3072, D}; pg8::StaticOrder S; S.init(T, 3072, F.G, (int)blockIdx.x);
        if (F.tid < 128) ((LAS float*)(F.lds + RT_OFF + 4096))[F.tid] = (F.tid < 64) ? F.in[9][F.tid] : F.in[12][F.tid - 64];
        fill_rstd_table(F, S, SS);
        pg8::EpiKVQ E{(bf16*)(ws + WS_KN), (bf16*)(ws + WS_V2), (bf16*)(ws + WS_QN), (const LAS float*)(F.lds + RT_OFF), (const LAS float*)(F.lds + RT_OFF + 4096), (const LAS float*)(F.lds + RT_OFF + 4096 + 256), 0};
        pg8::gemm_phase<pg8::EpiKVQ, pg8::StaticOrder, PG8_ALIGN, PG8_SP2>(F.lds + RING_OFF, g, S, E);
        SEAM(7);
    }
    if (IN(8)) {
        const attn_body::AttnTensors AT{(const attn_body::bf16*)(ws + WS_QN), (const attn_body::bf16*)(ws + WS_KN), (const attn_body::bf16*)(ws + WS_V2), (attn_body::bf16*)F.out};
        const attn_body::StaticOrder S((int)F.G, (int)blockIdx.x);
        attn_body::attn_phase<attn_body::StaticOrder>((char*)lds + RING_OFF, AT, S);
        combine_local(F);
        SEAM(8);
    }
    if (IN(10)) {
        pg8::Gemm g{RC, Wbo, T, D, D}; pg8::StaticOrder S; S.init(T, D, F.G, (int)blockIdx.x);
        pg8::EpiResB<1> E{nullptr, RA, RA, nullptr, SS};
        pg8::gemm_phase<pg8::EpiResB<1>, pg8::StaticOrder, PG8_ALIGN, PG8_SP2>(F.lds + RING_OFF, g, S, E);
        PSEAM(10, 2);
    }
    if (IN(11)) {
        pg8::Gemm g{RA, W1b, T, FF, D}; pg8::StaticOrder S; S.init(T, FF, F.G, (int)blockIdx.x);
        fill_rstd_table(F, S, SS);
        pg8::EpiUp E{HM, (const LAS float*)(F.lds + RT_OFF), 0};
        pg8::gemm_phase<pg8::EpiUp, pg8::StaticOrder, PG8_ALIGN, PG8_SP2>(F.lds + RING_OFF, g, S, E);
        PSEAM(11, 3);
    }
    if (IN(12)) {
        pg8::Gemm g{HM, W2b, T, D, FF}; pg8::StaticOrder S; S.init(T, D, F.G, (int)blockIdx.x);
        pg8::EpiResB<2> E{nullptr, RA, nullptr, F.out, nullptr};
        pg8::gemm_phase<pg8::EpiResB<2>, pg8::StaticOrder, PG8_ALIGN, PG8_SP2>(F.lds + RING_OFF, g, S, E);
    }
#undef IN
#undef SEAM
}

extern "C" void kernel_launch(void* const* d_in, const int* in_sizes, int n_in, void* d_out, int out_size, void* d_ws, size_t ws_size, hipStream_t stream) {
    static int grid = 0;
    if (grid == 0) {
        if (n_in != 19 || out_size != T * D || ws_size < WS_END) { fprintf(stderr, "kernel_launch: unexpected shapes (n_in %d out %d ws %zu)\n", n_in, out_size, ws_size); grid = -1; return; }
        int dev = 0, cus = 0, per_cu = 0;
        if (hipGetDevice(&dev) != hipSuccess || hipDeviceGetAttribute(&cus, hipDeviceAttributeMultiprocessorCount, dev) != hipSuccess) { grid = -1; return; }
        if (hipFuncSetAttribute((const void*)mega, hipFuncAttributeMaxDynamicSharedMemorySize, LDS_BYTES) != hipSuccess) { fprintf(stderr, "kernel_launch: hipFuncSetAttribute failed\n"); grid = -1; return; }
        if (hipOccupancyMaxActiveBlocksPerMultiprocessor(&per_cu, (const void*)mega, NWAVES * 64, LDS_BYTES) != hipSuccess || per_cu < 1) { fprintf(stderr, "kernel_launch: occupancy query says %d blocks per CU\n", per_cu); grid = -1; (void)hipGetLastError(); return; }
        if (cus < 256) { fprintf(stderr, "kernel_launch: built for the 256 CUs of an MI355X (one resident workgroup per CU), found %d\n", cus); grid = -1; return; }
        grid = 256;
    }
    if (grid < 0) return;
    unsigned char* ws = (unsigned char*)d_ws;
    (void)hipMemsetAsync(ws + WS_CTL, 0, 64 * 1024, stream);
    Args a{};
    for (int i = 0; i < 19; ++i) a.in[i] = (const float*)d_in[i];
    a.out = (float*)d_out; a.ws = ws;
    int li = 0;
    auto run = [&](int lo, int hi) { a.ph_lo = lo; a.ph_hi = hi; a.li = li++; hipLaunchKernelGGL(mega, dim3(grid), dim3(NWAVES * 64), LDS_BYTES, stream, a); };
    run(0, 13);
}
```

```cpp
#include <hip/hip_runtime.h>
#include <cstdio>
#include <cstdint>

typedef unsigned short bf16;
typedef short bf16x8 __attribute__((ext_vector_type(8)));
typedef float f32x4 __attribute__((ext_vector_type(4)));

constexpr int NB = 4, SEQ = 4096, T = NB * SEQ, D = 1024, FF = 4096;
constexpr int GH = 4, GDK = 128, GDV = 256, GR = 16, CH = 64, NCH = SEQ / CH;
constexpr int GIN = 3088;
constexpr int DH = 8, DDH = 64, DVD = 128;
constexpr float EPS = 1e-6f;
constexpr float LOG2E = 1.4426950408889634f;
constexpr float LAMBDA_INIT = 0.35550906759f;

constexpr size_t MiB = 1u << 20;
constexpr size_t WS_CTL = 0;
constexpr size_t WS_SS = 1 * MiB;
constexpr size_t WS_ZB = 2 * MiB;
constexpr size_t WS_WZ = 3 * MiB;
constexpr size_t WS_WIN = 4 * MiB;
constexpr size_t WS_WAO = 10 * MiB;
constexpr size_t WS_W1A = 12 * MiB;
constexpr size_t WS_W2A = 20 * MiB;
constexpr size_t WS_WKVQ = 28 * MiB;
constexpr size_t WS_WBO = 34 * MiB;
constexpr size_t WS_W1B = 36 * MiB;
constexpr size_t WS_W2B = 44 * MiB;
constexpr size_t WS_B = 52 * MiB;
constexpr size_t WS_A = 180 * MiB;
constexpr size_t WS_C = 212 * MiB;
constexpr size_t WS_END = 244 * MiB;
constexpr size_t PSLOT = 2 * MiB, PQ = 0, PK = 256 * 1024, PV = 512 * 1024, PG = 1 * MiB, PBC = 1536 * 1024;
constexpr size_t WS_HM = WS_B;
constexpr size_t WS_KN = WS_B, WS_V2 = WS_B + 32 * MiB, WS_QN = WS_B + 64 * MiB;

__host__ __device__ __forceinline__ unsigned f2bf(float f) { unsigned u = __builtin_bit_cast(unsigned, f); return (u + 0x7fffu + ((u >> 16) & 1u)) >> 16; }
__host__ __device__ __forceinline__ float bf2f(unsigned h) { return __builtin_bit_cast(float, h << 16); }

__host__ __device__ __forceinline__ int kvq_dest_row(int n) {
    if (n >= 1024 && n < 2048) return n;
    const int tile = n >> 8, w = n & 255, lb = w >> 5, j = w & 31, wc = lb >> 1, bj = lb & 1;
    return (tile << 8) + 128 * bj + 32 * wc + j;
}

namespace pg8 {
#define PG8_LAS __attribute__((address_space(3)))
typedef unsigned short bf16_t;
typedef short bf16x8 __attribute__((ext_vector_type(8)));
typedef float f32x4 __attribute__((ext_vector_type(4)));
typedef unsigned u32x4 __attribute__((ext_vector_type(4)));
constexpr int BM = 256, BK = 64, HALF = 128, HTB = HALF * BK * 2  , STAGE_BYTES = 8 * HTB, NXCD = 8, WGM = 8;

__host__ __device__ __forceinline__ int lds_byte(int r, int c) { const int st = (r >> 4) * 2 + (c >> 5), rr = r & 15, cc = c & 31, ob = rr * 64 + cc * 2; return st * 1024 + (ob ^ (((ob >> 9) & 1) << 5)); }
__host__ __device__ __forceinline__ void stage_rc(int b, int& R, int& C) { const int st = b / 1024, sb = b % 1024, swz = sb ^ (((sb >> 9) & 1) << 5); R = (st >> 1) * 16 + swz / 64; C = (st & 1) * 32 + (swz % 64) / 2; }
__host__ __device__ __forceinline__ int perm32(int rho) { const int n = rho >> 4, i = rho & 15; return 8 * (i >> 2) + 4 * n + (i & 3); }

struct Unit { int pm, pn; };
struct Gemm { const bf16_t* A; const bf16_t* Bt; int M, N, K; };

struct StaticOrder {
    int nM, nN, nwg, G, c;
    __host__ __device__ void init(int M, int N, int G_, int c_) { nM = M / BM; nN = N / BM; nwg = nM * nN; G = G_; c = c_; }
    __host__ __device__ bool next(int i, Unit& u) const {
        const long L = (long)i * G + c; if (L >= nwg) return false;
        int wgid = (int)L; { const int q = nwg / NXCD, r = nwg % NXCD, xcd = wgid % NXCD, off = wgid / NXCD; wgid = (xcd < r ? xcd * (q + 1) : r * (q + 1) + (xcd - r) * q) + off; }
        const int nig = WGM * nN, gid = wgid / nig, fm = gid * WGM, gsz = (nM - fm) < WGM ? (nM - fm) : WGM;
        u.pm = fm + ((wgid % nig) % gsz); u.pn = (wgid % nig) / gsz; return true;
    }
    __device__ __forceinline__ void a_ready(const Unit&) const {}
    __device__ __forceinline__ void done(const Unit&) const {}
};

__device__ __forceinline__ unsigned cvt_pk_bf16(float lo, float hi) { unsigned r; asm volatile("v_cvt_pk_bf16_f32 %0, %1, %2" : "=v"(r) : "v"(lo), "v"(hi)); return r; }
typedef float f32x2 __attribute__((ext_vector_type(2)));
typedef unsigned u32x2 __attribute__((ext_vector_type(2)));
__device__ __forceinline__ void store16_wt(void* p, u32x4 v) { asm volatile("global_store_dwordx4 %0, %1, off sc1\n\ts_nop 1" :: "v"(p), "v"(v) : "memory"); }
constexpr int TOK = 16384;
constexpr float RMS_EPS = 1e-6f;
__device__ __forceinline__ float silu_f(float g) { return g * __builtin_amdgcn_rcpf(1.0f + __builtin_amdgcn_exp2f(-1.4426950408889634f * g)); }
__device__ __forceinline__ float row_rstd(const float* ss, int row) {
    const f32x4 a = *(const f32x4*)(ss + (size_t)row * 16), b = *(const f32x4*)(ss + (size_t)row * 16 + 4), c = *(const f32x4*)(ss + (size_t)row * 16 + 8), d = *(const f32x4*)(ss + (size_t)row * 16 + 12);
    const float q = ((a[0] + a[1]) + (a[2] + a[3])) + ((b[0] + b[1]) + (b[2] + b[3])) + ((c[0] + c[1]) + (c[2] + c[3])) + ((d[0] + d[1]) + (d[2] + d[3]));
    return __builtin_amdgcn_rsqf(q * (1.0f / 1024.0f) + RMS_EPS);
}
struct EpiInProj {
    static constexpr bool PERM = true, AFTER_DRAIN = false;
    unsigned char* slots; const PG8_LAS float* rt; mutable int ui;
    __device__ __forceinline__ void operator()(const f32x4 (&acc)[2][2][4][2], const Unit& u, int wr, int wc, int fr, int fq) const {
        const int row0 = wr * 64 + fr; const int pn = u.pn; const PG8_LAS float* rtu = rt + ui * 256 + wr * 64 + fr; ++ui;
        unsigned char* sl = slots + (size_t)u.pm * (2u << 20); bf16_t* base; int ldc, colt; const bool act = pn >= 8;
        if (pn < 2) { base = (bf16_t*)sl; ldc = 512; colt = pn * BM; } else if (pn < 4) { base = (bf16_t*)(sl + 256 * 1024); ldc = 512; colt = (pn - 2) * BM; }
        else if (pn < 8) { base = (bf16_t*)(sl + 512 * 1024); ldc = 1024; colt = (pn - 4) * BM; } else { base = (bf16_t*)(sl + 1024 * 1024); ldc = 1024; colt = (pn - 8) * BM; }
        const int col0 = colt + wc * 32 + 8 * fq;
#pragma unroll
        for (int ai = 0; ai < 2; ++ai)
#pragma unroll
            for (int m = 0; m < 4; ++m) { bf16_t* rowp = base + (size_t)(row0 + ai * HALF + m * 16) * ldc + col0; const float rs = rtu[ai * HALF + m * 16];
#pragma unroll
                for (int bj = 0; bj < 2; ++bj) { f32x4 v0 = acc[ai][bj][m][0] * rs, v1 = acc[ai][bj][m][1] * rs;
                    if (act) { v0 = (f32x4){silu_f(v0[0]), silu_f(v0[1]), silu_f(v0[2]), silu_f(v0[3])}; v1 = (f32x4){silu_f(v1[0]), silu_f(v1[1]), silu_f(v1[2]), silu_f(v1[3])}; }
                    u32x4 w; w.x = cvt_pk_bf16(v0[0], v0[1]); w.y = cvt_pk_bf16(v0[2], v0[3]); w.z = cvt_pk_bf16(v1[0], v1[1]); w.w = cvt_pk_bf16(v1[2], v1[3]);
                    store16_wt(rowp + bj * HALF, w); } }
    }
};
template <int MODE> struct EpiResB {
    static constexpr bool PERM = true, AFTER_DRAIN = false;
    const float* basef; const bf16_t* baseb; bf16_t* hb; float* outf; float* ss;
    __device__ __forceinline__ void operator()(const f32x4 (&acc)[2][2][4][2], const Unit& u, int wr, int wc, int fr, int fq) const {
        const int col0 = u.pn * BM + wc * 32 + 8 * fq;
#pragma unroll
        for (int ai = 0; ai < 2; ++ai)
#pragma unroll
            for (int m = 0; m < 4; ++m) { const int row = u.pm * BM + ai * HALF + wr * 64 + m * 16 + fr; const size_t off = (size_t)row * 1024 + col0; float s = 0.f;
#pragma unroll
                for (int bj = 0; bj < 2; ++bj) { f32x4 h0, h1;
                    if (MODE == 0) { h0 = *(const f32x4*)(basef + off + bj * HALF); h1 = *(const f32x4*)(basef + off + bj * HALF + 4); }
                    else { const u32x4 b = *(const u32x4*)(baseb + off + bj * HALF);
                        h0 = (f32x4){__builtin_bit_cast(float, b.x << 16), __builtin_bit_cast(float, b.x & 0xffff0000u), __builtin_bit_cast(float, b.y << 16), __builtin_bit_cast(float, b.y & 0xffff0000u)};
                        h1 = (f32x4){__builtin_bit_cast(float, b.z << 16), __builtin_bit_cast(float, b.z & 0xffff0000u), __builtin_bit_cast(float, b.w << 16), __builtin_bit_cast(float, b.w & 0xffff0000u)}; }
                    h0 = h0 + acc[ai][bj][m][0]; h1 = h1 + acc[ai][bj][m][1];
                    if (MODE == 2) { __builtin_nontemporal_store(h0, (f32x4*)(outf + off + bj * HALF)); __builtin_nontemporal_store(h1, (f32x4*)(outf + off + bj * HALF + 4)); }
                    else { u32x4 w; w.x = cvt_pk_bf16(h0[0], h0[1]); w.y = cvt_pk_bf16(h0[2], h0[3]); w.z = cvt_pk_bf16(h1[0], h1[1]); w.w = cvt_pk_bf16(h1[2], h1[3]);
                        *(u32x4*)(hb + off + bj * HALF) = w;
                        s += ((h0[0] * h0[0] + h0[1] * h0[1]) + (h0[2] * h0[2] + h0[3] * h0[3])) + ((h1[0] * h1[0] + h1[1] * h1[1]) + (h1[2] * h1[2] + h1[3] * h1[3])); } }
                if (MODE != 2) { s += __shfl_xor(s, 16); s += __shfl_xor(s, 32); if (fq == 0) ss[(size_t)row * 16 + u.pn * 4 + wc] = s; }
                if (m & 1) asm volatile("" ::: "memory"); }
    }
};
struct EpiUp {
    static constexpr bool PERM = true, AFTER_DRAIN = false;
    bf16_t* O; const PG8_LAS float* rt; mutable int ui;
    __device__ __forceinline__ void operator()(const f32x4 (&acc)[2][2][4][2], const Unit& u, int wr, int wc, int fr, int fq) const {
        const int col0 = u.pn * BM + wc * 32 + 8 * fq; const PG8_LAS float* rtu = rt + ui * 256 + wr * 64 + fr; ++ui;
#pragma unroll
        for (int ai = 0; ai < 2; ++ai)
#pragma unroll
            for (int m = 0; m < 4; ++m) { const int row = u.pm * BM + ai * HALF + wr * 64 + m * 16 + fr; const float rs = rtu[ai * HALF + m * 16]; bf16_t* rowp = O + (size_t)row * 4096 + col0;
#pragma unroll
                for (int bj = 0; bj < 2; ++bj) { f32x4 v0 = acc[ai][bj][m][0] * rs, v1 = acc[ai][bj][m][1] * rs;
#pragma unroll
                    for (int e = 0; e < 4; ++e) { const float a = __builtin_fmaxf(v0[e], 0.f), b = __builtin_fmaxf(v1[e], 0.f); v0[e] = a * a; v1[e] = b * b; }
                    u32x4 w; w.x = cvt_pk_bf16(v0[0], v0[1]); w.y = cvt_pk_bf16(v0[2], v0[3]); w.z = cvt_pk_bf16(v1[0], v1[1]); w.w = cvt_pk_bf16(v1[2], v1[3]);
                    store16_wt(rowp + bj * HALF, w); } }
    }
};
struct EpiKVQ {
    static constexpr bool PERM = true, AFTER_DRAIN = false;
    bf16_t *kn, *v2, *qn; const PG8_LAS float* rt; const PG8_LAS float *gk, *gq; mutable int ui;
    __device__ __forceinline__ void operator()(const f32x4 (&acc)[2][2][4][2], const Unit& u, int wr, int wc, int fr, int fq) const {
        const int pn = u.pn; const PG8_LAS float* rtu = rt + ui * 256 + wr * 64 + fr; ++ui;
        if (pn >= 4 && pn < 8) {
            const int col0 = (pn - 4) * BM + wc * 32 + 8 * fq;
#pragma unroll
            for (int ai = 0; ai < 2; ++ai)
#pragma unroll
                for (int m = 0; m < 4; ++m) { const int row = u.pm * BM + ai * HALF + wr * 64 + m * 16 + fr; const float rs = rtu[ai * HALF + m * 16]; bf16_t* rowp = v2 + (size_t)row * 1024 + col0;
#pragma unroll
                    for (int bj = 0; bj < 2; ++bj) { const f32x4 v0 = acc[ai][bj][m][0] * rs, v1 = acc[ai][bj][m][1] * rs;
                        u32x4 w; w.x = cvt_pk_bf16(v0[0], v0[1]); w.y = cvt_pk_bf16(v0[2], v0[3]); w.z = cvt_pk_bf16(v1[0], v1[1]); w.w = cvt_pk_bf16(v1[2], v1[3]);
                        store16_wt(rowp + bj * HALF, w); } }
        } else {
            const bool isq = pn >= 8; const PG8_LAS float* gp = isq ? gq : gk; bf16_t* dst = isq ? qn : kn; const int pl = isq ? pn - 8 : pn;
            const float sc = isq ? 0.125f * 1.4426950408889634f : 1.0f;
            f32x4 gv[2][2];
#pragma unroll
            for (int bj = 0; bj < 2; ++bj)
#pragma unroll
                for (int n = 0; n < 2; ++n) gv[bj][n] = *(const PG8_LAS f32x4*)(gp + 32 * bj + 8 * fq + 4 * n) * sc;
            const int col0 = pl * BM + wc * 64 + 8 * fq;
#pragma unroll
            for (int ai = 0; ai < 2; ++ai)
#pragma unroll
                for (int m = 0; m < 4; ++m) { const int row = u.pm * BM + ai * HALF + wr * 64 + m * 16 + fr; const float rs = rtu[ai * HALF + m * 16]; bf16_t* rowp = dst + (size_t)row * 1024 + col0;
                    f32x4 x[2][2]; float s = 0.f;
#pragma unroll
                    for (int bj = 0; bj < 2; ++bj)
#pragma unroll
                        for (int n = 0; n < 2; ++n) { x[bj][n] = acc[ai][bj][m][n] * rs; s += (x[bj][n][0] * x[bj][n][0] + x[bj][n][1] * x[bj][n][1]) + (x[bj][n][2] * x[bj][n][2] + x[bj][n][3] * x[bj][n][3]); }
                    s += __shfl_xor(s, 16); s += __shfl_xor(s, 32);
                    const float r2 = __builtin_amdgcn_rsqf(s * (1.0f / 64.0f) + RMS_EPS);
#pragma unroll
                    for (int bj = 0; bj < 2; ++bj) { const f32x4 v0 = x[bj][0] * r2 * gv[bj][0], v1 = x[bj][1] * r2 * gv[bj][1];
                        u32x4 w; w.x = cvt_pk_bf16(v0[0], v0[1]); w.y = cvt_pk_bf16(v0[2], v0[3]); w.z = cvt_pk_bf16(v1[0], v1[1]); w.w = cvt_pk_bf16(v1[2], v1[3]);
                        store16_wt(rowp + 32 * bj, w); } }
        }
    }
};

template <class Epi, class Sched, bool ALIGN_EPI = false, bool SP2 = false>
__device__ __forceinline__ void gemm_phase(PG8_LAS unsigned char* lds, const Gemm g, const Sched& S, const Epi& E) {
    const int tid = threadIdx.x, wid = __builtin_amdgcn_readfirstlane(tid >> 6), lane = tid & 63, wr = wid >> 2, wc = wid & 3, fr = lane & 15, fq = lane >> 4;
    const int K = g.K, nt = K / BK;
    unsigned voffA[2], voffB[2];
#pragma unroll
    for (int i = 0; i < 2; ++i) { int R, C; stage_rc(tid * 16 + i * 8192, R, C); const int Rb = Epi::PERM ? ((R & ~31) + perm32(R & 31)) : R;
        voffA[i] = (unsigned)(R * K + C) * 2u; voffB[i] = (unsigned)(Rb * K + C) * 2u; }
    const size_t kstep = (size_t)(BK * 2);
    const size_t hstep = (size_t)HALF * K * 2;
    const size_t tstep = 2 * hstep;
    const unsigned ldsw = (unsigned)wid * 1024u;
    const int aoff = lds_byte(wr * 64 + fr, fq * 8), boff = lds_byte(wc * 32 + fr, fq * 8);
#define PG8_SA(b, h) (((b) * 2 + (h)) * HTB)
#define PG8_SB(b, h) ((4 + (b) * 2 + (h)) * HTB)
#define PG8_STAGE(bufoff, gbase, voff) do { _Pragma("unroll") for (int _i = 0; _i < 2; ++_i) \
        __builtin_amdgcn_global_load_lds((const unsigned*)((const char*)(gbase) + (voff)[_i]), (PG8_LAS unsigned*)(lds + (bufoff) + ldsw + _i * 8192), 16, 0, 0); } while (0)
#define PG8_LDA(dst, b, h) do { _Pragma("unroll") for (int m = 0; m < 4; ++m) _Pragma("unroll") for (int k = 0; k < 2; ++k) dst[m][k] = *(const PG8_LAS bf16x8*)(lds + PG8_SA(b, h) + aoff + m * 2048 + k * 1024); } while (0)
#define PG8_LDB(dst, b, h) do { _Pragma("unroll") for (int n = 0; n < 2; ++n) _Pragma("unroll") for (int k = 0; k < 2; ++k) dst[n][k] = *(const PG8_LAS bf16x8*)(lds + PG8_SB(b, h) + boff + n * 2048 + k * 1024); } while (0)
#define PG8_MMA(ai, bj, At, Bt) do { __builtin_amdgcn_s_setprio(1); _Pragma("unroll") for (int m = 0; m < 4; ++m) _Pragma("unroll") for (int n = 0; n < 2; ++n) _Pragma("unroll") for (int k = 0; k < 2; ++k) \
        acc[ai][bj][m][n] = __builtin_amdgcn_mfma_f32_16x16x32_bf16(Bt[n][k], At[m][k], acc[ai][bj][m][n], 0, 0, 0); __builtin_amdgcn_s_setprio(0); } while (0)
#define PG8_WAIT_V(n) asm volatile("s_waitcnt vmcnt(" #n ")" ::: "memory")
#define PG8_WAIT_L(n) asm volatile("s_waitcnt lgkmcnt(" #n ")" ::: "memory")
#define PG8_BAR __builtin_amdgcn_s_barrier()
#define PG8_SCHED __builtin_amdgcn_sched_barrier(0)
    Unit cur, nxt; int ui = 0;
    if (!S.next(0, cur)) return;
    f32x4 acc[2][2][4][2];
#pragma unroll
    for (int a = 0; a < 2; ++a)
#pragma unroll
        for (int b = 0; b < 2; ++b)
#pragma unroll
            for (int m = 0; m < 4; ++m)
#pragma unroll
                for (int n = 0; n < 2; ++n) acc[a][b][m][n] = (f32x4){0.f, 0.f, 0.f, 0.f};
    bf16x8 At[4][2], B0[2][2], B1[2][2];
    const char* cA = (const char*)g.A + (size_t)cur.pm * tstep; const char* cB = (const char*)g.Bt + (size_t)cur.pn * tstep;
    S.a_ready(cur);
    if constexpr (SP2) {
        PG8_STAGE(PG8_SB(0, 0), cB, voffB); PG8_STAGE(PG8_SB(0, 1), cB + hstep, voffB); PG8_STAGE(PG8_SA(0, 0), cA, voffA); PG8_STAGE(PG8_SA(0, 1), cA + hstep, voffA);
        if (wr == 1) PG8_BAR;
        PG8_WAIT_V(2); PG8_BAR;
        PG8_STAGE(PG8_SB(1, 0), cB + kstep, voffB); PG8_STAGE(PG8_SA(1, 0), cA + kstep, voffA); PG8_STAGE(PG8_SB(1, 1), cB + hstep + kstep, voffB);
        PG8_WAIT_V(6); PG8_BAR;
    } else {
        PG8_STAGE(PG8_SB(0, 0), cB, voffB); PG8_STAGE(PG8_SA(0, 0), cA, voffA); PG8_STAGE(PG8_SB(0, 1), cB + hstep, voffB); PG8_STAGE(PG8_SA(0, 1), cA + hstep, voffA);
        if (wr == 1) PG8_BAR;
        PG8_WAIT_V(4); PG8_BAR;
        PG8_STAGE(PG8_SB(1, 0), cB + kstep, voffB); PG8_STAGE(PG8_SA(1, 0), cA + kstep, voffA); PG8_STAGE(PG8_SB(1, 1), cB + hstep + kstep, voffB);
        PG8_WAIT_V(6); PG8_BAR;
    }
    for (;;) {
        const bool has_next = S.next(ui + 1, nxt);
        const char* nA = has_next ? (const char*)g.A + (size_t)nxt.pm * tstep : cA; const char* nB = has_next ? (const char*)g.Bt + (size_t)nxt.pn * tstep : cB;
        for (int t = 0; t < nt; t += 2) {
            const bool last = (t == nt - 2);
            const char* a1 = cA + (size_t)(t + 1) * kstep;
            const char* a2 = last ? nA : cA + (size_t)(t + 2) * kstep; const char* b2 = last ? nB : cB + (size_t)(t + 2) * kstep;
            const char* a3 = a2 + kstep; const char* b3 = b2 + kstep;
            if (last && has_next) S.a_ready(nxt);
            if constexpr (SP2) {
            PG8_LDB(B0, 0, 0); PG8_LDB(B1, 0, 1); PG8_SCHED; PG8_LDA(At, 0, 0); PG8_STAGE(PG8_SA(1, 1), a1 + hstep, voffA);
            PG8_WAIT_V(8); PG8_WAIT_L(0); PG8_BAR; PG8_MMA(0, 0, At, B0); PG8_MMA(0, 1, At, B1); PG8_BAR; PG8_SCHED;
            PG8_LDA(At, 0, 1); PG8_STAGE(PG8_SB(0, 0), b2, voffB); PG8_STAGE(PG8_SB(0, 1), b2 + hstep, voffB); PG8_STAGE(PG8_SA(0, 0), a2, voffA);
            PG8_WAIT_V(8); PG8_WAIT_L(0); PG8_BAR; PG8_MMA(1, 0, At, B0); PG8_MMA(1, 1, At, B1); PG8_BAR; PG8_SCHED;
            PG8_LDB(B0, 1, 0); PG8_LDB(B1, 1, 1); PG8_SCHED; PG8_LDA(At, 1, 0); PG8_STAGE(PG8_SA(0, 1), a2 + hstep, voffA);
            PG8_WAIT_V(8); PG8_WAIT_L(0); PG8_BAR; PG8_MMA(0, 0, At, B0); PG8_MMA(0, 1, At, B1); PG8_BAR; PG8_SCHED;
            PG8_LDA(At, 1, 1); PG8_STAGE(PG8_SB(1, 0), b3, voffB); PG8_STAGE(PG8_SB(1, 1), b3 + hstep, voffB); PG8_STAGE(PG8_SA(1, 0), a3, voffA);
            PG8_WAIT_V(8); PG8_WAIT_L(0); PG8_BAR; PG8_MMA(1, 0, At, B0); PG8_MMA(1, 1, At, B1); PG8_BAR; PG8_SCHED;
            } else {
            PG8_LDB(B0, 0, 0); PG8_SCHED; PG8_LDA(At, 0, 0); PG8_STAGE(PG8_SA(1, 1), a1 + hstep, voffA);
            PG8_WAIT_L(8); PG8_BAR; PG8_WAIT_L(0); PG8_MMA(0, 0, At, B0); PG8_BAR; PG8_SCHED;
            PG8_LDB(B1, 0, 1); PG8_STAGE(PG8_SB(0, 0), b2, voffB);
            PG8_BAR; PG8_WAIT_L(0); PG8_MMA(0, 1, At, B1); PG8_BAR;
            PG8_LDA(At, 0, 1); PG8_STAGE(PG8_SA(0, 0), a2, voffA);
            PG8_BAR; PG8_WAIT_L(0); PG8_MMA(1, 0, At, B0); PG8_BAR; PG8_SCHED;
            PG8_STAGE(PG8_SB(0, 1), b2 + hstep, voffB);
            PG8_WAIT_V(6); PG8_BAR; PG8_MMA(1, 1, At, B1); PG8_BAR;
            PG8_LDB(B0, 1, 0); PG8_SCHED; PG8_LDA(At, 1, 0); PG8_STAGE(PG8_SA(0, 1), a2 + hstep, voffA);
            PG8_WAIT_L(8); PG8_BAR; PG8_WAIT_L(0); PG8_MMA(0, 0, At, B0); PG8_BAR; PG8_SCHED;
            PG8_LDB(B1, 1, 1); PG8_STAGE(PG8_SB(1, 0), b3, voffB);
            PG8_BAR; PG8_WAIT_L(0); PG8_MMA(0, 1, At, B1); PG8_BAR;
            PG8_LDA(At, 1, 1); PG8_STAGE(PG8_SA(1, 0), a3, voffA);
            PG8_BAR; PG8_WAIT_L(0); PG8_MMA(1, 0, At, B0); PG8_BAR; PG8_SCHED;
            PG8_STAGE(PG8_SB(1, 1), b3 + hstep, voffB);
            PG8_WAIT_V(6); PG8_BAR; PG8_MMA(1, 1, At, B1); PG8_BAR;
            }
        }
        if constexpr (ALIGN_EPI) { if (wr == 0) PG8_BAR; }
        if constexpr (!Epi::AFTER_DRAIN) { E(acc, cur, wr, wc, fr, fq); S.done(cur); }
        if (!has_next) break;
#pragma unroll
        for (int a = 0; a < 2; ++a)
#pragma unroll
            for (int b = 0; b < 2; ++b)
#pragma unroll
                for (int m = 0; m < 4; ++m)
#pragma unroll
                    for (int n = 0; n < 2; ++n) acc[a][b][m][n] = (f32x4){0.f, 0.f, 0.f, 0.f};
        cur = nxt; cA = nA; cB = nB; ++ui;
        if constexpr (ALIGN_EPI) { if (wr == 1) PG8_BAR; }
    }
    PG8_WAIT_V(0);
    if constexpr (!ALIGN_EPI) { if (wr == 0) PG8_BAR; }
    PG8_BAR;
    if constexpr (Epi::AFTER_DRAIN) { E.fused(acc, cur, wr, wc, fr, fq, lds, wid, lane); S.done(cur); }
#undef PG8_SA
#undef PG8_SB
#undef PG8_STAGE
#undef PG8_LDA
#undef PG8_LDB
#undef PG8_MMA
#undef PG8_WAIT_V
#undef PG8_WAIT_L
#undef PG8_BAR
#undef PG8_SCHED
}
}

#ifndef PG8_SP2
#define PG8_SP2 true
#endif
#ifndef PG8_ALIGN
#define PG8_ALIGN true
#endif

#include <hip/hip_bf16.h>
#include <cmath>
namespace attn_body {
using bf16=__hip_bfloat16;
using bf16x8=__attribute__((ext_vector_type(8)))short;
using s16x4=__attribute__((ext_vector_type(4)))short;
using f32x16=__attribute__((ext_vector_type(16)))float;
using u32x4=__attribute__((ext_vector_type(4)))unsigned;
constexpr int BATCH=4,NHC=16,SEQ=4096,D=64,DVV=128;
constexpr int QP=1024,KP=1024,VP=1024,OP=2048;
constexpr int NW=8,QBLK=32,QB=QBLK*NW,KVBLK=64,NQB=SEQ/QB;
constexpr int ATTN_UNIT_ROWS=QB;
__device__ __forceinline__ int crow(int r,int hi){return (r&3)+8*(r>>2)+4*hi;}
#define SBAR() __builtin_amdgcn_sched_barrier(0)
__device__ __forceinline__ void cmask(f32x16&p0,f32x16&p1,int jb,int qrel,int hi){
  const float NEG=-INFINITY; int kb=64*jb+4*hi;
  #pragma unroll
  for(int r=0;r<16;++r){int kv=kb+(r&3)+8*(r>>2); if(kv>qrel)p0[r]=NEG; if(kv+32>qrel)p1[r]=NEG;}
}

constexpr int NSLOT=3, SLOTB=8192, VSLOTB=2*SLOTB;
constexpr int LDS_K=0, LDS_V=NSLOT*SLOTB, LDS_WS=LDS_V+NSLOT*VSLOTB, LDS_OST=LDS_WS+NW*64*4, LDS_BYTES=LDS_OST+NW*4096;
constexpr float C2=0.125f*1.4426950408889634f;
__device__ __forceinline__ void glds16(const void*gsrc,unsigned lds_dst){unsigned keep;
  asm volatile("s_mov_b32 %0, m0\n\ts_mov_b32 m0, %2\n\ts_nop 0\n\tglobal_load_lds_dwordx4 %1, off\n\ts_mov_b32 m0, %0":"=&s"(keep):"v"(gsrc),"s"(lds_dst):"memory");}
__device__ __forceinline__ float max3f(float a,float b,float c){float r;asm("v_max3_f32 %0, %1, %2, %3":"=v"(r):"v"(a),"v"(b),"v"(c));return r;}
__device__ __forceinline__ float max2f(float a,float b){float r;asm("v_max_f32_e32 %0, %1, %2":"=v"(r):"v"(a),"v"(b));return r;}
__device__ __forceinline__ float fadd_s(float a,float b){float r;asm("v_add_f32_e32 %0, %1, %2":"=v"(r):"v"(a),"v"(b));return r;}
__device__ __forceinline__ float fsub_s(float a,float b){float r;asm("v_sub_f32_e32 %0, %1, %2":"=v"(r):"v"(a),"v"(b));return r;}
typedef float f32x2_t __attribute__((ext_vector_type(2))); typedef __bf16 bf16x2_t __attribute__((ext_vector_type(2)));
__device__ __forceinline__ unsigned cvtpk_s(float lo,float hi){f32x2_t v={lo,hi};bf16x2_t b=__builtin_convertvector(v,bf16x2_t);return __builtin_bit_cast(unsigned,b);}
#define WAIT_BAR(N) asm volatile("s_waitcnt vmcnt(" #N ") lgkmcnt(0)\n\ts_barrier":::"memory")

__device__ __forceinline__ void qkt(f32x16&p0,f32x16&p1,const char*Kslot,const bf16x8*qr,const f32x16&negm,int r32,int hi){
  const char*kb=Kslot+hi*1024+r32*16;
  #pragma unroll
  for(int d0=0;d0<4;++d0){
    const bf16x8 b0=*reinterpret_cast<const bf16x8*>(kb+d0*2048);
    const bf16x8 b1=*reinterpret_cast<const bf16x8*>(kb+d0*2048+512);
    if(d0==0){p0=__builtin_amdgcn_mfma_f32_32x32x16_bf16(b0,qr[0],negm,0,0,0);p1=__builtin_amdgcn_mfma_f32_32x32x16_bf16(b1,qr[0],negm,0,0,0);}
    else{p0=__builtin_amdgcn_mfma_f32_32x32x16_bf16(b0,qr[d0],p0,0,0,0);p1=__builtin_amdgcn_mfma_f32_32x32x16_bf16(b1,qr[d0],p1,0,0,0);}}
}
typedef __attribute__((address_space(3))) const char* lds_cptr;
typedef short v4i16_t __attribute__((ext_vector_type(4)));
__device__ __forceinline__ void kload8(bf16x8*kf,lds_cptr kp){
  kf[0]=*(const __attribute__((address_space(3))) bf16x8*)(kp);      kf[1]=*(const __attribute__((address_space(3))) bf16x8*)(kp+512);
  kf[2]=*(const __attribute__((address_space(3))) bf16x8*)(kp+2048); kf[3]=*(const __attribute__((address_space(3))) bf16x8*)(kp+2560);
  kf[4]=*(const __attribute__((address_space(3))) bf16x8*)(kp+4096); kf[5]=*(const __attribute__((address_space(3))) bf16x8*)(kp+4608);
  kf[6]=*(const __attribute__((address_space(3))) bf16x8*)(kp+6144); kf[7]=*(const __attribute__((address_space(3))) bf16x8*)(kp+6656);
}
__device__ __forceinline__ void kload2(bf16x8*kf,lds_cptr kp,int j){ kf[2*j]=*(const __attribute__((address_space(3))) bf16x8*)(kp+j*2048); kf[2*j+1]=*(const __attribute__((address_space(3))) bf16x8*)(kp+j*2048+512); }
__device__ __forceinline__ s16x4 vtr(lds_cptr p){ return __builtin_bit_cast(s16x4,__builtin_amdgcn_ds_read_tr16_b64_v4i16((__attribute__((address_space(3))) v4i16_t*)p)); }
__device__ __forceinline__ float rowmax(const f32x16&p0,const f32x16&p1){
  float a=max3f(p0[0],p0[1],p1[0]),b=max3f(p0[2],p0[3],p1[1]);a=max3f(a,p1[2],p1[3]);
  #pragma unroll
  for(int r=4;r<16;r+=4){a=max3f(a,p0[r],p0[r+1]);b=max3f(b,p0[r+2],p0[r+3]);a=max3f(a,p1[r],p1[r+1]);b=max3f(b,p1[r+2],p1[r+3]);}
  const float m=max2f(a,b);
  auto rr=__builtin_amdgcn_permlane32_swap(__float_as_uint(m),__float_as_uint(m),false,false);
  return max2f(__uint_as_float(rr[0]),__uint_as_float(rr[1]));
}
__device__ __forceinline__ void pv(f32x16*o,int vb,bf16x8 pa0,bf16x8 pa1,bf16x8 pa2,bf16x8 pa3){
  #pragma unroll
  for(int d0=0;d0<4;++d0){s16x4 lo[4],hi[4];
    #pragma unroll
    for(int ks=0;ks<4;++ks){
      asm volatile("ds_read_b64_tr_b16 %0,%1 offset:%c2":"=&v"(lo[ks]):"v"(vb),"i"(d0*4096+ks*1024):"memory");
      asm volatile("ds_read_b64_tr_b16 %0,%1 offset:%c2":"=&v"(hi[ks]):"v"(vb),"i"(d0*4096+ks*1024+512):"memory");}
    asm volatile("s_waitcnt lgkmcnt(0)":::"memory");SBAR();
    #define PK(k) (bf16x8){lo[k][0],lo[k][1],lo[k][2],lo[k][3],hi[k][0],hi[k][1],hi[k][2],hi[k][3]}
    o[d0]=__builtin_amdgcn_mfma_f32_32x32x16_bf16(pa0,PK(0),o[d0],0,0,0);
    o[d0]=__builtin_amdgcn_mfma_f32_32x32x16_bf16(pa1,PK(1),o[d0],0,0,0);
    o[d0]=__builtin_amdgcn_mfma_f32_32x32x16_bf16(pa2,PK(2),o[d0],0,0,0);
    o[d0]=__builtin_amdgcn_mfma_f32_32x32x16_bf16(pa3,PK(3),o[d0],0,0,0);
    #undef PK
  }
}

#ifndef ATTN_STORE16
#define ATTN_STORE16(p,v) (*(u32x4*)(p)=(v))
#endif
template<int THRL> __device__ __forceinline__ void attn_unit(int b,int hc,int qb,const bf16*Q,const bf16*__restrict__ K,const bf16*__restrict__ V,bf16*O,char*shm){
  const int qkcol=hc*D, vcol=(hc>>1)*DVV, ocol=hc*DVV;
  const int tid=threadIdx.x,lane=tid&63,r32=lane&31,hi=lane>>5; const int wid=__builtin_amdgcn_readfirstlane(tid>>6);
  const long rowbase=(long)b*SEQ; const int q0=qb*QB;
  const bf16*Qw=Q+(rowbase+q0+wid*QBLK)*QP+qkcol;
  const bf16*Kh=K+rowbase*KP+qkcol,*Vh=V+rowbase*VP+vcol;
  const unsigned lds0=(unsigned)(uintptr_t)shm;
  float*wsf=(float*)(shm+LDS_WS)+wid*64;
  const bf16*ksrc=Kh+(long)lane*KP+wid*8;
  const bf16*vsrc=Vh+(long)(16*(wid&3)+(lane>>2))*VP+(wid>>2)*32+(lane&3)*8;
  const unsigned kdst=lds0+LDS_K+wid*1024, vdst=lds0+LDS_V+wid*1024;
  #define DMA_K(t,slot) glds16(ksrc+(long)(t)*KVBLK*KP,(unsigned)__builtin_amdgcn_readfirstlane(kdst+(slot)))
  #define DMA_V(t,slot) do{ glds16(vsrc+(long)(t)*KVBLK*VP,(unsigned)__builtin_amdgcn_readfirstlane(vdst+2*(slot))); glds16(vsrc+64+(long)(t)*KVBLK*VP,(unsigned)__builtin_amdgcn_readfirstlane(vdst+2*(slot)+8192)); }while(0)
  const int vb0=(int)(lds0+LDS_V)+((lane>>4)&1)*32+(lane&3)*8+(4*hi+((lane&15)>>2))*64;
  const char*Kbase=shm+LDS_K; bf16x8 kf[8];
  const lds_cptr shm3=(lds_cptr)shm; const lds_cptr kp0=shm3+LDS_K+hi*1024+r32*16; const lds_cptr vp0=shm3+LDS_V+((lane>>4)&1)*32+(lane&3)*8+(4*hi+((lane&15)>>2))*64;
  const int NT=(q0+QB)/KVBLK;
  DMA_K(0,0);DMA_V(0,0);DMA_K(1,SLOTB);
  bf16x8 qr[4];
  #pragma unroll
  for(int d0=0;d0<4;++d0)qr[d0]=*reinterpret_cast<const bf16x8*>(&Qw[(long)r32*QP+d0*16+hi*8]);
  float mhat=0.f,l_reg=0.f;f32x16 o[4];o[0]=f32x16{};o[1]=f32x16{};o[2]=f32x16{};o[3]=f32x16{};
  const int qrel=wid*QBLK+r32;
  #define CMASK(P0,P1,t) do{int jb_=(t)-(NT-4); if(jb_>=0)cmask(P0,P1,jb_,qrel,hi);}while(0)
  bool resc=false;
  #define START(P0,P1) do{ const float rm=rowmax(P0,P1); resc=false; \
    { const float dl=rm; mhat=fadd_s(mhat,dl); \
      _Pragma("unroll") for(int r=0;r<16;++r){P0[r]=fsub_s(P0[r],dl);P1[r]=fsub_s(P1[r],dl);} } \
    _Pragma("unroll") for(int r=0;r<16;++r)P0[r]=__builtin_amdgcn_exp2f(P0[r]); }while(0)
  #define RESC() do{ if(resc){ asm volatile("s_waitcnt lgkmcnt(0)":::"memory"); \
      _Pragma("unroll") for(int d_=0;d_<4;++d_) _Pragma("unroll") for(int r=0;r<16;++r)o[d_][r]*=wsf[crow(r,hi)]; } }while(0)
  f32x16 pA0,pA1,pB0,pB1;
  int sl_prev=0,sl_cur=0,sl_next=SLOTB;
  #define ROT() do{sl_prev=sl_cur;sl_cur=sl_next;sl_next=(sl_next==(NSLOT-1)*SLOTB)?0:sl_next+SLOTB;}while(0)
  DMA_K(2,2*SLOTB);
  WAIT_BAR(4);
  { const f32x16 z0=f32x16{}; qkt(pA0,pA1,Kbase,qr,z0,r32,hi); }asm volatile("s_nop 15\n\ts_nop 7":"+v"(pA0),"+v"(pA1));CMASK(pA0,pA1,0);
  START(pA0,pA1);
  _Pragma("unroll") for(int r=0;r<16;++r)pA1[r]=__builtin_amdgcn_exp2f(pA1[r]);
  WAIT_BAR(0);
  DMA_K(3,0);DMA_V(1,SLOTB);
  ROT();
  kload8(kf,kp0+sl_cur);
  WAIT_BAR(3);
  s16x4 vlo[4],vhi[4]; u32x4 pw0,pw1,pw2,pw3;
  #define PKW(P,B) cvtpk_s(P[B],P[B+1])
  #define PAF(k) __builtin_bit_cast(bf16x8,pw##k)
  #define VFR(i) (bf16x8){vlo[i][0],vlo[i][1],vlo[i][2],vlo[i][3],vhi[i][0],vhi[i][1],vhi[i][2],vhi[i][3]}
  #define PIN(x) asm volatile("":"+v"(x))
  #define MX3(a,b,c) __builtin_fmaxf(__builtin_fmaxf((a),(b)),(c))
  #define GAPA(MF,A0,A1,A2,A3,W0,W1,PW) do{ MF; sacc+=A0; sacc+=A1; sacc+=A2; sacc+=A3; PIN(sacc); W0; W1; PIN(PW); SBAR(); }while(0)
  #define EX(v) __builtin_amdgcn_exp2f(v)
  #define GAPB(MF,X,B) do{ MF; X[B]=EX(X[B]-mhat); X[B+1]=EX(X[B+1]-mhat); PIN(X); SBAR(); }while(0)
  #define VRD(p,i) do{ vlo[p]=vtr(vp_+(((i)>>2)*4096+((i)&3)*1024)); vhi[p]=vtr(vp_+(((i)>>2)*4096+((i)&3)*1024+512)); }while(0)
  #define KRD(G,j) do{ if(G){ kload2(kf,kp0+sl_next,j); SBAR(); } }while(0)
  #define ZC (f32x16{})
  #define STEP(C0,C1,P0,P1,t,GK,GV,GL) do{ SBAR(); \
    const lds_cptr vp_=vp0+2*sl_prev; \
    float sacc=(P0[0]+P0[1]); \
    GAPA(C0=__builtin_amdgcn_mfma_f32_32x32x16_bf16(kf[0],qr[0],ZC,0,0,0), P0[2],P0[3],P0[4],P0[5],     pw0[0]=PKW(P0,0), pw0[1]=PKW(P0,2), pw0); \
    GAPA(C1=__builtin_amdgcn_mfma_f32_32x32x16_bf16(kf[1],qr[0],ZC,0,0,0), P0[6],P0[7],P0[8],P0[9],     pw0[2]=PKW(P0,4), pw0[3]=PKW(P0,6), pw0); \
    GAPA(C0=__builtin_amdgcn_mfma_f32_32x32x16_bf16(kf[2],qr[1],C0,0,0,0),   P0[10],P0[11],P0[12],P0[13], pw1[0]=PKW(P0,8), pw1[1]=PKW(P0,10), pw1); \
    GAPA(C1=__builtin_amdgcn_mfma_f32_32x32x16_bf16(kf[3],qr[1],C1,0,0,0),   P0[14],P0[15],P1[0],P1[1],   pw1[2]=PKW(P0,12),pw1[3]=PKW(P0,14), pw1); \
    GAPA(C0=__builtin_amdgcn_mfma_f32_32x32x16_bf16(kf[4],qr[2],C0,0,0,0),   P1[2],P1[3],P1[4],P1[5],     pw2[0]=PKW(P1,0), pw2[1]=PKW(P1,2), pw2); \
    VRD(0,0); SBAR(); GAPA(C1=__builtin_amdgcn_mfma_f32_32x32x16_bf16(kf[5],qr[2],C1,0,0,0),   P1[6],P1[7],P1[8],P1[9],     pw2[2]=PKW(P1,4), pw2[3]=PKW(P1,6), pw2); \
    VRD(1,4); SBAR(); GAPA(C0=__builtin_amdgcn_mfma_f32_32x32x16_bf16(kf[6],qr[3],C0,0,0,0),   P1[10],P1[11],P1[12],P1[13], pw3[0]=PKW(P1,8), pw3[1]=PKW(P1,10), pw3); \
    VRD(2,1); SBAR(); GAPA(C1=__builtin_amdgcn_mfma_f32_32x32x16_bf16(kf[7],qr[3],C1,0,0,0),   P1[14],P1[15],0.f,0.f,       pw3[2]=PKW(P1,12),pw3[3]=PKW(P1,14), pw3); \
    l_reg+=sacc; \
    if(GK){DMA_K((t)+3,sl_cur);} if(GV){DMA_V((t)+1,sl_next);} \
    CMASK(C0,C1,t); \
    { float a=MX3(C0[0],C0[1],C1[0]),b=MX3(C0[2],C0[3],C1[1]); a=MX3(a,C1[2],C1[3]); \
      _Pragma("unroll") for(int r=4;r<16;r+=4){a=MX3(a,C0[r],C0[r+1]);b=MX3(b,C0[r+2],C0[r+3]);a=MX3(a,C1[r],C1[r+1]);b=MX3(b,C1[r+2],C1[r+3]);} \
      float rm=__builtin_fmaxf(a,b); { auto rr=__builtin_amdgcn_permlane32_swap(__float_as_uint(rm),__float_as_uint(rm),false,false); rm=__builtin_fmaxf(__uint_as_float(rr[0]),__uint_as_float(rr[1])); } \
      rm-=mhat; resc=false; \
      if(__builtin_expect(__any(rm>(float)THRL),0)){ const float dl=__builtin_fmaxf(rm,0.f); mhat+=dl; \
        const float f=__builtin_amdgcn_exp2f(-dl); l_reg*=f; if(hi==0)wsf[r32]=f; resc=true; } } \
    SBAR(); \
    VRD(3,5);  SBAR(); GAPB(o[0]=__builtin_amdgcn_mfma_f32_32x32x16_bf16(PAF(0),VFR(0),o[0],0,0,0), C0,0); \
    VRD(0,2);  SBAR(); GAPB(o[1]=__builtin_amdgcn_mfma_f32_32x32x16_bf16(PAF(0),VFR(1),o[1],0,0,0), C0,2); \
    VRD(1,6);  SBAR(); KRD(GL,0); GAPB(o[0]=__builtin_amdgcn_mfma_f32_32x32x16_bf16(PAF(1),VFR(2),o[0],0,0,0), C0,4); \
    VRD(2,3);  SBAR(); KRD(GL,1); GAPB(o[1]=__builtin_amdgcn_mfma_f32_32x32x16_bf16(PAF(1),VFR(3),o[1],0,0,0), C0,6); \
    VRD(3,7);  SBAR(); KRD(GL,2); GAPB(o[0]=__builtin_amdgcn_mfma_f32_32x32x16_bf16(PAF(2),VFR(0),o[0],0,0,0), C0,8); \
    VRD(0,8);  SBAR(); KRD(GL,3); GAPB(o[1]=__builtin_amdgcn_mfma_f32_32x32x16_bf16(PAF(2),VFR(1),o[1],0,0,0), C0,10); \
    VRD(1,12); SBAR(); GAPB(o[0]=__builtin_amdgcn_mfma_f32_32x32x16_bf16(PAF(3),VFR(2),o[0],0,0,0), C0,12); \
    VRD(2,9);  SBAR(); GAPB(o[1]=__builtin_amdgcn_mfma_f32_32x32x16_bf16(PAF(3),VFR(3),o[1],0,0,0), C0,14); \
    VRD(3,13); SBAR(); GAPB(o[2]=__builtin_amdgcn_mfma_f32_32x32x16_bf16(PAF(0),VFR(0),o[2],0,0,0), C1,0); \
    VRD(0,10); SBAR(); GAPB(o[3]=__builtin_amdgcn_mfma_f32_32x32x16_bf16(PAF(0),VFR(1),o[3],0,0,0), C1,2); \
    VRD(1,14); SBAR(); GAPB(o[2]=__builtin_amdgcn_mfma_f32_32x32x16_bf16(PAF(1),VFR(2),o[2],0,0,0), C1,4); \
    VRD(2,11); SBAR(); GAPB(o[3]=__builtin_amdgcn_mfma_f32_32x32x16_bf16(PAF(1),VFR(3),o[3],0,0,0), C1,6); \
    VRD(3,15); SBAR(); GAPB(o[2]=__builtin_amdgcn_mfma_f32_32x32x16_bf16(PAF(2),VFR(0),o[2],0,0,0), C1,8); \
    GAPB(o[3]=__builtin_amdgcn_mfma_f32_32x32x16_bf16(PAF(2),VFR(1),o[3],0,0,0), C1,10); \
    GAPB(o[2]=__builtin_amdgcn_mfma_f32_32x32x16_bf16(PAF(3),VFR(2),o[2],0,0,0), C1,12); \
    GAPB(o[3]=__builtin_amdgcn_mfma_f32_32x32x16_bf16(PAF(3),VFR(3),o[3],0,0,0), C1,14); \
    }while(0)
  int t=1;
  #undef CMASK
  #define CMASK(P0,P1,t) do{}while(0)
  for(;t+5<NT;t+=2){
    STEP(pB0,pB1,pA0,pA1,t,true,true,true);     WAIT_BAR(3); RESC(); ROT();
    STEP(pA0,pA1,pB0,pB1,t+1,true,true,true);   WAIT_BAR(3); RESC(); ROT();
  }
  #undef CMASK
  #define CMASK(P0,P1,t) do{int jb_=(t)-(NT-4); if(jb_>=0)cmask(P0,P1,jb_,qrel,hi);}while(0)
  #define ENDW(tt) do{ if((tt)+3<NT){WAIT_BAR(3);} else if((tt)+2<NT){WAIT_BAR(2);} else {WAIT_BAR(0);} }while(0)
  for(;t+1<NT;t+=2){
    STEP(pB0,pB1,pA0,pA1,t,(t+3<NT),(t+1<NT),(t+1<NT));       ENDW(t);   RESC(); ROT();
    STEP(pA0,pA1,pB0,pB1,t+1,(t+4<NT),(t+2<NT),(t+2<NT));     ENDW(t+1); RESC(); ROT();
  }
  STEP(pB0,pB1,pA0,pA1,NT-1,false,false,false); RESC();
  { float sacc=pB0[0]+pB0[1]; _Pragma("unroll") for(int r=2;r<16;++r)sacc+=pB0[r]; _Pragma("unroll") for(int r=0;r<16;++r)sacc+=pB1[r]; l_reg+=sacc;
    pw0=(u32x4){PKW(pB0,0),PKW(pB0,2),PKW(pB0,4),PKW(pB0,6)};pw1=(u32x4){PKW(pB0,8),PKW(pB0,10),PKW(pB0,12),PKW(pB0,14)};pw2=(u32x4){PKW(pB1,0),PKW(pB1,2),PKW(pB1,4),PKW(pB1,6)};pw3=(u32x4){PKW(pB1,8),PKW(pB1,10),PKW(pB1,12),PKW(pB1,14)};
    SBAR(); pv(o,vb0+2*sl_cur,PAF(0),PAF(1),PAF(2),PAF(3)); }
  #undef PKW
  #undef PAF
  #undef VFR
  #undef PIN
  #undef MX3
  #undef GAPA
  #undef GAPB
  #undef EX
  #undef VRD
  #undef KRD
  #undef STEP
  #undef ZC
  #undef ENDW
  {auto rr=__builtin_amdgcn_permlane32_swap(__float_as_uint(l_reg),__float_as_uint(l_reg),false,false);l_reg=__uint_as_float(rr[0])+__uint_as_float(rr[1]);}
  if(hi==0)wsf[32+r32]=l_reg;asm volatile("s_waitcnt lgkmcnt(0)":::"memory");
  float rli[16];
  #pragma unroll
  for(int r=0;r<16;++r)rli[r]=__builtin_amdgcn_rcpf(wsf[32+crow(r,hi)]);
  bf16*Ow=O+(rowbase+q0+wid*QBLK)*OP+ocol;
  { bf16*stg=(bf16*)(shm+LDS_OST)+wid*2048;
    #pragma unroll
    for(int h2=0;h2<2;++h2){
    #pragma unroll
    for(int r=0;r<16;++r){const int orow=crow(r,hi);
      #pragma unroll
      for(int d0=0;d0<2;++d0)stg[orow*64+d0*32+r32]=__float2bfloat16(o[2*h2+d0][r]*rli[r]);}
    asm volatile("s_waitcnt lgkmcnt(0)":::"memory");
    #pragma unroll
    for(int i=0;i<4;++i){const int row=i*8+(lane>>3),ch=lane&7; const u32x4 v=*(const u32x4*)(stg+row*64+ch*8); ATTN_STORE16(Ow+(long)row*OP+h2*64+ch*8,v);}
    asm volatile("s_waitcnt lgkmcnt(0)":::"memory"); } }
  asm volatile("s_waitcnt lgkmcnt(0)\n\ts_barrier":::"memory");
  #undef DMA_K
  #undef DMA_V
  #undef CMASK
  #undef START
  #undef RESC
  #undef ROT
}
constexpr int ATTN_LDS_BYTES=LDS_BYTES;
struct AttnTensors { const bf16* Q; const bf16* K; const bf16* V; bf16* O; };
struct AttnUnit { int bh; int qb; };
struct StaticOrder {
  int vcu;
  __device__ __forceinline__ explicit StaticOrder(int grid,int block):vcu((block%8)*(grid/8)+block/8){}
  __device__ __forceinline__ bool next(int i,AttnUnit&u)const{ if(i>=4)return false; const int p=vcu&7; u.bh=(vcu>>3)*2+(i>>1); u.qb=(i&1)?15-p:p; return true; }
  __device__ __forceinline__ void a_ready(const AttnUnit&)const{}
  __device__ __forceinline__ void done(const AttnUnit&)const{}
};
template<class Sched,int THRL=8> __device__ __forceinline__ void attn_phase(char*lds,const AttnTensors&T,const Sched&S){
  AttnUnit u;
  for(int i=0;S.next(i,u);++i){ S.a_ready(u); attn_unit<THRL>(u.bh/NHC,u.bh%NHC,u.qb,T.Q,T.K,T.V,T.O,lds); S.done(u); }
}
#undef SBAR
#undef WAIT_BAR
}

#define GAS __attribute__((address_space(1)))
#define LAS __attribute__((address_space(3)))
typedef unsigned v4u __attribute__((ext_vector_type(4)));
typedef GAS unsigned gu32;
typedef GAS unsigned long long gu64;
#define RLX_AGENT __ATOMIC_RELAXED, __HIP_MEMORY_SCOPE_AGENT
#define LDS_WAIT() asm volatile("s_waitcnt lgkmcnt(0)" ::: "memory")
#define VM_WAIT() asm volatile("s_waitcnt vmcnt(0)" ::: "memory")
__device__ __forceinline__ unsigned pk2(float lo, float hi) { return f2bf(lo) | (f2bf(hi) << 16); }

#define XB_TMO      128
#define XB_XCNT(j)  (256  + 64 * (j))
#define XB_XSUB(j)  (1280 + 64 * (j))
#define XB_XGEN(j)  (2304 + 64 * (j))
#define XB_TOP      3328
#define XB_TOPGEN   3392
#define XCD_BAR_WORDS 3456
#define XB_SPIN_CAP (1u << 18)

__device__ __forceinline__ unsigned xb_ld(unsigned* p)              { return __hip_atomic_load(p, __ATOMIC_RELAXED, __HIP_MEMORY_SCOPE_AGENT); }
__device__ __forceinline__ unsigned xb_add(unsigned* p, unsigned v) { return __hip_atomic_fetch_add(p, v, __ATOMIC_RELAXED, __HIP_MEMORY_SCOPE_AGENT); }
__device__ __forceinline__ unsigned xb_xcc_id() { return (unsigned)__builtin_amdgcn_s_getreg((3 << 11) | 20) & 0xFu; }
#define XB_SPIN(cond, bar) do { unsigned _sp = 0; while (cond) { __builtin_amdgcn_s_sleep(1); \
    if ((++_sp & 255u) == 0u) { if (xb_ld(&(bar)[XB_TMO])) break; if (_sp > XB_SPIN_CAP) { atomicAdd(&(bar)[XB_TMO], 1u); break; } } } } while (0)

struct XcdBarrier {
    unsigned* bar; unsigned x;
    volatile LAS unsigned* st;
};

__device__ __forceinline__ XcdBarrier xcd_barrier_post(unsigned* bar, volatile LAS unsigned* st) {
    XcdBarrier b; b.bar = bar; b.x = xb_xcc_id(); b.st = st;
    if (threadIdx.x == 0) (void)xb_add(&bar[XB_XCNT(b.x)], 1u);
    return b;
}
__device__ __forceinline__ void xcd_barrier_complete(unsigned* bar, unsigned x, unsigned& nloc, unsigned& nx) {
    const unsigned G = gridDim.x * gridDim.y * gridDim.z;
    unsigned sum, cnt, mine, sp = 0u;
    for (;;) {
        sum = 0u; cnt = 0u; mine = 0u;
#pragma unroll
        for (unsigned j = 0; j < 16; ++j) { const unsigned c = xb_ld(&bar[XB_XCNT(j)]); sum += c; cnt += (c > 0u) ? 1u : 0u; mine = (j == x) ? c : mine; }
        if (sum == G) break;
        __builtin_amdgcn_s_sleep(1);
        if ((++sp & 255u) == 0u) { if (xb_ld(&bar[XB_TMO])) break; if (sp > XB_SPIN_CAP) { atomicAdd(&bar[XB_TMO], 1u); break; } }
    }
    nloc = mine > 0u ? mine : 1u; nx = cnt > 0u ? cnt : 1u;
}

__device__ __forceinline__ void xcd_barrier(const XcdBarrier& b) {
    asm volatile("s_waitcnt vmcnt(0)" ::: "memory");
    __syncthreads();
    if (threadIdx.x == 0) {
        unsigned* bar = b.bar;
        __builtin_amdgcn_s_waitcnt(0);
        unsigned nloc = b.st[0], nx = b.st[1];
        if (nloc == 0u) { xcd_barrier_complete(bar, b.x, nloc, nx); b.st[0] = nloc; b.st[1] = nx; }
        const unsigned old = xb_add(&bar[XB_XSUB(b.x)], 1u);
        const unsigned gen = old / nloc;
        if (old + 1u == (gen + 1u) * nloc) {
            __builtin_amdgcn_fence(__ATOMIC_RELEASE, "agent");
            asm volatile("s_waitcnt vmcnt(0)" ::: "memory");
            const unsigned og = xb_add(&bar[XB_TOP], 1u);
            const unsigned tg = og / nx;
            if (og + 1u == (tg + 1u) * nx) xb_add(&bar[XB_TOPGEN], 1u);
            else XB_SPIN(xb_ld(&bar[XB_TOPGEN]) == tg, bar);
            __builtin_amdgcn_fence(__ATOMIC_ACQUIRE, "agent");
            xb_add(&bar[XB_XGEN(b.x)], 1u);
            asm volatile("s_waitcnt vmcnt(0)" ::: "memory");
        } else {
            XB_SPIN(xb_ld(&bar[XB_XGEN(b.x)]) == gen, bar);
            __builtin_amdgcn_fence(__ATOMIC_ACQUIRE, "agent");
            asm volatile("s_waitcnt vmcnt(0)" ::: "memory");
        }
    }
    __syncthreads();
}

constexpr int NWAVES = 8;
constexpr int RING_OFF = 0, RING_BYTES = 131072;
constexpr int LDSCTL_OFF = RING_BYTES, MISC_OFF = LDSCTL_OFF + 320;
constexpr int LDS_BYTES = 147456;

constexpr int CW_XCC = 8192;
constexpr int CW_PANEL = 8448;
__device__ __forceinline__ void panel_sync(gu32* ctl, unsigned* tmo, int seam, int pm, bool same_xcc) {
    asm volatile("s_waitcnt vmcnt(0)" ::: "memory");
    __syncthreads();
    if (threadIdx.x == 0) {
        gu32* c = ctl + CW_PANEL + (seam * 64 + pm) * 16;
        if (!same_xcc) { __builtin_amdgcn_fence(__ATOMIC_RELEASE, "agent"); asm volatile("s_waitcnt vmcnt(0)" ::: "memory"); }
        __hip_atomic_fetch_add(c, 1u, __ATOMIC_RELAXED, __HIP_MEMORY_SCOPE_AGENT);
        unsigned sp = 0;
        while (__hip_atomic_load(c, __ATOMIC_RELAXED, __HIP_MEMORY_SCOPE_AGENT) < 4u) { __builtin_amdgcn_s_sleep(1);
            if ((++sp & 255u) == 0u) { if (xb_ld(tmo)) break; if (sp > XB_SPIN_CAP) { atomicAdd(tmo, 1u); break; } } }
        __builtin_amdgcn_fence(__ATOMIC_ACQUIRE, "agent");
        asm volatile("s_waitcnt vmcnt(0)" ::: "memory");
    }
    __syncthreads();
}
constexpr int CW_BAR = 4096;

struct Frame {
    LAS unsigned char* lds;
    volatile LAS unsigned* MISC;
    gu32* ctl;
    int tid, lane, wave, vcu, G;
    const float* in[19]; float* out; unsigned char* ws;
};
struct WDesc { const float* W; const float* gain; bf16* WT; int ldn, c0, K, ncols, roff, mode; };
__device__ __forceinline__ WDesc wdesc(const Frame& F, int i) {
    unsigned char* ws = F.ws; WDesc d;
    switch (i) {
    case 0:  d = WDesc{F.in[2], F.in[1], (bf16*)(ws + WS_WIN), GIN, 0, D, 3072, 0, 0}; break;
    case 1:  d = WDesc{F.in[6], nullptr, (bf16*)(ws + WS_WAO), D, 0, D, D, 0, 0}; break;
    case 2:  d = WDesc{F.in[17], F.in[16], (bf16*)(ws + WS_W1A), FF, 0, D, FF, 0, 0}; break;
    case 3:  d = WDesc{F.in[18], nullptr, (bf16*)(ws + WS_W2A), D, 0, FF, D, 0, 0}; break;
    case 4:  d = WDesc{F.in[8], F.in[7], (bf16*)(ws + WS_WKVQ), 2048, 0, D, 2048, 0, 1}; break;
    case 5:  d = WDesc{F.in[11], F.in[10], (bf16*)(ws + WS_WKVQ), D, 0, D, D, 2048, 1}; break;
    case 6:  d = WDesc{F.in[15], nullptr, (bf16*)(ws + WS_WBO), D, 0, D, D, 0, 0}; break;
    case 7:  d = WDesc{F.in[17] + (size_t)D * FF, F.in[16] + D, (bf16*)(ws + WS_W1B), FF, 0, D, FF, 0, 0}; break;
    default: d = WDesc{F.in[18] + (size_t)D * FF, nullptr, (bf16*)(ws + WS_W2B), D, 0, FF, D, 0, 0}; break;
    }
    return d;
}
__device__ __forceinline__ void p0_transpose_item(const WDesc& d, LAS float* scr, int item, int lane) {
    const int nblk = d.ncols / 64, kb = item / nblk, nb = item % nblk, k0 = 64 * kb, n0 = 64 * nb;
    const int kq = lane >> 4, n4 = (lane & 15) * 4;
    f32x4 v[16];
#pragma unroll
    for (int i = 0; i < 16; ++i) v[i] = __builtin_nontemporal_load((const GAS f32x4*)(d.W + (size_t)(k0 + 4 * i + kq) * d.ldn + d.c0 + n0 + n4));
    const int c = lane & 7;
    f32x4 g0 = (f32x4){1.f, 1.f, 1.f, 1.f}, g1 = g0;
    if (d.gain) { g0 = *(const GAS f32x4*)(d.gain + k0 + 8 * c); g1 = *(const GAS f32x4*)(d.gain + k0 + 8 * c + 4); }
#pragma unroll
    for (int i = 0; i < 16; ++i) { const int kk = 4 * i + kq; *(LAS f32x4*)(scr + kk * 64 + (n4 ^ (kk & 0x38))) = v[i]; }
    LDS_WAIT(); asm volatile("" ::: "memory");
#pragma unroll
    for (int jj = 0; jj < 8; ++jj) { const int n = (lane >> 3) + 8 * jj; const LAS float* sp = scr + (8 * c) * 64 + (n ^ (c << 3));
        const int dr = d.mode ? kvq_dest_row(d.roff + n0 + n) : d.roff + n0 + n;
        v4u o; o.x = pk2(sp[0 * 64] * g0[0], sp[1 * 64] * g0[1]); o.y = pk2(sp[2 * 64] * g0[2], sp[3 * 64] * g0[3]); o.z = pk2(sp[4 * 64] * g1[0], sp[5 * 64] * g1[1]); o.w = pk2(sp[6 * 64] * g1[2], sp[7 * 64] * g1[3]);
        pg8::store16_wt((void*)(d.WT + (size_t)dr * d.K + k0 + 8 * c), o); }
    LDS_WAIT(); asm volatile("" ::: "memory");
}
__device__ __forceinline__ float wave_sum(float v) {
#pragma unroll
    for (int o = 1; o < 64; o <<= 1) v += __shfl_xor(v, o);
    return v;
}
template <int NR> __device__ __forceinline__ void rows_to_bf16(const Frame& F, const float* xrow, bf16* orow, float* ssrow) {
    f32x4 v[NR][4];
#pragma unroll
    for (int r = 0; r < NR; ++r)
#pragma unroll
        for (int j = 0; j < 4; ++j) v[r][j] = __builtin_nontemporal_load(((const GAS f32x4*)(xrow + (size_t)r * D) + F.lane) + 64 * j);
#pragma unroll
    for (int r = 0; r < NR; ++r) { float s = 0.f;
#pragma unroll
        for (int j = 0; j < 4; ++j) s += (v[r][j].x * v[r][j].x + v[r][j].y * v[r][j].y) + (v[r][j].z * v[r][j].z + v[r][j].w * v[r][j].w);
        s = wave_sum(s);
        if (F.lane < 16) ssrow[(size_t)r * 16 + F.lane] = (F.lane == 0) ? s : 0.f;
        GAS unsigned long long* o8 = (GAS unsigned long long*)(orow + (size_t)r * D) + F.lane;
#pragma unroll
        for (int j = 0; j < 4; ++j) o8[64 * j] = (unsigned long long)pk2(v[r][j].x, v[r][j].y) | ((unsigned long long)pk2(v[r][j].z, v[r][j].w) << 32); }
}
__device__ __forceinline__ void p0_prologue(Frame& F) {
    LAS float* scr = (LAS float*)(F.lds + RING_OFF + F.wave * 16384);
    const int gw = F.vcu * NWAVES + F.wave, NGW = F.G * NWAVES;
    int base = 0;
    for (int mi = 0; mi < 9; ++mi) {
        const WDesc d = wdesc(F, mi); const int nit = (d.K / 64) * (d.ncols / 64);
        int it = gw - (base % NGW); if (it < 0) it += NGW;
        for (; it < nit; it += NGW) p0_transpose_item(d, scr, it, F.lane);
        base += nit;
    }
    { const float* W = F.in[2]; const float* g = F.in[1]; bf16* Wz = (bf16*)(F.ws + WS_WZ);
      for (int idx = gw * 64 + F.lane; idx < 16 * D; idx += NGW * 64) { const int k = idx >> 4, r = idx & 15; Wz[(size_t)r * D + k] = (bf16)f2bf(W[(size_t)k * GIN + 3072 + r] * g[k]); } }
    bf16* XB = (bf16*)(F.ws + WS_A); float* SS = (float*)(F.ws + WS_SS);
    for (int m = 4 * gw; m < T; m += 4 * NGW) rows_to_bf16<4>(F, F.in[0] + (size_t)m * D, XB + (size_t)m * D, SS + (size_t)m * 16);
}


__device__ __forceinline__ void combine_local(Frame& F) {
    const int lane = F.lane, wave = F.wave;
    const float* lp = F.in[13]; const float* hg = F.in[14];
    const float s1 = wave_sum(lp[lane] * lp[64 + lane]), s2 = wave_sum(lp[128 + lane] * lp[192 + lane]);
    const float lam = __expf(s1) - __expf(s2) + LAMBDA_INIT;
    const int bhh = F.vcu >> 3, p = F.vcu & 7, b = bhh >> 3, h = bhh & 7, sg = lane & 7;
    float g[16];
#pragma unroll
    for (int j = 0; j < 16; ++j) g[j] = hg[16 * sg + j] * (1.f - LAMBDA_INIT);
    const bf16* O32 = (const bf16*)F.out; bf16* OD = (bf16*)(F.ws + WS_C);
    asm volatile("s_waitcnt vmcnt(0)" ::: "memory"); __syncthreads();
    for (int it0 = 0; it0 < 8; it0 += 4) {
        bf16x8 a0[4], a1[4], b0[4], b1[4]; size_t tt[4];
#pragma unroll
        for (int q = 0; q < 4; ++q) { const int r = (it0 + q) * 64 + wave * 8 + (lane >> 3);
            tt[q] = (size_t)b * SEQ + (size_t)((r < 256) ? p : 15 - p) * 256 + (r & 255);
            const bf16* p0 = O32 + tt[q] * 2048 + (2 * h) * 128 + 16 * sg;
            a0[q] = *(const bf16x8*)p0; a1[q] = *(const bf16x8*)(p0 + 8); b0[q] = *(const bf16x8*)(p0 + 128); b1[q] = *(const bf16x8*)(p0 + 136); }
#pragma unroll
        for (int q = 0; q < 4; ++q) {
            float o[16]; float s = 0.f;
#pragma unroll
            for (int j = 0; j < 8; ++j) { o[j] = bf2f((unsigned short)a0[q][j]) - lam * bf2f((unsigned short)b0[q][j]); o[8 + j] = bf2f((unsigned short)a1[q][j]) - lam * bf2f((unsigned short)b1[q][j]); }
#pragma unroll
            for (int j = 0; j < 16; ++j) s += o[j] * o[j];
            s += __shfl_xor(s, 1); s += __shfl_xor(s, 2); s += __shfl_xor(s, 4);
            const float rstd = __builtin_amdgcn_rsqf(s * (1.f / 128.f) + EPS);
            v4u w0, w1;
            w0.x = pk2(o[0] * rstd * g[0], o[1] * rstd * g[1]); w0.y = pk2(o[2] * rstd * g[2], o[3] * rstd * g[3]); w0.z = pk2(o[4] * rstd * g[4], o[5] * rstd * g[5]); w0.w = pk2(o[6] * rstd * g[6], o[7] * rstd * g[7]);
            w1.x = pk2(o[8] * rstd * g[8], o[9] * rstd * g[9]); w1.y = pk2(o[10] * rstd * g[10], o[11] * rstd * g[11]); w1.z = pk2(o[12] * rstd * g[12], o[13] * rstd * g[13]); w1.w = pk2(o[14] * rstd * g[14], o[15] * rstd * g[15]);
            bf16* qd = OD + tt[q] * 1024 + h * 128 + 16 * sg;
            *(v4u*)qd = w0; *(v4u*)(qd + 8) = w1; }
    }
}
constexpr int RT_OFF = 132096;
__device__ __forceinline__ unsigned off_b(unsigned row, unsigned ch) { return 256u * row + 16u * (ch ^ (((row & 3) << 2) | ((row >> 2) & 3))); }
__device__ __forceinline__ unsigned row_addr16(unsigned lane, unsigned rb, unsigned s) { return off_b((lane & 15) + 16 * rb, 4 * s + (lane >> 4)); }
__device__ __forceinline__ unsigned tr_addr16(unsigned lane, unsigned c, unsigned ks, unsigned t) { const unsigned g = lane >> 4, q = (lane & 15) >> 2, p = lane & 3; return off_b(32 * ks + 8 * g + 4 * t + q, 2 * c + (p >> 1)) + 8 * (p & 1); }
typedef short v4i16_t __attribute__((ext_vector_type(4)));
__device__ __forceinline__ bf16x8 tr_frag(LAS unsigned char* img, unsigned lane, unsigned c, unsigned ks) {
    const v4i16_t lo = __builtin_amdgcn_ds_read_tr16_b64_v4i16((LAS v4i16_t*)(img + tr_addr16(lane, c, ks, 0)));
    const v4i16_t hi = __builtin_amdgcn_ds_read_tr16_b64_v4i16((LAS v4i16_t*)(img + tr_addr16(lane, c, ks, 1)));
    return (bf16x8){lo[0], lo[1], lo[2], lo[3], hi[0], hi[1], hi[2], hi[3]};
}
__device__ __forceinline__ bf16x8 row_frag(LAS unsigned char* img, unsigned lane, unsigned rb, unsigned s) { return *(const LAS bf16x8*)(img + row_addr16(lane, rb, s)); }
#define MFMA16(a, b, c) __builtin_amdgcn_mfma_f32_16x16x32_bf16(a, b, c, 0, 0, 0)

constexpr int ZP_OFF = 137216;
__device__ __forceinline__ void gate_phase(Frame& F) {
    LAS float* ZP = (LAS float*)(F.lds + ZP_OFF);
    const bf16* XB = (const bf16*)(F.ws + WS_A); const bf16* Wz = (const bf16*)(F.ws + WS_WZ); const float* wgu = F.in[3]; const float* bg = F.in[4]; unsigned char* SL = F.ws + WS_B;
    const float* SS = (const float*)(F.ws + WS_SS);
    const int lane = F.lane, wave = F.wave, fr = lane & 15, fq = lane >> 4;
    LAS float* ST = (LAS float*)(F.lds + wave * 16384);
    float wb[4][4], bb[4];
#pragma unroll
    for (int nt = 0; nt < 4; ++nt) { bb[nt] = bg[64 * wave + 16 * nt + fr];
#pragma unroll
        for (int kk = 0; kk < 4; ++kk) wb[nt][kk] = wgu[(4 * kk + fq) * 512 + 64 * wave + 16 * nt + fr]; }
    for (int u = F.vcu; u < T / CH; u += F.G) {
        const size_t t0 = (size_t)u * CH;
        { const int mt = wave & 3, kh = wave >> 2; f32x4 acc = (f32x4){0.f, 0.f, 0.f, 0.f};
          const bf16* ap = XB + (t0 + mt * 16 + fr) * D + kh * 512 + 8 * fq; const bf16* bp = Wz + (size_t)fr * D + kh * 512 + 8 * fq;
#pragma unroll
          for (int ks = 0; ks < 16; ++ks) acc = MFMA16(__builtin_nontemporal_load((const bf16x8*)(ap + ks * 32)), *(const bf16x8*)(bp + ks * 32), acc);
#pragma unroll
          for (int j = 0; j < 4; ++j) ZP[(kh * 64 + mt * 16 + 4 * fq + j) * 17 + fr] = acc[j] * pg8::row_rstd(SS, (int)t0 + mt * 16 + 4 * fq + j); }
        __syncthreads();
        float carry[4] = {0.f, 0.f, 0.f, 0.f};
#pragma unroll 1
        for (int mt = 0; mt < 4; ++mt) {
            float za[4];
#pragma unroll
            for (int kk = 0; kk < 4; ++kk) za[kk] = ZP[(mt * 16 + fr) * 17 + 4 * kk + fq] + ZP[(64 + mt * 16 + fr) * 17 + 4 * kk + fq];
#pragma unroll
            for (int nt = 0; nt < 4; ++nt) {
                f32x4 x = (f32x4){bb[nt], bb[nt], bb[nt], bb[nt]};
#pragma unroll
                for (int kk = 0; kk < 4; ++kk) x = __builtin_amdgcn_mfma_f32_16x16x4f32(za[kk], wb[nt][kk], x, 0, 0, 0);
                float p[4]; float run = 0.f;
#pragma unroll
                for (int r = 0; r < 4; ++r) { const float ls = fminf(x[r], 0.f) - __logf(1.f + __expf(-fabsf(x[r]))); run += ls * (1.f / 16.f); p[r] = run; }
                float s1 = run; { const float t = __shfl_up(s1, 16); if (fq >= 1) s1 += t; }
                float s2 = s1;  { const float t = __shfl_up(s2, 32); if (fq >= 2) s2 += t; }
                const float base = carry[nt] + (s2 - run);
                carry[nt] += __shfl(s2, 48 + fr);
#pragma unroll
                for (int r = 0; r < 4; ++r) { const int row = mt * 16 + 4 * fq + r; ST[row * 64 + ((16 * nt + fr) ^ (((row >> 2) & 3) << 4))] = base + p[r]; }
            }
        }
        LDS_WAIT(); asm volatile("" ::: "memory");
#pragma unroll
        for (int i = 0; i < 16; ++i) { const int row = 4 * i + fq; const f32x4 v = *(const LAS f32x4*)(ST + row * 64 + ((4 * fr) ^ (((row >> 2) & 3) << 4)));
            *(f32x4*)((float*)(SL + (size_t)(u >> 2) * PSLOT + PBC) + ((u & 3) * 64 + row) * 512 + 64 * wave + 4 * fr) = v; }
        __syncthreads();
    }
}

struct GlaSet { unsigned k0, k1, k2, k3; f32x4 bca, bcb, bla, blb; v4u va, vb; float dca, dcb; };
__device__ __forceinline__ void gla_state_phase(Frame& F) {
    LAS unsigned char* lds = F.lds;
    bf16* SP = (bf16*)F.out;
    const int tid = F.tid, lane = F.lane, wave = F.wave;
    const int pos = tid >> 3, sub = tid & 7, mt = wave >> 1, nt = wave & 1;
    constexpr int NP = NCH / 2;
    for (int u = F.vcu; u < 256; u += F.G) {
        const int bh = u >> 4, ki = (u >> 2) & 3, vi = u & 3, b = bh >> 2, h = bh & 3;
        const unsigned char* SL = F.ws + WS_B + (size_t)(16 * b) * PSLOT;
        const int koff = pos * 512 + h * GDK + ki * 32 + sub * 4, loff = 63 * 512 + h * GDK + ki * 32 + sub * 4;
        const int voff = pos * 1024 + h * GDV + vi * 64 + sub * 8, doff = 63 * 512 + h * GDK + ki * 32 + nt * 16 + (lane & 15);
        bf16* spp = SP + ((size_t)(bh * NP) * GDV + vi * 64 + mt * 16 + 4 * (lane >> 4)) * GDK + ki * 32 + nt * 16 + (lane & 15);
        const unsigned kw = off_b(pos, sub >> 1) + 8 * (sub & 1), vw = off_b(pos, sub);
        f32x4 acc = (f32x4){0.f, 0.f, 0.f, 0.f};
#define GLA_LOAD(S, m) do { const unsigned char* sl_ = SL + (size_t)((m) >> 1) * PSLOT; const int r_ = ((m) & 1) * 128; \
        const bf16* kp_ = (const bf16*)(sl_ + PK) + r_ * 512 + koff; const float* bp_ = (const float*)(sl_ + PBC) + r_ * 512; const bf16* vp_ = (const bf16*)(sl_ + PV) + r_ * 1024 + voff; \
        { const unsigned long long ka_ = *(const unsigned long long*)kp_, kb_ = *(const unsigned long long*)(kp_ + 64 * 512); S.k0 = (unsigned)ka_; S.k1 = (unsigned)(ka_ >> 32); S.k2 = (unsigned)kb_; S.k3 = (unsigned)(kb_ >> 32); } \
        S.bca = *(const f32x4*)(bp_ + koff); S.bcb = *(const f32x4*)(bp_ + koff + 64 * 512); S.bla = *(const f32x4*)(bp_ + loff); S.blb = *(const f32x4*)(bp_ + loff + 64 * 512); \
        S.va = *(const v4u*)vp_; S.vb = *(const v4u*)(vp_ + 64 * 1024); S.dca = bp_[doff]; S.dcb = bp_[doff + 64 * 512]; } while (0)
#define GLA_STEP(S, m, buf) do { \
        { const f32x4 ea = S.bla + S.blb - S.bca, eb = S.blb - S.bcb;                                    \
          const unsigned w0 = pk2(bf2f(S.k0 & 0xffffu) * __expf(ea[0]), bf2f(S.k0 >> 16) * __expf(ea[1])), w1 = pk2(bf2f(S.k1 & 0xffffu) * __expf(ea[2]), bf2f(S.k1 >> 16) * __expf(ea[3])); \
          const unsigned w2 = pk2(bf2f(S.k2 & 0xffffu) * __expf(eb[0]), bf2f(S.k2 >> 16) * __expf(eb[1])), w3 = pk2(bf2f(S.k3 & 0xffffu) * __expf(eb[2]), bf2f(S.k3 >> 16) * __expf(eb[3])); \
          *(LAS unsigned long long*)(lds + (buf) * 65536 + kw) = (unsigned long long)w0 | ((unsigned long long)w1 << 32); \
          *(LAS unsigned long long*)(lds + (buf) * 65536 + 16384 + kw) = (unsigned long long)w2 | ((unsigned long long)w3 << 32); \
          *(LAS v4u*)(lds + (buf) * 65536 + 32768 + vw) = S.va; *(LAS v4u*)(lds + (buf) * 65536 + 49152 + vw) = S.vb; } \
        const float dec_ = __expf(S.dca + S.dcb); \
        if ((m) + 2 < NP) GLA_LOAD(S, (m) + 2); \
        __syncthreads(); \
        _Pragma("unroll") for (int j = 0; j < 4; ++j) __builtin_nontemporal_store((bf16)f2bf(acc[j]), spp + (size_t)(m) * GDV * GDK + j * GDK); \
        acc = acc * dec_; \
        _Pragma("unroll") for (int ks = 0; ks < 4; ++ks) acc = MFMA16(tr_frag(lds + (buf) * 65536 + 32768, lane, mt, ks), tr_frag(lds + (buf) * 65536, lane, nt, ks), acc); } while (0)
        GlaSet s0, s1;
        GLA_LOAD(s0, 0); GLA_LOAD(s1, 1);
        for (int m = 0; m < NP; m += 2) { GLA_STEP(s0, m, 0); GLA_STEP(s1, m + 1, 1); }
#undef GLA_LOAD
#undef GLA_STEP
        __syncthreads();
    }
}

struct GlaRaw { bf16x8 q[4], k[4]; f32x4 b0[4], b1[4], l0, l1; };
__device__ __forceinline__ void gla_out_phase(Frame& F) {
    LAS unsigned char* lds = F.lds;
    LAS unsigned char *QI = lds, *AI = lds + 16384, *KI = lds + 32768, *VI = lds + 65536, *OL = lds;
    LAS float* RED = (LAS float*)(lds + RT_OFF); LAS float* RS = RED + 512;
    const int pm = 8 * ((int)blockIdx.x & 7) + (((int)blockIdx.x >> 3) & 7), hq = ((int)blockIdx.x >> 6) & 3;
    const unsigned char* SL = F.ws + WS_B + (size_t)pm * PSLOT;
    const bf16* QG = (const bf16*)(SL + PQ); const bf16* KG = (const bf16*)(SL + PK); const bf16* VG = (const bf16*)(SL + PV); const bf16* GGp = (const bf16*)(SL + PG);
    const float* BC = (const float*)(SL + PBC); const bf16* SP = (const bf16*)F.out; bf16* OG = (bf16*)(F.ws + WS_C) + (size_t)pm * 256 * 1024; const float* hg = F.in[5];
    const int tid = F.tid, lane = F.lane, wave = F.wave, fr = lane & 15, fq = lane >> 4;
    const float g0 = hg[32 * wave + fr], g1 = hg[32 * wave + 16 + fr];
    constexpr int NU = 2;
#define GLA_T0(u) ((size_t)(u) * (2 * CH))
#define GLA_H(u) (hq)
#define GLA_LOADRAW(R, u) do { const size_t t0_ = GLA_T0(u); const int h_ = GLA_H(u); \
        _Pragma("unroll") for (int r = 0; r < 4; ++r) { const int n = tid + 512 * r, pos = n >> 4, ch = n & 15; const size_t e = (t0_ + pos) * 512 + h_ * GDK + ch * 8; \
            R.q[r] = __builtin_nontemporal_load((const bf16x8*)(QG + e)); R.k[r] = __builtin_nontemporal_load((const bf16x8*)(KG + e)); \
            R.b0[r] = __builtin_nontemporal_load((const f32x4*)(BC + e)); R.b1[r] = __builtin_nontemporal_load((const f32x4*)(BC + e + 4)); } \
        { const size_t e = (t0_ + 63) * 512 + h_ * GDK + (tid & 15) * 8; R.l0 = *(const f32x4*)(BC + e); R.l1 = *(const f32x4*)(BC + e + 4); } } while (0)
#define GLA_LOADSF(u) do { const bf16* sp = SP + ((size_t)((((pm >> 4) * 4 + hq) * 32) + 2 * (pm & 15) + (u)) * GDV + 32 * wave + fr) * GDK + 8 * fq; \
        _Pragma("unroll") for (int nt = 0; nt < 2; ++nt) _Pragma("unroll") for (int ks = 0; ks < 4; ++ks) sf[nt][ks] = __builtin_nontemporal_load((const bf16x8*)(sp + nt * 16 * GDK + ks * 32)); } while (0)
    int u = 0;
    bf16x8 sf[2][4];
    GLA_LOADSF(u);
    for (;;) {
        const size_t t0 = GLA_T0(u); const int h = GLA_H(u); const int un = u + 1; const bool has_next = un < NU;
        GlaRaw R; GLA_LOADRAW(R, u);
        v4u vv[8];
#pragma unroll
        for (int r = 0; r < 8; ++r) { const int n = tid + 512 * r, pos = n >> 5, c32 = n & 31; vv[r] = __builtin_nontemporal_load((const v4u*)(VG + (t0 + pos) * 1024 + h * GDV + c32 * 8)); }
        v4u wq1[2];
#pragma unroll
        for (int r = 0; r < 4; ++r) { const int n = tid + 512 * r, pos = n >> 4, ch = n & 15;
            float qq[8], kk[8];
#pragma unroll
            for (int j = 0; j < 8; ++j) { float bj = j < 4 ? R.b0[r][j & 3] : R.b1[r][j & 3]; if (r >= 2) bj += j < 4 ? R.l0[j & 3] : R.l1[j & 3]; const float ex = __expf(bj);
                qq[j] = bf2f((unsigned short)R.q[r][j]) * ex * 0.08838834764831845f; kk[j] = bf2f((unsigned short)R.k[r][j]) * __builtin_amdgcn_rcpf(ex); }
            v4u wqr; wqr.x = pk2(qq[0], qq[1]); wqr.y = pk2(qq[2], qq[3]); wqr.z = pk2(qq[4], qq[5]); wqr.w = pk2(qq[6], qq[7]);
            if (r < 2) *(LAS v4u*)(QI + off_b(pos, ch)) = wqr; else wq1[r - 2] = wqr;
            v4u wk; wk.x = pk2(kk[0], kk[1]); wk.y = pk2(kk[2], kk[3]); wk.z = pk2(kk[4], kk[5]); wk.w = pk2(kk[6], kk[7]);
            *(LAS v4u*)(KI + (pos >> 6) * 16384 + off_b(pos & 63, ch)) = wk; }
        {
#pragma unroll
          for (int r = 0; r < 8; ++r) { const int n = tid + 512 * r, pos = n >> 5, c32 = n & 31; *(LAS v4u*)(VI + ((pos >> 6) * 2 + (c32 >> 4)) * 16384 + off_b(pos & 63, c32 & 15)) = vv[r]; } }
#pragma unroll 1
        for (int hf = 0; hf < 2; ++hf) {
            if (hf) {
#pragma unroll
                for (int r = 0; r < 2; ++r) { const int n = tid + 512 * r, pos = n >> 4, ch = n & 15; *(LAS v4u*)(QI + off_b(pos, ch)) = wq1[r]; } }
            __syncthreads();
            { const int mt = wave >> 1;
#pragma unroll
              for (int q = 0; q < (hf ? 4 : 2); ++q) { const int nt = (hf ? 4 : 2) * (wave & 1) + q; f32x4 a4 = (f32x4){0.f, 0.f, 0.f, 0.f};
                  const bool diag = hf ? (nt >= 4) : true; const int ntl = (hf && nt >= 4) ? nt - 4 : nt;
                  if (!diag || ntl <= mt) { LAS unsigned char* kimg = KI + ((hf && nt >= 4) ? 16384 : 0);
#pragma unroll
                      for (int ks = 0; ks < 4; ++ks) a4 = MFMA16(row_frag(QI, lane, mt, ks), row_frag(kimg, lane, ntl, ks), a4); }
#pragma unroll
                  for (int r = 0; r < 4; ++r) { const int ii = mt * 16 + 4 * fq + r, jl = ntl * 16 + fr, jj = nt * 16 + fr; const float val = (!diag || jl <= ii) ? a4[r] : 0.f;
                      *(LAS unsigned short*)(AI + off_b(ii, jj >> 3) + 2 * (jj & 7)) = (unsigned short)f2bf(val); } } }
            __syncthreads();
            f32x4 o[4][2];
#pragma unroll
            for (int m = 0; m < 4; ++m) { o[m][0] = (f32x4){0.f, 0.f, 0.f, 0.f}; o[m][1] = (f32x4){0.f, 0.f, 0.f, 0.f}; }
#pragma unroll
            for (int ks = 0; ks < (hf ? 4 : 2); ++ks) { bf16x8 bfr[2];
#pragma unroll
                for (int nt = 0; nt < 2; ++nt) { const int dv = 32 * wave + 16 * nt; bfr[nt] = tr_frag(VI + ((ks >> 1) * 2 + (dv >> 7)) * 16384, lane, (dv & 127) >> 4, ks & 1); }
#pragma unroll
                for (int m = 0; m < 4; ++m) { const bf16x8 a = row_frag(AI, lane, m, ks); o[m][0] = MFMA16(a, bfr[0], o[m][0]); o[m][1] = MFMA16(a, bfr[1], o[m][1]); } }
#pragma unroll
            for (int ks = 0; ks < 4; ++ks)
#pragma unroll
                for (int m = 0; m < 4; ++m) { const bf16x8 a = row_frag(QI, lane, m, ks); o[m][0] = MFMA16(a, sf[0][ks], o[m][0]); o[m][1] = MFMA16(a, sf[1][ks], o[m][1]); }
            bf16x8 gv[4];
#pragma unroll
            for (int r = 0; r < 4; ++r) { const int n = tid + 512 * r, pos = n >> 5, c32 = n & 31; gv[r] = __builtin_nontemporal_load((const bf16x8*)(GGp + (t0 + 64 * hf + pos) * 1024 + h * GDV + c32 * 8)); }
            if (hf && has_next) GLA_LOADSF(un);
#pragma unroll
            for (int m = 0; m < 4; ++m)
#pragma unroll
                for (int r = 0; r < 4; ++r) { float s = o[m][0][r] * o[m][0][r] + o[m][1][r] * o[m][1][r];
                    s += __shfl_xor(s, 1); s += __shfl_xor(s, 2); s += __shfl_xor(s, 4); s += __shfl_xor(s, 8);
                    if (fr == 0) RED[wave * 64 + m * 16 + 4 * fq + r] = s; }
            __syncthreads();
            if (tid < 64) { float tot = 0.f;
#pragma unroll
                for (int w = 0; w < 8; ++w) tot += RED[w * 64 + tid];
                RS[tid] = __builtin_amdgcn_rsqf(tot * (1.f / GDV) + EPS); }
            __syncthreads();
#pragma unroll
            for (int m = 0; m < 4; ++m) { const f32x4 rs4 = *(const LAS f32x4*)(RS + m * 16 + 4 * fq);
#pragma unroll
                for (int r = 0; r < 4; ++r) { LAS unsigned char* rowp = OL + (m * 16 + 4 * fq + r) * 512 + (32 * wave + fr) * 2;
                    *(LAS unsigned short*)rowp = (unsigned short)f2bf(o[m][0][r] * rs4[r] * g0); *(LAS unsigned short*)(rowp + 32) = (unsigned short)f2bf(o[m][1][r] * rs4[r] * g1); } }
            __syncthreads();
#pragma unroll
            for (int r = 0; r < 4; ++r) { const int n = tid + 512 * r, pos = n >> 5, c32 = n & 31;
                const bf16x8 ov = *(const LAS bf16x8*)(OL + pos * 512 + c32 * 16); const size_t e = (t0 + 64 * hf + pos) * 1024 + h * GDV + c32 * 8;
                v4u w; w.x = pk2(bf2f((unsigned short)ov[0]) * bf2f((unsigned short)gv[r][0]), bf2f((unsigned short)ov[1]) * bf2f((unsigned short)gv[r][1]));
                w.y = pk2(bf2f((unsigned short)ov[2]) * bf2f((unsigned short)gv[r][2]), bf2f((unsigned short)ov[3]) * bf2f((unsigned short)gv[r][3]));
                w.z = pk2(bf2f((unsigned short)ov[4]) * bf2f((unsigned short)gv[r][4]), bf2f((unsigned short)ov[5]) * bf2f((unsigned short)gv[r][5]));
                w.w = pk2(bf2f((unsigned short)ov[6]) * bf2f((unsigned short)gv[r][6]), bf2f((unsigned short)ov[7]) * bf2f((unsigned short)gv[r][7]));
                *(v4u*)(OG + e) = w; }
            __syncthreads();
        }
        if (!has_next) break;
        u = un;
    }
#undef GLA_T0
#undef GLA_H
#undef GLA_LOADRAW
#undef GLA_LOADSF
}
__device__ __forceinline__ void fill_rstd_table(Frame& F, const pg8::StaticOrder& S, const float* ss) {
    LAS float* RT = (LAS float*)(F.lds + RT_OFF); pg8::Unit u;
    for (int i = 0; i < 4 && S.next(i, u); ++i) if (F.tid < 256) RT[i * 256 + F.tid] = pg8::row_rstd(ss, u.pm * 256 + F.tid);
    __syncthreads();
}

struct Args { const float* in[19]; float* out; unsigned char* ws; int ph_lo, ph_hi, li, pad; };
__global__ void __launch_bounds__(NWAVES * 64, 2) mega(Args args) {
    extern __shared__ __attribute__((aligned(16))) unsigned char lds[];
    Frame F;
    F.lds = (LAS unsigned char*)lds;
    F.MISC = (volatile LAS unsigned*)(F.lds + MISC_OFF);
    F.tid = threadIdx.x; F.lane = F.tid & 63; F.wave = __builtin_amdgcn_readfirstlane(F.tid >> 6);
    F.G = gridDim.x; { const int bx = blockIdx.x; F.vcu = (F.G % 8 == 0) ? (bx % 8) * (F.G / 8) + bx / 8 : bx; }
#pragma unroll
    for (int i = 0; i < 19; ++i) F.in[i] = args.in[i];
    F.out = args.out; F.ws = args.ws; F.ctl = (gu32*)(args.ws + WS_CTL);
    unsigned char* ws = args.ws;
    for (int u = F.tid; u < (LDS_BYTES - LDSCTL_OFF) / 4; u += NWAVES * 64) ((LAS unsigned*)(F.lds + LDSCTL_OFF))[u] = 0u;
    __syncthreads();
    const int lo = args.ph_lo, hi = args.ph_hi;
    XcdBarrier bar; bar.bar = (unsigned*)(F.ctl + CW_BAR) + args.li * XCD_BAR_WORDS; bar.x = 0; bar.st = nullptr;
    if (hi - lo > 1) bar = xcd_barrier_post((unsigned*)(F.ctl + CW_BAR) + args.li * XCD_BAR_WORDS, F.MISC + 8);
    if (F.tid == 0) __hip_atomic_store(F.ctl + CW_XCC + blockIdx.x, xb_xcc_id() + 1u, RLX_AGENT);
    const int pm_own = 8 * ((int)blockIdx.x & 7) + (((int)blockIdx.x >> 3) & 7);
    bool grp_same = false;
#define IN(k) (lo <= (k) && (k) < hi)
#define SEAM(k) do { if (IN(k) && IN((k) + ((k) == 8 ? 2 : 1))) xcd_barrier(bar); } while (0)
#define PSEAM(k, s) do { if (IN(k) && IN((k) + 1)) panel_sync(F.ctl, bar.bar + XB_TMO, (s), pm_own, grp_same); } while (0)
    bf16 *Win = (bf16*)(ws + WS_WIN), *Wao = (bf16*)(ws + WS_WAO), *W1a = (bf16*)(ws + WS_W1A), *W2a = (bf16*)(ws + WS_W2A);
    bf16 *Wkvq = (bf16*)(ws + WS_WKVQ), *Wbo = (bf16*)(ws + WS_WBO), *W1b = (bf16*)(ws + WS_W1B), *W2b = (bf16*)(ws + WS_W2B);
    float* SS = (float*)(ws + WS_SS);
    bf16 *RA = (bf16*)(ws + WS_A), *RC = (bf16*)(ws + WS_C), *HM = (bf16*)(ws + WS_HM);

    if (IN(0)) { p0_prologue(F); SEAM(0); }
    if (hi - lo > 1) {
        const int b0 = ((int)blockIdx.x & 7) + 8 * (((int)blockIdx.x >> 3) & 7); unsigned x0 = 0, same = 1;
        for (int q = 0; q < 4; ++q) { const unsigned xq = __hip_atomic_load(F.ctl + CW_XCC + b0 + 64 * q, RLX_AGENT); if (q == 0) x0 = xq; same &= (xq == x0 && xq != 0u) ? 1u : 0u; }
        grp_same = __builtin_amdgcn_readfirstlane(same) != 0;
    }
    if (IN(1)) {
        pg8::Gemm g{RA, Win, T, 3072, D}; pg8::StaticOrder S; S.init(T, 3072, F.G, (int)blockIdx.x);
        fill_rstd_table(F, S, SS);
        pg8::EpiInProj E{ws + WS_B, (const LAS float*)(F.lds + RT_OFF), 0};
        pg8::gemm_phase<pg8::EpiInProj, pg8::StaticOrder, PG8_ALIGN, PG8_SP2>(F.lds + RING_OFF, g, S, E);
        gate_phase(F);
        SEAM(1);
    }
    if (IN(2)) { gla_state_phase(F); SEAM(2); }
    if (IN(3)) { gla_out_phase(F); PSEAM(3, 4); }
    if (IN(4)) {
        pg8::Gemm g{RC, Wao, T, D, D}; pg8::StaticOrder S; S.init(T, D, F.G, (int)blockIdx.x);
        pg8::EpiResB<1> E{nullptr, RA, RA, nullptr, SS};
        pg8::gemm_phase<pg8::EpiResB<1>, pg8::StaticOrder, PG8_ALIGN, PG8_SP2>(F.lds + RING_OFF, g, S, E);
        PSEAM(4, 0);
    }
    if (IN(5)) {
        pg8::Gemm g{RA, W1a, T, FF, D}; pg8::StaticOrder S; S.init(T, FF, F.G, (int)blockIdx.x);
        fill_rstd_table(F, S, SS);
        pg8::EpiUp E{HM, (const LAS float*)(F.lds + RT_OFF), 0};
        pg8::gemm_phase<pg8::EpiUp, pg8::StaticOrder, PG8_ALIGN, PG8_SP2>(F.lds + RING_OFF, g, S, E);
        PSEAM(5, 1);
    }
    if (IN(6)) {
        pg8::Gemm g{HM, W2a, T, D, FF}; pg8::StaticOrder S; S.init(T, D, F.G, (int)blockIdx.x);
        pg8::EpiResB<1> E{nullptr, RA, RA, nullptr, SS};
        pg8::gemm_phase<pg8::EpiResB<1>, pg8::StaticOrder, PG8_ALIGN, PG8_SP2>(F.lds + RING_OFF, g, S, E);
        SEAM(6);
    }
    if (IN(7)) {
        pg8::Gemm g{RA, Wkvq, T, 3072, D}; pg8::StaticOrder S; S.init(T, 3072, F.G, (int)blockIdx.x);
        if (F.tid < 128) ((LAS float*)(F.lds + RT_OFF + 4096))[F.tid] = (F.tid < 64) ? F.in[9][F.tid] : F.in[12][F.tid - 64];
        fill_rstd_table(F, S, SS);
        pg8::EpiKVQ E{(bf16*)(ws + WS_KN), (bf16*)(ws + WS_V2), (bf16*)(ws + WS_QN), (const LAS float*)(F.lds + RT_OFF), (const LAS float*)(F.lds + RT_OFF + 4096), (const LAS float*)(F.lds + RT_OFF + 4096 + 256), 0};
        pg8::gemm_phase<pg8::EpiKVQ, pg8::StaticOrder, PG8_ALIGN, PG8_SP2>(F.lds + RING_OFF, g, S, E);
        SEAM(7);
    }
    if (IN(8)) {
        const attn_body::AttnTensors AT{(const attn_body::bf16*)(ws + WS_QN), (const attn_body::bf16*)(ws + WS_KN), (const attn_body::bf16*)(ws + WS_V2), (attn_body::bf16*)F.out};
        const attn_body::StaticOrder S((int)F.G, (int)blockIdx.x);
        attn_body::attn_phase<attn_body::StaticOrder>((char*)lds + RING_OFF, AT, S);
        combine_local(F);
        SEAM(8);
    }
    if (IN(10)) {
        pg8::Gemm g{RC, Wbo, T, D, D}; pg8::StaticOrder S; S.init(T, D, F.G, (int)blockIdx.x);
        pg8::EpiResB<1> E{nullptr, RA, RA, nullptr, SS};
        pg8::gemm_phase<pg8::EpiResB<1>, pg8::StaticOrder, PG8_ALIGN, PG8_SP2>(F.lds + RING_OFF, g, S, E);
        PSEAM(10, 2);
    }
    if (IN(11)) {
        pg8::Gemm g{RA, W1b, T, FF, D}; pg8::StaticOrder S; S.init(T, FF, F.G, (int)blockIdx.x);
        fill_rstd_table(F, S, SS);
        pg8::EpiUp E{HM, (const LAS float*)(F.lds + RT_OFF), 0};
        pg8::gemm_phase<pg8::EpiUp, pg8::StaticOrder, PG8_ALIGN, PG8_SP2>(F.lds + RING_OFF, g, S, E);
        PSEAM(11, 3);
    }
    if (IN(12)) {
        pg8::Gemm g{HM, W2b, T, D, FF}; pg8::StaticOrder S; S.init(T, D, F.G, (int)blockIdx.x);
        pg8::EpiResB<2> E{nullptr, RA, nullptr, F.out, nullptr};
        pg8::gemm_phase<pg8::EpiResB<2>, pg8::StaticOrder, PG8_ALIGN, PG8_SP2>(F.lds + RING_OFF, g, S, E);
    }
#undef IN
#undef SEAM
}

extern "C" void kernel_launch(void* const* d_in, const int* in_sizes, int n_in, void* d_out, int out_size, void* d_ws, size_t ws_size, hipStream_t stream) {
    static int grid = 0;
    if (grid == 0) {
        if (n_in != 19 || out_size != T * D || ws_size < WS_END) { fprintf(stderr, "kernel_launch: unexpected shapes (n_in %d out %d ws %zu)\n", n_in, out_size, ws_size); grid = -1; return; }
        int dev = 0, cus = 0, per_cu = 0;
        if (hipGetDevice(&dev) != hipSuccess || hipDeviceGetAttribute(&cus, hipDeviceAttributeMultiprocessorCount, dev) != hipSuccess) { grid = -1; return; }
        if (hipFuncSetAttribute((const void*)mega, hipFuncAttributeMaxDynamicSharedMemorySize, LDS_BYTES) != hipSuccess) { fprintf(stderr, "kernel_launch: hipFuncSetAttribute failed\n"); grid = -1; return; }
        if (hipOccupancyMaxActiveBlocksPerMultiprocessor(&per_cu, (const void*)mega, NWAVES * 64, LDS_BYTES) != hipSuccess || per_cu < 1) { fprintf(stderr, "kernel_launch: occupancy query says %d blocks per CU\n", per_cu); grid = -1; (void)hipGetLastError(); return; }
        if (cus < 256) { fprintf(stderr, "kernel_launch: built for the 256 CUs of an MI355X (one resident workgroup per CU), found %d\n", cus); grid = -1; return; }
        grid = 256;
    }
    if (grid < 0) return;
    unsigned char* ws = (unsigned char*)d_ws;
    (void)hipMemsetAsync(ws + WS_CTL, 0, 128 * 1024, stream);
    Args a{};
    for (int i = 0; i < 19; ++i) a.in[i] = (const float*)d_in[i];
    a.out = (float*)d_out; a.ws = ws;
    int li = 0;
    auto run = [&](int lo, int hi) { a.ph_lo = lo; a.ph_hi = hi; a.li = li++; hipLaunchKernelGGL(mega, dim3(grid), dim3(NWAVES * 64), LDS_BYTES, stream, a); };
    run(0, 13);
}
```

```cpp
#include <hip/hip_runtime.h>
#include <cstdio>
#include <cstdint>

typedef unsigned short bf16;
typedef short bf16x8 __attribute__((ext_vector_type(8)));
typedef float f32x4 __attribute__((ext_vector_type(4)));

constexpr int NB = 4, SEQ = 4096, T = NB * SEQ, D = 1024, FF = 4096;
constexpr int GH = 4, GDK = 128, GDV = 256, GR = 16, CH = 64, NCH = SEQ / CH;
constexpr int GIN = 3088;
constexpr int DH = 8, DDH = 64, DVD = 128;
constexpr float EPS = 1e-6f;
constexpr float LOG2E = 1.4426950408889634f;
constexpr float LAMBDA_INIT = 0.35550906759f;

constexpr size_t MiB = 1u << 20;
constexpr size_t WS_CTL = 0;
constexpr size_t WS_SS = 1 * MiB;
constexpr size_t WS_ZB = 2 * MiB;
constexpr size_t WS_WZ = 3 * MiB;
constexpr size_t WS_WIN = 4 * MiB;
constexpr size_t WS_WAO = 10 * MiB;
constexpr size_t WS_W1A = 12 * MiB;
constexpr size_t WS_W2A = 20 * MiB;
constexpr size_t WS_WKVQ = 28 * MiB;
constexpr size_t WS_WBO = 34 * MiB;
constexpr size_t WS_W1B = 36 * MiB;
constexpr size_t WS_W2B = 44 * MiB;
constexpr size_t WS_B = 52 * MiB;
constexpr size_t WS_A = 180 * MiB;
constexpr size_t WS_C = 212 * MiB;
constexpr size_t WS_END = 244 * MiB;
constexpr size_t PSLOT = 2 * MiB, PQ = 0, PK = 256 * 1024, PV = 512 * 1024, PG = 1 * MiB, PBC = 1536 * 1024;
constexpr size_t WS_HM = WS_B;
constexpr size_t WS_KN = WS_B, WS_V2 = WS_B + 32 * MiB, WS_QN = WS_B + 64 * MiB;

__host__ __device__ __forceinline__ unsigned f2bf(float f) { unsigned u = __builtin_bit_cast(unsigned, f); return (u + 0x7fffu + ((u >> 16) & 1u)) >> 16; }
__host__ __device__ __forceinline__ float bf2f(unsigned h) { return __builtin_bit_cast(float, h << 16); }

__host__ __device__ __forceinline__ int kvq_dest_row(int n) {
    if (n >= 1024 && n < 2048) return n;
    const int tile = n >> 8, w = n & 255, lb = w >> 5, j = w & 31, wc = lb >> 1, bj = lb & 1;
    return (tile << 8) + 128 * bj + 32 * wc + j;
}

namespace pg8 {
#define PG8_LAS __attribute__((address_space(3)))
typedef unsigned short bf16_t;
typedef short bf16x8 __attribute__((ext_vector_type(8)));
typedef float f32x4 __attribute__((ext_vector_type(4)));
typedef unsigned u32x4 __attribute__((ext_vector_type(4)));
constexpr int BM = 256, BK = 64, HALF = 128, HTB = HALF * BK * 2  , STAGE_BYTES = 8 * HTB, NXCD = 8, WGM = 8;

__host__ __device__ __forceinline__ int lds_byte(int r, int c) { const int st = (r >> 4) * 2 + (c >> 5), rr = r & 15, cc = c & 31, ob = rr * 64 + cc * 2; return st * 1024 + (ob ^ (((ob >> 9) & 1) << 5)); }
__host__ __device__ __forceinline__ void stage_rc(int b, int& R, int& C) { const int st = b / 1024, sb = b % 1024, swz = sb ^ (((sb >> 9) & 1) << 5); R = (st >> 1) * 16 + swz / 64; C = (st & 1) * 32 + (swz % 64) / 2; }
__host__ __device__ __forceinline__ int perm32(int rho) { const int n = rho >> 4, i = rho & 15; return 8 * (i >> 2) + 4 * n + (i & 3); }

struct Unit { int pm, pn; };
struct Gemm { const bf16_t* A; const bf16_t* Bt; int M, N, K; };

struct StaticOrder {
    int nM, nN, nwg, G, c;
    __host__ __device__ void init(int M, int N, int G_, int c_) { nM = M / BM; nN = N / BM; nwg = nM * nN; G = G_; c = c_; }
    __host__ __device__ bool next(int i, Unit& u) const {
        const long L = (long)i * G + c; if (L >= nwg) return false;
        int wgid = (int)L; { const int q = nwg / NXCD, r = nwg % NXCD, xcd = wgid % NXCD, off = wgid / NXCD; wgid = (xcd < r ? xcd * (q + 1) : r * (q + 1) + (xcd - r) * q) + off; }
        const int nig = WGM * nN, gid = wgid / nig, fm = gid * WGM, gsz = (nM - fm) < WGM ? (nM - fm) : WGM;
        u.pm = fm + ((wgid % nig) % gsz); u.pn = (wgid % nig) / gsz; return true;
    }
    __device__ __forceinline__ void a_ready(const Unit&) const {}
    __device__ __forceinline__ void done(const Unit&) const {}
};

__device__ __forceinline__ unsigned cvt_pk_bf16(float lo, float hi) { unsigned r; asm volatile("v_cvt_pk_bf16_f32 %0, %1, %2" : "=v"(r) : "v"(lo), "v"(hi)); return r; }
typedef float f32x2 __attribute__((ext_vector_type(2)));
typedef unsigned u32x2 __attribute__((ext_vector_type(2)));
__device__ __forceinline__ void store16_wt(void* p, u32x4 v) { asm volatile("global_store_dwordx4 %0, %1, off sc1\n\ts_nop 1" :: "v"(p), "v"(v) : "memory"); }
constexpr int TOK = 16384;
constexpr float RMS_EPS = 1e-6f;
__device__ __forceinline__ float silu_f(float g) { return g * __builtin_amdgcn_rcpf(1.0f + __builtin_amdgcn_exp2f(-1.4426950408889634f * g)); }
__device__ __forceinline__ float row_rstd(const float* ss, int row) {
    const f32x4 a = *(const f32x4*)(ss + (size_t)row * 16), b = *(const f32x4*)(ss + (size_t)row * 16 + 4), c = *(const f32x4*)(ss + (size_t)row * 16 + 8), d = *(const f32x4*)(ss + (size_t)row * 16 + 12);
    const float q = ((a[0] + a[1]) + (a[2] + a[3])) + ((b[0] + b[1]) + (b[2] + b[3])) + ((c[0] + c[1]) + (c[2] + c[3])) + ((d[0] + d[1]) + (d[2] + d[3]));
    return __builtin_amdgcn_rsqf(q * (1.0f / 1024.0f) + RMS_EPS);
}
struct EpiInProj {
    static constexpr bool PERM = true, AFTER_DRAIN = false;
    unsigned char* slots; const PG8_LAS float* rt; mutable int ui;
    __device__ __forceinline__ void operator()(const f32x4 (&acc)[2][2][4][2], const Unit& u, int wr, int wc, int fr, int fq) const {
        const int row0 = wr * 64 + fr; const int pn = u.pn; const PG8_LAS float* rtu = rt + ui * 256 + wr * 64 + fr; ++ui;
        unsigned char* sl = slots + (size_t)u.pm * (2u << 20); bf16_t* base; int ldc, colt; const bool act = pn >= 8;
        if (pn < 2) { base = (bf16_t*)sl; ldc = 512; colt = pn * BM; } else if (pn < 4) { base = (bf16_t*)(sl + 256 * 1024); ldc = 512; colt = (pn - 2) * BM; }
        else if (pn < 8) { base = (bf16_t*)(sl + 512 * 1024); ldc = 1024; colt = (pn - 4) * BM; } else { base = (bf16_t*)(sl + 1024 * 1024); ldc = 1024; colt = (pn - 8) * BM; }
        const int col0 = colt + wc * 32 + 8 * fq;
#pragma unroll
        for (int ai = 0; ai < 2; ++ai)
#pragma unroll
            for (int m = 0; m < 4; ++m) { bf16_t* rowp = base + (size_t)(row0 + ai * HALF + m * 16) * ldc + col0; const float rs = rtu[ai * HALF + m * 16];
#pragma unroll
                for (int bj = 0; bj < 2; ++bj) { f32x4 v0 = acc[ai][bj][m][0] * rs, v1 = acc[ai][bj][m][1] * rs;
                    if (act) { v0 = (f32x4){silu_f(v0[0]), silu_f(v0[1]), silu_f(v0[2]), silu_f(v0[3])}; v1 = (f32x4){silu_f(v1[0]), silu_f(v1[1]), silu_f(v1[2]), silu_f(v1[3])}; }
                    u32x4 w; w.x = cvt_pk_bf16(v0[0], v0[1]); w.y = cvt_pk_bf16(v0[2], v0[3]); w.z = cvt_pk_bf16(v1[0], v1[1]); w.w = cvt_pk_bf16(v1[2], v1[3]);
                    store16_wt(rowp + bj * HALF, w); } }
    }
};
template <int MODE> struct EpiResB {
    static constexpr bool PERM = true, AFTER_DRAIN = false;
    const float* basef; const bf16_t* baseb; bf16_t* hb; float* outf; float* ss;
    __device__ __forceinline__ void operator()(const f32x4 (&acc)[2][2][4][2], const Unit& u, int wr, int wc, int fr, int fq) const {
        const int col0 = u.pn * BM + wc * 32 + 8 * fq;
#pragma unroll
        for (int ai = 0; ai < 2; ++ai)
#pragma unroll
            for (int m = 0; m < 4; ++m) { const int row = u.pm * BM + ai * HALF + wr * 64 + m * 16 + fr; const size_t off = (size_t)row * 1024 + col0; float s = 0.f;
#pragma unroll
                for (int bj = 0; bj < 2; ++bj) { f32x4 h0, h1;
                    if (MODE == 0) { h0 = *(const f32x4*)(basef + off + bj * HALF); h1 = *(const f32x4*)(basef + off + bj * HALF + 4); }
                    else { const u32x4 b = *(const u32x4*)(baseb + off + bj * HALF);
                        h0 = (f32x4){__builtin_bit_cast(float, b.x << 16), __builtin_bit_cast(float, b.x & 0xffff0000u), __builtin_bit_cast(float, b.y << 16), __builtin_bit_cast(float, b.y & 0xffff0000u)};
                        h1 = (f32x4){__builtin_bit_cast(float, b.z << 16), __builtin_bit_cast(float, b.z & 0xffff0000u), __builtin_bit_cast(float, b.w << 16), __builtin_bit_cast(float, b.w & 0xffff0000u)}; }
                    h0 = h0 + acc[ai][bj][m][0]; h1 = h1 + acc[ai][bj][m][1];
                    if (MODE == 2) { __builtin_nontemporal_store(h0, (f32x4*)(outf + off + bj * HALF)); __builtin_nontemporal_store(h1, (f32x4*)(outf + off + bj * HALF + 4)); }
                    else { u32x4 w; w.x = cvt_pk_bf16(h0[0], h0[1]); w.y = cvt_pk_bf16(h0[2], h0[3]); w.z = cvt_pk_bf16(h1[0], h1[1]); w.w = cvt_pk_bf16(h1[2], h1[3]);
                        *(u32x4*)(hb + off + bj * HALF) = w;
                        s += ((h0[0] * h0[0] + h0[1] * h0[1]) + (h0[2] * h0[2] + h0[3] * h0[3])) + ((h1[0] * h1[0] + h1[1] * h1[1]) + (h1[2] * h1[2] + h1[3] * h1[3])); } }
                if (MODE != 2) { s += __shfl_xor(s, 16); s += __shfl_xor(s, 32); if (fq == 0) ss[(size_t)row * 16 + u.pn * 4 + wc] = s; }
                if (m & 1) asm volatile("" ::: "memory"); }
    }
};
struct EpiUp {
    static constexpr bool PERM = true, AFTER_DRAIN = false;
    bf16_t* O; const PG8_LAS float* rt; mutable int ui;
    __device__ __forceinline__ void operator()(const f32x4 (&acc)[2][2][4][2], const Unit& u, int wr, int wc, int fr, int fq) const {
        const int col0 = u.pn * BM + wc * 32 + 8 * fq; const PG8_LAS float* rtu = rt + ui * 256 + wr * 64 + fr; ++ui;
#pragma unroll
        for (int ai = 0; ai < 2; ++ai)
#pragma unroll
            for (int m = 0; m < 4; ++m) { const int row = u.pm * BM + ai * HALF + wr * 64 + m * 16 + fr; const float rs = rtu[ai * HALF + m * 16]; bf16_t* rowp = O + (size_t)row * 4096 + col0;
#pragma unroll
                for (int bj = 0; bj < 2; ++bj) { f32x4 v0 = acc[ai][bj][m][0] * rs, v1 = acc[ai][bj][m][1] * rs;
#pragma unroll
                    for (int e = 0; e < 4; ++e) { const float a = __builtin_fmaxf(v0[e], 0.f), b = __builtin_fmaxf(v1[e], 0.f); v0[e] = a * a; v1[e] = b * b; }
                    u32x4 w; w.x = cvt_pk_bf16(v0[0], v0[1]); w.y = cvt_pk_bf16(v0[2], v0[3]); w.z = cvt_pk_bf16(v1[0], v1[1]); w.w = cvt_pk_bf16(v1[2], v1[3]);
                    store16_wt(rowp + bj * HALF, w); } }
    }
};
struct EpiKVQ {
    static constexpr bool PERM = true, AFTER_DRAIN = false;
    unsigned char* slots; const PG8_LAS float* rt; const PG8_LAS float *gk, *gq; mutable int ui;
    __device__ __forceinline__ void operator()(const f32x4 (&acc)[2][2][4][2], const Unit& u, int wr, int wc, int fr, int fq) const {
        const int pn = u.pn; const PG8_LAS float* rtu = rt + ui * 256 + wr * 64 + fr; ++ui; unsigned char* sl = slots + (size_t)u.pm * (2u << 20);
        if (pn >= 4 && pn < 8) {
            const int col0 = (pn - 4) * BM + wc * 32 + 8 * fq;
#pragma unroll
            for (int ai = 0; ai < 2; ++ai)
#pragma unroll
                for (int m = 0; m < 4; ++m) { const int row = ai * HALF + wr * 64 + m * 16 + fr; const float rs = rtu[ai * HALF + m * 16]; bf16_t* rowp = (bf16_t*)(sl + 512 * 1024) + (size_t)row * 1024 + col0;
#pragma unroll
                    for (int bj = 0; bj < 2; ++bj) { const f32x4 v0 = acc[ai][bj][m][0] * rs, v1 = acc[ai][bj][m][1] * rs;
                        u32x4 w; w.x = cvt_pk_bf16(v0[0], v0[1]); w.y = cvt_pk_bf16(v0[2], v0[3]); w.z = cvt_pk_bf16(v1[0], v1[1]); w.w = cvt_pk_bf16(v1[2], v1[3]);
                        store16_wt(rowp + bj * HALF, w); } }
        } else {
            const bool isq = pn >= 8; const PG8_LAS float* gp = isq ? gq : gk; bf16_t* dst = (bf16_t*)(sl + (isq ? 1024 * 1024 : 0)); const int pl = isq ? pn - 8 : pn;
            const float sc = isq ? 0.125f * 1.4426950408889634f : 1.0f;
            f32x4 gv[2][2];
#pragma unroll
            for (int bj = 0; bj < 2; ++bj)
#pragma unroll
                for (int n = 0; n < 2; ++n) gv[bj][n] = *(const PG8_LAS f32x4*)(gp + 32 * bj + 8 * fq + 4 * n) * sc;
            const int col0 = pl * BM + wc * 64 + 8 * fq;
#pragma unroll
            for (int ai = 0; ai < 2; ++ai)
#pragma unroll
                for (int m = 0; m < 4; ++m) { const int row = ai * HALF + wr * 64 + m * 16 + fr; const float rs = rtu[ai * HALF + m * 16]; bf16_t* rowp = dst + (size_t)row * 1024 + col0;
                    f32x4 x[2][2]; float s = 0.f;
#pragma unroll
                    for (int bj = 0; bj < 2; ++bj)
#pragma unroll
                        for (int n = 0; n < 2; ++n) { x[bj][n] = acc[ai][bj][m][n] * rs; s += (x[bj][n][0] * x[bj][n][0] + x[bj][n][1] * x[bj][n][1]) + (x[bj][n][2] * x[bj][n][2] + x[bj][n][3] * x[bj][n][3]); }
                    s += __shfl_xor(s, 16); s += __shfl_xor(s, 32);
                    const float r2 = __builtin_amdgcn_rsqf(s * (1.0f / 64.0f) + RMS_EPS);
#pragma unroll
                    for (int bj = 0; bj < 2; ++bj) { const f32x4 v0 = x[bj][0] * r2 * gv[bj][0], v1 = x[bj][1] * r2 * gv[bj][1];
                        u32x4 w; w.x = cvt_pk_bf16(v0[0], v0[1]); w.y = cvt_pk_bf16(v0[2], v0[3]); w.z = cvt_pk_bf16(v1[0], v1[1]); w.w = cvt_pk_bf16(v1[2], v1[3]);
                        store16_wt(rowp + 32 * bj, w); } }
        }
    }
};

template <class Epi, class Sched, bool ALIGN_EPI = false, bool SP2 = false>
__device__ __forceinline__ void gemm_phase(PG8_LAS unsigned char* lds, const Gemm g, const Sched& S, const Epi& E) {
    const int tid = threadIdx.x, wid = __builtin_amdgcn_readfirstlane(tid >> 6), lane = tid & 63, wr = wid >> 2, wc = wid & 3, fr = lane & 15, fq = lane >> 4;
    const int K = g.K, nt = K / BK;
    unsigned voffA[2], voffB[2];
#pragma unroll
    for (int i = 0; i < 2; ++i) { int R, C; stage_rc(tid * 16 + i * 8192, R, C); const int Rb = Epi::PERM ? ((R & ~31) + perm32(R & 31)) : R;
        voffA[i] = (unsigned)(R * K + C) * 2u; voffB[i] = (unsigned)(Rb * K + C) * 2u; }
    const size_t kstep = (size_t)(BK * 2);
    const size_t hstep = (size_t)HALF * K * 2;
    const size_t tstep = 2 * hstep;
    const unsigned ldsw = (unsigned)wid * 1024u;
    const int aoff = lds_byte(wr * 64 + fr, fq * 8), boff = lds_byte(wc * 32 + fr, fq * 8);
#define PG8_SA(b, h) (((b) * 2 + (h)) * HTB)
#define PG8_SB(b, h) ((4 + (b) * 2 + (h)) * HTB)
#define PG8_STAGE(bufoff, gbase, voff) do { _Pragma("unroll") for (int _i = 0; _i < 2; ++_i) \
        __builtin_amdgcn_global_load_lds((const unsigned*)((const char*)(gbase) + (voff)[_i]), (PG8_LAS unsigned*)(lds + (bufoff) + ldsw + _i * 8192), 16, 0, 0); } while (0)
#define PG8_LDA(dst, b, h) do { _Pragma("unroll") for (int m = 0; m < 4; ++m) _Pragma("unroll") for (int k = 0; k < 2; ++k) dst[m][k] = *(const PG8_LAS bf16x8*)(lds + PG8_SA(b, h) + aoff + m * 2048 + k * 1024); } while (0)
#define PG8_LDB(dst, b, h) do { _Pragma("unroll") for (int n = 0; n < 2; ++n) _Pragma("unroll") for (int k = 0; k < 2; ++k) dst[n][k] = *(const PG8_LAS bf16x8*)(lds + PG8_SB(b, h) + boff + n * 2048 + k * 1024); } while (0)
#define PG8_MMA(ai, bj, At, Bt) do { __builtin_amdgcn_s_setprio(1); _Pragma("unroll") for (int m = 0; m < 4; ++m) _Pragma("unroll") for (int n = 0; n < 2; ++n) _Pragma("unroll") for (int k = 0; k < 2; ++k) \
        acc[ai][bj][m][n] = __builtin_amdgcn_mfma_f32_16x16x32_bf16(Bt[n][k], At[m][k], acc[ai][bj][m][n], 0, 0, 0); __builtin_amdgcn_s_setprio(0); } while (0)
#define PG8_WAIT_V(n) asm volatile("s_waitcnt vmcnt(" #n ")" ::: "memory")
#define PG8_WAIT_L(n) asm volatile("s_waitcnt lgkmcnt(" #n ")" ::: "memory")
#define PG8_BAR __builtin_amdgcn_s_barrier()
#define PG8_SCHED __builtin_amdgcn_sched_barrier(0)
    Unit cur, nxt; int ui = 0;
    if (!S.next(0, cur)) return;
    f32x4 acc[2][2][4][2];
#pragma unroll
    for (int a = 0; a < 2; ++a)
#pragma unroll
        for (int b = 0; b < 2; ++b)
#pragma unroll
            for (int m = 0; m < 4; ++m)
#pragma unroll
                for (int n = 0; n < 2; ++n) acc[a][b][m][n] = (f32x4){0.f, 0.f, 0.f, 0.f};
    bf16x8 At[4][2], B0[2][2], B1[2][2];
    const char* cA = (const char*)g.A + (size_t)cur.pm * tstep; const char* cB = (const char*)g.Bt + (size_t)cur.pn * tstep;
    S.a_ready(cur);
    if constexpr (SP2) {
        PG8_STAGE(PG8_SB(0, 0), cB, voffB); PG8_STAGE(PG8_SB(0, 1), cB + hstep, voffB); PG8_STAGE(PG8_SA(0, 0), cA, voffA); PG8_STAGE(PG8_SA(0, 1), cA + hstep, voffA);
        if (wr == 1) PG8_BAR;
        PG8_WAIT_V(2); PG8_BAR;
        PG8_STAGE(PG8_SB(1, 0), cB + kstep, voffB); PG8_STAGE(PG8_SA(1, 0), cA + kstep, voffA); PG8_STAGE(PG8_SB(1, 1), cB + hstep + kstep, voffB);
        PG8_WAIT_V(6); PG8_BAR;
    } else {
        PG8_STAGE(PG8_SB(0, 0), cB, voffB); PG8_STAGE(PG8_SA(0, 0), cA, voffA); PG8_STAGE(PG8_SB(0, 1), cB + hstep, voffB); PG8_STAGE(PG8_SA(0, 1), cA + hstep, voffA);
        if (wr == 1) PG8_BAR;
        PG8_WAIT_V(4); PG8_BAR;
        PG8_STAGE(PG8_SB(1, 0), cB + kstep, voffB); PG8_STAGE(PG8_SA(1, 0), cA + kstep, voffA); PG8_STAGE(PG8_SB(1, 1), cB + hstep + kstep, voffB);
        PG8_WAIT_V(6); PG8_BAR;
    }
    for (;;) {
        const bool has_next = S.next(ui + 1, nxt);
        const char* nA = has_next ? (const char*)g.A + (size_t)nxt.pm * tstep : cA; const char* nB = has_next ? (const char*)g.Bt + (size_t)nxt.pn * tstep : cB;
        for (int t = 0; t < nt; t += 2) {
            const bool last = (t == nt - 2);
            const char* a1 = cA + (size_t)(t + 1) * kstep;
            const char* a2 = last ? nA : cA + (size_t)(t + 2) * kstep; const char* b2 = last ? nB : cB + (size_t)(t + 2) * kstep;
            const char* a3 = a2 + kstep; const char* b3 = b2 + kstep;
            if (last && has_next) S.a_ready(nxt);
            if constexpr (SP2) {
            PG8_LDB(B0, 0, 0); PG8_LDB(B1, 0, 1); PG8_SCHED; PG8_LDA(At, 0, 0); PG8_STAGE(PG8_SA(1, 1), a1 + hstep, voffA);
            PG8_WAIT_V(8); PG8_WAIT_L(0); PG8_BAR; PG8_MMA(0, 0, At, B0); PG8_MMA(0, 1, At, B1); PG8_BAR; PG8_SCHED;
            PG8_LDA(At, 0, 1); PG8_STAGE(PG8_SB(0, 0), b2, voffB); PG8_STAGE(PG8_SB(0, 1), b2 + hstep, voffB); PG8_STAGE(PG8_SA(0, 0), a2, voffA);
            PG8_WAIT_V(8); PG8_WAIT_L(0); PG8_BAR; PG8_MMA(1, 0, At, B0); PG8_MMA(1, 1, At, B1); PG8_BAR; PG8_SCHED;
            PG8_LDB(B0, 1, 0); PG8_LDB(B1, 1, 1); PG8_SCHED; PG8_LDA(At, 1, 0); PG8_STAGE(PG8_SA(0, 1), a2 + hstep, voffA);
            PG8_WAIT_V(8); PG8_WAIT_L(0); PG8_BAR; PG8_MMA(0, 0, At, B0); PG8_MMA(0, 1, At, B1); PG8_BAR; PG8_SCHED;
            PG8_LDA(At, 1, 1); PG8_STAGE(PG8_SB(1, 0), b3, voffB); PG8_STAGE(PG8_SB(1, 1), b3 + hstep, voffB); PG8_STAGE(PG8_SA(1, 0), a3, voffA);
            PG8_WAIT_V(8); PG8_WAIT_L(0); PG8_BAR; PG8_MMA(1, 0, At, B0); PG8_MMA(1, 1, At, B1); PG8_BAR; PG8_SCHED;
            } else {
            PG8_LDB(B0, 0, 0); PG8_SCHED; PG8_LDA(At, 0, 0); PG8_STAGE(PG8_SA(1, 1), a1 + hstep, voffA);
            PG8_WAIT_L(8); PG8_BAR; PG8_WAIT_L(0); PG8_MMA(0, 0, At, B0); PG8_BAR; PG8_SCHED;
            PG8_LDB(B1, 0, 1); PG8_STAGE(PG8_SB(0, 0), b2, voffB);
            PG8_BAR; PG8_WAIT_L(0); PG8_MMA(0, 1, At, B1); PG8_BAR;
            PG8_LDA(At, 0, 1); PG8_STAGE(PG8_SA(0, 0), a2, voffA);
            PG8_BAR; PG8_WAIT_L(0); PG8_MMA(1, 0, At, B0); PG8_BAR; PG8_SCHED;
            PG8_STAGE(PG8_SB(0, 1), b2 + hstep, voffB);
            PG8_WAIT_V(6); PG8_BAR; PG8_MMA(1, 1, At, B1); PG8_BAR;
            PG8_LDB(B0, 1, 0); PG8_SCHED; PG8_LDA(At, 1, 0); PG8_STAGE(PG8_SA(0, 1), a2 + hstep, voffA);
            PG8_WAIT_L(8); PG8_BAR; PG8_WAIT_L(0); PG8_MMA(0, 0, At, B0); PG8_BAR; PG8_SCHED;
            PG8_LDB(B1, 1, 1); PG8_STAGE(PG8_SB(1, 0), b3, voffB);
            PG8_BAR; PG8_WAIT_L(0); PG8_MMA(0, 1, At, B1); PG8_BAR;
            PG8_LDA(At, 1, 1); PG8_STAGE(PG8_SA(1, 0), a3, voffA);
            PG8_BAR; PG8_WAIT_L(0); PG8_MMA(1, 0, At, B0); PG8_BAR; PG8_SCHED;
            PG8_STAGE(PG8_SB(1, 1), b3 + hstep, voffB);
            PG8_WAIT_V(6); PG8_BAR; PG8_MMA(1, 1, At, B1); PG8_BAR;
            }
        }
        if constexpr (ALIGN_EPI) { if (wr == 0) PG8_BAR; }
        if constexpr (!Epi::AFTER_DRAIN) { E(acc, cur, wr, wc, fr, fq); S.done(cur); }
        if (!has_next) break;
#pragma unroll
        for (int a = 0; a < 2; ++a)
#pragma unroll
            for (int b = 0; b < 2; ++b)
#pragma unroll
                for (int m = 0; m < 4; ++m)
#pragma unroll
                    for (int n = 0; n < 2; ++n) acc[a][b][m][n] = (f32x4){0.f, 0.f, 0.f, 0.f};
        cur = nxt; cA = nA; cB = nB; ++ui;
        if constexpr (ALIGN_EPI) { if (wr == 1) PG8_BAR; }
    }
    PG8_WAIT_V(0);
    if constexpr (!ALIGN_EPI) { if (wr == 0) PG8_BAR; }
    PG8_BAR;
    if constexpr (Epi::AFTER_DRAIN) { E.fused(acc, cur, wr, wc, fr, fq, lds, wid, lane); S.done(cur); }
#undef PG8_SA
#undef PG8_SB
#undef PG8_STAGE
#undef PG8_LDA
#undef PG8_LDB
#undef PG8_MMA
#undef PG8_WAIT_V
#undef PG8_WAIT_L
#undef PG8_BAR
#undef PG8_SCHED
}
}

#ifndef PG8_SP2
#define PG8_SP2 true
#endif
#ifndef PG8_ALIGN
#define PG8_ALIGN true
#endif

#include <hip/hip_bf16.h>
#include <cmath>
namespace attn_body {
using bf16=__hip_bfloat16;
using bf16x8=__attribute__((ext_vector_type(8)))short;
using s16x4=__attribute__((ext_vector_type(4)))short;
using f32x16=__attribute__((ext_vector_type(16)))float;
using u32x4=__attribute__((ext_vector_type(4)))unsigned;
constexpr int BATCH=4,NHC=16,SEQ=4096,D=64,DVV=128;
constexpr int QP=1024,KP=1024,VP=1024,OP=2048;
constexpr int NW=8,QBLK=32,QB=QBLK*NW,KVBLK=64,NQB=SEQ/QB;
constexpr int ATTN_UNIT_ROWS=QB;
__device__ __forceinline__ int crow(int r,int hi){return (r&3)+8*(r>>2)+4*hi;}
#define SBAR() __builtin_amdgcn_sched_barrier(0)
__device__ __forceinline__ void cmask(f32x16&p0,f32x16&p1,int jb,int qrel,int hi){
  const float NEG=-INFINITY; int kb=64*jb+4*hi;
  #pragma unroll
  for(int r=0;r<16;++r){int kv=kb+(r&3)+8*(r>>2); if(kv>qrel)p0[r]=NEG; if(kv+32>qrel)p1[r]=NEG;}
}

constexpr int NSLOT=3, SLOTB=8192, VSLOTB=2*SLOTB;
constexpr int LDS_K=0, LDS_V=NSLOT*SLOTB, LDS_WS=LDS_V+NSLOT*VSLOTB, LDS_OST=LDS_WS+NW*64*4, LDS_BYTES=LDS_OST+NW*4096;
constexpr float C2=0.125f*1.4426950408889634f;
__device__ __forceinline__ void glds16(const void*gsrc,unsigned lds_dst){unsigned keep;
  asm volatile("s_mov_b32 %0, m0\n\ts_mov_b32 m0, %2\n\ts_nop 0\n\tglobal_load_lds_dwordx4 %1, off\n\ts_mov_b32 m0, %0":"=&s"(keep):"v"(gsrc),"s"(lds_dst):"memory");}
__device__ __forceinline__ float max3f(float a,float b,float c){float r;asm("v_max3_f32 %0, %1, %2, %3":"=v"(r):"v"(a),"v"(b),"v"(c));return r;}
__device__ __forceinline__ float max2f(float a,float b){float r;asm("v_max_f32_e32 %0, %1, %2":"=v"(r):"v"(a),"v"(b));return r;}
__device__ __forceinline__ float fadd_s(float a,float b){float r;asm("v_add_f32_e32 %0, %1, %2":"=v"(r):"v"(a),"v"(b));return r;}
__device__ __forceinline__ float fsub_s(float a,float b){float r;asm("v_sub_f32_e32 %0, %1, %2":"=v"(r):"v"(a),"v"(b));return r;}
typedef float f32x2_t __attribute__((ext_vector_type(2))); typedef __bf16 bf16x2_t __attribute__((ext_vector_type(2)));
__device__ __forceinline__ unsigned cvtpk_s(float lo,float hi){f32x2_t v={lo,hi};bf16x2_t b=__builtin_convertvector(v,bf16x2_t);return __builtin_bit_cast(unsigned,b);}
#define WAIT_BAR(N) asm volatile("s_waitcnt vmcnt(" #N ") lgkmcnt(0)\n\ts_barrier":::"memory")

__device__ __forceinline__ void qkt(f32x16&p0,f32x16&p1,const char*Kslot,const bf16x8*qr,const f32x16&negm,int r32,int hi){
  const char*kb=Kslot+hi*1024+r32*16;
  #pragma unroll
  for(int d0=0;d0<4;++d0){
    const bf16x8 b0=*reinterpret_cast<const bf16x8*>(kb+d0*2048);
    const bf16x8 b1=*reinterpret_cast<const bf16x8*>(kb+d0*2048+512);
    if(d0==0){p0=__builtin_amdgcn_mfma_f32_32x32x16_bf16(b0,qr[0],negm,0,0,0);p1=__builtin_amdgcn_mfma_f32_32x32x16_bf16(b1,qr[0],negm,0,0,0);}
    else{p0=__builtin_amdgcn_mfma_f32_32x32x16_bf16(b0,qr[d0],p0,0,0,0);p1=__builtin_amdgcn_mfma_f32_32x32x16_bf16(b1,qr[d0],p1,0,0,0);}}
}
typedef __attribute__((address_space(3))) const char* lds_cptr;
typedef short v4i16_t __attribute__((ext_vector_type(4)));
__device__ __forceinline__ void kload8(bf16x8*kf,lds_cptr kp){
  kf[0]=*(const __attribute__((address_space(3))) bf16x8*)(kp);      kf[1]=*(const __attribute__((address_space(3))) bf16x8*)(kp+512);
  kf[2]=*(const __attribute__((address_space(3))) bf16x8*)(kp+2048); kf[3]=*(const __attribute__((address_space(3))) bf16x8*)(kp+2560);
  kf[4]=*(const __attribute__((address_space(3))) bf16x8*)(kp+4096); kf[5]=*(const __attribute__((address_space(3))) bf16x8*)(kp+4608);
  kf[6]=*(const __attribute__((address_space(3))) bf16x8*)(kp+6144); kf[7]=*(const __attribute__((address_space(3))) bf16x8*)(kp+6656);
}
__device__ __forceinline__ void kload2(bf16x8*kf,lds_cptr kp,int j){ kf[2*j]=*(const __attribute__((address_space(3))) bf16x8*)(kp+j*2048); kf[2*j+1]=*(const __attribute__((address_space(3))) bf16x8*)(kp+j*2048+512); }
__device__ __forceinline__ s16x4 vtr(lds_cptr p){ return __builtin_bit_cast(s16x4,__builtin_amdgcn_ds_read_tr16_b64_v4i16((__attribute__((address_space(3))) v4i16_t*)p)); }
__device__ __forceinline__ float rowmax(const f32x16&p0,const f32x16&p1){
  float a=max3f(p0[0],p0[1],p1[0]),b=max3f(p0[2],p0[3],p1[1]);a=max3f(a,p1[2],p1[3]);
  #pragma unroll
  for(int r=4;r<16;r+=4){a=max3f(a,p0[r],p0[r+1]);b=max3f(b,p0[r+2],p0[r+3]);a=max3f(a,p1[r],p1[r+1]);b=max3f(b,p1[r+2],p1[r+3]);}
  const float m=max2f(a,b);
  auto rr=__builtin_amdgcn_permlane32_swap(__float_as_uint(m),__float_as_uint(m),false,false);
  return max2f(__uint_as_float(rr[0]),__uint_as_float(rr[1]));
}
__device__ __forceinline__ void pv(f32x16*o,int vb,bf16x8 pa0,bf16x8 pa1,bf16x8 pa2,bf16x8 pa3){
  #pragma unroll
  for(int d0=0;d0<4;++d0){s16x4 lo[4],hi[4];
    #pragma unroll
    for(int ks=0;ks<4;++ks){
      asm volatile("ds_read_b64_tr_b16 %0,%1 offset:%c2":"=&v"(lo[ks]):"v"(vb),"i"(d0*4096+ks*1024):"memory");
      asm volatile("ds_read_b64_tr_b16 %0,%1 offset:%c2":"=&v"(hi[ks]):"v"(vb),"i"(d0*4096+ks*1024+512):"memory");}
    asm volatile("s_waitcnt lgkmcnt(0)":::"memory");SBAR();
    #define PK(k) (bf16x8){lo[k][0],lo[k][1],lo[k][2],lo[k][3],hi[k][0],hi[k][1],hi[k][2],hi[k][3]}
    o[d0]=__builtin_amdgcn_mfma_f32_32x32x16_bf16(pa0,PK(0),o[d0],0,0,0);
    o[d0]=__builtin_amdgcn_mfma_f32_32x32x16_bf16(pa1,PK(1),o[d0],0,0,0);
    o[d0]=__builtin_amdgcn_mfma_f32_32x32x16_bf16(pa2,PK(2),o[d0],0,0,0);
    o[d0]=__builtin_amdgcn_mfma_f32_32x32x16_bf16(pa3,PK(3),o[d0],0,0,0);
    #undef PK
  }
}

#ifndef ATTN_STORE16
#define ATTN_STORE16(p,v) (*(u32x4*)(p)=(v))
#endif
template<int THRL> __device__ __forceinline__ void attn_unit(int b,int hc,int qb,const bf16*Q,const bf16*__restrict__ K,const bf16*__restrict__ V,bf16*O,char*shm){
  const int qkcol=hc*D, vcol=(hc>>1)*DVV, ocol=hc*DVV;
  const int tid=threadIdx.x,lane=tid&63,r32=lane&31,hi=lane>>5; const int wid=__builtin_amdgcn_readfirstlane(tid>>6);
  const long rowbase=(long)b*SEQ; const int q0=qb*QB;
  constexpr long PSL=1048576;
  const bf16*Qw=Q+(long)(16*b+qb)*PSL+(long)(wid*QBLK)*QP+qkcol;
  const bf16*Kh=K+(long)(16*b)*PSL+qkcol,*Vh=V+(long)(16*b)*PSL+vcol;
  const unsigned lds0=(unsigned)(uintptr_t)shm;
  float*wsf=(float*)(shm+LDS_WS)+wid*64;
  const bf16*ksrc=Kh+(long)lane*KP+wid*8;
  const bf16*vsrc=Vh+(long)(16*(wid&3)+(lane>>2))*VP+(wid>>2)*32+(lane&3)*8;
  const unsigned kdst=lds0+LDS_K+wid*1024, vdst=lds0+LDS_V+wid*1024;
  #define TOFF(t) ((long)((t)>>2)*PSL+(long)((t)&3)*KVBLK*KP)
  #define DMA_K(t,slot) glds16(ksrc+TOFF(t),(unsigned)__builtin_amdgcn_readfirstlane(kdst+(slot)))
  #define DMA_V(t,slot) do{ glds16(vsrc+TOFF(t),(unsigned)__builtin_amdgcn_readfirstlane(vdst+2*(slot))); glds16(vsrc+64+TOFF(t),(unsigned)__builtin_amdgcn_readfirstlane(vdst+2*(slot)+8192)); }while(0)
  const int vb0=(int)(lds0+LDS_V)+((lane>>4)&1)*32+(lane&3)*8+(4*hi+((lane&15)>>2))*64;
  const char*Kbase=shm+LDS_K; bf16x8 kf[8];
  const lds_cptr shm3=(lds_cptr)shm; const lds_cptr kp0=shm3+LDS_K+hi*1024+r32*16; const lds_cptr vp0=shm3+LDS_V+((lane>>4)&1)*32+(lane&3)*8+(4*hi+((lane&15)>>2))*64;
  const int NT=(q0+QB)/KVBLK;
  DMA_K(0,0);DMA_V(0,0);DMA_K(1,SLOTB);
  bf16x8 qr[4];
  #pragma unroll
  for(int d0=0;d0<4;++d0)qr[d0]=*reinterpret_cast<const bf16x8*>(&Qw[(long)r32*QP+d0*16+hi*8]);
  float mhat=0.f,l_reg=0.f;f32x16 o[4];o[0]=f32x16{};o[1]=f32x16{};o[2]=f32x16{};o[3]=f32x16{};
  const int qrel=wid*QBLK+r32;
  #define CMASK(P0,P1,t) do{int jb_=(t)-(NT-4); if(jb_>=0)cmask(P0,P1,jb_,qrel,hi);}while(0)
  bool resc=false;
  #define START(P0,P1) do{ const float rm=rowmax(P0,P1); resc=false; \
    { const float dl=rm; mhat=fadd_s(mhat,dl); \
      _Pragma("unroll") for(int r=0;r<16;++r){P0[r]=fsub_s(P0[r],dl);P1[r]=fsub_s(P1[r],dl);} } \
    _Pragma("unroll") for(int r=0;r<16;++r)P0[r]=__builtin_amdgcn_exp2f(P0[r]); }while(0)
  #define RESC() do{ if(resc){ asm volatile("s_waitcnt lgkmcnt(0)":::"memory"); \
      _Pragma("unroll") for(int d_=0;d_<4;++d_) _Pragma("unroll") for(int r=0;r<16;++r)o[d_][r]*=wsf[crow(r,hi)]; } }while(0)
  f32x16 pA0,pA1,pB0,pB1;
  int sl_prev=0,sl_cur=0,sl_next=SLOTB;
  #define ROT() do{sl_prev=sl_cur;sl_cur=sl_next;sl_next=(sl_next==(NSLOT-1)*SLOTB)?0:sl_next+SLOTB;}while(0)
  DMA_K(2,2*SLOTB);
  WAIT_BAR(4);
  { const f32x16 z0=f32x16{}; qkt(pA0,pA1,Kbase,qr,z0,r32,hi); }asm volatile("s_nop 15\n\ts_nop 7":"+v"(pA0),"+v"(pA1));CMASK(pA0,pA1,0);
  START(pA0,pA1);
  _Pragma("unroll") for(int r=0;r<16;++r)pA1[r]=__builtin_amdgcn_exp2f(pA1[r]);
  WAIT_BAR(0);
  DMA_K(3,0);DMA_V(1,SLOTB);
  ROT();
  kload8(kf,kp0+sl_cur);
  WAIT_BAR(3);
  s16x4 vlo[4],vhi[4]; u32x4 pw0,pw1,pw2,pw3;
  #define PKW(P,B) cvtpk_s(P[B],P[B+1])
  #define PAF(k) __builtin_bit_cast(bf16x8,pw##k)
  #define VFR(i) (bf16x8){vlo[i][0],vlo[i][1],vlo[i][2],vlo[i][3],vhi[i][0],vhi[i][1],vhi[i][2],vhi[i][3]}
  #define PIN(x) asm volatile("":"+v"(x))
  #define MX3(a,b,c) __builtin_fmaxf(__builtin_fmaxf((a),(b)),(c))
  #define GAPA(MF,A0,A1,A2,A3,W0,W1,PW) do{ MF; sacc+=A0; sacc+=A1; sacc+=A2; sacc+=A3; PIN(sacc); W0; W1; PIN(PW); SBAR(); }while(0)
  #define EX(v) __builtin_amdgcn_exp2f(v)
  #define GAPB(MF,X,B) do{ MF; X[B]=EX(X[B]-mhat); X[B+1]=EX(X[B+1]-mhat); PIN(X); SBAR(); }while(0)
  #define VRD(p,i) do{ vlo[p]=vtr(vp_+(((i)>>2)*4096+((i)&3)*1024)); vhi[p]=vtr(vp_+(((i)>>2)*4096+((i)&3)*1024+512)); }while(0)
  #define KRD(G,j) do{ if(G){ kload2(kf,kp0+sl_next,j); SBAR(); } }while(0)
  #define ZC (f32x16{})
  #define STEP(C0,C1,P0,P1,t,GK,GV,GL) do{ SBAR(); \
    const lds_cptr vp_=vp0+2*sl_prev; \
    float sacc=(P0[0]+P0[1]); \
    GAPA(C0=__builtin_amdgcn_mfma_f32_32x32x16_bf16(kf[0],qr[0],ZC,0,0,0), P0[2],P0[3],P0[4],P0[5],     pw0[0]=PKW(P0,0), pw0[1]=PKW(P0,2), pw0); \
    GAPA(C1=__builtin_amdgcn_mfma_f32_32x32x16_bf16(kf[1],qr[0],ZC,0,0,0), P0[6],P0[7],P0[8],P0[9],     pw0[2]=PKW(P0,4), pw0[3]=PKW(P0,6), pw0); \
    GAPA(C0=__builtin_amdgcn_mfma_f32_32x32x16_bf16(kf[2],qr[1],C0,0,0,0),   P0[10],P0[11],P0[12],P0[13], pw1[0]=PKW(P0,8), pw1[1]=PKW(P0,10), pw1); \
    GAPA(C1=__builtin_amdgcn_mfma_f32_32x32x16_bf16(kf[3],qr[1],C1,0,0,0),   P0[14],P0[15],P1[0],P1[1],   pw1[2]=PKW(P0,12),pw1[3]=PKW(P0,14), pw1); \
    GAPA(C0=__builtin_amdgcn_mfma_f32_32x32x16_bf16(kf[4],qr[2],C0,0,0,0),   P1[2],P1[3],P1[4],P1[5],     pw2[0]=PKW(P1,0), pw2[1]=PKW(P1,2), pw2); \
    VRD(0,0); SBAR(); GAPA(C1=__builtin_amdgcn_mfma_f32_32x32x16_bf16(kf[5],qr[2],C1,0,0,0),   P1[6],P1[7],P1[8],P1[9],     pw2[2]=PKW(P1,4), pw2[3]=PKW(P1,6), pw2); \
    VRD(1,4); SBAR(); GAPA(C0=__builtin_amdgcn_mfma_f32_32x32x16_bf16(kf[6],qr[3],C0,0,0,0),   P1[10],P1[11],P1[12],P1[13], pw3[0]=PKW(P1,8), pw3[1]=PKW(P1,10), pw3); \
    VRD(2,1); SBAR(); GAPA(C1=__builtin_amdgcn_mfma_f32_32x32x16_bf16(kf[7],qr[3],C1,0,0,0),   P1[14],P1[15],0.f,0.f,       pw3[2]=PKW(P1,12),pw3[3]=PKW(P1,14), pw3); \
    l_reg+=sacc; \
    if(GK){DMA_K((t)+3,sl_cur);} if(GV){DMA_V((t)+1,sl_next);} \
    CMASK(C0,C1,t); \
    { float a=MX3(C0[0],C0[1],C1[0]),b=MX3(C0[2],C0[3],C1[1]); a=MX3(a,C1[2],C1[3]); \
      _Pragma("unroll") for(int r=4;r<16;r+=4){a=MX3(a,C0[r],C0[r+1]);b=MX3(b,C0[r+2],C0[r+3]);a=MX3(a,C1[r],C1[r+1]);b=MX3(b,C1[r+2],C1[r+3]);} \
      float rm=__builtin_fmaxf(a,b); { auto rr=__builtin_amdgcn_permlane32_swap(__float_as_uint(rm),__float_as_uint(rm),false,false); rm=__builtin_fmaxf(__uint_as_float(rr[0]),__uint_as_float(rr[1])); } \
      rm-=mhat; resc=false; \
      if(__builtin_expect(__any(rm>(float)THRL),0)){ const float dl=__builtin_fmaxf(rm,0.f); mhat+=dl; \
        const float f=__builtin_amdgcn_exp2f(-dl); l_reg*=f; if(hi==0)wsf[r32]=f; resc=true; } } \
    SBAR(); \
    VRD(3,5);  SBAR(); GAPB(o[0]=__builtin_amdgcn_mfma_f32_32x32x16_bf16(PAF(0),VFR(0),o[0],0,0,0), C0,0); \
    VRD(0,2);  SBAR(); GAPB(o[1]=__builtin_amdgcn_mfma_f32_32x32x16_bf16(PAF(0),VFR(1),o[1],0,0,0), C0,2); \
    VRD(1,6);  SBAR(); KRD(GL,0); GAPB(o[0]=__builtin_amdgcn_mfma_f32_32x32x16_bf16(PAF(1),VFR(2),o[0],0,0,0), C0,4); \
    VRD(2,3);  SBAR(); KRD(GL,1); GAPB(o[1]=__builtin_amdgcn_mfma_f32_32x32x16_bf16(PAF(1),VFR(3),o[1],0,0,0), C0,6); \
    VRD(3,7);  SBAR(); KRD(GL,2); GAPB(o[0]=__builtin_amdgcn_mfma_f32_32x32x16_bf16(PAF(2),VFR(0),o[0],0,0,0), C0,8); \
    VRD(0,8);  SBAR(); KRD(GL,3); GAPB(o[1]=__builtin_amdgcn_mfma_f32_32x32x16_bf16(PAF(2),VFR(1),o[1],0,0,0), C0,10); \
    VRD(1,12); SBAR(); GAPB(o[0]=__builtin_amdgcn_mfma_f32_32x32x16_bf16(PAF(3),VFR(2),o[0],0,0,0), C0,12); \
    VRD(2,9);  SBAR(); GAPB(o[1]=__builtin_amdgcn_mfma_f32_32x32x16_bf16(PAF(3),VFR(3),o[1],0,0,0), C0,14); \
    VRD(3,13); SBAR(); GAPB(o[2]=__builtin_amdgcn_mfma_f32_32x32x16_bf16(PAF(0),VFR(0),o[2],0,0,0), C1,0); \
    VRD(0,10); SBAR(); GAPB(o[3]=__builtin_amdgcn_mfma_f32_32x32x16_bf16(PAF(0),VFR(1),o[3],0,0,0), C1,2); \
    VRD(1,14); SBAR(); GAPB(o[2]=__builtin_amdgcn_mfma_f32_32x32x16_bf16(PAF(1),VFR(2),o[2],0,0,0), C1,4); \
    VRD(2,11); SBAR(); GAPB(o[3]=__builtin_amdgcn_mfma_f32_32x32x16_bf16(PAF(1),VFR(3),o[3],0,0,0), C1,6); \
    VRD(3,15); SBAR(); GAPB(o[2]=__builtin_amdgcn_mfma_f32_32x32x16_bf16(PAF(2),VFR(0),o[2],0,0,0), C1,8); \
    GAPB(o[3]=__builtin_amdgcn_mfma_f32_32x32x16_bf16(PAF(2),VFR(1),o[3],0,0,0), C1,10); \
    GAPB(o[2]=__builtin_amdgcn_mfma_f32_32x32x16_bf16(PAF(3),VFR(2),o[2],0,0,0), C1,12); \
    GAPB(o[3]=__builtin_amdgcn_mfma_f32_32x32x16_bf16(PAF(3),VFR(3),o[3],0,0,0), C1,14); \
    }while(0)
  int t=1;
  #undef CMASK
  #define CMASK(P0,P1,t) do{}while(0)
  for(;t+5<NT;t+=2){
    STEP(pB0,pB1,pA0,pA1,t,true,true,true);     WAIT_BAR(3); RESC(); ROT();
    STEP(pA0,pA1,pB0,pB1,t+1,true,true,true);   WAIT_BAR(3); RESC(); ROT();
  }
  #undef CMASK
  #define CMASK(P0,P1,t) do{int jb_=(t)-(NT-4); if(jb_>=0)cmask(P0,P1,jb_,qrel,hi);}while(0)
  #define ENDW(tt) do{ if((tt)+3<NT){WAIT_BAR(3);} else if((tt)+2<NT){WAIT_BAR(2);} else {WAIT_BAR(0);} }while(0)
  for(;t+1<NT;t+=2){
    STEP(pB0,pB1,pA0,pA1,t,(t+3<NT),(t+1<NT),(t+1<NT));       ENDW(t);   RESC(); ROT();
    STEP(pA0,pA1,pB0,pB1,t+1,(t+4<NT),(t+2<NT),(t+2<NT));     ENDW(t+1); RESC(); ROT();
  }
  STEP(pB0,pB1,pA0,pA1,NT-1,false,false,false); RESC();
  { float sacc=pB0[0]+pB0[1]; _Pragma("unroll") for(int r=2;r<16;++r)sacc+=pB0[r]; _Pragma("unroll") for(int r=0;r<16;++r)sacc+=pB1[r]; l_reg+=sacc;
    pw0=(u32x4){PKW(pB0,0),PKW(pB0,2),PKW(pB0,4),PKW(pB0,6)};pw1=(u32x4){PKW(pB0,8),PKW(pB0,10),PKW(pB0,12),PKW(pB0,14)};pw2=(u32x4){PKW(pB1,0),PKW(pB1,2),PKW(pB1,4),PKW(pB1,6)};pw3=(u32x4){PKW(pB1,8),PKW(pB1,10),PKW(pB1,12),PKW(pB1,14)};
    SBAR(); pv(o,vb0+2*sl_cur,PAF(0),PAF(1),PAF(2),PAF(3)); }
  #undef PKW
  #undef PAF
  #undef VFR
  #undef PIN
  #undef MX3
  #undef GAPA
  #undef GAPB
  #undef EX
  #undef VRD
  #undef KRD
  #undef STEP
  #undef ZC
  #undef ENDW
  {auto rr=__builtin_amdgcn_permlane32_swap(__float_as_uint(l_reg),__float_as_uint(l_reg),false,false);l_reg=__uint_as_float(rr[0])+__uint_as_float(rr[1]);}
  if(hi==0)wsf[32+r32]=l_reg;asm volatile("s_waitcnt lgkmcnt(0)":::"memory");
  float rli[16];
  #pragma unroll
  for(int r=0;r<16;++r)rli[r]=__builtin_amdgcn_rcpf(wsf[32+crow(r,hi)]);
  bf16*Ow=O+(rowbase+q0+wid*QBLK)*OP+ocol;
  { bf16*stg=(bf16*)(shm+LDS_OST)+wid*2048;
    #pragma unroll
    for(int h2=0;h2<2;++h2){
    #pragma unroll
    for(int r=0;r<16;++r){const int orow=crow(r,hi);
      #pragma unroll
      for(int d0=0;d0<2;++d0)stg[orow*64+d0*32+r32]=__float2bfloat16(o[2*h2+d0][r]*rli[r]);}
    asm volatile("s_waitcnt lgkmcnt(0)":::"memory");
    #pragma unroll
    for(int i=0;i<4;++i){const int row=i*8+(lane>>3),ch=lane&7; const u32x4 v=*(const u32x4*)(stg+row*64+ch*8); ATTN_STORE16(Ow+(long)row*OP+h2*64+ch*8,v);}
    asm volatile("s_waitcnt lgkmcnt(0)":::"memory"); } }
  asm volatile("s_waitcnt lgkmcnt(0)\n\ts_barrier":::"memory");
  #undef DMA_K
  #undef TOFF
  #undef DMA_V
  #undef CMASK
  #undef START
  #undef RESC
  #undef ROT
}
constexpr int ATTN_LDS_BYTES=LDS_BYTES;
struct AttnTensors { const bf16* Q; const bf16* K; const bf16* V; bf16* O; };
struct AttnUnit { int bh; int qb; };
struct StaticOrder {
  int vcu;
  __device__ __forceinline__ explicit StaticOrder(int grid,int block):vcu((block%8)*(grid/8)+block/8){}
  __device__ __forceinline__ bool next(int i,AttnUnit&u)const{ if(i>=4)return false; const int p=vcu&7; u.bh=(vcu>>3)*2+(i>>1); u.qb=(i&1)?15-p:p; return true; }
  __device__ __forceinline__ void a_ready(const AttnUnit&)const{}
  __device__ __forceinline__ void done(const AttnUnit&)const{}
};
template<class Sched,int THRL=8> __device__ __forceinline__ void attn_phase(char*lds,const AttnTensors&T,const Sched&S){
  AttnUnit u;
  for(int i=0;S.next(i,u);++i){ S.a_ready(u); attn_unit<THRL>(u.bh/NHC,u.bh%NHC,u.qb,T.Q,T.K,T.V,T.O,lds); S.done(u); }
}
#undef SBAR
#undef WAIT_BAR
}

#define GAS __attribute__((address_space(1)))
#define LAS __attribute__((address_space(3)))
typedef unsigned v4u __attribute__((ext_vector_type(4)));
typedef GAS unsigned gu32;
typedef GAS unsigned long long gu64;
#define RLX_AGENT __ATOMIC_RELAXED, __HIP_MEMORY_SCOPE_AGENT
#define LDS_WAIT() asm volatile("s_waitcnt lgkmcnt(0)" ::: "memory")
#define VM_WAIT() asm volatile("s_waitcnt vmcnt(0)" ::: "memory")
__device__ __forceinline__ unsigned pk2(float lo, float hi) { return f2bf(lo) | (f2bf(hi) << 16); }

#define XB_TMO      128
#define XB_XCNT(j)  (256  + 64 * (j))
#define XB_XSUB(j)  (1280 + 64 * (j))
#define XB_XGEN(j)  (2304 + 64 * (j))
#define XB_TOP      3328
#define XB_TOPGEN   3392
#define XCD_BAR_WORDS 3456
#define XB_SPIN_CAP (1u << 18)

__device__ __forceinline__ unsigned xb_ld(unsigned* p)              { return __hip_atomic_load(p, __ATOMIC_RELAXED, __HIP_MEMORY_SCOPE_AGENT); }
__device__ __forceinline__ unsigned xb_add(unsigned* p, unsigned v) { return __hip_atomic_fetch_add(p, v, __ATOMIC_RELAXED, __HIP_MEMORY_SCOPE_AGENT); }
__device__ __forceinline__ unsigned xb_xcc_id() { return (unsigned)__builtin_amdgcn_s_getreg((3 << 11) | 20) & 0xFu; }
#define XB_SPIN(cond, bar) do { unsigned _sp = 0; while (cond) { __builtin_amdgcn_s_sleep(1); \
    if ((++_sp & 255u) == 0u) { if (xb_ld(&(bar)[XB_TMO])) break; if (_sp > XB_SPIN_CAP) { atomicAdd(&(bar)[XB_TMO], 1u); break; } } } } while (0)

struct XcdBarrier {
    unsigned* bar; unsigned x;
    volatile LAS unsigned* st;
};

__device__ __forceinline__ XcdBarrier xcd_barrier_post(unsigned* bar, volatile LAS unsigned* st) {
    XcdBarrier b; b.bar = bar; b.x = xb_xcc_id(); b.st = st;
    if (threadIdx.x == 0) (void)xb_add(&bar[XB_XCNT(b.x)], 1u);
    return b;
}
__device__ __forceinline__ void xcd_barrier_complete(unsigned* bar, unsigned x, unsigned& nloc, unsigned& nx) {
    const unsigned G = gridDim.x * gridDim.y * gridDim.z;
    unsigned sum, cnt, mine, sp = 0u;
    for (;;) {
        sum = 0u; cnt = 0u; mine = 0u;
#pragma unroll
        for (unsigned j = 0; j < 16; ++j) { const unsigned c = xb_ld(&bar[XB_XCNT(j)]); sum += c; cnt += (c > 0u) ? 1u : 0u; mine = (j == x) ? c : mine; }
        if (sum == G) break;
        __builtin_amdgcn_s_sleep(1);
        if ((++sp & 255u) == 0u) { if (xb_ld(&bar[XB_TMO])) break; if (sp > XB_SPIN_CAP) { atomicAdd(&bar[XB_TMO], 1u); break; } }
    }
    nloc = mine > 0u ? mine : 1u; nx = cnt > 0u ? cnt : 1u;
}

__device__ __forceinline__ void xcd_barrier(const XcdBarrier& b) {
    asm volatile("s_waitcnt vmcnt(0)" ::: "memory");
    __syncthreads();
    if (threadIdx.x == 0) {
        unsigned* bar = b.bar;
        __builtin_amdgcn_s_waitcnt(0);
        unsigned nloc = b.st[0], nx = b.st[1];
        if (nloc == 0u) { xcd_barrier_complete(bar, b.x, nloc, nx); b.st[0] = nloc; b.st[1] = nx; }
        const unsigned old = xb_add(&bar[XB_XSUB(b.x)], 1u);
        const unsigned gen = old / nloc;
        if (old + 1u == (gen + 1u) * nloc) {
            __builtin_amdgcn_fence(__ATOMIC_RELEASE, "agent");
            asm volatile("s_waitcnt vmcnt(0)" ::: "memory");
            const unsigned og = xb_add(&bar[XB_TOP], 1u);
            const unsigned tg = og / nx;
            if (og + 1u == (tg + 1u) * nx) xb_add(&bar[XB_TOPGEN], 1u);
            else XB_SPIN(xb_ld(&bar[XB_TOPGEN]) == tg, bar);
            __builtin_amdgcn_fence(__ATOMIC_ACQUIRE, "agent");
            xb_add(&bar[XB_XGEN(b.x)], 1u);
            asm volatile("s_waitcnt vmcnt(0)" ::: "memory");
        } else {
            XB_SPIN(xb_ld(&bar[XB_XGEN(b.x)]) == gen, bar);
            __builtin_amdgcn_fence(__ATOMIC_ACQUIRE, "agent");
            asm volatile("s_waitcnt vmcnt(0)" ::: "memory");
        }
    }
    __syncthreads();
}

constexpr int NWAVES = 8;
constexpr int RING_OFF = 0, RING_BYTES = 131072;
constexpr int LDSCTL_OFF = RING_BYTES, MISC_OFF = LDSCTL_OFF + 320;
constexpr int LDS_BYTES = 147456;

constexpr int CW_XCC = 8192;
constexpr int CW_PANEL = 8448;
__device__ __forceinline__ void panel_sync(gu32* ctl, unsigned* tmo, int seam, int pm, bool same_xcc) {
    asm volatile("s_waitcnt vmcnt(0)" ::: "memory");
    __syncthreads();
    if (threadIdx.x == 0) {
        gu32* c = ctl + CW_PANEL + (seam * 64 + pm) * 16;
        if (!same_xcc) { __builtin_amdgcn_fence(__ATOMIC_RELEASE, "agent"); asm volatile("s_waitcnt vmcnt(0)" ::: "memory"); }
        __hip_atomic_fetch_add(c, 1u, __ATOMIC_RELAXED, __HIP_MEMORY_SCOPE_AGENT);
        unsigned sp = 0;
        while (__hip_atomic_load(c, __ATOMIC_RELAXED, __HIP_MEMORY_SCOPE_AGENT) < 4u) { __builtin_amdgcn_s_sleep(1);
            if ((++sp & 255u) == 0u) { if (xb_ld(tmo)) break; if (sp > XB_SPIN_CAP) { atomicAdd(tmo, 1u); break; } } }
        __builtin_amdgcn_fence(__ATOMIC_ACQUIRE, "agent");
        asm volatile("s_waitcnt vmcnt(0)" ::: "memory");
    }
    __syncthreads();
}
constexpr int CW_BAR = 4096;

struct Frame {
    LAS unsigned char* lds;
    volatile LAS unsigned* MISC;
    gu32* ctl;
    int tid, lane, wave, vcu, G;
    const float* in[19]; float* out; unsigned char* ws;
};
struct WDesc { const float* W; const float* gain; bf16* WT; int ldn, c0, K, ncols, roff, mode; };
__device__ __forceinline__ WDesc wdesc(const Frame& F, int i) {
    unsigned char* ws = F.ws; WDesc d;
    switch (i) {
    case 0:  d = WDesc{F.in[2], F.in[1], (bf16*)(ws + WS_WIN), GIN, 0, D, 3072, 0, 0}; break;
    case 1:  d = WDesc{F.in[6], nullptr, (bf16*)(ws + WS_WAO), D, 0, D, D, 0, 0}; break;
    case 2:  d = WDesc{F.in[17], F.in[16], (bf16*)(ws + WS_W1A), FF, 0, D, FF, 0, 0}; break;
    case 3:  d = WDesc{F.in[18], nullptr, (bf16*)(ws + WS_W2A), D, 0, FF, D, 0, 0}; break;
    case 4:  d = WDesc{F.in[8], F.in[7], (bf16*)(ws + WS_WKVQ), 2048, 0, D, 2048, 0, 1}; break;
    case 5:  d = WDesc{F.in[11], F.in[10], (bf16*)(ws + WS_WKVQ), D, 0, D, D, 2048, 1}; break;
    case 6:  d = WDesc{F.in[15], nullptr, (bf16*)(ws + WS_WBO), D, 0, D, D, 0, 0}; break;
    case 7:  d = WDesc{F.in[17] + (size_t)D * FF, F.in[16] + D, (bf16*)(ws + WS_W1B), FF, 0, D, FF, 0, 0}; break;
    default: d = WDesc{F.in[18] + (size_t)D * FF, nullptr, (bf16*)(ws + WS_W2B), D, 0, FF, D, 0, 0}; break;
    }
    return d;
}
__device__ __forceinline__ void p0_transpose_item(const WDesc& d, LAS float* scr, int item, int lane) {
    const int nblk = d.ncols / 64, kb = item / nblk, nb = item % nblk, k0 = 64 * kb, n0 = 64 * nb;
    const int kq = lane >> 4, n4 = (lane & 15) * 4;
    f32x4 v[16];
#pragma unroll
    for (int i = 0; i < 16; ++i) v[i] = __builtin_nontemporal_load((const GAS f32x4*)(d.W + (size_t)(k0 + 4 * i + kq) * d.ldn + d.c0 + n0 + n4));
    const int c = lane & 7;
    f32x4 g0 = (f32x4){1.f, 1.f, 1.f, 1.f}, g1 = g0;
    if (d.gain) { g0 = *(const GAS f32x4*)(d.gain + k0 + 8 * c); g1 = *(const GAS f32x4*)(d.gain + k0 + 8 * c + 4); }
#pragma unroll
    for (int i = 0; i < 16; ++i) { const int kk = 4 * i + kq; *(LAS f32x4*)(scr + kk * 64 + (n4 ^ (kk & 0x38))) = v[i]; }
    LDS_WAIT(); asm volatile("" ::: "memory");
#pragma unroll
    for (int jj = 0; jj < 8; ++jj) { const int n = (lane >> 3) + 8 * jj; const LAS float* sp = scr + (8 * c) * 64 + (n ^ (c << 3));
        const int dr = d.mode ? kvq_dest_row(d.roff + n0 + n) : d.roff + n0 + n;
        v4u o; o.x = pk2(sp[0 * 64] * g0[0], sp[1 * 64] * g0[1]); o.y = pk2(sp[2 * 64] * g0[2], sp[3 * 64] * g0[3]); o.z = pk2(sp[4 * 64] * g1[0], sp[5 * 64] * g1[1]); o.w = pk2(sp[6 * 64] * g1[2], sp[7 * 64] * g1[3]);
        pg8::store16_wt((void*)(d.WT + (size_t)dr * d.K + k0 + 8 * c), o); }
    LDS_WAIT(); asm volatile("" ::: "memory");
}
__device__ __forceinline__ float wave_sum(float v) {
#pragma unroll
    for (int o = 1; o < 64; o <<= 1) v += __shfl_xor(v, o);
    return v;
}
template <int NR> __device__ __forceinline__ void rows_to_bf16(const Frame& F, const float* xrow, bf16* orow, float* ssrow) {
    f32x4 v[NR][4];
#pragma unroll
    for (int r = 0; r < NR; ++r)
#pragma unroll
        for (int j = 0; j < 4; ++j) v[r][j] = __builtin_nontemporal_load(((const GAS f32x4*)(xrow + (size_t)r * D) + F.lane) + 64 * j);
#pragma unroll
    for (int r = 0; r < NR; ++r) { float s = 0.f;
#pragma unroll
        for (int j = 0; j < 4; ++j) s += (v[r][j].x * v[r][j].x + v[r][j].y * v[r][j].y) + (v[r][j].z * v[r][j].z + v[r][j].w * v[r][j].w);
        s = wave_sum(s);
        if (F.lane < 16) ssrow[(size_t)r * 16 + F.lane] = (F.lane == 0) ? s : 0.f;
        GAS unsigned long long* o8 = (GAS unsigned long long*)(orow + (size_t)r * D) + F.lane;
#pragma unroll
        for (int j = 0; j < 4; ++j) o8[64 * j] = (unsigned long long)pk2(v[r][j].x, v[r][j].y) | ((unsigned long long)pk2(v[r][j].z, v[r][j].w) << 32); }
}
__device__ __forceinline__ void p0_prologue(Frame& F) {
    LAS float* scr = (LAS float*)(F.lds + RING_OFF + F.wave * 16384);
    const int gw = F.vcu * NWAVES + F.wave, NGW = F.G * NWAVES;
    int base = 0;
    for (int mi = 0; mi < 9; ++mi) {
        const WDesc d = wdesc(F, mi); const int nit = (d.K / 64) * (d.ncols / 64);
        int it = gw - (base % NGW); if (it < 0) it += NGW;
        for (; it < nit; it += NGW) p0_transpose_item(d, scr, it, F.lane);
        base += nit;
    }
    { const float* W = F.in[2]; const float* g = F.in[1]; bf16* Wz = (bf16*)(F.ws + WS_WZ);
      for (int idx = gw * 64 + F.lane; idx < 16 * D; idx += NGW * 64) { const int k = idx >> 4, r = idx & 15; Wz[(size_t)r * D + k] = (bf16)f2bf(W[(size_t)k * GIN + 3072 + r] * g[k]); } }
    bf16* XB = (bf16*)(F.ws + WS_A); float* SS = (float*)(F.ws + WS_SS);
    for (int m = 4 * gw; m < T; m += 4 * NGW) rows_to_bf16<4>(F, F.in[0] + (size_t)m * D, XB + (size_t)m * D, SS + (size_t)m * 16);
}


__device__ __forceinline__ void combine_local(Frame& F) {
    const int lane = F.lane, wave = F.wave;
    const float* lp = F.in[13]; const float* hg = F.in[14];
    const float s1 = wave_sum(lp[lane] * lp[64 + lane]), s2 = wave_sum(lp[128 + lane] * lp[192 + lane]);
    const float lam = __expf(s1) - __expf(s2) + LAMBDA_INIT;
    const int bhh = F.vcu >> 3, p = F.vcu & 7, b = bhh >> 3, h = bhh & 7, sg = lane & 7;
    float g[16];
#pragma unroll
    for (int j = 0; j < 16; ++j) g[j] = hg[16 * sg + j] * (1.f - LAMBDA_INIT);
    const bf16* O32 = (const bf16*)F.out; bf16* OD = (bf16*)(F.ws + WS_C);
    asm volatile("s_waitcnt vmcnt(0)" ::: "memory"); __syncthreads();
    for (int it0 = 0; it0 < 8; it0 += 4) {
        bf16x8 a0[4], a1[4], b0[4], b1[4]; size_t tt[4];
#pragma unroll
        for (int q = 0; q < 4; ++q) { const int r = (it0 + q) * 64 + wave * 8 + (lane >> 3);
            tt[q] = (size_t)b * SEQ + (size_t)((r < 256) ? p : 15 - p) * 256 + (r & 255);
            const bf16* p0 = O32 + tt[q] * 2048 + (2 * h) * 128 + 16 * sg;
            a0[q] = *(const bf16x8*)p0; a1[q] = *(const bf16x8*)(p0 + 8); b0[q] = *(const bf16x8*)(p0 + 128); b1[q] = *(const bf16x8*)(p0 + 136); }
#pragma unroll
        for (int q = 0; q < 4; ++q) {
            float o[16]; float s = 0.f;
#pragma unroll
            for (int j = 0; j < 8; ++j) { o[j] = bf2f((unsigned short)a0[q][j]) - lam * bf2f((unsigned short)b0[q][j]); o[8 + j] = bf2f((unsigned short)a1[q][j]) - lam * bf2f((unsigned short)b1[q][j]); }
#pragma unroll
            for (int j = 0; j < 16; ++j) s += o[j] * o[j];
            s += __shfl_xor(s, 1); s += __shfl_xor(s, 2); s += __shfl_xor(s, 4);
            const float rstd = __builtin_amdgcn_rsqf(s * (1.f / 128.f) + EPS);
            v4u w0, w1;
            w0.x = pk2(o[0] * rstd * g[0], o[1] * rstd * g[1]); w0.y = pk2(o[2] * rstd * g[2], o[3] * rstd * g[3]); w0.z = pk2(o[4] * rstd * g[4], o[5] * rstd * g[5]); w0.w = pk2(o[6] * rstd * g[6], o[7] * rstd * g[7]);
            w1.x = pk2(o[8] * rstd * g[8], o[9] * rstd * g[9]); w1.y = pk2(o[10] * rstd * g[10], o[11] * rstd * g[11]); w1.z = pk2(o[12] * rstd * g[12], o[13] * rstd * g[13]); w1.w = pk2(o[14] * rstd * g[14], o[15] * rstd * g[15]);
            bf16* qd = OD + tt[q] * 1024 + h * 128 + 16 * sg;
            *(v4u*)qd = w0; *(v4u*)(qd + 8) = w1; }
    }
}
constexpr int RT_OFF = 132096;
__device__ __forceinline__ unsigned off_b(unsigned row, unsigned ch) { return 256u * row + 16u * (ch ^ (((row & 3) << 2) | ((row >> 2) & 3))); }
__device__ __forceinline__ unsigned row_addr16(unsigned lane, unsigned rb, unsigned s) { return off_b((lane & 15) + 16 * rb, 4 * s + (lane >> 4)); }
__device__ __forceinline__ unsigned tr_addr16(unsigned lane, unsigned c, unsigned ks, unsigned t) { const unsigned g = lane >> 4, q = (lane & 15) >> 2, p = lane & 3; return off_b(32 * ks + 8 * g + 4 * t + q, 2 * c + (p >> 1)) + 8 * (p & 1); }
typedef short v4i16_t __attribute__((ext_vector_type(4)));
__device__ __forceinline__ bf16x8 tr_frag(LAS unsigned char* img, unsigned lane, unsigned c, unsigned ks) {
    const v4i16_t lo = __builtin_amdgcn_ds_read_tr16_b64_v4i16((LAS v4i16_t*)(img + tr_addr16(lane, c, ks, 0)));
    const v4i16_t hi = __builtin_amdgcn_ds_read_tr16_b64_v4i16((LAS v4i16_t*)(img + tr_addr16(lane, c, ks, 1)));
    return (bf16x8){lo[0], lo[1], lo[2], lo[3], hi[0], hi[1], hi[2], hi[3]};
}
__device__ __forceinline__ bf16x8 row_frag(LAS unsigned char* img, unsigned lane, unsigned rb, unsigned s) { return *(const LAS bf16x8*)(img + row_addr16(lane, rb, s)); }
#define MFMA16(a, b, c) __builtin_amdgcn_mfma_f32_16x16x32_bf16(a, b, c, 0, 0, 0)

constexpr int ZP_OFF = 137216;
__device__ __forceinline__ void gate_phase(Frame& F) {
    LAS float* ZP = (LAS float*)(F.lds + ZP_OFF);
    const bf16* XB = (const bf16*)(F.ws + WS_A); const bf16* Wz = (const bf16*)(F.ws + WS_WZ); const float* wgu = F.in[3]; const float* bg = F.in[4]; unsigned char* SL = F.ws + WS_B;
    const float* SS = (const float*)(F.ws + WS_SS);
    const int lane = F.lane, wave = F.wave, fr = lane & 15, fq = lane >> 4;
    LAS float* ST = (LAS float*)(F.lds + wave * 16384);
    float wb[4][4], bb[4];
#pragma unroll
    for (int nt = 0; nt < 4; ++nt) { bb[nt] = bg[64 * wave + 16 * nt + fr];
#pragma unroll
        for (int kk = 0; kk < 4; ++kk) wb[nt][kk] = wgu[(4 * kk + fq) * 512 + 64 * wave + 16 * nt + fr]; }
    for (int u = F.vcu; u < T / CH; u += F.G) {
        const size_t t0 = (size_t)u * CH;
        { const int mt = wave & 3, kh = wave >> 2; f32x4 acc = (f32x4){0.f, 0.f, 0.f, 0.f};
          const bf16* ap = XB + (t0 + mt * 16 + fr) * D + kh * 512 + 8 * fq; const bf16* bp = Wz + (size_t)fr * D + kh * 512 + 8 * fq;
#pragma unroll
          for (int ks = 0; ks < 16; ++ks) acc = MFMA16(__builtin_nontemporal_load((const bf16x8*)(ap + ks * 32)), *(const bf16x8*)(bp + ks * 32), acc);
#pragma unroll
          for (int j = 0; j < 4; ++j) ZP[(kh * 64 + mt * 16 + 4 * fq + j) * 17 + fr] = acc[j] * pg8::row_rstd(SS, (int)t0 + mt * 16 + 4 * fq + j); }
        __syncthreads();
        float carry[4] = {0.f, 0.f, 0.f, 0.f};
#pragma unroll 1
        for (int mt = 0; mt < 4; ++mt) {
            float za[4];
#pragma unroll
            for (int kk = 0; kk < 4; ++kk) za[kk] = ZP[(mt * 16 + fr) * 17 + 4 * kk + fq] + ZP[(64 + mt * 16 + fr) * 17 + 4 * kk + fq];
#pragma unroll
            for (int nt = 0; nt < 4; ++nt) {
                f32x4 x = (f32x4){bb[nt], bb[nt], bb[nt], bb[nt]};
#pragma unroll
                for (int kk = 0; kk < 4; ++kk) x = __builtin_amdgcn_mfma_f32_16x16x4f32(za[kk], wb[nt][kk], x, 0, 0, 0);
                float p[4]; float run = 0.f;
#pragma unroll
                for (int r = 0; r < 4; ++r) { const float ls = fminf(x[r], 0.f) - __logf(1.f + __expf(-fabsf(x[r]))); run += ls * (1.f / 16.f); p[r] = run; }
                float s1 = run; { const float t = __shfl_up(s1, 16); if (fq >= 1) s1 += t; }
                float s2 = s1;  { const float t = __shfl_up(s2, 32); if (fq >= 2) s2 += t; }
                const float base = carry[nt] + (s2 - run);
                carry[nt] += __shfl(s2, 48 + fr);
#pragma unroll
                for (int r = 0; r < 4; ++r) { const int row = mt * 16 + 4 * fq + r; ST[row * 64 + ((16 * nt + fr) ^ (((row >> 2) & 3) << 4))] = base + p[r]; }
            }
        }
        LDS_WAIT(); asm volatile("" ::: "memory");
#pragma unroll
        for (int i = 0; i < 16; ++i) { const int row = 4 * i + fq; const f32x4 v = *(const LAS f32x4*)(ST + row * 64 + ((4 * fr) ^ (((row >> 2) & 3) << 4)));
            *(f32x4*)((float*)(SL + (size_t)(u >> 2) * PSLOT + PBC) + ((u & 3) * 64 + row) * 512 + 64 * wave + 4 * fr) = v; }
        __syncthreads();
    }
}

struct GlaSet { unsigned k0, k1, k2, k3; f32x4 bca, bcb, bla, blb; v4u va, vb; float dca, dcb; };
__device__ __forceinline__ void gla_state_phase(Frame& F) {
    LAS unsigned char* lds = F.lds;
    bf16* SP = (bf16*)F.out;
    const int tid = F.tid, lane = F.lane, wave = F.wave;
    const int pos = tid >> 3, sub = tid & 7, mt = wave >> 1, nt = wave & 1;
    constexpr int NP = NCH / 2;
    for (int u = F.vcu; u < 256; u += F.G) {
        const int bh = u >> 4, ki = (u >> 2) & 3, vi = u & 3, b = bh >> 2, h = bh & 3;
        const unsigned char* SL = F.ws + WS_B + (size_t)(16 * b) * PSLOT;
        const int koff = pos * 512 + h * GDK + ki * 32 + sub * 4, loff = 63 * 512 + h * GDK + ki * 32 + sub * 4;
        const int voff = pos * 1024 + h * GDV + vi * 64 + sub * 8, doff = 63 * 512 + h * GDK + ki * 32 + nt * 16 + (lane & 15);
        bf16* spp = SP + ((size_t)(bh * NP) * GDV + vi * 64 + mt * 16 + 4 * (lane >> 4)) * GDK + ki * 32 + nt * 16 + (lane & 15);
        const unsigned kw = off_b(pos, sub >> 1) + 8 * (sub & 1), vw = off_b(pos, sub);
        f32x4 acc = (f32x4){0.f, 0.f, 0.f, 0.f};
#define GLA_LOAD(S, m) do { const unsigned char* sl_ = SL + (size_t)((m) >> 1) * PSLOT; const int r_ = ((m) & 1) * 128; \
        const bf16* kp_ = (const bf16*)(sl_ + PK) + r_ * 512 + koff; const float* bp_ = (const float*)(sl_ + PBC) + r_ * 512; const bf16* vp_ = (const bf16*)(sl_ + PV) + r_ * 1024 + voff; \
        { const unsigned long long ka_ = *(const unsigned long long*)kp_, kb_ = *(const unsigned long long*)(kp_ + 64 * 512); S.k0 = (unsigned)ka_; S.k1 = (unsigned)(ka_ >> 32); S.k2 = (unsigned)kb_; S.k3 = (unsigned)(kb_ >> 32); } \
        S.bca = *(const f32x4*)(bp_ + koff); S.bcb = *(const f32x4*)(bp_ + koff + 64 * 512); S.bla = *(const f32x4*)(bp_ + loff); S.blb = *(const f32x4*)(bp_ + loff + 64 * 512); \
        S.va = *(const v4u*)vp_; S.vb = *(const v4u*)(vp_ + 64 * 1024); S.dca = bp_[doff]; S.dcb = bp_[doff + 64 * 512]; } while (0)
#define GLA_STEP(S, m, buf) do { \
        { const f32x4 ea = S.bla + S.blb - S.bca, eb = S.blb - S.bcb;                                    \
          const unsigned w0 = pk2(bf2f(S.k0 & 0xffffu) * __expf(ea[0]), bf2f(S.k0 >> 16) * __expf(ea[1])), w1 = pk2(bf2f(S.k1 & 0xffffu) * __expf(ea[2]), bf2f(S.k1 >> 16) * __expf(ea[3])); \
          const unsigned w2 = pk2(bf2f(S.k2 & 0xffffu) * __expf(eb[0]), bf2f(S.k2 >> 16) * __expf(eb[1])), w3 = pk2(bf2f(S.k3 & 0xffffu) * __expf(eb[2]), bf2f(S.k3 >> 16) * __expf(eb[3])); \
          *(LAS unsigned long long*)(lds + (buf) * 65536 + kw) = (unsigned long long)w0 | ((unsigned long long)w1 << 32); \
          *(LAS unsigned long long*)(lds + (buf) * 65536 + 16384 + kw) = (unsigned long long)w2 | ((unsigned long long)w3 << 32); \
          *(LAS v4u*)(lds + (buf) * 65536 + 32768 + vw) = S.va; *(LAS v4u*)(lds + (buf) * 65536 + 49152 + vw) = S.vb; } \
        const float dec_ = __expf(S.dca + S.dcb); \
        if ((m) + 2 < NP) GLA_LOAD(S, (m) + 2); \
        __syncthreads(); \
        _Pragma("unroll") for (int j = 0; j < 4; ++j) __builtin_nontemporal_store((bf16)f2bf(acc[j]), spp + (size_t)(m) * GDV * GDK + j * GDK); \
        acc = acc * dec_; \
        _Pragma("unroll") for (int ks = 0; ks < 4; ++ks) acc = MFMA16(tr_frag(lds + (buf) * 65536 + 32768, lane, mt, ks), tr_frag(lds + (buf) * 65536, lane, nt, ks), acc); } while (0)
        GlaSet s0, s1;
        GLA_LOAD(s0, 0); GLA_LOAD(s1, 1);
        for (int m = 0; m < NP; m += 2) { GLA_STEP(s0, m, 0); GLA_STEP(s1, m + 1, 1); }
#undef GLA_LOAD
#undef GLA_STEP
        __syncthreads();
    }
}

struct GlaRaw { bf16x8 q[4], k[4]; f32x4 b0[4], b1[4], l0, l1; };
__device__ __forceinline__ void gla_out_phase(Frame& F) {
    LAS unsigned char* lds = F.lds;
    LAS unsigned char *QI = lds, *AI = lds + 16384, *KI = lds + 32768, *VI = lds + 65536, *OL = lds;
    LAS float* RED = (LAS float*)(lds + RT_OFF); LAS float* RS = RED + 512;
    const int pm = 8 * ((int)blockIdx.x & 7) + (((int)blockIdx.x >> 3) & 7), hq = ((int)blockIdx.x >> 6) & 3;
    const unsigned char* SL = F.ws + WS_B + (size_t)pm * PSLOT;
    const bf16* QG = (const bf16*)(SL + PQ); const bf16* KG = (const bf16*)(SL + PK); const bf16* VG = (const bf16*)(SL + PV); const bf16* GGp = (const bf16*)(SL + PG);
    const float* BC = (const float*)(SL + PBC); const bf16* SP = (const bf16*)F.out; bf16* OG = (bf16*)(F.ws + WS_C) + (size_t)pm * 256 * 1024; const float* hg = F.in[5];
    const int tid = F.tid, lane = F.lane, wave = F.wave, fr = lane & 15, fq = lane >> 4;
    const float g0 = hg[32 * wave + fr], g1 = hg[32 * wave + 16 + fr];
    constexpr int NU = 2;
#define GLA_T0(u) ((size_t)(u) * (2 * CH))
#define GLA_H(u) (hq)
#define GLA_LOADRAW(R, u) do { const size_t t0_ = GLA_T0(u); const int h_ = GLA_H(u); \
        _Pragma("unroll") for (int r = 0; r < 4; ++r) { const int n = tid + 512 * r, pos = n >> 4, ch = n & 15; const size_t e = (t0_ + pos) * 512 + h_ * GDK + ch * 8; \
            R.q[r] = __builtin_nontemporal_load((const bf16x8*)(QG + e)); R.k[r] = __builtin_nontemporal_load((const bf16x8*)(KG + e)); \
            R.b0[r] = __builtin_nontemporal_load((const f32x4*)(BC + e)); R.b1[r] = __builtin_nontemporal_load((const f32x4*)(BC + e + 4)); } \
        { const size_t e = (t0_ + 63) * 512 + h_ * GDK + (tid & 15) * 8; R.l0 = *(const f32x4*)(BC + e); R.l1 = *(const f32x4*)(BC + e + 4); } } while (0)
#define GLA_LOADSF(u) do { const bf16* sp = SP + ((size_t)((((pm >> 4) * 4 + hq) * 32) + 2 * (pm & 15) + (u)) * GDV + 32 * wave + fr) * GDK + 8 * fq; \
        _Pragma("unroll") for (int nt = 0; nt < 2; ++nt) _Pragma("unroll") for (int ks = 0; ks < 4; ++ks) sf[nt][ks] = __builtin_nontemporal_load((const bf16x8*)(sp + nt * 16 * GDK + ks * 32)); } while (0)
    int u = 0;
    bf16x8 sf[2][4];
    GLA_LOADSF(u);
    for (;;) {
        const size_t t0 = GLA_T0(u); const int h = GLA_H(u); const int un = u + 1; const bool has_next = un < NU;
        GlaRaw R; GLA_LOADRAW(R, u);
        v4u vv[8];
#pragma unroll
        for (int r = 0; r < 8; ++r) { const int n = tid + 512 * r, pos = n >> 5, c32 = n & 31; vv[r] = __builtin_nontemporal_load((const v4u*)(VG + (t0 + pos) * 1024 + h * GDV + c32 * 8)); }
        v4u wq1[2];
#pragma unroll
        for (int r = 0; r < 4; ++r) { const int n = tid + 512 * r, pos = n >> 4, ch = n & 15;
            float qq[8], kk[8];
#pragma unroll
            for (int j = 0; j < 8; ++j) { float bj = j < 4 ? R.b0[r][j & 3] : R.b1[r][j & 3]; if (r >= 2) bj += j < 4 ? R.l0[j & 3] : R.l1[j & 3]; const float ex = __expf(bj);
                qq[j] = bf2f((unsigned short)R.q[r][j]) * ex * 0.08838834764831845f; kk[j] = bf2f((unsigned short)R.k[r][j]) * __builtin_amdgcn_rcpf(ex); }
            v4u wqr; wqr.x = pk2(qq[0], qq[1]); wqr.y = pk2(qq[2], qq[3]); wqr.z = pk2(qq[4], qq[5]); wqr.w = pk2(qq[6], qq[7]);
            if (r < 2) *(LAS v4u*)(QI + off_b(pos, ch)) = wqr; else wq1[r - 2] = wqr;
            v4u wk; wk.x = pk2(kk[0], kk[1]); wk.y = pk2(kk[2], kk[3]); wk.z = pk2(kk[4], kk[5]); wk.w = pk2(kk[6], kk[7]);
            *(LAS v4u*)(KI + (pos >> 6) * 16384 + off_b(pos & 63, ch)) = wk; }
        {
#pragma unroll
          for (int r = 0; r < 8; ++r) { const int n = tid + 512 * r, pos = n >> 5, c32 = n & 31; *(LAS v4u*)(VI + ((pos >> 6) * 2 + (c32 >> 4)) * 16384 + off_b(pos & 63, c32 & 15)) = vv[r]; } }
#pragma unroll 1
        for (int hf = 0; hf < 2; ++hf) {
            if (hf) {
#pragma unroll
                for (int r = 0; r < 2; ++r) { const int n = tid + 512 * r, pos = n >> 4, ch = n & 15; *(LAS v4u*)(QI + off_b(pos, ch)) = wq1[r]; } }
            __syncthreads();
            { const int mt = wave >> 1;
#pragma unroll
              for (int q = 0; q < (hf ? 4 : 2); ++q) { const int nt = (hf ? 4 : 2) * (wave & 1) + q; f32x4 a4 = (f32x4){0.f, 0.f, 0.f, 0.f};
                  const bool diag = hf ? (nt >= 4) : true; const int ntl = (hf && nt >= 4) ? nt - 4 : nt;
                  if (!diag || ntl <= mt) { LAS unsigned char* kimg = KI + ((hf && nt >= 4) ? 16384 : 0);
#pragma unroll
                      for (int ks = 0; ks < 4; ++ks) a4 = MFMA16(row_frag(QI, lane, mt, ks), row_frag(kimg, lane, ntl, ks), a4); }
#pragma unroll
                  for (int r = 0; r < 4; ++r) { const int ii = mt * 16 + 4 * fq + r, jl = ntl * 16 + fr, jj = nt * 16 + fr; const float val = (!diag || jl <= ii) ? a4[r] : 0.f;
                      *(LAS unsigned short*)(AI + off_b(ii, jj >> 3) + 2 * (jj & 7)) = (unsigned short)f2bf(val); } } }
            __syncthreads();
            f32x4 o[4][2];
#pragma unroll
            for (int m = 0; m < 4; ++m) { o[m][0] = (f32x4){0.f, 0.f, 0.f, 0.f}; o[m][1] = (f32x4){0.f, 0.f, 0.f, 0.f}; }
#pragma unroll
            for (int ks = 0; ks < (hf ? 4 : 2); ++ks) { bf16x8 bfr[2];
#pragma unroll
                for (int nt = 0; nt < 2; ++nt) { const int dv = 32 * wave + 16 * nt; bfr[nt] = tr_frag(VI + ((ks >> 1) * 2 + (dv >> 7)) * 16384, lane, (dv & 127) >> 4, ks & 1); }
#pragma unroll
                for (int m = 0; m < 4; ++m) { const bf16x8 a = row_frag(AI, lane, m, ks); o[m][0] = MFMA16(a, bfr[0], o[m][0]); o[m][1] = MFMA16(a, bfr[1], o[m][1]); } }
#pragma unroll
            for (int ks = 0; ks < 4; ++ks)
#pragma unroll
                for (int m = 0; m < 4; ++m) { const bf16x8 a = row_frag(QI, lane, m, ks); o[m][0] = MFMA16(a, sf[0][ks], o[m][0]); o[m][1] = MFMA16(a, sf[1][ks], o[m][1]); }
            bf16x8 gv[4];
#pragma unroll
            for (int r = 0; r < 4; ++r) { const int n = tid + 512 * r, pos = n >> 5, c32 = n & 31; gv[r] = __builtin_nontemporal_load((const bf16x8*)(GGp + (t0 + 64 * hf + pos) * 1024 + h * GDV + c32 * 8)); }
            if (hf && has_next) GLA_LOADSF(un);
#pragma unroll
            for (int m = 0; m < 4; ++m)
#pragma unroll
                for (int r = 0; r < 4; ++r) { float s = o[m][0][r] * o[m][0][r] + o[m][1][r] * o[m][1][r];
                    s += __shfl_xor(s, 1); s += __shfl_xor(s, 2); s += __shfl_xor(s, 4); s += __shfl_xor(s, 8);
                    if (fr == 0) RED[wave * 64 + m * 16 + 4 * fq + r] = s; }
            __syncthreads();
            if (tid < 64) { float tot = 0.f;
#pragma unroll
                for (int w = 0; w < 8; ++w) tot += RED[w * 64 + tid];
                RS[tid] = __builtin_amdgcn_rsqf(tot * (1.f / GDV) + EPS); }
            __syncthreads();
#pragma unroll
            for (int m = 0; m < 4; ++m) { const f32x4 rs4 = *(const LAS f32x4*)(RS + m * 16 + 4 * fq);
#pragma unroll
                for (int r = 0; r < 4; ++r) { LAS unsigned char* rowp = OL + (m * 16 + 4 * fq + r) * 512 + (32 * wave + fr) * 2;
                    *(LAS unsigned short*)rowp = (unsigned short)f2bf(o[m][0][r] * rs4[r] * g0); *(LAS unsigned short*)(rowp + 32) = (unsigned short)f2bf(o[m][1][r] * rs4[r] * g1); } }
            __syncthreads();
#pragma unroll
            for (int r = 0; r < 4; ++r) { const int n = tid + 512 * r, pos = n >> 5, c32 = n & 31;
                const bf16x8 ov = *(const LAS bf16x8*)(OL + pos * 512 + c32 * 16); const size_t e = (t0 + 64 * hf + pos) * 1024 + h * GDV + c32 * 8;
                v4u w; w.x = pk2(bf2f((unsigned short)ov[0]) * bf2f((unsigned short)gv[r][0]), bf2f((unsigned short)ov[1]) * bf2f((unsigned short)gv[r][1]));
                w.y = pk2(bf2f((unsigned short)ov[2]) * bf2f((unsigned short)gv[r][2]), bf2f((unsigned short)ov[3]) * bf2f((unsigned short)gv[r][3]));
                w.z = pk2(bf2f((unsigned short)ov[4]) * bf2f((unsigned short)gv[r][4]), bf2f((unsigned short)ov[5]) * bf2f((unsigned short)gv[r][5]));
                w.w = pk2(bf2f((unsigned short)ov[6]) * bf2f((unsigned short)gv[r][6]), bf2f((unsigned short)ov[7]) * bf2f((unsigned short)gv[r][7]));
                *(v4u*)(OG + e) = w; }
            __syncthreads();
        }
        if (!has_next) break;
        u = un;
    }
#undef GLA_T0
#undef GLA_H
#undef GLA_LOADRAW
#undef GLA_LOADSF
}
__device__ __forceinline__ void fill_rstd_table(Frame& F, const pg8::StaticOrder& S, const float* ss) {
    LAS float* RT = (LAS float*)(F.lds + RT_OFF); pg8::Unit u;
    for (int i = 0; i < 4 && S.next(i, u); ++i) if (F.tid < 256) RT[i * 256 + F.tid] = pg8::row_rstd(ss, u.pm * 256 + F.tid);
    __syncthreads();
}

struct Args { const float* in[19]; float* out; unsigned char* ws; int ph_lo, ph_hi, li, pad; };
__global__ void __launch_bounds__(NWAVES * 64, 2) mega(Args args) {
    extern __shared__ __attribute__((aligned(16))) unsigned char lds[];
    Frame F;
    F.lds = (LAS unsigned char*)lds;
    F.MISC = (volatile LAS unsigned*)(F.lds + MISC_OFF);
    F.tid = threadIdx.x; F.lane = F.tid & 63; F.wave = __builtin_amdgcn_readfirstlane(F.tid >> 6);
    F.G = gridDim.x; { const int bx = blockIdx.x; F.vcu = (F.G % 8 == 0) ? (bx % 8) * (F.G / 8) + bx / 8 : bx; }
#pragma unroll
    for (int i = 0; i < 19; ++i) F.in[i] = args.in[i];
    F.out = args.out; F.ws = args.ws; F.ctl = (gu32*)(args.ws + WS_CTL);
    unsigned char* ws = args.ws;
    for (int u = F.tid; u < (LDS_BYTES - LDSCTL_OFF) / 4; u += NWAVES * 64) ((LAS unsigned*)(F.lds + LDSCTL_OFF))[u] = 0u;
    __syncthreads();
    const int lo = args.ph_lo, hi = args.ph_hi;
    XcdBarrier bar; bar.bar = (unsigned*)(F.ctl + CW_BAR) + args.li * XCD_BAR_WORDS; bar.x = 0; bar.st = nullptr;
    if (hi - lo > 1) bar = xcd_barrier_post((unsigned*)(F.ctl + CW_BAR) + args.li * XCD_BAR_WORDS, F.MISC + 8);
    if (F.tid == 0) __hip_atomic_store(F.ctl + CW_XCC + blockIdx.x, xb_xcc_id() + 1u, RLX_AGENT);
    const int pm_own = 8 * ((int)blockIdx.x & 7) + (((int)blockIdx.x >> 3) & 7);
    bool grp_same = false;
#define IN(k) (lo <= (k) && (k) < hi)
#define SEAM(k) do { if (IN(k) && IN((k) + ((k) == 8 ? 2 : 1))) xcd_barrier(bar); } while (0)
#define PSEAM(k, s) do { if (IN(k) && IN((k) + 1)) panel_sync(F.ctl, bar.bar + XB_TMO, (s), pm_own, grp_same); } while (0)
    bf16 *Win = (bf16*)(ws + WS_WIN), *Wao = (bf16*)(ws + WS_WAO), *W1a = (bf16*)(ws + WS_W1A), *W2a = (bf16*)(ws + WS_W2A);
    bf16 *Wkvq = (bf16*)(ws + WS_WKVQ), *Wbo = (bf16*)(ws + WS_WBO), *W1b = (bf16*)(ws + WS_W1B), *W2b = (bf16*)(ws + WS_W2B);
    float* SS = (float*)(ws + WS_SS);
    bf16 *RA = (bf16*)(ws + WS_A), *RC = (bf16*)(ws + WS_C), *HM = (bf16*)(ws + WS_HM);

    if (IN(0)) { p0_prologue(F); SEAM(0); }
    if (hi - lo > 1) {
        const int b0 = ((int)blockIdx.x & 7) + 8 * (((int)blockIdx.x >> 3) & 7); unsigned x0 = 0, same = 1;
        for (int q = 0; q < 4; ++q) { const unsigned xq = __hip_atomic_load(F.ctl + CW_XCC + b0 + 64 * q, RLX_AGENT); if (q == 0) x0 = xq; same &= (xq == x0 && xq != 0u) ? 1u : 0u; }
        grp_same = __builtin_amdgcn_readfirstlane(same) != 0;
    }
    if (IN(1)) {
        pg8::Gemm g{RA, Win, T, 3072, D}; pg8::StaticOrder S; S.init(T, 3072, F.G, (int)blockIdx.x);
        fill_rstd_table(F, S, SS);
        pg8::EpiInProj E{ws + WS_B, (const LAS float*)(F.lds + RT_OFF), 0};
        pg8::gemm_phase<pg8::EpiInProj, pg8::StaticOrder, PG8_ALIGN, PG8_SP2>(F.lds + RING_OFF, g, S, E);
        gate_phase(F);
        SEAM(1);
    }
    if (IN(2)) { gla_state_phase(F); SEAM(2); }
    if (IN(3)) { gla_out_phase(F); PSEAM(3, 4); }
    if (IN(4)) {
        pg8::Gemm g{RC, Wao, T, D, D}; pg8::StaticOrder S; S.init(T, D, F.G, (int)blockIdx.x);
        pg8::EpiResB<1> E{nullptr, RA, RA, nullptr, SS};
        pg8::gemm_phase<pg8::EpiResB<1>, pg8::StaticOrder, PG8_ALIGN, PG8_SP2>(F.lds + RING_OFF, g, S, E);
        PSEAM(4, 0);
    }
    if (IN(5)) {
        pg8::Gemm g{RA, W1a, T, FF, D}; pg8::StaticOrder S; S.init(T, FF, F.G, (int)blockIdx.x);
        fill_rstd_table(F, S, SS);
        pg8::EpiUp E{HM, (const LAS float*)(F.lds + RT_OFF), 0};
        pg8::gemm_phase<pg8::EpiUp, pg8::StaticOrder, PG8_ALIGN, PG8_SP2>(F.lds + RING_OFF, g, S, E);
        PSEAM(5, 1);
    }
    if (IN(6)) {
        pg8::Gemm g{HM, W2a, T, D, FF}; pg8::StaticOrder S; S.init(T, D, F.G, (int)blockIdx.x);
        pg8::EpiResB<1> E{nullptr, RA, RA, nullptr, SS};
        pg8::gemm_phase<pg8::EpiResB<1>, pg8::StaticOrder, PG8_ALIGN, PG8_SP2>(F.lds + RING_OFF, g, S, E);
        PSEAM(6, 5);
    }
    if (IN(7)) {
        pg8::Gemm g{RA, Wkvq, T, 3072, D}; pg8::StaticOrder S; S.init(T, 3072, F.G, (int)blockIdx.x);
        if (F.tid < 128) ((LAS float*)(F.lds + RT_OFF + 4096))[F.tid] = (F.tid < 64) ? F.in[9][F.tid] : F.in[12][F.tid - 64];
        fill_rstd_table(F, S, SS);
        pg8::EpiKVQ E{ws + WS_B, (const LAS float*)(F.lds + RT_OFF), (const LAS float*)(F.lds + RT_OFF + 4096), (const LAS float*)(F.lds + RT_OFF + 4096 + 256), 0};
        pg8::gemm_phase<pg8::EpiKVQ, pg8::StaticOrder, PG8_ALIGN, PG8_SP2>(F.lds + RING_OFF, g, S, E);
        SEAM(7);
    }
    if (IN(8)) {
        const attn_body::AttnTensors AT{(const attn_body::bf16*)(ws + WS_B + 1024 * 1024), (const attn_body::bf16*)(ws + WS_B), (const attn_body::bf16*)(ws + WS_B + 512 * 1024), (attn_body::bf16*)F.out};
        const attn_body::StaticOrder S((int)F.G, (int)blockIdx.x);
        attn_body::attn_phase<attn_body::StaticOrder>((char*)lds + RING_OFF, AT, S);
        combine_local(F);
        SEAM(8);
    }
    if (IN(10)) {
        pg8::Gemm g{RC, Wbo, T, D, D}; pg8::StaticOrder S; S.init(T, D, F.G, (int)blockIdx.x);
        pg8::EpiResB<1> E{nullptr, RA, RA, nullptr, SS};
        pg8::gemm_phase<pg8::EpiResB<1>, pg8::StaticOrder, PG8_ALIGN, PG8_SP2>(F.lds + RING_OFF, g, S, E);
        PSEAM(10, 2);
    }
    if (IN(11)) {
        pg8::Gemm g{RA, W1b, T, FF, D}; pg8::StaticOrder S; S.init(T, FF, F.G, (int)blockIdx.x);
        fill_rstd_table(F, S, SS);
        pg8::EpiUp E{HM, (const LAS float*)(F.lds + RT_OFF), 0};
        pg8::gemm_phase<pg8::EpiUp, pg8::StaticOrder, PG8_ALIGN, PG8_SP2>(F.lds + RING_OFF, g, S, E);
        PSEAM(11, 3);
    }
    if (IN(12)) {
        pg8::Gemm g{HM, W2b, T, D, FF}; pg8::StaticOrder S; S.init(T, D, F.G, (int)blockIdx.x);
        pg8::EpiResB<2> E{nullptr, RA, nullptr, F.out, nullptr};
        pg8::gemm_phase<pg8::EpiResB<2>, pg8::StaticOrder, PG8_ALIGN, PG8_SP2>(F.lds + RING_OFF, g, S, E);
    }
#undef IN
#undef SEAM
}

extern "C" void kernel_launch(void* const* d_in, const int* in_sizes, int n_in, void* d_out, int out_size, void* d_ws, size_t ws_size, hipStream_t stream) {
    static int grid = 0;
    if (grid == 0) {
        if (n_in != 19 || out_size != T * D || ws_size < WS_END) { fprintf(stderr, "kernel_launch: unexpected shapes (n_in %d out %d ws %zu)\n", n_in, out_size, ws_size); grid = -1; return; }
        int dev = 0, cus = 0, per_cu = 0;
        if (hipGetDevice(&dev) != hipSuccess || hipDeviceGetAttribute(&cus, hipDeviceAttributeMultiprocessorCount, dev) != hipSuccess) { grid = -1; return; }
        if (hipFuncSetAttribute((const void*)mega, hipFuncAttributeMaxDynamicSharedMemorySize, LDS_BYTES) != hipSuccess) { fprintf(stderr, "kernel_launch: hipFuncSetAttribute failed\n"); grid = -1; return; }
        if (hipOccupancyMaxActiveBlocksPerMultiprocessor(&per_cu, (const void*)mega, NWAVES * 64, LDS_BYTES) != hipSuccess || per_cu < 1) { fprintf(stderr, "kernel_launch: occupancy query says %d blocks per CU\n", per_cu); grid = -1; (void)hipGetLastError(); return; }
        if (cus < 256) { fprintf(stderr, "kernel_launch: built for the 256 CUs of an MI355X (one resident workgroup per CU), found %d\n", cus); grid = -1; return; }
        grid = 256;
    }
    if (grid < 0) return;
    unsigned char* ws = (unsigned char*)d_ws;
    (void)hipMemsetAsync(ws + WS_CTL, 0, 128 * 1024, stream);
    Args a{};
    for (int i = 0; i < 19; ++i) a.in[i] = (const float*)d_in[i];
    a.out = (float*)d_out; a.ws = ws;
    int li = 0;
    auto run = [&](int lo, int hi) { a.ph_lo = lo; a.ph_hi = hi; a.li = li++; hipLaunchKernelGGL(mega, dim3(grid), dim3(NWAVES * 64), LDS_BYTES, stream, a); };
    run(0, 13);
}
```

```cpp
#include <hip/hip_runtime.h>
#include <cstdio>
#include <cstdint>

typedef unsigned short bf16;
typedef short bf16x8 __attribute__((ext_vector_type(8)));
typedef float f32x4 __attribute__((ext_vector_type(4)));

constexpr int NB = 4, SEQ = 4096, T = NB * SEQ, D = 1024, FF = 4096;
constexpr int GH = 4, GDK = 128, GDV = 256, GR = 16, CH = 64, NCH = SEQ / CH;
constexpr int GIN = 3088;
constexpr int DH = 8, DDH = 64, DVD = 128;
constexpr float EPS = 1e-6f;
constexpr float LOG2E = 1.4426950408889634f;
constexpr float LAMBDA_INIT = 0.35550906759f;

constexpr size_t MiB = 1u << 20;
constexpr size_t WS_CTL = 0;
constexpr size_t WS_SS = 1 * MiB;
constexpr size_t WS_ZB = 2 * MiB;
constexpr size_t WS_WZ = 3 * MiB;
constexpr size_t WS_WIN = 4 * MiB;
constexpr size_t WS_WAO = 10 * MiB;
constexpr size_t WS_W1A = 12 * MiB;
constexpr size_t WS_W2A = 20 * MiB;
constexpr size_t WS_WKVQ = 28 * MiB;
constexpr size_t WS_WBO = 34 * MiB;
constexpr size_t WS_W1B = 36 * MiB;
constexpr size_t WS_W2B = 44 * MiB;
constexpr size_t WS_B = 52 * MiB;
constexpr size_t WS_A = 180 * MiB;
constexpr size_t WS_C = 212 * MiB;
constexpr size_t WS_END = 244 * MiB;
constexpr size_t PSLOT = 2 * MiB, PQ = 0, PK = 256 * 1024, PV = 512 * 1024, PG = 1 * MiB, PBC = 1536 * 1024;
constexpr size_t WS_HM = WS_B;
constexpr size_t WS_KN = WS_B, WS_V2 = WS_B + 32 * MiB, WS_QN = WS_B + 64 * MiB;

__host__ __device__ __forceinline__ unsigned f2bf(float f) { unsigned u = __builtin_bit_cast(unsigned, f); return (u + 0x7fffu + ((u >> 16) & 1u)) >> 16; }
__host__ __device__ __forceinline__ float bf2f(unsigned h) { return __builtin_bit_cast(float, h << 16); }

__host__ __device__ __forceinline__ int kvq_dest_row(int n) {
    if (n >= 1024 && n < 2048) return n;
    const int tile = n >> 8, w = n & 255, lb = w >> 5, j = w & 31, wc = lb >> 1, bj = lb & 1;
    return (tile << 8) + 128 * bj + 32 * wc + j;
}

namespace pg8 {
#define PG8_LAS __attribute__((address_space(3)))
typedef unsigned short bf16_t;
typedef short bf16x8 __attribute__((ext_vector_type(8)));
typedef float f32x4 __attribute__((ext_vector_type(4)));
typedef unsigned u32x4 __attribute__((ext_vector_type(4)));
constexpr int BM = 256, BK = 64, HALF = 128, HTB = HALF * BK * 2  , STAGE_BYTES = 8 * HTB, NXCD = 8, WGM = 8;

__host__ __device__ __forceinline__ int lds_byte(int r, int c) { const int st = (r >> 4) * 2 + (c >> 5), rr = r & 15, cc = c & 31, ob = rr * 64 + cc * 2; return st * 1024 + (ob ^ (((ob >> 9) & 1) << 5)); }
__host__ __device__ __forceinline__ void stage_rc(int b, int& R, int& C) { const int st = b / 1024, sb = b % 1024, swz = sb ^ (((sb >> 9) & 1) << 5); R = (st >> 1) * 16 + swz / 64; C = (st & 1) * 32 + (swz % 64) / 2; }
__host__ __device__ __forceinline__ int perm32(int rho) { const int n = rho >> 4, i = rho & 15; return 8 * (i >> 2) + 4 * n + (i & 3); }

struct Unit { int pm, pn; };
struct Gemm { const bf16_t* A; const bf16_t* Bt; int M, N, K; };

struct StaticOrder {
    int nM, nN, nwg, G, c;
    __host__ __device__ void init(int M, int N, int G_, int c_) { nM = M / BM; nN = N / BM; nwg = nM * nN; G = G_; c = c_; }
    __host__ __device__ bool next(int i, Unit& u) const {
        const long L = (long)i * G + c; if (L >= nwg) return false;
        int wgid = (int)L; { const int q = nwg / NXCD, r = nwg % NXCD, xcd = wgid % NXCD, off = wgid / NXCD; wgid = (xcd < r ? xcd * (q + 1) : r * (q + 1) + (xcd - r) * q) + off; }
        const int nig = WGM * nN, gid = wgid / nig, fm = gid * WGM, gsz = (nM - fm) < WGM ? (nM - fm) : WGM;
        u.pm = fm + ((wgid % nig) % gsz); u.pn = (wgid % nig) / gsz; return true;
    }
    __device__ __forceinline__ void a_ready(const Unit&) const {}
    __device__ __forceinline__ void done(const Unit&) const {}
};

__device__ __forceinline__ unsigned cvt_pk_bf16(float lo, float hi) { unsigned r; asm volatile("v_cvt_pk_bf16_f32 %0, %1, %2" : "=v"(r) : "v"(lo), "v"(hi)); return r; }
typedef float f32x2 __attribute__((ext_vector_type(2)));
typedef unsigned u32x2 __attribute__((ext_vector_type(2)));
__device__ __forceinline__ void store16_wt(void* p, u32x4 v) { asm volatile("global_store_dwordx4 %0, %1, off sc1\n\ts_nop 1" :: "v"(p), "v"(v) : "memory"); }
constexpr int TOK = 16384;
constexpr float RMS_EPS = 1e-6f;
__device__ __forceinline__ float silu_f(float g) { return g * __builtin_amdgcn_rcpf(1.0f + __builtin_amdgcn_exp2f(-1.4426950408889634f * g)); }
__device__ __forceinline__ float row_rstd(const float* ss, int row) {
    const f32x4 a = *(const f32x4*)(ss + (size_t)row * 16), b = *(const f32x4*)(ss + (size_t)row * 16 + 4), c = *(const f32x4*)(ss + (size_t)row * 16 + 8), d = *(const f32x4*)(ss + (size_t)row * 16 + 12);
    const float q = ((a[0] + a[1]) + (a[2] + a[3])) + ((b[0] + b[1]) + (b[2] + b[3])) + ((c[0] + c[1]) + (c[2] + c[3])) + ((d[0] + d[1]) + (d[2] + d[3]));
    return __builtin_amdgcn_rsqf(q * (1.0f / 1024.0f) + RMS_EPS);
}
struct EpiInProj {
    static constexpr bool PERM = true, AFTER_DRAIN = false;
    unsigned char* slots; const PG8_LAS float* rt; mutable int ui;
    __device__ __forceinline__ void operator()(const f32x4 (&acc)[2][2][4][2], const Unit& u, int wr, int wc, int fr, int fq) const {
        const int row0 = wr * 64 + fr; const int pn = u.pn; const PG8_LAS float* rtu = rt + ui * 256 + wr * 64 + fr; ++ui;
        unsigned char* sl = slots + (size_t)u.pm * (2u << 20); bf16_t* base; int ldc, colt; const bool act = pn >= 8;
        if (pn < 2) { base = (bf16_t*)sl; ldc = 512; colt = pn * BM; } else if (pn < 4) { base = (bf16_t*)(sl + 256 * 1024); ldc = 512; colt = (pn - 2) * BM; }
        else if (pn < 8) { base = (bf16_t*)(sl + 512 * 1024); ldc = 1024; colt = (pn - 4) * BM; } else { base = (bf16_t*)(sl + 1024 * 1024); ldc = 1024; colt = (pn - 8) * BM; }
        const int col0 = colt + wc * 32 + 8 * fq;
#pragma unroll
        for (int ai = 0; ai < 2; ++ai)
#pragma unroll
            for (int m = 0; m < 4; ++m) { bf16_t* rowp = base + (size_t)(row0 + ai * HALF + m * 16) * ldc + col0; const float rs = rtu[ai * HALF + m * 16];
#pragma unroll
                for (int bj = 0; bj < 2; ++bj) { f32x4 v0 = acc[ai][bj][m][0] * rs, v1 = acc[ai][bj][m][1] * rs;
                    if (act) { v0 = (f32x4){silu_f(v0[0]), silu_f(v0[1]), silu_f(v0[2]), silu_f(v0[3])}; v1 = (f32x4){silu_f(v1[0]), silu_f(v1[1]), silu_f(v1[2]), silu_f(v1[3])}; }
                    u32x4 w; w.x = cvt_pk_bf16(v0[0], v0[1]); w.y = cvt_pk_bf16(v0[2], v0[3]); w.z = cvt_pk_bf16(v1[0], v1[1]); w.w = cvt_pk_bf16(v1[2], v1[3]);
                    store16_wt(rowp + bj * HALF, w); } }
    }
};
template <int MODE> struct EpiResB {
    static constexpr bool PERM = true, AFTER_DRAIN = false;
    const float* basef; const bf16_t* baseb; bf16_t* hb; float* outf; float* ss;
    __device__ __forceinline__ void operator()(const f32x4 (&acc)[2][2][4][2], const Unit& u, int wr, int wc, int fr, int fq) const {
        const int col0 = u.pn * BM + wc * 32 + 8 * fq;
#pragma unroll
        for (int ai = 0; ai < 2; ++ai)
#pragma unroll
            for (int m = 0; m < 4; ++m) { const int row = u.pm * BM + ai * HALF + wr * 64 + m * 16 + fr; const size_t off = (size_t)row * 1024 + col0; float s = 0.f;
#pragma unroll
                for (int bj = 0; bj < 2; ++bj) { f32x4 h0, h1;
                    if (MODE == 0) { h0 = *(const f32x4*)(basef + off + bj * HALF); h1 = *(const f32x4*)(basef + off + bj * HALF + 4); }
                    else { const u32x4 b = *(const u32x4*)(baseb + off + bj * HALF);
                        h0 = (f32x4){__builtin_bit_cast(float, b.x << 16), __builtin_bit_cast(float, b.x & 0xffff0000u), __builtin_bit_cast(float, b.y << 16), __builtin_bit_cast(float, b.y & 0xffff0000u)};
                        h1 = (f32x4){__builtin_bit_cast(float, b.z << 16), __builtin_bit_cast(float, b.z & 0xffff0000u), __builtin_bit_cast(float, b.w << 16), __builtin_bit_cast(float, b.w & 0xffff0000u)}; }
                    h0 = h0 + acc[ai][bj][m][0]; h1 = h1 + acc[ai][bj][m][1];
                    if (MODE == 2) { __builtin_nontemporal_store(h0, (f32x4*)(outf + off + bj * HALF)); __builtin_nontemporal_store(h1, (f32x4*)(outf + off + bj * HALF + 4)); }
                    else { u32x4 w; w.x = cvt_pk_bf16(h0[0], h0[1]); w.y = cvt_pk_bf16(h0[2], h0[3]); w.z = cvt_pk_bf16(h1[0], h1[1]); w.w = cvt_pk_bf16(h1[2], h1[3]);
                        *(u32x4*)(hb + off + bj * HALF) = w;
                        s += ((h0[0] * h0[0] + h0[1] * h0[1]) + (h0[2] * h0[2] + h0[3] * h0[3])) + ((h1[0] * h1[0] + h1[1] * h1[1]) + (h1[2] * h1[2] + h1[3] * h1[3])); } }
                if (MODE != 2) { s += __shfl_xor(s, 16); s += __shfl_xor(s, 32); if (fq == 0) ss[(size_t)row * 16 + u.pn * 4 + wc] = s; }
                if (m & 1) asm volatile("" ::: "memory"); }
    }
};
struct EpiUp {
    static constexpr bool PERM = true, AFTER_DRAIN = false;
    bf16_t* O; const PG8_LAS float* rt; mutable int ui;
    __device__ __forceinline__ void operator()(const f32x4 (&acc)[2][2][4][2], const Unit& u, int wr, int wc, int fr, int fq) const {
        const int col0 = u.pn * BM + wc * 32 + 8 * fq; const PG8_LAS float* rtu = rt + ui * 256 + wr * 64 + fr; ++ui;
#pragma unroll
        for (int ai = 0; ai < 2; ++ai)
#pragma unroll
            for (int m = 0; m < 4; ++m) { const int row = u.pm * BM + ai * HALF + wr * 64 + m * 16 + fr; const float rs = rtu[ai * HALF + m * 16]; bf16_t* rowp = O + (size_t)row * 4096 + col0;
#pragma unroll
                for (int bj = 0; bj < 2; ++bj) { f32x4 v0 = acc[ai][bj][m][0] * rs, v1 = acc[ai][bj][m][1] * rs;
#pragma unroll
                    for (int e = 0; e < 4; ++e) { const float a = __builtin_fmaxf(v0[e], 0.f), b = __builtin_fmaxf(v1[e], 0.f); v0[e] = a * a; v1[e] = b * b; }
                    u32x4 w; w.x = cvt_pk_bf16(v0[0], v0[1]); w.y = cvt_pk_bf16(v0[2], v0[3]); w.z = cvt_pk_bf16(v1[0], v1[1]); w.w = cvt_pk_bf16(v1[2], v1[3]);
                    store16_wt(rowp + bj * HALF, w); } }
    }
};
struct EpiKVQ {
    static constexpr bool PERM = true, AFTER_DRAIN = false;
    unsigned char* slots; const PG8_LAS float* rt; const PG8_LAS float *gk, *gq; mutable int ui;
    __device__ __forceinline__ void operator()(const f32x4 (&acc)[2][2][4][2], const Unit& u, int wr, int wc, int fr, int fq) const {
        const int pn = u.pn; const PG8_LAS float* rtu = rt + ui * 256 + wr * 64 + fr; ++ui; unsigned char* sl = slots + (size_t)u.pm * (2u << 20);
        if (pn >= 4 && pn < 8) {
            const int col0 = (pn - 4) * BM + wc * 32 + 8 * fq;
#pragma unroll
            for (int ai = 0; ai < 2; ++ai)
#pragma unroll
                for (int m = 0; m < 4; ++m) { const int row = ai * HALF + wr * 64 + m * 16 + fr; const float rs = rtu[ai * HALF + m * 16]; bf16_t* rowp = (bf16_t*)(sl + 512 * 1024) + (size_t)row * 1024 + col0;
#pragma unroll
                    for (int bj = 0; bj < 2; ++bj) { const f32x4 v0 = acc[ai][bj][m][0] * rs, v1 = acc[ai][bj][m][1] * rs;
                        u32x4 w; w.x = cvt_pk_bf16(v0[0], v0[1]); w.y = cvt_pk_bf16(v0[2], v0[3]); w.z = cvt_pk_bf16(v1[0], v1[1]); w.w = cvt_pk_bf16(v1[2], v1[3]);
                        store16_wt(rowp + bj * HALF, w); } }
        } else {
            const bool isq = pn >= 8; const PG8_LAS float* gp = isq ? gq : gk; bf16_t* dst = (bf16_t*)(sl + (isq ? 1024 * 1024 : 0)); const int pl = isq ? pn - 8 : pn;
            const float sc = isq ? 0.125f * 1.4426950408889634f : 1.0f;
            f32x4 gv[2][2];
#pragma unroll
            for (int bj = 0; bj < 2; ++bj)
#pragma unroll
                for (int n = 0; n < 2; ++n) gv[bj][n] = *(const PG8_LAS f32x4*)(gp + 32 * bj + 8 * fq + 4 * n) * sc;
            const int col0 = pl * BM + wc * 64 + 8 * fq;
#pragma unroll
            for (int ai = 0; ai < 2; ++ai)
#pragma unroll
                for (int m = 0; m < 4; ++m) { const int row = ai * HALF + wr * 64 + m * 16 + fr; const float rs = rtu[ai * HALF + m * 16]; bf16_t* rowp = dst + (size_t)row * 1024 + col0;
                    f32x4 x[2][2]; float s = 0.f;
#pragma unroll
                    for (int bj = 0; bj < 2; ++bj)
#pragma unroll
                        for (int n = 0; n < 2; ++n) { x[bj][n] = acc[ai][bj][m][n] * rs; s += (x[bj][n][0] * x[bj][n][0] + x[bj][n][1] * x[bj][n][1]) + (x[bj][n][2] * x[bj][n][2] + x[bj][n][3] * x[bj][n][3]); }
                    s += __shfl_xor(s, 16); s += __shfl_xor(s, 32);
                    const float r2 = __builtin_amdgcn_rsqf(s * (1.0f / 64.0f) + RMS_EPS);
#pragma unroll
                    for (int bj = 0; bj < 2; ++bj) { const f32x4 v0 = x[bj][0] * r2 * gv[bj][0], v1 = x[bj][1] * r2 * gv[bj][1];
                        u32x4 w; w.x = cvt_pk_bf16(v0[0], v0[1]); w.y = cvt_pk_bf16(v0[2], v0[3]); w.z = cvt_pk_bf16(v1[0], v1[1]); w.w = cvt_pk_bf16(v1[2], v1[3]);
                        store16_wt(rowp + 32 * bj, w); } }
        }
    }
};

template <class Epi, class Sched, bool ALIGN_EPI = false, bool SP2 = false>
__device__ __forceinline__ void gemm_phase(PG8_LAS unsigned char* lds, const Gemm g, const Sched& S, const Epi& E) {
    const int tid = threadIdx.x, wid = __builtin_amdgcn_readfirstlane(tid >> 6), lane = tid & 63, wr = wid >> 2, wc = wid & 3, fr = lane & 15, fq = lane >> 4;
    const int K = g.K, nt = K / BK;
    unsigned voffA[2], voffB[2];
#pragma unroll
    for (int i = 0; i < 2; ++i) { int R, C; stage_rc(tid * 16 + i * 8192, R, C); const int Rb = Epi::PERM ? ((R & ~31) + perm32(R & 31)) : R;
        voffA[i] = (unsigned)(R * K + C) * 2u; voffB[i] = (unsigned)(Rb * K + C) * 2u; }
    const size_t kstep = (size_t)(BK * 2);
    const size_t hstep = (size_t)HALF * K * 2;
    const size_t tstep = 2 * hstep;
    const unsigned ldsw = (unsigned)wid * 1024u;
    const int aoff = lds_byte(wr * 64 + fr, fq * 8), boff = lds_byte(wc * 32 + fr, fq * 8);
#define PG8_SA(b, h) (((b) * 2 + (h)) * HTB)
#define PG8_SB(b, h) ((4 + (b) * 2 + (h)) * HTB)
#define PG8_STAGE(bufoff, gbase, voff) do { _Pragma("unroll") for (int _i = 0; _i < 2; ++_i) \
        __builtin_amdgcn_global_load_lds((const unsigned*)((const char*)(gbase) + (voff)[_i]), (PG8_LAS unsigned*)(lds + (bufoff) + ldsw + _i * 8192), 16, 0, 0); } while (0)
#define PG8_LDA(dst, b, h) do { _Pragma("unroll") for (int m = 0; m < 4; ++m) _Pragma("unroll") for (int k = 0; k < 2; ++k) dst[m][k] = *(const PG8_LAS bf16x8*)(lds + PG8_SA(b, h) + aoff + m * 2048 + k * 1024); } while (0)
#define PG8_LDB(dst, b, h) do { _Pragma("unroll") for (int n = 0; n < 2; ++n) _Pragma("unroll") for (int k = 0; k < 2; ++k) dst[n][k] = *(const PG8_LAS bf16x8*)(lds + PG8_SB(b, h) + boff + n * 2048 + k * 1024); } while (0)
#define PG8_MMA(ai, bj, At, Bt) do { __builtin_amdgcn_s_setprio(1); _Pragma("unroll") for (int m = 0; m < 4; ++m) _Pragma("unroll") for (int n = 0; n < 2; ++n) _Pragma("unroll") for (int k = 0; k < 2; ++k) \
        acc[ai][bj][m][n] = __builtin_amdgcn_mfma_f32_16x16x32_bf16(Bt[n][k], At[m][k], acc[ai][bj][m][n], 0, 0, 0); __builtin_amdgcn_s_setprio(0); } while (0)
#define PG8_WAIT_V(n) asm volatile("s_waitcnt vmcnt(" #n ")" ::: "memory")
#define PG8_WAIT_L(n) asm volatile("s_waitcnt lgkmcnt(" #n ")" ::: "memory")
#define PG8_BAR __builtin_amdgcn_s_barrier()
#define PG8_SCHED __builtin_amdgcn_sched_barrier(0)
    Unit cur, nxt; int ui = 0;
    if (!S.next(0, cur)) return;
    f32x4 acc[2][2][4][2];
#pragma unroll
    for (int a = 0; a < 2; ++a)
#pragma unroll
        for (int b = 0; b < 2; ++b)
#pragma unroll
            for (int m = 0; m < 4; ++m)
#pragma unroll
                for (int n = 0; n < 2; ++n) acc[a][b][m][n] = (f32x4){0.f, 0.f, 0.f, 0.f};
    bf16x8 At[4][2], B0[2][2], B1[2][2];
    const char* cA = (const char*)g.A + (size_t)cur.pm * tstep; const char* cB = (const char*)g.Bt + (size_t)cur.pn * tstep;
    S.a_ready(cur);
    if constexpr (SP2) {
        PG8_STAGE(PG8_SB(0, 0), cB, voffB); PG8_STAGE(PG8_SB(0, 1), cB + hstep, voffB); PG8_STAGE(PG8_SA(0, 0), cA, voffA); PG8_STAGE(PG8_SA(0, 1), cA + hstep, voffA);
        if (wr == 1) PG8_BAR;
        PG8_WAIT_V(2); PG8_BAR;
        PG8_STAGE(PG8_SB(1, 0), cB + kstep, voffB); PG8_STAGE(PG8_SA(1, 0), cA + kstep, voffA); PG8_STAGE(PG8_SB(1, 1), cB + hstep + kstep, voffB);
        PG8_WAIT_V(6); PG8_BAR;
    } else {
        PG8_STAGE(PG8_SB(0, 0), cB, voffB); PG8_STAGE(PG8_SA(0, 0), cA, voffA); PG8_STAGE(PG8_SB(0, 1), cB + hstep, voffB); PG8_STAGE(PG8_SA(0, 1), cA + hstep, voffA);
        if (wr == 1) PG8_BAR;
        PG8_WAIT_V(4); PG8_BAR;
        PG8_STAGE(PG8_SB(1, 0), cB + kstep, voffB); PG8_STAGE(PG8_SA(1, 0), cA + kstep, voffA); PG8_STAGE(PG8_SB(1, 1), cB + hstep + kstep, voffB);
        PG8_WAIT_V(6); PG8_BAR;
    }
    for (;;) {
        const bool has_next = S.next(ui + 1, nxt);
        const char* nA = has_next ? (const char*)g.A + (size_t)nxt.pm * tstep : cA; const char* nB = has_next ? (const char*)g.Bt + (size_t)nxt.pn * tstep : cB;
        for (int t = 0; t < nt; t += 2) {
            const bool last = (t == nt - 2);
            const char* a1 = cA + (size_t)(t + 1) * kstep;
            const char* a2 = last ? nA : cA + (size_t)(t + 2) * kstep; const char* b2 = last ? nB : cB + (size_t)(t + 2) * kstep;
            const char* a3 = a2 + kstep; const char* b3 = b2 + kstep;
            if (last && has_next) S.a_ready(nxt);
            if constexpr (SP2) {
            PG8_LDB(B0, 0, 0); PG8_LDB(B1, 0, 1); PG8_SCHED; PG8_LDA(At, 0, 0); PG8_STAGE(PG8_SA(1, 1), a1 + hstep, voffA);
            PG8_WAIT_V(8); PG8_WAIT_L(0); PG8_BAR; PG8_MMA(0, 0, At, B0); PG8_MMA(0, 1, At, B1); PG8_BAR; PG8_SCHED;
            PG8_LDA(At, 0, 1); PG8_STAGE(PG8_SB(0, 0), b2, voffB); PG8_STAGE(PG8_SB(0, 1), b2 + hstep, voffB); PG8_STAGE(PG8_SA(0, 0), a2, voffA);
            PG8_WAIT_V(8); PG8_WAIT_L(0); PG8_BAR; PG8_MMA(1, 0, At, B0); PG8_MMA(1, 1, At, B1); PG8_BAR; PG8_SCHED;
            PG8_LDB(B0, 1, 0); PG8_LDB(B1, 1, 1); PG8_SCHED; PG8_LDA(At, 1, 0); PG8_STAGE(PG8_SA(0, 1), a2 + hstep, voffA);
            PG8_WAIT_V(8); PG8_WAIT_L(0); PG8_BAR; PG8_MMA(0, 0, At, B0); PG8_MMA(0, 1, At, B1); PG8_BAR; PG8_SCHED;
            PG8_LDA(At, 1, 1); PG8_STAGE(PG8_SB(1, 0), b3, voffB); PG8_STAGE(PG8_SB(1, 1), b3 + hstep, voffB); PG8_STAGE(PG8_SA(1, 0), a3, voffA);
            PG8_WAIT_V(8); PG8_WAIT_L(0); PG8_BAR; PG8_MMA(1, 0, At, B0); PG8_MMA(1, 1, At, B1); PG8_BAR; PG8_SCHED;
            } else {
            PG8_LDB(B0, 0, 0); PG8_SCHED; PG8_LDA(At, 0, 0); PG8_STAGE(PG8_SA(1, 1), a1 + hstep, voffA);
            PG8_WAIT_L(8); PG8_BAR; PG8_WAIT_L(0); PG8_MMA(0, 0, At, B0); PG8_BAR; PG8_SCHED;
            PG8_LDB(B1, 0, 1); PG8_STAGE(PG8_SB(0, 0), b2, voffB);
            PG8_BAR; PG8_WAIT_L(0); PG8_MMA(0, 1, At, B1); PG8_BAR;
            PG8_LDA(At, 0, 1); PG8_STAGE(PG8_SA(0, 0), a2, voffA);
            PG8_BAR; PG8_WAIT_L(0); PG8_MMA(1, 0, At, B0); PG8_BAR; PG8_SCHED;
            PG8_STAGE(PG8_SB(0, 1), b2 + hstep, voffB);
            PG8_WAIT_V(6); PG8_BAR; PG8_MMA(1, 1, At, B1); PG8_BAR;
            PG8_LDB(B0, 1, 0); PG8_SCHED; PG8_LDA(At, 1, 0); PG8_STAGE(PG8_SA(0, 1), a2 + hstep, voffA);
            PG8_WAIT_L(8); PG8_BAR; PG8_WAIT_L(0); PG8_MMA(0, 0, At, B0); PG8_BAR; PG8_SCHED;
            PG8_LDB(B1, 1, 1); PG8_STAGE(PG8_SB(1, 0), b3, voffB);
            PG8_BAR; PG8_WAIT_L(0); PG8_MMA(0, 1, At, B1); PG8_BAR;
            PG8_LDA(At, 1, 1); PG8_STAGE(PG8_SA(1, 0), a3, voffA);
            PG8_BAR; PG8_WAIT_L(0); PG8_MMA(1, 0, At, B0); PG8_BAR; PG8_SCHED;
            PG8_STAGE(PG8_SB(1, 1), b3 + hstep, voffB);
            PG8_WAIT_V(6); PG8_BAR; PG8_MMA(1, 1, At, B1); PG8_BAR;
            }
        }
        if constexpr (ALIGN_EPI) { if (wr == 0) PG8_BAR; }
        if constexpr (!Epi::AFTER_DRAIN) { E(acc, cur, wr, wc, fr, fq); S.done(cur); }
        if (!has_next) break;
#pragma unroll
        for (int a = 0; a < 2; ++a)
#pragma unroll
            for (int b = 0; b < 2; ++b)
#pragma unroll
                for (int m = 0; m < 4; ++m)
#pragma unroll
                    for (int n = 0; n < 2; ++n) acc[a][b][m][n] = (f32x4){0.f, 0.f, 0.f, 0.f};
        cur = nxt; cA = nA; cB = nB; ++ui;
        if constexpr (ALIGN_EPI) { if (wr == 1) PG8_BAR; }
    }
    PG8_WAIT_V(0);
    if constexpr (!ALIGN_EPI) { if (wr == 0) PG8_BAR; }
    PG8_BAR;
    if constexpr (Epi::AFTER_DRAIN) { E.fused(acc, cur, wr, wc, fr, fq, lds, wid, lane); S.done(cur); }
#undef PG8_SA
#undef PG8_SB
#undef PG8_STAGE
#undef PG8_LDA
#undef PG8_LDB
#undef PG8_MMA
#undef PG8_WAIT_V
#undef PG8_WAIT_L
#undef PG8_BAR
#undef PG8_SCHED
}
}

#ifndef PG8_SP2
#define PG8_SP2 true
#endif
#ifndef PG8_ALIGN
#define PG8_ALIGN true
#endif

#include <hip/hip_bf16.h>
#include <cmath>
namespace attn_body {
using bf16=__hip_bfloat16;
using bf16x8=__attribute__((ext_vector_type(8)))short;
using s16x4=__attribute__((ext_vector_type(4)))short;
using f32x16=__attribute__((ext_vector_type(16)))float;
using u32x4=__attribute__((ext_vector_type(4)))unsigned;
constexpr int BATCH=4,NHC=16,SEQ=4096,D=64,DVV=128;
constexpr int QP=1024,KP=1024,VP=1024,OP=2048;
constexpr int NW=8,QBLK=32,QB=QBLK*NW,KVBLK=64,NQB=SEQ/QB;
constexpr int ATTN_UNIT_ROWS=QB;
__device__ __forceinline__ int crow(int r,int hi){return (r&3)+8*(r>>2)+4*hi;}
#define SBAR() __builtin_amdgcn_sched_barrier(0)
__device__ __forceinline__ void cmask(f32x16&p0,f32x16&p1,int jb,int qrel,int hi){
  const float NEG=-INFINITY; int kb=64*jb+4*hi;
  #pragma unroll
  for(int r=0;r<16;++r){int kv=kb+(r&3)+8*(r>>2); if(kv>qrel)p0[r]=NEG; if(kv+32>qrel)p1[r]=NEG;}
}

constexpr int NSLOT=3, SLOTB=8192, VSLOTB=2*SLOTB;
constexpr int LDS_K=0, LDS_V=NSLOT*SLOTB, LDS_WS=LDS_V+NSLOT*VSLOTB, LDS_OST=LDS_WS+NW*64*4, LDS_BYTES=LDS_OST+NW*4096;
constexpr float C2=0.125f*1.4426950408889634f;
__device__ __forceinline__ void glds16(const void*gsrc,unsigned lds_dst){unsigned keep;
  asm volatile("s_mov_b32 %0, m0\n\ts_mov_b32 m0, %2\n\ts_nop 0\n\tglobal_load_lds_dwordx4 %1, off\n\ts_mov_b32 m0, %0":"=&s"(keep):"v"(gsrc),"s"(lds_dst):"memory");}
__device__ __forceinline__ float max3f(float a,float b,float c){float r;asm("v_max3_f32 %0, %1, %2, %3":"=v"(r):"v"(a),"v"(b),"v"(c));return r;}
__device__ __forceinline__ float max2f(float a,float b){float r;asm("v_max_f32_e32 %0, %1, %2":"=v"(r):"v"(a),"v"(b));return r;}
__device__ __forceinline__ float fadd_s(float a,float b){float r;asm("v_add_f32_e32 %0, %1, %2":"=v"(r):"v"(a),"v"(b));return r;}
__device__ __forceinline__ float fsub_s(float a,float b){float r;asm("v_sub_f32_e32 %0, %1, %2":"=v"(r):"v"(a),"v"(b));return r;}
typedef float f32x2_t __attribute__((ext_vector_type(2))); typedef __bf16 bf16x2_t __attribute__((ext_vector_type(2)));
__device__ __forceinline__ unsigned cvtpk_s(float lo,float hi){f32x2_t v={lo,hi};bf16x2_t b=__builtin_convertvector(v,bf16x2_t);return __builtin_bit_cast(unsigned,b);}
#define WAIT_BAR(N) asm volatile("s_waitcnt vmcnt(" #N ") lgkmcnt(0)\n\ts_barrier":::"memory")

__device__ __forceinline__ void qkt(f32x16&p0,f32x16&p1,const char*Kslot,const bf16x8*qr,const f32x16&negm,int r32,int hi){
  const char*kb=Kslot+hi*1024+r32*16;
  #pragma unroll
  for(int d0=0;d0<4;++d0){
    const bf16x8 b0=*reinterpret_cast<const bf16x8*>(kb+d0*2048);
    const bf16x8 b1=*reinterpret_cast<const bf16x8*>(kb+d0*2048+512);
    if(d0==0){p0=__builtin_amdgcn_mfma_f32_32x32x16_bf16(b0,qr[0],negm,0,0,0);p1=__builtin_amdgcn_mfma_f32_32x32x16_bf16(b1,qr[0],negm,0,0,0);}
    else{p0=__builtin_amdgcn_mfma_f32_32x32x16_bf16(b0,qr[d0],p0,0,0,0);p1=__builtin_amdgcn_mfma_f32_32x32x16_bf16(b1,qr[d0],p1,0,0,0);}}
}
typedef __attribute__((address_space(3))) const char* lds_cptr;
typedef short v4i16_t __attribute__((ext_vector_type(4)));
__device__ __forceinline__ void kload8(bf16x8*kf,lds_cptr kp){
  kf[0]=*(const __attribute__((address_space(3))) bf16x8*)(kp);      kf[1]=*(const __attribute__((address_space(3))) bf16x8*)(kp+512);
  kf[2]=*(const __attribute__((address_space(3))) bf16x8*)(kp+2048); kf[3]=*(const __attribute__((address_space(3))) bf16x8*)(kp+2560);
  kf[4]=*(const __attribute__((address_space(3))) bf16x8*)(kp+4096); kf[5]=*(const __attribute__((address_space(3))) bf16x8*)(kp+4608);
  kf[6]=*(const __attribute__((address_space(3))) bf16x8*)(kp+6144); kf[7]=*(const __attribute__((address_space(3))) bf16x8*)(kp+6656);
}
__device__ __forceinline__ void kload2(bf16x8*kf,lds_cptr kp,int j){ kf[2*j]=*(const __attribute__((address_space(3))) bf16x8*)(kp+j*2048); kf[2*j+1]=*(const __attribute__((address_space(3))) bf16x8*)(kp+j*2048+512); }
__device__ __forceinline__ s16x4 vtr(lds_cptr p){ return __builtin_bit_cast(s16x4,__builtin_amdgcn_ds_read_tr16_b64_v4i16((__attribute__((address_space(3))) v4i16_t*)p)); }
__device__ __forceinline__ float rowmax(const f32x16&p0,const f32x16&p1){
  float a=max3f(p0[0],p0[1],p1[0]),b=max3f(p0[2],p0[3],p1[1]);a=max3f(a,p1[2],p1[3]);
  #pragma unroll
  for(int r=4;r<16;r+=4){a=max3f(a,p0[r],p0[r+1]);b=max3f(b,p0[r+2],p0[r+3]);a=max3f(a,p1[r],p1[r+1]);b=max3f(b,p1[r+2],p1[r+3]);}
  const float m=max2f(a,b);
  auto rr=__builtin_amdgcn_permlane32_swap(__float_as_uint(m),__float_as_uint(m),false,false);
  return max2f(__uint_as_float(rr[0]),__uint_as_float(rr[1]));
}
__device__ __forceinline__ void pv(f32x16*o,int vb,bf16x8 pa0,bf16x8 pa1,bf16x8 pa2,bf16x8 pa3){
  #pragma unroll
  for(int d0=0;d0<4;++d0){s16x4 lo[4],hi[4];
    #pragma unroll
    for(int ks=0;ks<4;++ks){
      asm volatile("ds_read_b64_tr_b16 %0,%1 offset:%c2":"=&v"(lo[ks]):"v"(vb),"i"(d0*4096+ks*1024):"memory");
      asm volatile("ds_read_b64_tr_b16 %0,%1 offset:%c2":"=&v"(hi[ks]):"v"(vb),"i"(d0*4096+ks*1024+512):"memory");}
    asm volatile("s_waitcnt lgkmcnt(0)":::"memory");SBAR();
    #define PK(k) (bf16x8){lo[k][0],lo[k][1],lo[k][2],lo[k][3],hi[k][0],hi[k][1],hi[k][2],hi[k][3]}
    o[d0]=__builtin_amdgcn_mfma_f32_32x32x16_bf16(pa0,PK(0),o[d0],0,0,0);
    o[d0]=__builtin_amdgcn_mfma_f32_32x32x16_bf16(pa1,PK(1),o[d0],0,0,0);
    o[d0]=__builtin_amdgcn_mfma_f32_32x32x16_bf16(pa2,PK(2),o[d0],0,0,0);
    o[d0]=__builtin_amdgcn_mfma_f32_32x32x16_bf16(pa3,PK(3),o[d0],0,0,0);
    #undef PK
  }
}

#ifndef ATTN_STORE16
#define ATTN_STORE16(p,v) (*(u32x4*)(p)=(v))
#endif
template<int THRL,bool FR> __device__ __forceinline__ void attn_unit(int b,int hc,int qb,const bf16*Q,const bf16*__restrict__ K,const bf16*__restrict__ V,bf16*O,char*shm){
  const int qkcol=hc*D, vcol=(hc>>1)*DVV, ocol=hc*DVV;
  const int tid=threadIdx.x; int lane; asm volatile("v_mbcnt_lo_u32_b32 %0, -1, 0\n\tv_mbcnt_hi_u32_b32 %0, -1, %0":"=v"(lane));
  const int r32=lane&31,hi=lane>>5; const int wid=__builtin_amdgcn_readfirstlane(tid>>6);
  const long rowbase=(long)b*SEQ; const int q0=qb*QB;
  constexpr long PSL=1048576;
  const bf16*Qw=Q+(long)(16*b+qb)*PSL+(long)(wid*QBLK)*QP+qkcol;
  const bf16*Kh=K+(long)(16*b)*PSL+qkcol,*Vh=V+(long)(16*b)*PSL+vcol;
  const unsigned lds0=(unsigned)(uintptr_t)shm;
  float*wsf=(float*)(shm+LDS_WS)+wid*64;
  const bf16*ksrc=Kh+(long)lane*KP+wid*8;
  const bf16*vsrc=Vh+(long)(16*(wid&3)+(lane>>2))*VP+(wid>>2)*32+(lane&3)*8;
  const unsigned kdst=lds0+LDS_K+wid*1024, vdst=lds0+LDS_V+wid*1024;
  #define TOFF(t) ((long)((t)>>2)*PSL+(long)((t)&3)*KVBLK*KP)
  #define DMA_K(t,slot) glds16(ksrc+TOFF(t),(unsigned)__builtin_amdgcn_readfirstlane(kdst+(slot)))
  #define DMA_V(t,slot) do{ glds16(vsrc+TOFF(t),(unsigned)__builtin_amdgcn_readfirstlane(vdst+2*(slot))); glds16(vsrc+64+TOFF(t),(unsigned)__builtin_amdgcn_readfirstlane(vdst+2*(slot)+8192)); }while(0)
  const int vb0=(int)(lds0+LDS_V)+((lane>>4)&1)*32+(lane&3)*8+(4*hi+((lane&15)>>2))*64;
  const char*Kbase=shm+LDS_K; bf16x8 kf[8];
  const lds_cptr shm3=(lds_cptr)shm; const lds_cptr kp0=shm3+LDS_K+hi*1024+r32*16; const lds_cptr vp0=shm3+LDS_V+((lane>>4)&1)*32+(lane&3)*8+(4*hi+((lane&15)>>2))*64;
  const int NT=(q0+QB)/KVBLK;
  DMA_K(0,0);DMA_V(0,0);DMA_K(1,SLOTB);
  bf16x8 qr[4];
  #pragma unroll
  for(int d0=0;d0<4;++d0)qr[d0]=*reinterpret_cast<const bf16x8*>(&Qw[(long)r32*QP+d0*16+hi*8]);
  float mhat=0.f,l_reg=0.f;f32x16 o[4];o[0]=f32x16{};o[1]=f32x16{};o[2]=f32x16{};o[3]=f32x16{};
  const int qrel=wid*QBLK+r32;
  #define CMASK(P0,P1,t) do{int jb_=(t)-(NT-4); if(jb_>=0)cmask(P0,P1,jb_,qrel,hi);}while(0)
  bool resc=false;
  #define START(P0,P1) do{ resc=false; \
    if(!FR){ const float rm=rowmax(P0,P1); const float dl=rm; mhat=fadd_s(mhat,dl); \
      _Pragma("unroll") for(int r=0;r<16;++r){P0[r]=fsub_s(P0[r],dl);P1[r]=fsub_s(P1[r],dl);} } \
    _Pragma("unroll") for(int r=0;r<16;++r)P0[r]=__builtin_amdgcn_exp2f(P0[r]); }while(0)
  #define RESC() do{ if(resc){ asm volatile("s_waitcnt lgkmcnt(0)":::"memory"); \
      _Pragma("unroll") for(int d_=0;d_<4;++d_) _Pragma("unroll") for(int r=0;r<16;++r)o[d_][r]*=wsf[crow(r,hi)]; } }while(0)
  f32x16 pA0,pA1,pB0,pB1;
  int sl_prev=0,sl_cur=0,sl_next=SLOTB;
  #define ROT() do{sl_prev=sl_cur;sl_cur=sl_next;sl_next=(sl_next==(NSLOT-1)*SLOTB)?0:sl_next+SLOTB;}while(0)
  DMA_K(2,2*SLOTB);
  WAIT_BAR(4);
  { const f32x16 z0=f32x16{}; qkt(pA0,pA1,Kbase,qr,z0,r32,hi); }asm volatile("s_nop 15\n\ts_nop 7":"+v"(pA0),"+v"(pA1));CMASK(pA0,pA1,0);
  START(pA0,pA1);
  _Pragma("unroll") for(int r=0;r<16;++r)pA1[r]=__builtin_amdgcn_exp2f(pA1[r]);
  WAIT_BAR(0);
  DMA_K(3,0);DMA_V(1,SLOTB);
  ROT();
  kload8(kf,kp0+sl_cur);
  WAIT_BAR(3);
  s16x4 vlo[4],vhi[4]; u32x4 pw0,pw1,pw2,pw3;
  #define PKW(P,B) cvtpk_s(P[B],P[B+1])
  #define PAF(k) __builtin_bit_cast(bf16x8,pw##k)
  #define VFR(i) (bf16x8){vlo[i][0],vlo[i][1],vlo[i][2],vlo[i][3],vhi[i][0],vhi[i][1],vhi[i][2],vhi[i][3]}
  #define PIN(x) asm volatile("":"+v"(x))
  #define MX3(a,b,c) __builtin_fmaxf(__builtin_fmaxf((a),(b)),(c))
  #define GAPA(MF,A0,A1,A2,A3,W0,W1,PW) do{ MF; sacc+=A0; sacc+=A1; sacc+=A2; sacc+=A3; PIN(sacc); W0; W1; PIN(PW); SBAR(); }while(0)
  #define EX(v) __builtin_amdgcn_exp2f(v)
  #define GAPB(MF,X,B) do{ MF; X[B]=EX(FR?X[B]:X[B]-mhat); X[B+1]=EX(FR?X[B+1]:X[B+1]-mhat); PIN(X); SBAR(); }while(0)
  #define VRD(p,i) do{ vlo[p]=vtr(vp_+(((i)>>2)*4096+((i)&3)*1024)); vhi[p]=vtr(vp_+(((i)>>2)*4096+((i)&3)*1024+512)); }while(0)
  #define KRD(G,j) do{ if(G){ kload2(kf,kp0+sl_next,j); SBAR(); } }while(0)
  #define ZC (f32x16{})
  #define QF(d) (FR ? qr[d] : *reinterpret_cast<const bf16x8*>(&Qw[(long)r32*QP+(d)*16+hi*8]))
  #define STEP(C0,C1,P0,P1,t,GK,GV,GL) do{ SBAR(); \
    const lds_cptr vp_=vp0+2*sl_prev; \
    float sacc=(P0[0]+P0[1]); \
    GAPA(C0=__builtin_amdgcn_mfma_f32_32x32x16_bf16(kf[0],QF(0),ZC,0,0,0), P0[2],P0[3],P0[4],P0[5],     pw0[0]=PKW(P0,0), pw0[1]=PKW(P0,2), pw0); \
    GAPA(C1=__builtin_amdgcn_mfma_f32_32x32x16_bf16(kf[1],QF(0),ZC,0,0,0), P0[6],P0[7],P0[8],P0[9],     pw0[2]=PKW(P0,4), pw0[3]=PKW(P0,6), pw0); \
    GAPA(C0=__builtin_amdgcn_mfma_f32_32x32x16_bf16(kf[2],QF(1),C0,0,0,0),   P0[10],P0[11],P0[12],P0[13], pw1[0]=PKW(P0,8), pw1[1]=PKW(P0,10), pw1); \
    GAPA(C1=__builtin_amdgcn_mfma_f32_32x32x16_bf16(kf[3],QF(1),C1,0,0,0),   P0[14],P0[15],P1[0],P1[1],   pw1[2]=PKW(P0,12),pw1[3]=PKW(P0,14), pw1); \
    GAPA(C0=__builtin_amdgcn_mfma_f32_32x32x16_bf16(kf[4],QF(2),C0,0,0,0),   P1[2],P1[3],P1[4],P1[5],     pw2[0]=PKW(P1,0), pw2[1]=PKW(P1,2), pw2); \
    VRD(0,0); SBAR(); GAPA(C1=__builtin_amdgcn_mfma_f32_32x32x16_bf16(kf[5],QF(2),C1,0,0,0),   P1[6],P1[7],P1[8],P1[9],     pw2[2]=PKW(P1,4), pw2[3]=PKW(P1,6), pw2); \
    VRD(1,4); SBAR(); GAPA(C0=__builtin_amdgcn_mfma_f32_32x32x16_bf16(kf[6],QF(3),C0,0,0,0),   P1[10],P1[11],P1[12],P1[13], pw3[0]=PKW(P1,8), pw3[1]=PKW(P1,10), pw3); \
    VRD(2,1); SBAR(); GAPA(C1=__builtin_amdgcn_mfma_f32_32x32x16_bf16(kf[7],QF(3),C1,0,0,0),   P1[14],P1[15],0.f,0.f,       pw3[2]=PKW(P1,12),pw3[3]=PKW(P1,14), pw3); \
    l_reg+=sacc; \
    if(GK){DMA_K((t)+3,sl_cur);} if(GV){DMA_V((t)+1,sl_next);} \
    CMASK(C0,C1,t); \
    resc=false; if(!FR){ float a=MX3(C0[0],C0[1],C1[0]),b=MX3(C0[2],C0[3],C1[1]); a=MX3(a,C1[2],C1[3]); \
      _Pragma("unroll") for(int r=4;r<16;r+=4){a=MX3(a,C0[r],C0[r+1]);b=MX3(b,C0[r+2],C0[r+3]);a=MX3(a,C1[r],C1[r+1]);b=MX3(b,C1[r+2],C1[r+3]);} \
      float rm=__builtin_fmaxf(a,b); { auto rr=__builtin_amdgcn_permlane32_swap(__float_as_uint(rm),__float_as_uint(rm),false,false); rm=__builtin_fmaxf(__uint_as_float(rr[0]),__uint_as_float(rr[1])); } \
      rm-=mhat; resc=false; \
      if(__builtin_expect(__any(rm>(float)THRL),0)){ const float dl=__builtin_fmaxf(rm,0.f); mhat+=dl; \
        const float f=__builtin_amdgcn_exp2f(-dl); l_reg*=f; if(hi==0)wsf[r32]=f; resc=true; } } \
    SBAR(); \
    VRD(3,5);  SBAR(); GAPB(o[0]=__builtin_amdgcn_mfma_f32_32x32x16_bf16(PAF(0),VFR(0),o[0],0,0,0), C0,0); \
    VRD(0,2);  SBAR(); GAPB(o[1]=__builtin_amdgcn_mfma_f32_32x32x16_bf16(PAF(0),VFR(1),o[1],0,0,0), C0,2); \
    VRD(1,6);  SBAR(); KRD(GL,0); GAPB(o[0]=__builtin_amdgcn_mfma_f32_32x32x16_bf16(PAF(1),VFR(2),o[0],0,0,0), C0,4); \
    VRD(2,3);  SBAR(); KRD(GL,1); GAPB(o[1]=__builtin_amdgcn_mfma_f32_32x32x16_bf16(PAF(1),VFR(3),o[1],0,0,0), C0,6); \
    VRD(3,7);  SBAR(); KRD(GL,2); GAPB(o[0]=__builtin_amdgcn_mfma_f32_32x32x16_bf16(PAF(2),VFR(0),o[0],0,0,0), C0,8); \
    VRD(0,8);  SBAR(); KRD(GL,3); GAPB(o[1]=__builtin_amdgcn_mfma_f32_32x32x16_bf16(PAF(2),VFR(1),o[1],0,0,0), C0,10); \
    VRD(1,12); SBAR(); GAPB(o[0]=__builtin_amdgcn_mfma_f32_32x32x16_bf16(PAF(3),VFR(2),o[0],0,0,0), C0,12); \
    VRD(2,9);  SBAR(); GAPB(o[1]=__builtin_amdgcn_mfma_f32_32x32x16_bf16(PAF(3),VFR(3),o[1],0,0,0), C0,14); \
    VRD(3,13); SBAR(); GAPB(o[2]=__builtin_amdgcn_mfma_f32_32x32x16_bf16(PAF(0),VFR(0),o[2],0,0,0), C1,0); \
    VRD(0,10); SBAR(); GAPB(o[3]=__builtin_amdgcn_mfma_f32_32x32x16_bf16(PAF(0),VFR(1),o[3],0,0,0), C1,2); \
    VRD(1,14); SBAR(); GAPB(o[2]=__builtin_amdgcn_mfma_f32_32x32x16_bf16(PAF(1),VFR(2),o[2],0,0,0), C1,4); \
    VRD(2,11); SBAR(); GAPB(o[3]=__builtin_amdgcn_mfma_f32_32x32x16_bf16(PAF(1),VFR(3),o[3],0,0,0), C1,6); \
    VRD(3,15); SBAR(); GAPB(o[2]=__builtin_amdgcn_mfma_f32_32x32x16_bf16(PAF(2),VFR(0),o[2],0,0,0), C1,8); \
    GAPB(o[3]=__builtin_amdgcn_mfma_f32_32x32x16_bf16(PAF(2),VFR(1),o[3],0,0,0), C1,10); \
    GAPB(o[2]=__builtin_amdgcn_mfma_f32_32x32x16_bf16(PAF(3),VFR(2),o[2],0,0,0), C1,12); \
    GAPB(o[3]=__builtin_amdgcn_mfma_f32_32x32x16_bf16(PAF(3),VFR(3),o[3],0,0,0), C1,14); \
    }while(0)
  int t=1;
  #undef CMASK
  #define CMASK(P0,P1,t) do{}while(0)
  for(;t+5<NT;t+=2){
    STEP(pB0,pB1,pA0,pA1,t,true,true,true);     WAIT_BAR(3); RESC(); ROT();
    STEP(pA0,pA1,pB0,pB1,t+1,true,true,true);   WAIT_BAR(3); RESC(); ROT();
  }
  #undef CMASK
  #define CMASK(P0,P1,t) do{int jb_=(t)-(NT-4); if(jb_>=0)cmask(P0,P1,jb_,qrel,hi);}while(0)
  #define ENDW(tt) do{ if((tt)+3<NT){WAIT_BAR(3);} else if((tt)+2<NT){WAIT_BAR(2);} else {WAIT_BAR(0);} }while(0)
  for(;t+1<NT;t+=2){
    STEP(pB0,pB1,pA0,pA1,t,(t+3<NT),(t+1<NT),(t+1<NT));       ENDW(t);   RESC(); ROT();
    STEP(pA0,pA1,pB0,pB1,t+1,(t+4<NT),(t+2<NT),(t+2<NT));     ENDW(t+1); RESC(); ROT();
  }
  STEP(pB0,pB1,pA0,pA1,NT-1,false,false,false); RESC();
  { float sacc=pB0[0]+pB0[1]; _Pragma("unroll") for(int r=2;r<16;++r)sacc+=pB0[r]; _Pragma("unroll") for(int r=0;r<16;++r)sacc+=pB1[r]; l_reg+=sacc;
    pw0=(u32x4){PKW(pB0,0),PKW(pB0,2),PKW(pB0,4),PKW(pB0,6)};pw1=(u32x4){PKW(pB0,8),PKW(pB0,10),PKW(pB0,12),PKW(pB0,14)};pw2=(u32x4){PKW(pB1,0),PKW(pB1,2),PKW(pB1,4),PKW(pB1,6)};pw3=(u32x4){PKW(pB1,8),PKW(pB1,10),PKW(pB1,12),PKW(pB1,14)};
    SBAR(); pv(o,vb0+2*sl_cur,PAF(0),PAF(1),PAF(2),PAF(3)); }
  #undef PKW
  #undef PAF
  #undef VFR
  #undef PIN
  #undef MX3
  #undef GAPA
  #undef GAPB
  #undef EX
  #undef VRD
  #undef KRD
  #undef STEP
  #undef QF
  #undef ZC
  #undef ENDW
  {auto rr=__builtin_amdgcn_permlane32_swap(__float_as_uint(l_reg),__float_as_uint(l_reg),false,false);l_reg=__uint_as_float(rr[0])+__uint_as_float(rr[1]);}
  if(hi==0)wsf[32+r32]=l_reg;asm volatile("s_waitcnt lgkmcnt(0)":::"memory");
  float rli[16];
  #pragma unroll
  for(int r=0;r<16;++r)rli[r]=__builtin_amdgcn_rcpf(wsf[32+crow(r,hi)]);
  bf16*Ow=O+(rowbase+q0+wid*QBLK)*OP+ocol;
  { bf16*stg=(bf16*)(shm+LDS_OST)+wid*2048;
    #pragma unroll
    for(int h2=0;h2<2;++h2){
    #pragma unroll
    for(int r=0;r<16;++r){const int orow=crow(r,hi);
      #pragma unroll
      for(int d0=0;d0<2;++d0)stg[orow*64+d0*32+r32]=__float2bfloat16(o[2*h2+d0][r]*rli[r]);}
    asm volatile("s_waitcnt lgkmcnt(0)":::"memory");
    #pragma unroll
    for(int i=0;i<4;++i){const int row=i*8+(lane>>3),ch=lane&7; const u32x4 v=*(const u32x4*)(stg+row*64+ch*8); ATTN_STORE16(Ow+(long)row*OP+h2*64+ch*8,v);}
    asm volatile("s_waitcnt lgkmcnt(0)":::"memory"); } }
  asm volatile("s_waitcnt lgkmcnt(0)\n\ts_barrier":::"memory");
  #undef DMA_K
  #undef TOFF
  #undef DMA_V
  #undef CMASK
  #undef START
  #undef RESC
  #undef ROT
}
constexpr int ATTN_LDS_BYTES=LDS_BYTES;
struct AttnTensors { const bf16* Q; const bf16* K; const bf16* V; bf16* O; };
struct AttnUnit { int bh; int qb; };
struct StaticOrder {
  int vcu;
  __device__ __forceinline__ explicit StaticOrder(int grid,int block):vcu((block%8)*(grid/8)+block/8){}
  __device__ __forceinline__ bool next(int i,AttnUnit&u)const{ if(i>=4)return false; const int p=vcu&7; u.bh=(vcu>>3)*2+(i>>1); u.qb=(i&1)?15-p:p; return true; }
  __device__ __forceinline__ void a_ready(const AttnUnit&)const{}
  __device__ __forceinline__ void done(const AttnUnit&)const{}
};
template<class Sched,bool FR,int THRL=8> __device__ __forceinline__ void attn_phase(char*lds,const AttnTensors&T,const Sched&S){
  AttnUnit u;
  for(int i=0;S.next(i,u);++i){ S.a_ready(u); attn_unit<THRL,FR>(u.bh/NHC,u.bh%NHC,u.qb,T.Q,T.K,T.V,T.O,lds); S.done(u); }
}
#undef SBAR
#undef WAIT_BAR
}

#define GAS __attribute__((address_space(1)))
#define LAS __attribute__((address_space(3)))
typedef unsigned v4u __attribute__((ext_vector_type(4)));
typedef GAS unsigned gu32;
typedef GAS unsigned long long gu64;
#define RLX_AGENT __ATOMIC_RELAXED, __HIP_MEMORY_SCOPE_AGENT
#define LDS_WAIT() asm volatile("s_waitcnt lgkmcnt(0)" ::: "memory")
#define VM_WAIT() asm volatile("s_waitcnt vmcnt(0)" ::: "memory")
__device__ __forceinline__ unsigned pk2(float lo, float hi) { return f2bf(lo) | (f2bf(hi) << 16); }

#define XB_TMO      128
#define XB_XCNT(j)  (256  + 64 * (j))
#define XB_XSUB(j)  (1280 + 64 * (j))
#define XB_XGEN(j)  (2304 + 64 * (j))
#define XB_TOP      3328
#define XB_TOPGEN   3392
#define XCD_BAR_WORDS 3456
#define XB_SPIN_CAP (1u << 18)

__device__ __forceinline__ unsigned xb_ld(unsigned* p)              { return __hip_atomic_load(p, __ATOMIC_RELAXED, __HIP_MEMORY_SCOPE_AGENT); }
__device__ __forceinline__ unsigned xb_add(unsigned* p, unsigned v) { return __hip_atomic_fetch_add(p, v, __ATOMIC_RELAXED, __HIP_MEMORY_SCOPE_AGENT); }
__device__ __forceinline__ unsigned xb_xcc_id() { return (unsigned)__builtin_amdgcn_s_getreg((3 << 11) | 20) & 0xFu; }
#define XB_SPIN(cond, bar) do { unsigned _sp = 0; while (cond) { __builtin_amdgcn_s_sleep(1); \
    if ((++_sp & 255u) == 0u) { if (xb_ld(&(bar)[XB_TMO])) break; if (_sp > XB_SPIN_CAP) { atomicAdd(&(bar)[XB_TMO], 1u); break; } } } } while (0)

struct XcdBarrier {
    unsigned* bar; unsigned x;
    volatile LAS unsigned* st;
};

__device__ __forceinline__ XcdBarrier xcd_barrier_post(unsigned* bar, volatile LAS unsigned* st) {
    XcdBarrier b; b.bar = bar; b.x = xb_xcc_id(); b.st = st;
    if (threadIdx.x == 0) (void)xb_add(&bar[XB_XCNT(b.x)], 1u);
    return b;
}
__device__ __forceinline__ void xcd_barrier_complete(unsigned* bar, unsigned x, unsigned& nloc, unsigned& nx) {
    const unsigned G = gridDim.x * gridDim.y * gridDim.z;
    unsigned sum, cnt, mine, sp = 0u;
    for (;;) {
        sum = 0u; cnt = 0u; mine = 0u;
#pragma unroll
        for (unsigned j = 0; j < 16; ++j) { const unsigned c = xb_ld(&bar[XB_XCNT(j)]); sum += c; cnt += (c > 0u) ? 1u : 0u; mine = (j == x) ? c : mine; }
        if (sum == G) break;
        __builtin_amdgcn_s_sleep(1);
        if ((++sp & 255u) == 0u) { if (xb_ld(&bar[XB_TMO])) break; if (sp > XB_SPIN_CAP) { atomicAdd(&bar[XB_TMO], 1u); break; } }
    }
    nloc = mine > 0u ? mine : 1u; nx = cnt > 0u ? cnt : 1u;
}

__device__ __forceinline__ void xcd_barrier(const XcdBarrier& b) {
    asm volatile("s_waitcnt vmcnt(0)" ::: "memory");
    __syncthreads();
    if (threadIdx.x == 0) {
        unsigned* bar = b.bar;
        __builtin_amdgcn_s_waitcnt(0);
        unsigned nloc = b.st[0], nx = b.st[1];
        if (nloc == 0u) { xcd_barrier_complete(bar, b.x, nloc, nx); b.st[0] = nloc; b.st[1] = nx; }
        const unsigned old = xb_add(&bar[XB_XSUB(b.x)], 1u);
        const unsigned gen = old / nloc;
        if (old + 1u == (gen + 1u) * nloc) {
            __builtin_amdgcn_fence(__ATOMIC_RELEASE, "agent");
            asm volatile("s_waitcnt vmcnt(0)" ::: "memory");
            const unsigned og = xb_add(&bar[XB_TOP], 1u);
            const unsigned tg = og / nx;
            if (og + 1u == (tg + 1u) * nx) xb_add(&bar[XB_TOPGEN], 1u);
            else XB_SPIN(xb_ld(&bar[XB_TOPGEN]) == tg, bar);
            __builtin_amdgcn_fence(__ATOMIC_ACQUIRE, "agent");
            xb_add(&bar[XB_XGEN(b.x)], 1u);
            asm volatile("s_waitcnt vmcnt(0)" ::: "memory");
        } else {
            XB_SPIN(xb_ld(&bar[XB_XGEN(b.x)]) == gen, bar);
            __builtin_amdgcn_fence(__ATOMIC_ACQUIRE, "agent");
            asm volatile("s_waitcnt vmcnt(0)" ::: "memory");
        }
    }
    __syncthreads();
}

constexpr int NWAVES = 8;
constexpr int RING_OFF = 0, RING_BYTES = 131072;
constexpr int LDSCTL_OFF = RING_BYTES, MISC_OFF = LDSCTL_OFF + 320;
constexpr int LDS_BYTES = 147456;

constexpr int CW_XCC = 8192;
constexpr int CW_PANEL = 8448;
__device__ __forceinline__ void panel_sync(gu32* ctl, unsigned* tmo, int seam, int pm, bool same_xcc) {
    asm volatile("s_waitcnt vmcnt(0)" ::: "memory");
    __syncthreads();
    if (threadIdx.x == 0) {
        gu32* c = ctl + CW_PANEL + (seam * 64 + pm) * 16;
        if (!same_xcc) { __builtin_amdgcn_fence(__ATOMIC_RELEASE, "agent"); asm volatile("s_waitcnt vmcnt(0)" ::: "memory"); }
        __hip_atomic_fetch_add(c, 1u, __ATOMIC_RELAXED, __HIP_MEMORY_SCOPE_AGENT);
        unsigned sp = 0;
        while (__hip_atomic_load(c, __ATOMIC_RELAXED, __HIP_MEMORY_SCOPE_AGENT) < 4u) { __builtin_amdgcn_s_sleep(1);
            if ((++sp & 255u) == 0u) { if (xb_ld(tmo)) break; if (sp > XB_SPIN_CAP) { atomicAdd(tmo, 1u); break; } } }
        __builtin_amdgcn_fence(__ATOMIC_ACQUIRE, "agent");
        asm volatile("s_waitcnt vmcnt(0)" ::: "memory");
    }
    __syncthreads();
}
constexpr int CW_BAR = 4096;

struct Frame {
    LAS unsigned char* lds;
    volatile LAS unsigned* MISC;
    gu32* ctl;
    int tid, lane, wave, vcu, G;
    const float* in[19]; float* out; unsigned char* ws;
};
struct WDesc { const float* W; const float* gain; bf16* WT; int ldn, c0, K, ncols, roff, mode; };
__device__ __forceinline__ WDesc wdesc(const Frame& F, int i) {
    unsigned char* ws = F.ws; WDesc d;
    switch (i) {
    case 0:  d = WDesc{F.in[2], F.in[1], (bf16*)(ws + WS_WIN), GIN, 0, D, 3072, 0, 0}; break;
    case 1:  d = WDesc{F.in[6], nullptr, (bf16*)(ws + WS_WAO), D, 0, D, D, 0, 0}; break;
    case 2:  d = WDesc{F.in[17], F.in[16], (bf16*)(ws + WS_W1A), FF, 0, D, FF, 0, 0}; break;
    case 3:  d = WDesc{F.in[18], nullptr, (bf16*)(ws + WS_W2A), D, 0, FF, D, 0, 0}; break;
    case 4:  d = WDesc{F.in[8], F.in[7], (bf16*)(ws + WS_WKVQ), 2048, 0, D, 2048, 0, 1}; break;
    case 5:  d = WDesc{F.in[11], F.in[10], (bf16*)(ws + WS_WKVQ), D, 0, D, D, 2048, 1}; break;
    case 6:  d = WDesc{F.in[15], nullptr, (bf16*)(ws + WS_WBO), D, 0, D, D, 0, 0}; break;
    case 7:  d = WDesc{F.in[17] + (size_t)D * FF, F.in[16] + D, (bf16*)(ws + WS_W1B), FF, 0, D, FF, 0, 0}; break;
    default: d = WDesc{F.in[18] + (size_t)D * FF, nullptr, (bf16*)(ws + WS_W2B), D, 0, FF, D, 0, 0}; break;
    }
    return d;
}
__device__ __forceinline__ void p0_transpose_item(const WDesc& d, LAS float* scr, int item, int lane) {
    const int nblk = d.ncols / 64, kb = item / nblk, nb = item % nblk, k0 = 64 * kb, n0 = 64 * nb;
    const int kq = lane >> 4, n4 = (lane & 15) * 4;
    f32x4 v[16];
#pragma unroll
    for (int i = 0; i < 16; ++i) v[i] = __builtin_nontemporal_load((const GAS f32x4*)(d.W + (size_t)(k0 + 4 * i + kq) * d.ldn + d.c0 + n0 + n4));
    const int c = lane & 7;
    f32x4 g0 = (f32x4){1.f, 1.f, 1.f, 1.f}, g1 = g0;
    if (d.gain) { g0 = *(const GAS f32x4*)(d.gain + k0 + 8 * c); g1 = *(const GAS f32x4*)(d.gain + k0 + 8 * c + 4); }
#pragma unroll
    for (int i = 0; i < 16; ++i) { const int kk = 4 * i + kq; *(LAS f32x4*)(scr + kk * 64 + (n4 ^ (kk & 0x38))) = v[i]; }
    LDS_WAIT(); asm volatile("" ::: "memory");
#pragma unroll
    for (int jj = 0; jj < 8; ++jj) { const int n = (lane >> 3) + 8 * jj; const LAS float* sp = scr + (8 * c) * 64 + (n ^ (c << 3));
        const int dr = d.mode ? kvq_dest_row(d.roff + n0 + n) : d.roff + n0 + n;
        v4u o; o.x = pk2(sp[0 * 64] * g0[0], sp[1 * 64] * g0[1]); o.y = pk2(sp[2 * 64] * g0[2], sp[3 * 64] * g0[3]); o.z = pk2(sp[4 * 64] * g1[0], sp[5 * 64] * g1[1]); o.w = pk2(sp[6 * 64] * g1[2], sp[7 * 64] * g1[3]);
        pg8::store16_wt((void*)(d.WT + (size_t)dr * d.K + k0 + 8 * c), o); }
    LDS_WAIT(); asm volatile("" ::: "memory");
}
__device__ __forceinline__ float wave_max_abs(float v) {
    v = fabsf(v);
#pragma unroll
    for (int o = 1; o < 64; o <<= 1) v = fmaxf(v, __shfl_xor(v, o));
    return __builtin_bit_cast(float, __builtin_amdgcn_readfirstlane(__builtin_bit_cast(int, v)));
}
__device__ __forceinline__ float wave_sum(float v) {
#pragma unroll
    for (int o = 1; o < 64; o <<= 1) v += __shfl_xor(v, o);
    return v;
}
template <int NR> __device__ __forceinline__ void rows_to_bf16(const Frame& F, const float* xrow, bf16* orow, float* ssrow) {
    f32x4 v[NR][4];
#pragma unroll
    for (int r = 0; r < NR; ++r)
#pragma unroll
        for (int j = 0; j < 4; ++j) v[r][j] = __builtin_nontemporal_load(((const GAS f32x4*)(xrow + (size_t)r * D) + F.lane) + 64 * j);
#pragma unroll
    for (int r = 0; r < NR; ++r) { float s = 0.f;
#pragma unroll
        for (int j = 0; j < 4; ++j) s += (v[r][j].x * v[r][j].x + v[r][j].y * v[r][j].y) + (v[r][j].z * v[r][j].z + v[r][j].w * v[r][j].w);
        s = wave_sum(s);
        if (F.lane < 16) ssrow[(size_t)r * 16 + F.lane] = (F.lane == 0) ? s : 0.f;
        GAS unsigned long long* o8 = (GAS unsigned long long*)(orow + (size_t)r * D) + F.lane;
#pragma unroll
        for (int j = 0; j < 4; ++j) o8[64 * j] = (unsigned long long)pk2(v[r][j].x, v[r][j].y) | ((unsigned long long)pk2(v[r][j].z, v[r][j].w) << 32); }
}
__device__ __forceinline__ void p0_prologue(Frame& F) {
    LAS float* scr = (LAS float*)(F.lds + RING_OFF + F.wave * 16384);
    const int gw = F.vcu * NWAVES + F.wave, NGW = F.G * NWAVES;
    int base = 0;
    for (int mi = 0; mi < 9; ++mi) {
        const WDesc d = wdesc(F, mi); const int nit = (d.K / 64) * (d.ncols / 64);
        int it = gw - (base % NGW); if (it < 0) it += NGW;
        for (; it < nit; it += NGW) p0_transpose_item(d, scr, it, F.lane);
        base += nit;
    }
    { const float* W = F.in[2]; const float* g = F.in[1]; bf16* Wz = (bf16*)(F.ws + WS_WZ);
      for (int idx = gw * 64 + F.lane; idx < 16 * D; idx += NGW * 64) { const int k = idx >> 4, r = idx & 15; Wz[(size_t)r * D + k] = (bf16)f2bf(W[(size_t)k * GIN + 3072 + r] * g[k]); } }
    bf16* XB = (bf16*)(F.ws + WS_A); float* SS = (float*)(F.ws + WS_SS);
    for (int m = 4 * gw; m < T; m += 4 * NGW) rows_to_bf16<4>(F, F.in[0] + (size_t)m * D, XB + (size_t)m * D, SS + (size_t)m * 16);
}


__device__ __forceinline__ void combine_local(Frame& F) {
    int lane; asm volatile("v_mbcnt_lo_u32_b32 %0, -1, 0\n\tv_mbcnt_hi_u32_b32 %0, -1, %0" : "=v"(lane));
    const int wave = F.wave;
    const float* lp = F.in[13]; const float* hg = F.in[14];
    const float s1 = wave_sum(lp[lane] * lp[64 + lane]), s2 = wave_sum(lp[128 + lane] * lp[192 + lane]);
    const float lam = __expf(s1) - __expf(s2) + LAMBDA_INIT;
    const int bhh = F.vcu >> 3, p = F.vcu & 7, b = bhh >> 3, h = bhh & 7, sg = lane & 7;
    float g[16];
#pragma unroll
    for (int j = 0; j < 16; ++j) g[j] = hg[16 * sg + j] * (1.f - LAMBDA_INIT);
    const bf16* O32 = (const bf16*)F.out; bf16* OD = (bf16*)(F.ws + WS_C);
    asm volatile("s_waitcnt vmcnt(0)" ::: "memory"); __syncthreads();
    for (int it0 = 0; it0 < 8; it0 += 4) {
        bf16x8 a0[4], a1[4], b0[4], b1[4]; size_t tt[4];
#pragma unroll
        for (int q = 0; q < 4; ++q) { const int r = (it0 + q) * 64 + wave * 8 + (lane >> 3);
            tt[q] = (size_t)b * SEQ + (size_t)((r < 256) ? p : 15 - p) * 256 + (r & 255);
            const bf16* p0 = O32 + tt[q] * 2048 + (2 * h) * 128 + 16 * sg;
            a0[q] = *(const bf16x8*)p0; a1[q] = *(const bf16x8*)(p0 + 8); b0[q] = *(const bf16x8*)(p0 + 128); b1[q] = *(const bf16x8*)(p0 + 136); }
#pragma unroll
        for (int q = 0; q < 4; ++q) {
            float o[16]; float s = 0.f;
#pragma unroll
            for (int j = 0; j < 8; ++j) { o[j] = bf2f((unsigned short)a0[q][j]) - lam * bf2f((unsigned short)b0[q][j]); o[8 + j] = bf2f((unsigned short)a1[q][j]) - lam * bf2f((unsigned short)b1[q][j]); }
#pragma unroll
            for (int j = 0; j < 16; ++j) s += o[j] * o[j];
            s += __shfl_xor(s, 1); s += __shfl_xor(s, 2); s += __shfl_xor(s, 4);
            const float rstd = __builtin_amdgcn_rsqf(s * (1.f / 128.f) + EPS);
            v4u w0, w1;
            w0.x = pk2(o[0] * rstd * g[0], o[1] * rstd * g[1]); w0.y = pk2(o[2] * rstd * g[2], o[3] * rstd * g[3]); w0.z = pk2(o[4] * rstd * g[4], o[5] * rstd * g[5]); w0.w = pk2(o[6] * rstd * g[6], o[7] * rstd * g[7]);
            w1.x = pk2(o[8] * rstd * g[8], o[9] * rstd * g[9]); w1.y = pk2(o[10] * rstd * g[10], o[11] * rstd * g[11]); w1.z = pk2(o[12] * rstd * g[12], o[13] * rstd * g[13]); w1.w = pk2(o[14] * rstd * g[14], o[15] * rstd * g[15]);
            bf16* qd = OD + tt[q] * 1024 + h * 128 + 16 * sg;
            *(v4u*)qd = w0; *(v4u*)(qd + 8) = w1; }
    }
}
constexpr int RT_OFF = 132096;
__device__ __forceinline__ unsigned off_b(unsigned row, unsigned ch) { return 256u * row + 16u * (ch ^ (((row & 3) << 2) | ((row >> 2) & 3))); }
__device__ __forceinline__ unsigned row_addr16(unsigned lane, unsigned rb, unsigned s) { return off_b((lane & 15) + 16 * rb, 4 * s + (lane >> 4)); }
__device__ __forceinline__ unsigned tr_addr16(unsigned lane, unsigned c, unsigned ks, unsigned t) { const unsigned g = lane >> 4, q = (lane & 15) >> 2, p = lane & 3; return off_b(32 * ks + 8 * g + 4 * t + q, 2 * c + (p >> 1)) + 8 * (p & 1); }
typedef short v4i16_t __attribute__((ext_vector_type(4)));
__device__ __forceinline__ bf16x8 tr_frag(LAS unsigned char* img, unsigned lane, unsigned c, unsigned ks) {
    const v4i16_t lo = __builtin_amdgcn_ds_read_tr16_b64_v4i16((LAS v4i16_t*)(img + tr_addr16(lane, c, ks, 0)));
    const v4i16_t hi = __builtin_amdgcn_ds_read_tr16_b64_v4i16((LAS v4i16_t*)(img + tr_addr16(lane, c, ks, 1)));
    return (bf16x8){lo[0], lo[1], lo[2], lo[3], hi[0], hi[1], hi[2], hi[3]};
}
__device__ __forceinline__ bf16x8 row_frag(LAS unsigned char* img, unsigned lane, unsigned rb, unsigned s) { return *(const LAS bf16x8*)(img + row_addr16(lane, rb, s)); }
#define MFMA16(a, b, c) __builtin_amdgcn_mfma_f32_16x16x32_bf16(a, b, c, 0, 0, 0)

constexpr int ZP_OFF = 137216;
__device__ __forceinline__ void gate_phase(Frame& F) {
    LAS float* ZP = (LAS float*)(F.lds + ZP_OFF);
    const bf16* XB = (const bf16*)(F.ws + WS_A); const bf16* Wz = (const bf16*)(F.ws + WS_WZ); const float* wgu = F.in[3]; const float* bg = F.in[4]; unsigned char* SL = F.ws + WS_B;
    const float* SS = (const float*)(F.ws + WS_SS);
    const int lane = F.lane, wave = F.wave, fr = lane & 15, fq = lane >> 4;
    LAS float* ST = (LAS float*)(F.lds + wave * 16384);
    float wb[4][4], bb[4];
#pragma unroll
    for (int nt = 0; nt < 4; ++nt) { bb[nt] = bg[64 * wave + 16 * nt + fr];
#pragma unroll
        for (int kk = 0; kk < 4; ++kk) wb[nt][kk] = wgu[(4 * kk + fq) * 512 + 64 * wave + 16 * nt + fr]; }
    for (int u = F.vcu; u < T / CH; u += F.G) {
        const size_t t0 = (size_t)u * CH;
        { const int mt = wave & 3, kh = wave >> 2; f32x4 acc = (f32x4){0.f, 0.f, 0.f, 0.f};
          const bf16* ap = XB + (t0 + mt * 16 + fr) * D + kh * 512 + 8 * fq; const bf16* bp = Wz + (size_t)fr * D + kh * 512 + 8 * fq;
#pragma unroll
          for (int ks = 0; ks < 16; ++ks) acc = MFMA16(__builtin_nontemporal_load((const bf16x8*)(ap + ks * 32)), *(const bf16x8*)(bp + ks * 32), acc);
#pragma unroll
          for (int j = 0; j < 4; ++j) ZP[(kh * 64 + mt * 16 + 4 * fq + j) * 17 + fr] = acc[j] * pg8::row_rstd(SS, (int)t0 + mt * 16 + 4 * fq + j); }
        __syncthreads();
        float carry[4] = {0.f, 0.f, 0.f, 0.f};
#pragma unroll 1
        for (int mt = 0; mt < 4; ++mt) {
            float za[4];
#pragma unroll
            for (int kk = 0; kk < 4; ++kk) za[kk] = ZP[(mt * 16 + fr) * 17 + 4 * kk + fq] + ZP[(64 + mt * 16 + fr) * 17 + 4 * kk + fq];
#pragma unroll
            for (int nt = 0; nt < 4; ++nt) {
                f32x4 x = (f32x4){bb[nt], bb[nt], bb[nt], bb[nt]};
#pragma unroll
                for (int kk = 0; kk < 4; ++kk) x = __builtin_amdgcn_mfma_f32_16x16x4f32(za[kk], wb[nt][kk], x, 0, 0, 0);
                float p[4]; float run = 0.f;
#pragma unroll
                for (int r = 0; r < 4; ++r) { const float ls = fminf(x[r], 0.f) - __logf(1.f + __expf(-fabsf(x[r]))); run += ls * (1.f / 16.f); p[r] = run; }
                float s1 = run; { const float t = __shfl_up(s1, 16); if (fq >= 1) s1 += t; }
                float s2 = s1;  { const float t = __shfl_up(s2, 32); if (fq >= 2) s2 += t; }
                const float base = carry[nt] + (s2 - run);
                carry[nt] += __shfl(s2, 48 + fr);
#pragma unroll
                for (int r = 0; r < 4; ++r) { const int row = mt * 16 + 4 * fq + r; ST[row * 64 + ((16 * nt + fr) ^ (((row >> 2) & 3) << 4))] = base + p[r]; }
            }
        }
        LDS_WAIT(); asm volatile("" ::: "memory");
#pragma unroll
        for (int i = 0; i < 16; ++i) { const int row = 4 * i + fq; const f32x4 v = *(const LAS f32x4*)(ST + row * 64 + ((4 * fr) ^ (((row >> 2) & 3) << 4)));
            *(f32x4*)((float*)(SL + (size_t)(u >> 2) * PSLOT + PBC) + ((u & 3) * 64 + row) * 512 + 64 * wave + 4 * fr) = v; }
        __syncthreads();
    }
}

struct GlaSet { unsigned k0, k1, k2, k3; f32x4 bca, bcb, bla, blb; v4u va, vb; float dca, dcb; };
__device__ __forceinline__ void gla_state_phase(Frame& F) {
    LAS unsigned char* lds = F.lds;
    bf16* SP = (bf16*)F.out;
    const int tid = F.tid, lane = F.lane, wave = F.wave;
    const int pos = tid >> 3, sub = tid & 7, mt = wave >> 1, nt = wave & 1;
    constexpr int NP = NCH / 2;
    for (int u = F.vcu; u < 256; u += F.G) {
        const int bh = u >> 4, ki = (u >> 2) & 3, vi = u & 3, b = bh >> 2, h = bh & 3;
        const unsigned char* SL = F.ws + WS_B + (size_t)(16 * b) * PSLOT;
        const int koff = pos * 512 + h * GDK + ki * 32 + sub * 4, loff = 63 * 512 + h * GDK + ki * 32 + sub * 4;
        const int voff = pos * 1024 + h * GDV + vi * 64 + sub * 8, doff = 63 * 512 + h * GDK + ki * 32 + nt * 16 + (lane & 15);
        bf16* spp = SP + ((size_t)(bh * NP) * GDV + vi * 64 + mt * 16 + 4 * (lane >> 4)) * GDK + ki * 32 + nt * 16 + (lane & 15);
        const unsigned kw = off_b(pos, sub >> 1) + 8 * (sub & 1), vw = off_b(pos, sub);
        f32x4 acc = (f32x4){0.f, 0.f, 0.f, 0.f};
#define GLA_LOAD(S, m) do { const unsigned char* sl_ = SL + (size_t)((m) >> 1) * PSLOT; const int r_ = ((m) & 1) * 128; \
        const bf16* kp_ = (const bf16*)(sl_ + PK) + r_ * 512 + koff; const float* bp_ = (const float*)(sl_ + PBC) + r_ * 512; const bf16* vp_ = (const bf16*)(sl_ + PV) + r_ * 1024 + voff; \
        { const unsigned long long ka_ = *(const unsigned long long*)kp_, kb_ = *(const unsigned long long*)(kp_ + 64 * 512); S.k0 = (unsigned)ka_; S.k1 = (unsigned)(ka_ >> 32); S.k2 = (unsigned)kb_; S.k3 = (unsigned)(kb_ >> 32); } \
        S.bca = *(const f32x4*)(bp_ + koff); S.bcb = *(const f32x4*)(bp_ + koff + 64 * 512); S.bla = *(const f32x4*)(bp_ + loff); S.blb = *(const f32x4*)(bp_ + loff + 64 * 512); \
        S.va = *(const v4u*)vp_; S.vb = *(const v4u*)(vp_ + 64 * 1024); S.dca = bp_[doff]; S.dcb = bp_[doff + 64 * 512]; } while (0)
#define GLA_STEP(S, m, buf) do { \
        { const f32x4 ea = S.bla + S.blb - S.bca, eb = S.blb - S.bcb;                                    \
          const unsigned w0 = pk2(bf2f(S.k0 & 0xffffu) * __expf(ea[0]), bf2f(S.k0 >> 16) * __expf(ea[1])), w1 = pk2(bf2f(S.k1 & 0xffffu) * __expf(ea[2]), bf2f(S.k1 >> 16) * __expf(ea[3])); \
          const unsigned w2 = pk2(bf2f(S.k2 & 0xffffu) * __expf(eb[0]), bf2f(S.k2 >> 16) * __expf(eb[1])), w3 = pk2(bf2f(S.k3 & 0xffffu) * __expf(eb[2]), bf2f(S.k3 >> 16) * __expf(eb[3])); \
          *(LAS unsigned long long*)(lds + (buf) * 65536 + kw) = (unsigned long long)w0 | ((unsigned long long)w1 << 32); \
          *(LAS unsigned long long*)(lds + (buf) * 65536 + 16384 + kw) = (unsigned long long)w2 | ((unsigned long long)w3 << 32); \
          *(LAS v4u*)(lds + (buf) * 65536 + 32768 + vw) = S.va; *(LAS v4u*)(lds + (buf) * 65536 + 49152 + vw) = S.vb; } \
        const float dec_ = __expf(S.dca + S.dcb); \
        if ((m) + 2 < NP) GLA_LOAD(S, (m) + 2); \
        __syncthreads(); \
        _Pragma("unroll") for (int j = 0; j < 4; ++j) __builtin_nontemporal_store((bf16)f2bf(acc[j]), spp + (size_t)(m) * GDV * GDK + j * GDK); \
        acc = acc * dec_; \
        _Pragma("unroll") for (int ks = 0; ks < 4; ++ks) acc = MFMA16(tr_frag(lds + (buf) * 65536 + 32768, lane, mt, ks), tr_frag(lds + (buf) * 65536, lane, nt, ks), acc); } while (0)
        GlaSet s0, s1;
        GLA_LOAD(s0, 0); GLA_LOAD(s1, 1);
        for (int m = 0; m < NP; m += 2) { GLA_STEP(s0, m, 0); GLA_STEP(s1, m + 1, 1); }
#undef GLA_LOAD
#undef GLA_STEP
        __syncthreads();
    }
}

struct GlaRaw { bf16x8 q[4], k[4]; f32x4 b0[4], b1[4], l0, l1; };
__device__ __forceinline__ void gla_out_phase(Frame& F) {
    LAS unsigned char* lds = F.lds;
    LAS unsigned char *QI = lds, *AI = lds + 16384, *KI = lds + 32768, *VI = lds + 65536, *OL = lds;
    LAS float* RED = (LAS float*)(lds + RT_OFF); LAS float* RS = RED + 512;
    const int pm = 8 * ((int)blockIdx.x & 7) + (((int)blockIdx.x >> 3) & 7), hq = ((int)blockIdx.x >> 6) & 3;
    const unsigned char* SL = F.ws + WS_B + (size_t)pm * PSLOT;
    const bf16* QG = (const bf16*)(SL + PQ); const bf16* KG = (const bf16*)(SL + PK); const bf16* VG = (const bf16*)(SL + PV); const bf16* GGp = (const bf16*)(SL + PG);
    const float* BC = (const float*)(SL + PBC); const bf16* SP = (const bf16*)F.out; bf16* OG = (bf16*)(F.ws + WS_C) + (size_t)pm * 256 * 1024; const float* hg = F.in[5];
    const int tid = F.tid, lane = F.lane, wave = F.wave, fr = lane & 15, fq = lane >> 4;
    const float g0 = hg[32 * wave + fr], g1 = hg[32 * wave + 16 + fr];
    constexpr int NU = 2;
#define GLA_T0(u) ((size_t)(u) * (2 * CH))
#define GLA_H(u) (hq)
#define GLA_LOADRAW(R, u) do { const size_t t0_ = GLA_T0(u); const int h_ = GLA_H(u); \
        _Pragma("unroll") for (int r = 0; r < 4; ++r) { const int n = tid + 512 * r, pos = n >> 4, ch = n & 15; const size_t e = (t0_ + pos) * 512 + h_ * GDK + ch * 8; \
            R.q[r] = __builtin_nontemporal_load((const bf16x8*)(QG + e)); R.k[r] = __builtin_nontemporal_load((const bf16x8*)(KG + e)); \
            R.b0[r] = __builtin_nontemporal_load((const f32x4*)(BC + e)); R.b1[r] = __builtin_nontemporal_load((const f32x4*)(BC + e + 4)); } \
        { const size_t e = (t0_ + 63) * 512 + h_ * GDK + (tid & 15) * 8; R.l0 = *(const f32x4*)(BC + e); R.l1 = *(const f32x4*)(BC + e + 4); } } while (0)
#define GLA_LOADSF(u) do { const bf16* sp = SP + ((size_t)((((pm >> 4) * 4 + hq) * 32) + 2 * (pm & 15) + (u)) * GDV + 32 * wave + fr) * GDK + 8 * fq; \
        _Pragma("unroll") for (int nt = 0; nt < 2; ++nt) _Pragma("unroll") for (int ks = 0; ks < 4; ++ks) sf[nt][ks] = __builtin_nontemporal_load((const bf16x8*)(sp + nt * 16 * GDK + ks * 32)); } while (0)
    int u = 0;
    bf16x8 sf[2][4];
    GLA_LOADSF(u);
    for (;;) {
        const size_t t0 = GLA_T0(u); const int h = GLA_H(u); const int un = u + 1; const bool has_next = un < NU;
        GlaRaw R; GLA_LOADRAW(R, u);
        v4u vv[8];
#pragma unroll
        for (int r = 0; r < 8; ++r) { const int n = tid + 512 * r, pos = n >> 5, c32 = n & 31; vv[r] = __builtin_nontemporal_load((const v4u*)(VG + (t0 + pos) * 1024 + h * GDV + c32 * 8)); }
        v4u wq1[2];
#pragma unroll
        for (int r = 0; r < 4; ++r) { const int n = tid + 512 * r, pos = n >> 4, ch = n & 15;
            float qq[8], kk[8];
#pragma unroll
            for (int j = 0; j < 8; ++j) { float bj = j < 4 ? R.b0[r][j & 3] : R.b1[r][j & 3]; if (r >= 2) bj += j < 4 ? R.l0[j & 3] : R.l1[j & 3]; const float ex = __expf(bj);
                qq[j] = bf2f((unsigned short)R.q[r][j]) * ex * 0.08838834764831845f; kk[j] = bf2f((unsigned short)R.k[r][j]) * __builtin_amdgcn_rcpf(ex); }
            v4u wqr; wqr.x = pk2(qq[0], qq[1]); wqr.y = pk2(qq[2], qq[3]); wqr.z = pk2(qq[4], qq[5]); wqr.w = pk2(qq[6], qq[7]);
            if (r < 2) *(LAS v4u*)(QI + off_b(pos, ch)) = wqr; else wq1[r - 2] = wqr;
            v4u wk; wk.x = pk2(kk[0], kk[1]); wk.y = pk2(kk[2], kk[3]); wk.z = pk2(kk[4], kk[5]); wk.w = pk2(kk[6], kk[7]);
            *(LAS v4u*)(KI + (pos >> 6) * 16384 + off_b(pos & 63, ch)) = wk; }
        {
#pragma unroll
          for (int r = 0; r < 8; ++r) { const int n = tid + 512 * r, pos = n >> 5, c32 = n & 31; *(LAS v4u*)(VI + ((pos >> 6) * 2 + (c32 >> 4)) * 16384 + off_b(pos & 63, c32 & 15)) = vv[r]; } }
#pragma unroll 1
        for (int hf = 0; hf < 2; ++hf) {
            if (hf) {
#pragma unroll
                for (int r = 0; r < 2; ++r) { const int n = tid + 512 * r, pos = n >> 4, ch = n & 15; *(LAS v4u*)(QI + off_b(pos, ch)) = wq1[r]; } }
            __syncthreads();
            { const int mt = wave >> 1;
#pragma unroll
              for (int q = 0; q < (hf ? 4 : 2); ++q) { const int nt = (hf ? 4 : 2) * (wave & 1) + q; f32x4 a4 = (f32x4){0.f, 0.f, 0.f, 0.f};
                  const bool diag = hf ? (nt >= 4) : true; const int ntl = (hf && nt >= 4) ? nt - 4 : nt;
                  if (!diag || ntl <= mt) { LAS unsigned char* kimg = KI + ((hf && nt >= 4) ? 16384 : 0);
#pragma unroll
                      for (int ks = 0; ks < 4; ++ks) a4 = MFMA16(row_frag(QI, lane, mt, ks), row_frag(kimg, lane, ntl, ks), a4); }
#pragma unroll
                  for (int r = 0; r < 4; ++r) { const int ii = mt * 16 + 4 * fq + r, jl = ntl * 16 + fr, jj = nt * 16 + fr; const float val = (!diag || jl <= ii) ? a4[r] : 0.f;
                      *(LAS unsigned short*)(AI + off_b(ii, jj >> 3) + 2 * (jj & 7)) = (unsigned short)f2bf(val); } } }
            __syncthreads();
            f32x4 o[4][2];
#pragma unroll
            for (int m = 0; m < 4; ++m) { o[m][0] = (f32x4){0.f, 0.f, 0.f, 0.f}; o[m][1] = (f32x4){0.f, 0.f, 0.f, 0.f}; }
#pragma unroll
            for (int ks = 0; ks < (hf ? 4 : 2); ++ks) { bf16x8 bfr[2];
#pragma unroll
                for (int nt = 0; nt < 2; ++nt) { const int dv = 32 * wave + 16 * nt; bfr[nt] = tr_frag(VI + ((ks >> 1) * 2 + (dv >> 7)) * 16384, lane, (dv & 127) >> 4, ks & 1); }
#pragma unroll
                for (int m = 0; m < 4; ++m) { const bf16x8 a = row_frag(AI, lane, m, ks); o[m][0] = MFMA16(a, bfr[0], o[m][0]); o[m][1] = MFMA16(a, bfr[1], o[m][1]); } }
#pragma unroll
            for (int ks = 0; ks < 4; ++ks)
#pragma unroll
                for (int m = 0; m < 4; ++m) { const bf16x8 a = row_frag(QI, lane, m, ks); o[m][0] = MFMA16(a, sf[0][ks], o[m][0]); o[m][1] = MFMA16(a, sf[1][ks], o[m][1]); }
            bf16x8 gv[4];
#pragma unroll
            for (int r = 0; r < 4; ++r) { const int n = tid + 512 * r, pos = n >> 5, c32 = n & 31; gv[r] = __builtin_nontemporal_load((const bf16x8*)(GGp + (t0 + 64 * hf + pos) * 1024 + h * GDV + c32 * 8)); }
            if (hf && has_next) GLA_LOADSF(un);
#pragma unroll
            for (int m = 0; m < 4; ++m)
#pragma unroll
                for (int r = 0; r < 4; ++r) { float s = o[m][0][r] * o[m][0][r] + o[m][1][r] * o[m][1][r];
                    s += __shfl_xor(s, 1); s += __shfl_xor(s, 2); s += __shfl_xor(s, 4); s += __shfl_xor(s, 8);
                    if (fr == 0) RED[wave * 64 + m * 16 + 4 * fq + r] = s; }
            __syncthreads();
            if (tid < 64) { float tot = 0.f;
#pragma unroll
                for (int w = 0; w < 8; ++w) tot += RED[w * 64 + tid];
                RS[tid] = __builtin_amdgcn_rsqf(tot * (1.f / GDV) + EPS); }
            __syncthreads();
#pragma unroll
            for (int m = 0; m < 4; ++m) { const f32x4 rs4 = *(const LAS f32x4*)(RS + m * 16 + 4 * fq);
#pragma unroll
                for (int r = 0; r < 4; ++r) { LAS unsigned char* rowp = OL + (m * 16 + 4 * fq + r) * 512 + (32 * wave + fr) * 2;
                    *(LAS unsigned short*)rowp = (unsigned short)f2bf(o[m][0][r] * rs4[r] * g0); *(LAS unsigned short*)(rowp + 32) = (unsigned short)f2bf(o[m][1][r] * rs4[r] * g1); } }
            __syncthreads();
#pragma unroll
            for (int r = 0; r < 4; ++r) { const int n = tid + 512 * r, pos = n >> 5, c32 = n & 31;
                const bf16x8 ov = *(const LAS bf16x8*)(OL + pos * 512 + c32 * 16); const size_t e = (t0 + 64 * hf + pos) * 1024 + h * GDV + c32 * 8;
                v4u w; w.x = pk2(bf2f((unsigned short)ov[0]) * bf2f((unsigned short)gv[r][0]), bf2f((unsigned short)ov[1]) * bf2f((unsigned short)gv[r][1]));
                w.y = pk2(bf2f((unsigned short)ov[2]) * bf2f((unsigned short)gv[r][2]), bf2f((unsigned short)ov[3]) * bf2f((unsigned short)gv[r][3]));
                w.z = pk2(bf2f((unsigned short)ov[4]) * bf2f((unsigned short)gv[r][4]), bf2f((unsigned short)ov[5]) * bf2f((unsigned short)gv[r][5]));
                w.w = pk2(bf2f((unsigned short)ov[6]) * bf2f((unsigned short)gv[r][6]), bf2f((unsigned short)ov[7]) * bf2f((unsigned short)gv[r][7]));
                *(v4u*)(OG + e) = w; }
            __syncthreads();
        }
        if (!has_next) break;
        u = un;
    }
#undef GLA_T0
#undef GLA_H
#undef GLA_LOADRAW
#undef GLA_LOADSF
}
__device__ __forceinline__ void fill_rstd_table(Frame& F, const pg8::StaticOrder& S, const float* ss) {
    LAS float* RT = (LAS float*)(F.lds + RT_OFF); pg8::Unit u;
    for (int i = 0; i < 4 && S.next(i, u); ++i) if (F.tid < 256) RT[i * 256 + F.tid] = pg8::row_rstd(ss, u.pm * 256 + F.tid);
    __syncthreads();
}

struct Args { const float* in[19]; float* out; unsigned char* ws; int ph_lo, ph_hi, li, pad; };
__global__ void __launch_bounds__(NWAVES * 64, 2) mega(Args args) {
    extern __shared__ __attribute__((aligned(16))) unsigned char lds[];
    Frame F;
    F.lds = (LAS unsigned char*)lds;
    F.MISC = (volatile LAS unsigned*)(F.lds + MISC_OFF);
    F.tid = threadIdx.x; F.lane = F.tid & 63; F.wave = __builtin_amdgcn_readfirstlane(F.tid >> 6);
    F.G = gridDim.x; { const int bx = blockIdx.x; F.vcu = (F.G % 8 == 0) ? (bx % 8) * (F.G / 8) + bx / 8 : bx; }
#pragma unroll
    for (int i = 0; i < 19; ++i) F.in[i] = args.in[i];
    F.out = args.out; F.ws = args.ws; F.ctl = (gu32*)(args.ws + WS_CTL);
    unsigned char* ws = args.ws;
    for (int u = F.tid; u < (LDS_BYTES - LDSCTL_OFF) / 4; u += NWAVES * 64) ((LAS unsigned*)(F.lds + LDSCTL_OFF))[u] = 0u;
    __syncthreads();
    const int lo = args.ph_lo, hi = args.ph_hi;
    XcdBarrier bar; bar.bar = (unsigned*)(F.ctl + CW_BAR) + args.li * XCD_BAR_WORDS; bar.x = 0; bar.st = nullptr;
    if (hi - lo > 1) bar = xcd_barrier_post((unsigned*)(F.ctl + CW_BAR) + args.li * XCD_BAR_WORDS, F.MISC + 8);
    if (F.tid == 0) __hip_atomic_store(F.ctl + CW_XCC + blockIdx.x, xb_xcc_id() + 1u, RLX_AGENT);
    const int pm_own = 8 * ((int)blockIdx.x & 7) + (((int)blockIdx.x >> 3) & 7);
    bool grp_same = false;
#define IN(k) (lo <= (k) && (k) < hi)
#define SEAM(k) do { if (IN(k) && IN((k) + ((k) == 8 ? 2 : 1))) xcd_barrier(bar); } while (0)
#define PSEAM(k, s) do { if (IN(k) && IN((k) + 1)) panel_sync(F.ctl, bar.bar + XB_TMO, (s), pm_own, grp_same); } while (0)
    bf16 *Win = (bf16*)(ws + WS_WIN), *Wao = (bf16*)(ws + WS_WAO), *W1a = (bf16*)(ws + WS_W1A), *W2a = (bf16*)(ws + WS_W2A);
    bf16 *Wkvq = (bf16*)(ws + WS_WKVQ), *Wbo = (bf16*)(ws + WS_WBO), *W1b = (bf16*)(ws + WS_W1B), *W2b = (bf16*)(ws + WS_W2B);
    float* SS = (float*)(ws + WS_SS);
    bf16 *RA = (bf16*)(ws + WS_A), *RC = (bf16*)(ws + WS_C), *HM = (bf16*)(ws + WS_HM);

    if (IN(0)) { p0_prologue(F); SEAM(0); }
    if (hi - lo > 1) {
        const int b0 = ((int)blockIdx.x & 7) + 8 * (((int)blockIdx.x >> 3) & 7); unsigned x0 = 0, same = 1;
        for (int q = 0; q < 4; ++q) { const unsigned xq = __hip_atomic_load(F.ctl + CW_XCC + b0 + 64 * q, RLX_AGENT); if (q == 0) x0 = xq; same &= (xq == x0 && xq != 0u) ? 1u : 0u; }
        grp_same = __builtin_amdgcn_readfirstlane(same) != 0;
    }
    if (IN(1)) {
        pg8::Gemm g{RA, Win, T, 3072, D}; pg8::StaticOrder S; S.init(T, 3072, F.G, (int)blockIdx.x);
        fill_rstd_table(F, S, SS);
        pg8::EpiInProj E{ws + WS_B, (const LAS float*)(F.lds + RT_OFF), 0};
        pg8::gemm_phase<pg8::EpiInProj, pg8::StaticOrder, PG8_ALIGN, PG8_SP2>(F.lds + RING_OFF, g, S, E);
        gate_phase(F);
        SEAM(1);
    }
    if (IN(2)) { gla_state_phase(F); SEAM(2); }
    if (IN(3)) { gla_out_phase(F); PSEAM(3, 4); }
    if (IN(4)) {
        pg8::Gemm g{RC, Wao, T, D, D}; pg8::StaticOrder S; S.init(T, D, F.G, (int)blockIdx.x);
        pg8::EpiResB<1> E{nullptr, RA, RA, nullptr, SS};
        pg8::gemm_phase<pg8::EpiResB<1>, pg8::StaticOrder, PG8_ALIGN, PG8_SP2>(F.lds + RING_OFF, g, S, E);
        PSEAM(4, 0);
    }
    if (IN(5)) {
        pg8::Gemm g{RA, W1a, T, FF, D}; pg8::StaticOrder S; S.init(T, FF, F.G, (int)blockIdx.x);
        fill_rstd_table(F, S, SS);
        pg8::EpiUp E{HM, (const LAS float*)(F.lds + RT_OFF), 0};
        pg8::gemm_phase<pg8::EpiUp, pg8::StaticOrder, PG8_ALIGN, PG8_SP2>(F.lds + RING_OFF, g, S, E);
        PSEAM(5, 1);
    }
    if (IN(6)) {
        pg8::Gemm g{HM, W2a, T, D, FF}; pg8::StaticOrder S; S.init(T, D, F.G, (int)blockIdx.x);
        pg8::EpiResB<1> E{nullptr, RA, RA, nullptr, SS};
        pg8::gemm_phase<pg8::EpiResB<1>, pg8::StaticOrder, PG8_ALIGN, PG8_SP2>(F.lds + RING_OFF, g, S, E);
        PSEAM(6, 5);
    }
    if (IN(7)) {
        pg8::Gemm g{RA, Wkvq, T, 3072, D}; pg8::StaticOrder S; S.init(T, 3072, F.G, (int)blockIdx.x);
        if (F.tid < 128) ((LAS float*)(F.lds + RT_OFF + 4096))[F.tid] = (F.tid < 64) ? F.in[9][F.tid] : F.in[12][F.tid - 64];
        fill_rstd_table(F, S, SS);
        pg8::EpiKVQ E{ws + WS_B, (const LAS float*)(F.lds + RT_OFF), (const LAS float*)(F.lds + RT_OFF + 4096), (const LAS float*)(F.lds + RT_OFF + 4096 + 256), 0};
        pg8::gemm_phase<pg8::EpiKVQ, pg8::StaticOrder, PG8_ALIGN, PG8_SP2>(F.lds + RING_OFF, g, S, E);
        SEAM(7);
    }
    if (IN(8)) {
        const attn_body::AttnTensors AT{(const attn_body::bf16*)(ws + WS_B + 1024 * 1024), (const attn_body::bf16*)(ws + WS_B), (const attn_body::bf16*)(ws + WS_B + 512 * 1024), (attn_body::bf16*)F.out};
        const attn_body::StaticOrder S((int)F.G, (int)blockIdx.x);
        float gmq = 0.f, gmk = 0.f;
        for (int i = 0; i < 64; ++i) { gmq = fmaxf(gmq, fabsf(F.in[12][i])); gmk = fmaxf(gmk, fabsf(F.in[9][i])); }
        const bool fast = __builtin_amdgcn_readfirstlane((int)(11.7f * gmq * gmk <= 100.f)) != 0;
        if (__builtin_expect(fast, 1)) attn_body::attn_phase<attn_body::StaticOrder, true>((char*)lds + RING_OFF, AT, S);
        else attn_body::attn_phase<attn_body::StaticOrder, false, 0>((char*)lds + RING_OFF, AT, S);
        combine_local(F);
        SEAM(8);
    }
    if (IN(10)) {
        pg8::Gemm g{RC, Wbo, T, D, D}; pg8::StaticOrder S; S.init(T, D, F.G, (int)blockIdx.x);
        pg8::EpiResB<1> E{nullptr, RA, RA, nullptr, SS};
        pg8::gemm_phase<pg8::EpiResB<1>, pg8::StaticOrder, PG8_ALIGN, PG8_SP2>(F.lds + RING_OFF, g, S, E);
        PSEAM(10, 2);
    }
    if (IN(11)) {
        pg8::Gemm g{RA, W1b, T, FF, D}; pg8::StaticOrder S; S.init(T, FF, F.G, (int)blockIdx.x);
        fill_rstd_table(F, S, SS);
        pg8::EpiUp E{HM, (const LAS float*)(F.lds + RT_OFF), 0};
        pg8::gemm_phase<pg8::EpiUp, pg8::StaticOrder, PG8_ALIGN, PG8_SP2>(F.lds + RING_OFF, g, S, E);
        PSEAM(11, 3);
    }
    if (IN(12)) {
        pg8::Gemm g{HM, W2b, T, D, FF}; pg8::StaticOrder S; S.init(T, D, F.G, (int)blockIdx.x);
        pg8::EpiResB<2> E{nullptr, RA, nullptr, F.out, nullptr};
        pg8::gemm_phase<pg8::EpiResB<2>, pg8::StaticOrder, PG8_ALIGN, PG8_SP2>(F.lds + RING_OFF, g, S, E);
    }
#undef IN
#undef SEAM
}

extern "C" void kernel_launch(void* const* d_in, const int* in_sizes, int n_in, void* d_out, int out_size, void* d_ws, size_t ws_size, hipStream_t stream) {
    static int grid = 0;
    if (grid == 0) {
        if (n_in != 19 || out_size != T * D || ws_size < WS_END) { fprintf(stderr, "kernel_launch: unexpected shapes (n_in %d out %d ws %zu)\n", n_in, out_size, ws_size); grid = -1; return; }
        int dev = 0, cus = 0, per_cu = 0;
        if (hipGetDevice(&dev) != hipSuccess || hipDeviceGetAttribute(&cus, hipDeviceAttributeMultiprocessorCount, dev) != hipSuccess) { grid = -1; return; }
        if (hipFuncSetAttribute((const void*)mega, hipFuncAttributeMaxDynamicSharedMemorySize, LDS_BYTES) != hipSuccess) { fprintf(stderr, "kernel_launch: hipFuncSetAttribute failed\n"); grid = -1; return; }
        if (hipOccupancyMaxActiveBlocksPerMultiprocessor(&per_cu, (const void*)mega, NWAVES * 64, LDS_BYTES) != hipSuccess || per_cu < 1) { fprintf(stderr, "kernel_launch: occupancy query says %d blocks per CU\n", per_cu); grid = -1; (void)hipGetLastError(); return; }
        if (cus < 256) { fprintf(stderr, "kernel_launch: built for the 256 CUs of an MI355X (one resident workgroup per CU), found %d\n", cus); grid = -1; return; }
        grid = 256;
    }
    if (grid < 0) return;
    unsigned char* ws = (unsigned char*)d_ws;
    (void)hipMemsetAsync(ws + WS_CTL, 0, 128 * 1024, stream);
    Args a{};
    for (int i = 0; i < 19; ++i) a.in[i] = (const float*)d_in[i];
    a.out = (float*)d_out; a.ws = ws;
    int li = 0;
    auto run = [&](int lo, int hi) { a.ph_lo = lo; a.ph_hi = hi; a.li = li++; hipLaunchKernelGGL(mega, dim3(grid), dim3(NWAVES * 64), LDS_BYTES, stream, a); };
    run(0, 13);
}
```
